# Optimizing an MI355X kernel written in HIP

```python
import jax, jax.numpy as jnp
from jax import lax
import numpy as np

D_MODEL = 1024
BATCH = 16
SEQ = 4096
DEPTH = 1

CONV_WIDTH = 512
CONV_K = 3
N_HEADS = 8
HEAD_DIM = 64
ATTN_WIDTH = N_HEADS * HEAD_DIM
IDX_HEADS = 8
IDX_DIM = 64
TOPK_ATTN = 256
Q_BLOCK = 128
PEER_HEADS = 8
PEER_N_KEYS = 128
PEER_N_EXPERTS = PEER_N_KEYS * PEER_N_KEYS
PEER_KEY_DIM = 128
PEER_HALF = PEER_KEY_DIM // 2
PEER_TOPK = 16
PEER_CHUNK = 128
N_MOD = 6
EPS = 1e-6

kernel_name = 'hybrid_conv_dsa_peer_block'


def _in_proj_sizes():
    return [CONV_WIDTH, CONV_WIDTH, CONV_WIDTH,
            ATTN_WIDTH, ATTN_WIDTH, ATTN_WIDTH,
            IDX_HEADS * IDX_DIM, IDX_DIM, IDX_HEADS,
            D_MODEL, D_MODEL]


def rms_norm(x, w):
    xf = x.astype(jnp.float32)
    y = xf * lax.rsqrt(jnp.mean(xf * xf, axis=-1, keepdims=True) + EPS)
    return (y * w.astype(jnp.float32)).astype(x.dtype)


def causal_dwconv(u, w):
    s = u.shape[1]
    pad = jnp.pad(u, ((0, 0), (CONV_K - 1, 0), (0, 0)))
    out = w[0] * pad[:, 0:s]
    for j in range(1, CONV_K):
        out = out + w[j] * pad[:, j:j + s]
    return out


def dsa_attention(q, k, v, q_idx, k_idx, w_idx):
    b, s = q.shape[0], q.shape[1]
    n_sel = min(TOPK_ATTN, s // 4)
    n_blk = s // Q_BLOCK
    key_pos = jnp.arange(s)
    k_idx_f = k_idx.astype(jnp.float32)
    gather = jax.vmap(lambda t, i: t[i])

    def to_blocks(t):
        return jnp.swapaxes(t.reshape(b, n_blk, Q_BLOCK, *t.shape[2:]), 0, 1)

    def block_fn(args):
        blk, qb, qib, wb = args
        q_pos = blk * Q_BLOCK + jnp.arange(Q_BLOCK)
        logits = jnp.einsum('bqhd,bsd->bqhs', qib.astype(jnp.float32), k_idx_f)
        score = jnp.einsum('bqhs,bqh->bqs', jax.nn.relu(logits), wb.astype(jnp.float32))
        causal = key_pos[None, :] <= q_pos[:, None]
        score = jnp.where(causal[None], score, -jnp.inf)
        _, sel = lax.top_k(score, n_sel)
        ks = gather(k, sel)
        vs = gather(v, sel)
        att = jnp.einsum('bqhd,bqkhd->bqhk', qb, ks).astype(jnp.float32) * (HEAD_DIM ** -0.5)
        valid = sel <= q_pos[None, :, None]
        att = jnp.where(valid[:, :, None, :], att, -jnp.inf)
        p = jax.nn.softmax(att, axis=-1).astype(vs.dtype)
        return jnp.einsum('bqhk,bqkhd->bqhd', p, vs)

    out = lax.map(block_fn, (jnp.arange(n_blk), to_blocks(q), to_blocks(q_idx), to_blocks(w_idx)))
    return jnp.swapaxes(out, 0, 1).reshape(b, s, N_HEADS * HEAD_DIM)


def peer_ffn(h, w_q, sub_keys, u, v):
    b, s, d = h.shape
    tok = h.reshape(-1, PEER_CHUNK, d)

    def chunk_fn(xc):
        q = (xc @ w_q).reshape(-1, PEER_HEADS, 2, PEER_HALF)
        s1 = jnp.einsum('chd,hnd->chn', q[:, :, 0], sub_keys[:, 0]).astype(jnp.float32)
        s2 = jnp.einsum('chd,hnd->chn', q[:, :, 1], sub_keys[:, 1]).astype(jnp.float32)
        v1, i1 = lax.top_k(s1, PEER_TOPK)
        v2, i2 = lax.top_k(s2, PEER_TOPK)
        cand = (v1[..., :, None] + v2[..., None, :]).reshape(v1.shape[0], PEER_HEADS, PEER_TOPK * PEER_TOPK)
        sc, ci = lax.top_k(cand, PEER_TOPK)
        e1 = jnp.take_along_axis(i1, ci // PEER_TOPK, axis=-1)
        e2 = jnp.take_along_axis(i2, ci % PEER_TOPK, axis=-1)
        expert = e1 * PEER_N_KEYS + e2
        g = jax.nn.softmax(sc, axis=-1)
        ue = u[expert]
        ve = v[expert]
        act = jax.nn.gelu(jnp.einsum('chkd,cd->chk', ue, xc).astype(jnp.float32), approximate=False)
        return jnp.einsum('chk,chkd->cd', (g * act).astype(ve.dtype), ve)

    return lax.map(chunk_fn, tok).reshape(b, s, d)


def setup_inputs(seed: int = 0) -> dict:
    key = jax.random.key(seed)
    ks = jax.random.split(key, 20)
    f32 = jnp.float32
    d = D_MODEL
    n_in = sum(_in_proj_sizes())
    nrm = lambda k, shape, scale: jax.random.normal(k, shape, f32) * scale
    return {
        'x': nrm(ks[0], (BATCH, SEQ, d), 1.0),
        'c': nrm(ks[1], (BATCH, d), 1.0),
        'w_ada': nrm(ks[2], (DEPTH, d, N_MOD * d), 0.5 * d ** -0.5),
        'b_ada': nrm(ks[3], (DEPTH, N_MOD * d), 0.01),
        'norm1_w': 1.0 + nrm(ks[4], (DEPTH, d), 0.02),
        'w_in': nrm(ks[5], (DEPTH, d, n_in), d ** -0.5),
        'conv_w': nrm(ks[6], (DEPTH, CONV_K, CONV_WIDTH), CONV_K ** -0.5),
        'w_conv_out': nrm(ks[7], (DEPTH, CONV_WIDTH, d), CONV_WIDTH ** -0.5),
        'q_norm_w': 1.0 + nrm(ks[8], (DEPTH, HEAD_DIM), 0.02),
        'k_norm_w': 1.0 + nrm(ks[9], (DEPTH, HEAD_DIM), 0.02),
        'w_attn_out': nrm(ks[10], (DEPTH, ATTN_WIDTH, d), ATTN_WIDTH ** -0.5),
        'w_o': nrm(ks[11], (DEPTH, d, d), d ** -0.5),
        'norm2_w': 1.0 + nrm(ks[12], (DEPTH, d), 0.02),
        'w_peer_q': nrm(ks[13], (DEPTH, d, PEER_HEADS * PEER_KEY_DIM), d ** -0.5),
        'peer_sub_keys': nrm(ks[14], (DEPTH, PEER_HEADS, 2, PEER_N_KEYS, PEER_HALF), PEER_HALF ** -0.5),
        'peer_u': nrm(ks[15], (DEPTH, PEER_N_EXPERTS, d), d ** -0.5),
        'peer_v': nrm(ks[16], (DEPTH, PEER_N_EXPERTS, d), 1.0),
    }


def reference(x, c, w_ada, b_ada, norm1_w, w_in, conv_w, w_conv_out, q_norm_w, k_norm_w,
              w_attn_out, w_o, norm2_w, w_peer_q, peer_sub_keys, peer_u, peer_v):
    b, s, _ = x.shape
    offsets = [int(o) for o in np.cumsum(_in_proj_sizes())[:-1]]
    for layer in range(DEPTH):
        mod = jax.nn.silu(c) @ w_ada[layer] + b_ada[layer]
        sh1, sc1, g1, sh2, sc2, g2 = jnp.split(mod[:, None, :], N_MOD, axis=-1)

        h = rms_norm(x, norm1_w[layer]) * (1.0 + sc1) + sh1
        proj = h @ w_in[layer]
        (cb, cc, cx, q, k, v, qi, ki, wi, gate_conv, gate_attn) = jnp.split(proj, offsets, axis=-1)

        y_conv = (cb * causal_dwconv(cc * cx, conv_w[layer])) @ w_conv_out[layer]

        q = rms_norm(q.reshape(b, s, N_HEADS, HEAD_DIM), q_norm_w[layer])
        k = rms_norm(k.reshape(b, s, N_HEADS, HEAD_DIM), k_norm_w[layer])
        v = v.reshape(b, s, N_HEADS, HEAD_DIM)
        qi = qi.reshape(b, s, IDX_HEADS, IDX_DIM)
        y_attn = dsa_attention(q, k, v, qi, ki, wi) @ w_attn_out[layer]

        mix = jax.nn.sigmoid(gate_conv) * y_conv + jax.nn.sigmoid(gate_attn) * y_attn
        x = x + g1 * (mix @ w_o[layer])

        h2 = rms_norm(x, norm2_w[layer]) * (1.0 + sc2) + sh2
        x = x + g2 * peer_ffn(h2, w_peer_q[layer], peer_sub_keys[layer], peer_u[layer], peer_v[layer])
    return x
```

```cpp
#include <hip/hip_runtime.h>
#include <hip/hip_cooperative_groups.h>
#include <cstdio>
#include <cstdint>
namespace cg = cooperative_groups;

#define LAS __attribute__((address_space(3)))
typedef unsigned short bf16;
typedef short bf16x8 __attribute__((ext_vector_type(8)));
typedef short s16x4 __attribute__((ext_vector_type(4)));
typedef float f32x2 __attribute__((ext_vector_type(2)));
typedef float f32x4 __attribute__((ext_vector_type(4)));
typedef float f32x16 __attribute__((ext_vector_type(16)));
typedef unsigned u32x2 __attribute__((ext_vector_type(2)));
typedef unsigned u32x4 __attribute__((ext_vector_type(4)));
typedef __bf16 bf16x2_t __attribute__((ext_vector_type(2)));

__device__ __forceinline__ unsigned pk2(float lo, float hi) { f32x2 v = {lo, hi}; bf16x2_t b = __builtin_convertvector(v, bf16x2_t); return __builtin_bit_cast(unsigned, b); }
__device__ __forceinline__ float bflo(unsigned u) { return __uint_as_float(u << 16); }
__device__ __forceinline__ float bfhi(unsigned u) { return __uint_as_float(u & 0xffff0000u); }
__device__ __forceinline__ float wave_sum(float v) {
#pragma unroll
    for (int o = 1; o < 64; o <<= 1) v += __shfl_xor(v, o);
    return v;
}
__device__ __forceinline__ unsigned ordf(float f) { unsigned u = __float_as_uint(f); return u ^ ((u & 0x80000000u) ? 0xffffffffu : 0x80000000u); }
__device__ __forceinline__ float unordf(unsigned u) { return __uint_as_float((u & 0x80000000u) ? (u ^ 0x80000000u) : ~u); }
#define LDS_WAIT() asm volatile("s_waitcnt lgkmcnt(0)" ::: "memory")

constexpr int NB = 16, SEQ = 4096, DM = 1024, T = NB * SEQ;
constexpr int NIN_PAD = 5888;
constexpr float EPS = 1e-6f;
constexpr float C2 = 0.125f * 1.4426950408889634f;
constexpr int NWAVES = 8;

constexpr size_t MiB = 1u << 20;
constexpr size_t WS_MOD = 1 * MiB;
constexpr size_t WS_WIN = 2 * MiB;
constexpr size_t WS_WCO = 14 * MiB;
constexpr size_t WS_WAO = 15 * MiB;
constexpr size_t WS_WO = 16 * MiB;
constexpr size_t WS_WPQ = 18 * MiB;
constexpr size_t WS_SK = 20 * MiB;
constexpr size_t WS_PU = 32 * MiB;
constexpr size_t WS_PV = 64 * MiB;
constexpr size_t WS_H = 96 * MiB;
constexpr size_t WS_CB = 224 * MiB;
constexpr size_t WS_CC = 288 * MiB;
constexpr size_t WS_CX = 352 * MiB;
constexpr size_t WS_Q = 416 * MiB;
constexpr size_t WS_K = 480 * MiB;
constexpr size_t WS_V = 544 * MiB;
constexpr size_t WS_QI = 608 * MiB;
constexpr size_t WS_GC = 672 * MiB;
constexpr size_t WS_GA = 800 * MiB;
constexpr size_t WS_KI = 928 * MiB;
constexpr size_t WS_WI = 936 * MiB;
constexpr size_t WS_MASK = 938 * MiB;
constexpr size_t WS_END = 970 * MiB;
constexpr size_t WS_PQ = WS_CC;
constexpr size_t WS_EIDX = WS_K;
constexpr size_t WS_EG = WS_K + 16 * MiB;

constexpr int LDS_BYTES = 147456;

namespace pg8 {
constexpr int BM = 256, BK = 64, HALF = 128, HTB = HALF * BK * 2, STAGE_BYTES = 8 * HTB, NXCD = 8, WGM = 8;
__host__ __device__ __forceinline__ int lds_byte(int r, int c) { const int st = (r >> 4) * 2 + (c >> 5), rr = r & 15, cc = c & 31, ob = rr * 64 + cc * 2; return st * 1024 + (ob ^ (((ob >> 9) & 1) << 5)); }
__host__ __device__ __forceinline__ void stage_rc(int b, int& R, int& C) { const int st = b / 1024, sb = b % 1024, swz = sb ^ (((sb >> 9) & 1) << 5); R = (st >> 1) * 16 + swz / 64; C = (st & 1) * 32 + (swz % 64) / 2; }
__host__ __device__ __forceinline__ int perm32(int rho) { const int n = rho >> 4, i = rho & 15; return 8 * (i >> 2) + 4 * n + (i & 3); }
struct Unit { int pm, pn; };
struct Gemm { const bf16* A; const bf16* Bt; int M, N, K; };
struct StaticOrder {
    int nM, nN, nwg, G, c;
    __device__ void init(int M, int N, int G_, int c_) { nM = M / BM; nN = N / BM; nwg = nM * nN; G = G_; c = c_; }
    __device__ bool next(int i, Unit& u) const {
        const long L = (long)i * G + c; if (L >= nwg) return false;
        int wgid = (int)L; { const int q = nwg / NXCD, r = nwg % NXCD, xcd = wgid % NXCD, off = wgid / NXCD; wgid = (xcd < r ? xcd * (q + 1) : r * (q + 1) + (xcd - r) * q) + off; }
        const int nig = WGM * nN, gid = wgid / nig, fm = gid * WGM, gsz = (nM - fm) < WGM ? (nM - fm) : WGM;
        u.pm = fm + ((wgid % nig) % gsz); u.pn = (wgid % nig) / gsz; return true;
    }
};

template <class Epi, bool ALIGN_EPI, bool SP2>
__device__ __forceinline__ void gemm_phase(LAS unsigned char* lds, const Gemm g, const StaticOrder& S, const Epi& E) {
    const int tid = threadIdx.x, wid = __builtin_amdgcn_readfirstlane(tid >> 6), lane = tid & 63, wr = wid >> 2, wc = wid & 3, fr = lane & 15, fq = lane >> 4;
    const int K = g.K, nt = K / BK;
    unsigned voffA[2], voffB[2];
#pragma unroll
    for (int i = 0; i < 2; ++i) { int R, C; stage_rc(tid * 16 + i * 8192, R, C); const int Rb = Epi::PERM ? ((R & ~31) + perm32(R & 31)) : R;
        voffA[i] = (unsigned)(R * K + C) * 2u; voffB[i] = (unsigned)(Rb * K + C) * 2u; }
    const size_t kstep = (size_t)(BK * 2);
    const size_t hstep = (size_t)HALF * K * 2;
    const size_t tstep = 2 * hstep;
    const unsigned ldsw = (unsigned)wid * 1024u;
    const int aoff = lds_byte(wr * 64 + fr, fq * 8), boff = lds_byte(wc * 32 + fr, fq * 8);
#define PG8_SA(b, h) (((b) * 2 + (h)) * HTB)
#define PG8_SB(b, h) ((4 + (b) * 2 + (h)) * HTB)
#define PG8_STAGE(bufoff, gbase, voff) do { _Pragma("unroll") for (int _i = 0; _i < 2; ++_i) \
        __builtin_amdgcn_global_load_lds((const unsigned*)((const char*)(gbase) + (voff)[_i]), (LAS unsigned*)(lds + (bufoff) + ldsw + _i * 8192), 16, 0, 0); } while (0)
#define PG8_LDA(dst, b, h) do { _Pragma("unroll") for (int m = 0; m < 4; ++m) _Pragma("unroll") for (int k = 0; k < 2; ++k) dst[m][k] = *(const LAS bf16x8*)(lds + PG8_SA(b, h) + aoff + m * 2048 + k * 1024); } while (0)
#define PG8_LDB(dst, b, h) do { _Pragma("unroll") for (int n = 0; n < 2; ++n) _Pragma("unroll") for (int k = 0; k < 2; ++k) dst[n][k] = *(const LAS bf16x8*)(lds + PG8_SB(b, h) + boff + n * 2048 + k * 1024); } while (0)
#define PG8_MMA(ai, bj, At, Bt) do { __builtin_amdgcn_s_setprio(1); _Pragma("unroll") for (int m = 0; m < 4; ++m) _Pragma("unroll") for (int n = 0; n < 2; ++n) _Pragma("unroll") for (int k = 0; k < 2; ++k) \
        acc[ai][bj][m][n] = __builtin_amdgcn_mfma_f32_16x16x32_bf16(Bt[n][k], At[m][k], acc[ai][bj][m][n], 0, 0, 0); __builtin_amdgcn_s_setprio(0); } while (0)
#define PG8_WAIT_V(n) asm volatile("s_waitcnt vmcnt(" #n ")" ::: "memory")
#define PG8_WAIT_L(n) asm volatile("s_waitcnt lgkmcnt(" #n ")" ::: "memory")
#define PG8_BAR __builtin_amdgcn_s_barrier()
#define PG8_SCHED __builtin_amdgcn_sched_barrier(0)
    Unit cur, nxt; int ui = 0;
    if (!S.next(0, cur)) return;
    f32x4 acc[2][2][4][2];
#pragma unroll
    for (int a = 0; a < 2; ++a)
#pragma unroll
        for (int b = 0; b < 2; ++b)
#pragma unroll
            for (int m = 0; m < 4; ++m)
#pragma unroll
                for (int n = 0; n < 2; ++n) acc[a][b][m][n] = (f32x4){0.f, 0.f, 0.f, 0.f};
    bf16x8 At[4][2], B0[2][2], B1[2][2];
    const char* cA = (const char*)g.A + (size_t)cur.pm * tstep; const char* cB = (const char*)g.Bt + (size_t)cur.pn * tstep;
    if constexpr (SP2) {
        PG8_STAGE(PG8_SB(0, 0), cB, voffB); PG8_STAGE(PG8_SB(0, 1), cB + hstep, voffB); PG8_STAGE(PG8_SA(0, 0), cA, voffA); PG8_STAGE(PG8_SA(0, 1), cA + hstep, voffA);
        if (wr == 1) PG8_BAR;
        PG8_WAIT_V(2); PG8_BAR;
        PG8_STAGE(PG8_SB(1, 0), cB + kstep, voffB); PG8_STAGE(PG8_SA(1, 0), cA + kstep, voffA); PG8_STAGE(PG8_SB(1, 1), cB + hstep + kstep, voffB);
        PG8_WAIT_V(6); PG8_BAR;
    } else {
        PG8_STAGE(PG8_SB(0, 0), cB, voffB); PG8_STAGE(PG8_SA(0, 0), cA, voffA); PG8_STAGE(PG8_SB(0, 1), cB + hstep, voffB); PG8_STAGE(PG8_SA(0, 1), cA + hstep, voffA);
        if (wr == 1) PG8_BAR;
        PG8_WAIT_V(4); PG8_BAR;
        PG8_STAGE(PG8_SB(1, 0), cB + kstep, voffB); PG8_STAGE(PG8_SA(1, 0), cA + kstep, voffA); PG8_STAGE(PG8_SB(1, 1), cB + hstep + kstep, voffB);
        PG8_WAIT_V(6); PG8_BAR;
    }
    for (;;) {
        const bool has_next = S.next(ui + 1, nxt);
        const char* nA = has_next ? (const char*)g.A + (size_t)nxt.pm * tstep : cA; const char* nB = has_next ? (const char*)g.Bt + (size_t)nxt.pn * tstep : cB;
        for (int t = 0; t < nt; t += 2) {
            const bool last = (t == nt - 2);
            const char* a1 = cA + (size_t)(t + 1) * kstep;
            const char* a2 = last ? nA : cA + (size_t)(t + 2) * kstep; const char* b2 = last ? nB : cB + (size_t)(t + 2) * kstep;
            const char* a3 = a2 + kstep; const char* b3 = b2 + kstep;
            if constexpr (SP2) {
            PG8_LDB(B0, 0, 0); PG8_LDB(B1, 0, 1); PG8_SCHED; PG8_LDA(At, 0, 0); PG8_STAGE(PG8_SA(1, 1), a1 + hstep, voffA);
            PG8_WAIT_V(8); PG8_WAIT_L(0); PG8_BAR; PG8_MMA(0, 0, At, B0); PG8_MMA(0, 1, At, B1); PG8_BAR; PG8_SCHED;
            PG8_LDA(At, 0, 1); PG8_STAGE(PG8_SB(0, 0), b2, voffB); PG8_STAGE(PG8_SB(0, 1), b2 + hstep, voffB); PG8_STAGE(PG8_SA(0, 0), a2, voffA);
            PG8_WAIT_V(8); PG8_WAIT_L(0); PG8_BAR; PG8_MMA(1, 0, At, B0); PG8_MMA(1, 1, At, B1); PG8_BAR; PG8_SCHED;
            PG8_LDB(B0, 1, 0); PG8_LDB(B1, 1, 1); PG8_SCHED; PG8_LDA(At, 1, 0); PG8_STAGE(PG8_SA(0, 1), a2 + hstep, voffA);
            PG8_WAIT_V(8); PG8_WAIT_L(0); PG8_BAR; PG8_MMA(0, 0, At, B0); PG8_MMA(0, 1, At, B1); PG8_BAR; PG8_SCHED;
            PG8_LDA(At, 1, 1); PG8_STAGE(PG8_SB(1, 0), b3, voffB); PG8_STAGE(PG8_SB(1, 1), b3 + hstep, voffB); PG8_STAGE(PG8_SA(1, 0), a3, voffA);
            PG8_WAIT_V(8); PG8_WAIT_L(0); PG8_BAR; PG8_MMA(1, 0, At, B0); PG8_MMA(1, 1, At, B1); PG8_BAR; PG8_SCHED;
            } else {
            PG8_LDB(B0, 0, 0); PG8_SCHED; PG8_LDA(At, 0, 0); PG8_STAGE(PG8_SA(1, 1), a1 + hstep, voffA);
            PG8_WAIT_L(8); PG8_BAR; PG8_WAIT_L(0); PG8_MMA(0, 0, At, B0); PG8_BAR; PG8_SCHED;
            PG8_LDB(B1, 0, 1); PG8_STAGE(PG8_SB(0, 0), b2, voffB);
            PG8_BAR; PG8_WAIT_L(0); PG8_MMA(0, 1, At, B1); PG8_BAR;
            PG8_LDA(At, 0, 1); PG8_STAGE(PG8_SA(0, 0), a2, voffA);
            PG8_BAR; PG8_WAIT_L(0); PG8_MMA(1, 0, At, B0); PG8_BAR; PG8_SCHED;
            PG8_STAGE(PG8_SB(0, 1), b2 + hstep, voffB);
            PG8_WAIT_V(6); PG8_BAR; PG8_MMA(1, 1, At, B1); PG8_BAR;
            PG8_LDB(B0, 1, 0); PG8_SCHED; PG8_LDA(At, 1, 0); PG8_STAGE(PG8_SA(0, 1), a2 + hstep, voffA);
            PG8_WAIT_L(8); PG8_BAR; PG8_WAIT_L(0); PG8_MMA(0, 0, At, B0); PG8_BAR; PG8_SCHED;
            PG8_LDB(B1, 1, 1); PG8_STAGE(PG8_SB(1, 0), b3, voffB);
            PG8_BAR; PG8_WAIT_L(0); PG8_MMA(0, 1, At, B1); PG8_BAR;
            PG8_LDA(At, 1, 1); PG8_STAGE(PG8_SA(1, 0), a3, voffA);
            PG8_BAR; PG8_WAIT_L(0); PG8_MMA(1, 0, At, B0); PG8_BAR; PG8_SCHED;
            PG8_STAGE(PG8_SB(1, 1), b3 + hstep, voffB);
            PG8_WAIT_V(6); PG8_BAR; PG8_MMA(1, 1, At, B1); PG8_BAR;
            }
        }
        if constexpr (ALIGN_EPI) { if (wr == 0) PG8_BAR; }
        E(acc, cur, wr, wc, fr, fq);
        if (!has_next) break;
#pragma unroll
        for (int a = 0; a < 2; ++a)
#pragma unroll
            for (int b = 0; b < 2; ++b)
#pragma unroll
                for (int m = 0; m < 4; ++m)
#pragma unroll
                    for (int n = 0; n < 2; ++n) acc[a][b][m][n] = (f32x4){0.f, 0.f, 0.f, 0.f};
        cur = nxt; cA = nA; cB = nB; ++ui;
        if constexpr (ALIGN_EPI) { if (wr == 1) PG8_BAR; }
    }
    PG8_WAIT_V(0);
    if constexpr (!ALIGN_EPI) { if (wr == 0) PG8_BAR; }
    PG8_BAR;
#undef PG8_SA
#undef PG8_SB
#undef PG8_STAGE
#undef PG8_LDA
#undef PG8_LDB
#undef PG8_MMA
#undef PG8_WAIT_V
#undef PG8_WAIT_L
#undef PG8_BAR
#undef PG8_SCHED
}
}

typedef const f32x4 (&AccRef)[2][2][4][2];

__device__ __forceinline__ u32x4 pack8(f32x4 v0, f32x4 v1) { u32x4 w; w.x = pk2(v0[0], v0[1]); w.y = pk2(v0[2], v0[3]); w.z = pk2(v1[0], v1[1]); w.w = pk2(v1[2], v1[3]); return w; }
__device__ __forceinline__ float sigm(float x) { return __builtin_amdgcn_rcpf(1.f + __builtin_amdgcn_exp2f(-1.4426950408889634f * x)); }

struct EpiInProj {
    static constexpr bool PERM = true;
    bf16 *CB, *CC, *CX, *Q, *K, *V, *QI, *GC, *GA, *KI; float* WI; const float* qnw; const float* knw;
    __device__ __forceinline__ void operator()(AccRef acc, const pg8::Unit& u, int wr, int wc, int fr, int fq) const {
        const int pn = u.pn; const size_t row0 = (size_t)u.pm * 256 + wr * 64 + fr;
        if (pn < 6 || (pn >= 10 && pn < 14)) {
            bf16* base = pn < 2 ? CB : pn < 4 ? CC : pn < 6 ? CX : pn < 12 ? V : QI;
            const int col0 = (pn & 1) * 256 + wc * 32 + 8 * fq;
#pragma unroll
            for (int ai = 0; ai < 2; ++ai)
#pragma unroll
                for (int m = 0; m < 4; ++m) { bf16* rowp = base + (row0 + ai * 128 + m * 16) * 512 + col0;
#pragma unroll
                    for (int bj = 0; bj < 2; ++bj) *(u32x4*)(rowp + bj * 128) = pack8(acc[ai][bj][m][0], acc[ai][bj][m][1]); }
        } else if (pn < 10) {
            const bool isq = pn < 8; bf16* base = isq ? Q : K; const float* nw = isq ? qnw : knw; const float sc = isq ? C2 : 1.f;
            const int head = 4 * (pn & 1) + wc;
            f32x4 w[2][2];
#pragma unroll
            for (int bj = 0; bj < 2; ++bj)
#pragma unroll
                for (int n = 0; n < 2; ++n) w[bj][n] = *(const f32x4*)(nw + 32 * bj + 8 * fq + 4 * n) * sc;
#pragma unroll
            for (int ai = 0; ai < 2; ++ai)
#pragma unroll
                for (int m = 0; m < 4; ++m) {
                    float ss = 0.f;
#pragma unroll
                    for (int bj = 0; bj < 2; ++bj)
#pragma unroll
                        for (int n = 0; n < 2; ++n) { const f32x4 x = acc[ai][bj][m][n]; ss += (x[0] * x[0] + x[1] * x[1]) + (x[2] * x[2] + x[3] * x[3]); }
                    ss += __shfl_xor(ss, 16); ss += __shfl_xor(ss, 32);
                    const float r = __builtin_amdgcn_rsqf(ss * (1.f / 64.f) + EPS);
                    bf16* rowp = base + (row0 + ai * 128 + m * 16) * 512 + head * 64 + 8 * fq;
#pragma unroll
                    for (int bj = 0; bj < 2; ++bj) *(u32x4*)(rowp + bj * 32) = pack8(acc[ai][bj][m][0] * r * w[bj][0], acc[ai][bj][m][1] * r * w[bj][1]);
                }
        } else if (pn < 22) {
            bf16* base = pn < 18 ? GC : GA; const int col0 = ((pn - 14) & 3) * 256 + wc * 32 + 8 * fq;
#pragma unroll
            for (int ai = 0; ai < 2; ++ai)
#pragma unroll
                for (int m = 0; m < 4; ++m) { bf16* rowp = base + (row0 + ai * 128 + m * 16) * 1024 + col0;
#pragma unroll
                    for (int bj = 0; bj < 2; ++bj) { f32x4 a = acc[ai][bj][m][0], b = acc[ai][bj][m][1];
#pragma unroll
                        for (int j = 0; j < 4; ++j) { a[j] = sigm(a[j]); b[j] = sigm(b[j]); }
                        *(u32x4*)(rowp + bj * 128) = pack8(a, b); } }
        } else {
            if (wc < 2) {
#pragma unroll
                for (int ai = 0; ai < 2; ++ai)
#pragma unroll
                    for (int m = 0; m < 4; ++m) *(u32x4*)(KI + (row0 + ai * 128 + m * 16) * 64 + wc * 32 + 8 * fq) = pack8(acc[ai][0][m][0], acc[ai][0][m][1]);
            } else if (wc == 2 && fq == 0) {
#pragma unroll
                for (int ai = 0; ai < 2; ++ai)
#pragma unroll
                    for (int m = 0; m < 4; ++m) { float* p = WI + (row0 + ai * 128 + m * 16) * 8; *(f32x4*)p = acc[ai][0][m][0]; *(f32x4*)(p + 4) = acc[ai][0][m][1]; }
            }
        }
    }
};

template <bool ADD> struct EpiMix {
    static constexpr bool PERM = true;
    const bf16* G; bf16* MIX;
    __device__ __forceinline__ void operator()(AccRef acc, const pg8::Unit& u, int wr, int wc, int fr, int fq) const {
        const size_t row0 = (size_t)u.pm * 256 + wr * 64 + fr; const int col0 = u.pn * 256 + wc * 32 + 8 * fq;
#pragma unroll
        for (int ai = 0; ai < 2; ++ai)
#pragma unroll
            for (int m = 0; m < 4; ++m) { const size_t off = (row0 + ai * 128 + m * 16) * 1024 + col0;
#pragma unroll
                for (int bj = 0; bj < 2; ++bj) {
                    const u32x4 g = *(const u32x4*)(G + off + bj * 128);
                    f32x4 a = acc[ai][bj][m][0], b = acc[ai][bj][m][1];
                    a[0] *= bflo(g.x); a[1] *= bfhi(g.x); a[2] *= bflo(g.y); a[3] *= bfhi(g.y); b[0] *= bflo(g.z); b[1] *= bfhi(g.z); b[2] *= bflo(g.w); b[3] *= bfhi(g.w);
                    if (ADD) { const u32x4 p = *(const u32x4*)(MIX + off + bj * 128);
                        a[0] += bflo(p.x); a[1] += bfhi(p.x); a[2] += bflo(p.y); a[3] += bfhi(p.y); b[0] += bflo(p.z); b[1] += bfhi(p.z); b[2] += bflo(p.w); b[3] += bfhi(p.w); }
                    *(u32x4*)(MIX + off + bj * 128) = pack8(a, b); } }
    }
};

struct EpiRes {
    static constexpr bool PERM = false;
    const float* X; const float* MOD; float* OUT;
    __device__ __forceinline__ void operator()(AccRef acc, const pg8::Unit& u, int wr, int wc, int fr, int fq) const {
        const size_t row0 = (size_t)u.pm * 256 + wr * 64 + fr; const int col0 = u.pn * 256 + wc * 32 + 4 * fq;
        const float* g1 = MOD + (size_t)(u.pm >> 4) * 6144 + 2048;
        f32x4 gv[2][2];
#pragma unroll
        for (int bj = 0; bj < 2; ++bj)
#pragma unroll
            for (int n = 0; n < 2; ++n) gv[bj][n] = *(const f32x4*)(g1 + col0 + bj * 128 + n * 16);
#pragma unroll
        for (int ai = 0; ai < 2; ++ai)
#pragma unroll
            for (int m = 0; m < 4; ++m) { const size_t off = (row0 + ai * 128 + m * 16) * 1024 + col0;
#pragma unroll
                for (int bj = 0; bj < 2; ++bj)
#pragma unroll
                    for (int n = 0; n < 2; ++n) *(f32x4*)(OUT + off + bj * 128 + n * 16) = *(const f32x4*)(X + off + bj * 128 + n * 16) + gv[bj][n] * acc[ai][bj][m][n]; }
    }
};

struct EpiPlain {
    static constexpr bool PERM = true;
    bf16* O;
    __device__ __forceinline__ void operator()(AccRef acc, const pg8::Unit& u, int wr, int wc, int fr, int fq) const {
        const size_t row0 = (size_t)u.pm * 256 + wr * 64 + fr; const int col0 = u.pn * 256 + wc * 32 + 8 * fq;
#pragma unroll
        for (int ai = 0; ai < 2; ++ai)
#pragma unroll
            for (int m = 0; m < 4; ++m) { bf16* rowp = O + (row0 + ai * 128 + m * 16) * 1024 + col0;
#pragma unroll
                for (int bj = 0; bj < 2; ++bj) *(u32x4*)(rowp + bj * 128) = pack8(acc[ai][bj][m][0], acc[ai][bj][m][1]); }
    }
};

struct Args { const float* in[17]; float* out; unsigned char* ws; int ph_lo, ph_hi; };

__device__ __forceinline__ void transpose_item(const float* W, int ldw, int k0, int n0, int ncols, bf16* WT, int K, int drow0, LAS float* scr, int lane) {
#pragma unroll 8
    for (int i = 0; i < 32; ++i) { const int kk = 2 * i + (lane >> 5), n = lane & 31; scr[kk * 33 + n] = (n < ncols) ? W[(size_t)(k0 + kk) * ldw + n0 + n] : 0.f; }
    LDS_WAIT(); asm volatile("" ::: "memory");
    const int c = lane & 7;
#pragma unroll
    for (int j = 0; j < 4; ++j) { const int n = (lane >> 3) + 8 * j; const LAS float* s = scr + (8 * c) * 33 + n;
        u32x4 o; o.x = pk2(s[0 * 33], s[1 * 33]); o.y = pk2(s[2 * 33], s[3 * 33]); o.z = pk2(s[4 * 33], s[5 * 33]); o.w = pk2(s[6 * 33], s[7 * 33]);
        *(u32x4*)(WT + (size_t)(drow0 + n) * K + k0 + 8 * c) = o; }
    LDS_WAIT(); asm volatile("" ::: "memory");
}
__device__ __forceinline__ void cvt_stream(const float* src, bf16* dst, size_t n8, size_t i0, size_t stride) {
    for (size_t i = i0; i < n8; i += stride) { const f32x4 a = *(const f32x4*)(src + 8 * i), b = *(const f32x4*)(src + 8 * i + 4); *(u32x4*)(dst + 8 * i) = pack8(a, b); }
}

__device__ __forceinline__ void p0_prologue(LAS unsigned char* lds, const Args& a, int G, int blk) {
    const int tid = threadIdx.x, lane = tid & 63, wave = __builtin_amdgcn_readfirstlane(tid >> 6);
    unsigned char* ws = a.ws;
    for (int task = blk; task < 96; task += G) {
        LAS float* sl = (LAS float*)(lds + 67584);
        for (int i = tid; i < NB * DM; i += 512) { const float v = a.in[1][i]; sl[i] = v * __builtin_amdgcn_rcpf(1.f + __expf(-v)); }
        __syncthreads();
        const int col = task * 64 + lane, kb = wave * 128;
        float acc[16];
#pragma unroll
        for (int b = 0; b < 16; ++b) acc[b] = 0.f;
        const float* wp = a.in[2] + col;
        for (int k = kb; k < kb + 128; k += 4) {
            const float w0 = wp[(size_t)(k + 0) * 6144], w1 = wp[(size_t)(k + 1) * 6144], w2 = wp[(size_t)(k + 2) * 6144], w3 = wp[(size_t)(k + 3) * 6144];
#pragma unroll
            for (int b = 0; b < 16; ++b) { const f32x4 s = *(const LAS f32x4*)(sl + b * 1024 + k); acc[b] += (s[0] * w0 + s[1] * w1) + (s[2] * w2 + s[3] * w3); }
        }
        LAS float* red = (LAS float*)lds;
#pragma unroll
        for (int b = 0; b < 16; ++b) red[(wave * 16 + b) * 64 + lane] = acc[b];
        __syncthreads();
        for (int o = tid; o < 1024; o += 512) { const int b = o >> 6, cl = o & 63; float s = 0.f;
#pragma unroll
            for (int w = 0; w < 8; ++w) s += red[(w * 16 + b) * 64 + cl];
            ((float*)(ws + WS_MOD))[b * 6144 + task * 64 + cl] = s + a.in[3][task * 64 + cl]; }
        __syncthreads();
    }
    LAS float* scr = (LAS float*)(lds + wave * 8448);
    const int gw = blk * NWAVES + wave, NGW = G * NWAVES;
    constexpr int I_IN = 184 * 16, I_CO = 8 * 32, I_AO = 8 * 32, I_O = 16 * 32, I_PQ = 16 * 32;
    for (int it = gw; it < I_IN + I_CO + I_AO + I_O + I_PQ; it += NGW) {
        int r = it;
        if (r < I_IN) {
            const int dg = r >> 4, kb = r & 15, tile = dg >> 3, gi = dg & 7; int src, nc = 32;
            if (tile < 6 || (tile >= 10 && tile < 14)) src = 32 * dg;
            else if (tile < 10) src = tile * 256 + 32 * (2 * (gi & 3) + (gi >> 2));
            else if (tile < 22) src = 3656 + 32 * (dg - 112);
            else { if (gi < 2) src = 3584 + 32 * gi; else if (gi == 2) { src = 3648; nc = 8; } else { src = 0; nc = 0; } }
            transpose_item(a.in[5], 5704, kb * 64, src, nc, (bf16*)(ws + WS_WIN), 1024, dg * 32, scr, lane); continue; }
        r -= I_IN;
        if (r < I_CO) { transpose_item(a.in[7], 1024, (r >> 5) * 64, (r & 31) * 32, 32, (bf16*)(ws + WS_WCO), 512, (r & 31) * 32, scr, lane); continue; } r -= I_CO;
        if (r < I_AO) { transpose_item(a.in[10], 1024, (r >> 5) * 64, (r & 31) * 32, 32, (bf16*)(ws + WS_WAO), 512, (r & 31) * 32, scr, lane); continue; } r -= I_AO;
        if (r < I_O) { transpose_item(a.in[11], 1024, (r >> 5) * 64, (r & 31) * 32, 32, (bf16*)(ws + WS_WO), 1024, (r & 31) * 32, scr, lane); continue; } r -= I_O;
        transpose_item(a.in[13], 1024, (r >> 5) * 64, (r & 31) * 32, 32, (bf16*)(ws + WS_WPQ), 1024, (r & 31) * 32, scr, lane);
    }
    const size_t gt = (size_t)blk * 512 + tid, NT_ = (size_t)G * 512;
    cvt_stream(a.in[14], (bf16*)(ws + WS_SK), (size_t)16 * 128 * 64 / 8, gt, NT_);
    cvt_stream(a.in[15], (bf16*)(ws + WS_PU), (size_t)16384 * 1024 / 8, gt, NT_);
    cvt_stream(a.in[16], (bf16*)(ws + WS_PV), (size_t)16384 * 1024 / 8, gt, NT_);
}

__device__ __forceinline__ void norm_mod_row(const float* xrow, const float* nw, const float* sh, const float* sc, bf16* orow, int lane) {
    const f32x4* xr = (const f32x4*)xrow + lane;
    f32x4 v[4]; float s = 0.f;
#pragma unroll
    for (int j = 0; j < 4; ++j) { v[j] = xr[64 * j]; s += (v[j].x * v[j].x + v[j].y * v[j].y) + (v[j].z * v[j].z + v[j].w * v[j].w); }
    const float r = __builtin_amdgcn_rsqf(wave_sum(s) * (1.f / DM) + EPS);
    unsigned long long* o8 = (unsigned long long*)orow + lane;
#pragma unroll
    for (int j = 0; j < 4; ++j) {
        const f32x4 w = ((const f32x4*)nw)[lane + 64 * j], a = ((const f32x4*)sc)[lane + 64 * j], b = ((const f32x4*)sh)[lane + 64 * j];
        const f32x4 h = (v[j] * r * w) * (a + 1.f) + b;
        o8[64 * j] = (unsigned long long)pk2(h.x, h.y) | ((unsigned long long)pk2(h.z, h.w) << 32);
    }
}
__device__ __forceinline__ void norm_phase(const float* X, const float* nw, const float* MOD, int sh_off, bf16* O, int G, int blk) {
    const int lane = threadIdx.x & 63, wave = __builtin_amdgcn_readfirstlane(threadIdx.x >> 6);
    for (int m = blk * NWAVES + wave; m < T; m += G * NWAVES) {
        const float* md = MOD + (size_t)(m >> 12) * 6144 + sh_off;
        norm_mod_row(X + (size_t)m * DM, nw, md, md + 1024, O + (size_t)m * DM, lane);
    }
}

__device__ __forceinline__ void conv_phase(bf16* CB, const bf16* CC, const bf16* CX, const float* cw, int G, int blk) {
    const size_t n = (size_t)T * 64;
    for (size_t i = (size_t)blk * 512 + threadIdx.x; i < n; i += (size_t)G * 512) {
        const int c8 = (int)(i & 63) * 8; const size_t row = i >> 6; const int t = (int)(row & (SEQ - 1));
        float accv[8];
#pragma unroll
        for (int e = 0; e < 8; ++e) accv[e] = 0.f;
#pragma unroll
        for (int j = 0; j < 3; ++j) {
            if (t - 2 + j >= 0) {
                const size_t off = (row - 2 + j) * 512 + c8;
                const u32x4 a = *(const u32x4*)(CC + off), b = *(const u32x4*)(CX + off);
                const f32x4 w0 = *(const f32x4*)(cw + j * 512 + c8), w1 = *(const f32x4*)(cw + j * 512 + c8 + 4);
                accv[0] += w0[0] * bflo(a.x) * bflo(b.x); accv[1] += w0[1] * bfhi(a.x) * bfhi(b.x);
                accv[2] += w0[2] * bflo(a.y) * bflo(b.y); accv[3] += w0[3] * bfhi(a.y) * bfhi(b.y);
                accv[4] += w1[0] * bflo(a.z) * bflo(b.z); accv[5] += w1[1] * bfhi(a.z) * bfhi(b.z);
                accv[6] += w1[2] * bflo(a.w) * bflo(b.w); accv[7] += w1[3] * bfhi(a.w) * bfhi(b.w);
            }
        }
        const u32x4 g = *(const u32x4*)(CB + row * 512 + c8);
        u32x4 o; o.x = pk2(accv[0] * bflo(g.x), accv[1] * bfhi(g.x)); o.y = pk2(accv[2] * bflo(g.y), accv[3] * bfhi(g.y));
        o.z = pk2(accv[4] * bflo(g.z), accv[5] * bfhi(g.z)); o.w = pk2(accv[6] * bflo(g.w), accv[7] * bfhi(g.w));
        *(u32x4*)(CB + row * 512 + c8) = o;
    }
}

template <int NR> __device__ __forceinline__ void select_query(const LAS unsigned* row, int nvalid, int tq, unsigned long long* mrow, int lane) {
    unsigned k[NR];
#pragma unroll
    for (int r = 0; r < NR; ++r) { const int idx = 64 * r + lane; k[r] = idx < nvalid ? row[idx] : 0u; }
    unsigned tau = 0u;
    if (tq >= 256) {
        for (int bit = 31; bit >= 0; --bit) {
            const unsigned cand = tau | (1u << bit);
            int cnt = 0;
#pragma unroll
            for (int r = 0; r < NR; ++r) cnt += __popcll(__ballot(k[r] >= cand));
            if (cnt >= 256) tau = cand;
            if (cnt == 256) break;
        }
    }
    if (tau == 0u) tau = 1u;
    unsigned long long mine = 0ull;
#pragma unroll
    for (int r = 0; r < NR; ++r) { const unsigned long long m = __ballot(k[r] >= tau); if (lane == r) mine = m; }
    mrow[lane] = mine;
}

__device__ __forceinline__ void indexer_phase(LAS unsigned char* lds, const bf16* QI, const bf16* KI, const float* WI, unsigned long long* MASK, int G, int blk) {
    LAS unsigned* sc = (LAS unsigned*)lds;
    const int tid = threadIdx.x, lane = tid & 63, wave = __builtin_amdgcn_readfirstlane(tid >> 6), r32 = lane & 31, hi = lane >> 5;
    const int ra = (r32 >> 4) & 1, rb = (r32 >> 3) & 1, rc = (r32 >> 2) & 1, rd = r32 & 3;
    for (int uid = blk; uid < T / 8; uid += G) {
        const int b = uid >> 9; int j = uid & 511; if (j >= 256) j = 767 - j;
        const int tq0 = 8 * j; const size_t row0 = (size_t)b * SEQ + tq0;
        const int nkt = (tq0 + 8 + 31) >> 5;
        bf16x8 aq[2][4]; f32x4 wv[2][2][2];
#pragma unroll
        for (int rt = 0; rt < 2; ++rt) {
            const bf16* qp = QI + (row0 + rt * 4 + 2 * rc + ra) * 512 + (4 * rb + rd) * 64 + hi * 8;
#pragma unroll
            for (int d0 = 0; d0 < 4; ++d0) aq[rt][d0] = *(const bf16x8*)(qp + d0 * 16);
#pragma unroll
            for (int a2 = 0; a2 < 2; ++a2) { const float* wp = WI + (row0 + rt * 4 + 2 * hi + a2) * 8; wv[rt][a2][0] = *(const f32x4*)wp; wv[rt][a2][1] = *(const f32x4*)(wp + 4); }
        }
        for (int kt = wave; kt < nkt; kt += NWAVES) {
            const int key = 32 * kt + r32;
            const bf16* kp = KI + ((size_t)b * SEQ + key) * 64 + hi * 8;
            bf16x8 bk[4];
#pragma unroll
            for (int d0 = 0; d0 < 4; ++d0) bk[d0] = *(const bf16x8*)(kp + d0 * 16);
#pragma unroll
            for (int rt = 0; rt < 2; ++rt) {
                f32x16 acc = {};
#pragma unroll
                for (int d0 = 0; d0 < 4; ++d0) acc = __builtin_amdgcn_mfma_f32_32x32x16_bf16(aq[rt][d0], bk[d0], acc, 0, 0, 0);
#pragma unroll
                for (int a2 = 0; a2 < 2; ++a2) {
                    float s = 0.f;
#pragma unroll
                    for (int i = 0; i < 8; ++i) s += fmaxf(acc[8 * a2 + i], 0.f) * wv[rt][a2][i >> 2][i & 3];
                    const int ql = rt * 4 + 2 * hi + a2;
                    const unsigned ck = (key <= tq0 + ql) ? ((ordf(s) & 0xfffff000u) | (unsigned)(4095 - key)) : 0u;
                    sc[ql * 4096 + key] = ck;
                }
            }
        }
        __syncthreads();
        {
            const int tq = tq0 + wave, nvalid = 32 * nkt;
            unsigned long long* mrow = MASK + (row0 + wave) * 64;
            const LAS unsigned* rowp = sc + wave * 4096;
            if (nvalid <= 1024) select_query<16>(rowp, nvalid, tq, mrow, lane);
            else if (nvalid <= 2048) select_query<32>(rowp, nvalid, tq, mrow, lane);
            else if (nvalid <= 3072) select_query<48>(rowp, nvalid, tq, mrow, lane);
            else select_query<64>(rowp, nvalid, tq, mrow, lane);
        }
        __syncthreads();
    }
}

namespace att {
constexpr int SLOTB = 8192;
constexpr int L_K = 0, L_V = 2 * SLOTB, L_WS = 4 * SLOTB, L_OST = L_WS + NWAVES * 256, L_END = L_OST + NWAVES * 4096;
__device__ __forceinline__ int crow(int r, int hi) { return (r & 3) + 8 * (r >> 2) + 4 * hi; }
#define SBAR() __builtin_amdgcn_sched_barrier(0)
__device__ __forceinline__ void qkt(f32x16& p0, f32x16& p1, const LAS unsigned char* kb, const bf16x8* qr, const f32x16& negm) {
#pragma unroll
    for (int d0 = 0; d0 < 4; ++d0) {
        const bf16x8 b0 = *(const LAS bf16x8*)(kb + d0 * 2048);
        const bf16x8 b1 = *(const LAS bf16x8*)(kb + d0 * 2048 + 512);
        if (d0 == 0) { p0 = __builtin_amdgcn_mfma_f32_32x32x16_bf16(b0, qr[0], negm, 0, 0, 0); p1 = __builtin_amdgcn_mfma_f32_32x32x16_bf16(b1, qr[0], negm, 0, 0, 0); }
        else { p0 = __builtin_amdgcn_mfma_f32_32x32x16_bf16(b0, qr[d0], p0, 0, 0, 0); p1 = __builtin_amdgcn_mfma_f32_32x32x16_bf16(b1, qr[d0], p1, 0, 0, 0); } }
}
__device__ __forceinline__ void pv(f32x16* o, int vb, bf16x8 pa0, bf16x8 pa1, bf16x8 pa2, bf16x8 pa3) {
#pragma unroll
    for (int d0 = 0; d0 < 2; ++d0) { s16x4 lo[4], hi[4];
#pragma unroll
        for (int ks = 0; ks < 4; ++ks) {
            asm volatile("ds_read_b64_tr_b16 %0,%1 offset:%c2" : "=&v"(lo[ks]) : "v"(vb), "i"(d0 * 4096 + ks * 1024) : "memory");
            asm volatile("ds_read_b64_tr_b16 %0,%1 offset:%c2" : "=&v"(hi[ks]) : "v"(vb), "i"(d0 * 4096 + ks * 1024 + 512) : "memory"); }
        asm volatile("s_waitcnt lgkmcnt(0)" ::: "memory"); SBAR();
#define PK(k) (bf16x8){lo[k][0], lo[k][1], lo[k][2], lo[k][3], hi[k][0], hi[k][1], hi[k][2], hi[k][3]}
        o[d0] = __builtin_amdgcn_mfma_f32_32x32x16_bf16(pa0, PK(0), o[d0], 0, 0, 0);
        o[d0] = __builtin_amdgcn_mfma_f32_32x32x16_bf16(pa1, PK(1), o[d0], 0, 0, 0);
        o[d0] = __builtin_amdgcn_mfma_f32_32x32x16_bf16(pa2, PK(2), o[d0], 0, 0, 0);
        o[d0] = __builtin_amdgcn_mfma_f32_32x32x16_bf16(pa3, PK(3), o[d0], 0, 0, 0);
#undef PK
    }
}

__device__ __forceinline__ void attn_phase(LAS unsigned char* lds, bf16* Q, const bf16* K, const bf16* V, const unsigned long long* MASK, const float* qnw, const float* knw, int G, int blk) {
    const int tid = threadIdx.x, lane = tid & 63, r32 = lane & 31, hi = lane >> 5, wid = __builtin_amdgcn_readfirstlane(tid >> 6);
    float mq = fabsf(qnw[lane]), mk = fabsf(knw[lane]);
#pragma unroll
    for (int o = 1; o < 64; o <<= 1) { mq = fmaxf(mq, __shfl_xor(mq, o)); mk = fmaxf(mk, __shfl_xor(mk, o)); }
    const float nb = -(8.f * 1.4426950408889634f) * mq * mk;
    f32x16 negm;
#pragma unroll
    for (int r = 0; r < 16; ++r) negm[r] = nb;
    LAS float* wsf = (LAS float*)(lds + L_WS) + wid * 64;
    const unsigned kdst = L_K + wid * 1024 + lane * 16, vdst = L_V + wid * 1024 + lane * 16;
    const LAS unsigned char* kp0 = lds + L_K + hi * 1024 + r32 * 16;
    const int vb0 = (int)(uintptr_t)(lds + L_V) + ((lane >> 4) & 1) * 32 + (lane & 3) * 8 + (4 * hi + ((lane & 15) >> 2)) * 64;
    for (int uid = blk; uid < 2048; uid += G) {
        const int ui = uid >> 8; int c = uid & 255; c = (c & 7) * 32 + (c >> 3);
        const int bh = c >> 1, s = c & 1, pp = ui >> 1, qb = (ui & 1) ? 15 - (2 * pp + s) : (2 * pp + s);
        const int b = bh >> 3, h = bh & 7, q0 = qb * 256;
        const size_t rowbase = (size_t)b * SEQ;
        bf16* Qw = Q + (rowbase + q0 + wid * 32) * 512 + h * 64;
        bf16x8 qr[4];
#pragma unroll
        for (int d0 = 0; d0 < 4; ++d0) qr[d0] = *(const bf16x8*)(Qw + (size_t)r32 * 512 + d0 * 16 + hi * 8);
        const int NT = 4 * (qb + 1);
        const unsigned long long* mptr = MASK + (rowbase + q0 + wid * 32 + r32) * 64;
        const bf16* ksrc = K + (rowbase + lane) * 512 + h * 64 + wid * 8;
        const bf16* vsrc = V + (rowbase + 16 * (wid & 3) + (lane >> 2)) * 512 + h * 64 + (wid >> 2) * 32 + (lane & 3) * 8;
        f32x16 o[2]; o[0] = f32x16{}; o[1] = f32x16{};
        float l_reg = 0.f;
        u32x4 kreg = *(const u32x4*)ksrc, vreg = *(const u32x4*)vsrc;
        unsigned long long mw = mptr[0], mwn = 0ull;
        *(LAS u32x4*)(lds + kdst) = kreg; *(LAS u32x4*)(lds + vdst) = vreg;
        __syncthreads();
        const int qmax = q0 + wid * 32 + 31;
        for (int t = 0; t < NT; ++t) {
            const int slot = (t & 1) * SLOTB;
            if (t + 1 < NT) { kreg = *(const u32x4*)(ksrc + (size_t)(t + 1) * 64 * 512); vreg = *(const u32x4*)(vsrc + (size_t)(t + 1) * 64 * 512); mwn = mptr[t + 1]; }
            if (64 * t <= qmax) {
                f32x16 p0, p1;
                qkt(p0, p1, kp0 + slot, qr, negm);
                const unsigned mlo = (unsigned)mw >> (4 * hi), mhi = (unsigned)(mw >> 32) >> (4 * hi);
                float sacc = 0.f;
#pragma unroll
                for (int r = 0; r < 16; ++r) {
                    const int bp = (r & 3) + 8 * (r >> 2);
                    const float e0 = __builtin_amdgcn_exp2f(p0[r]), e1 = __builtin_amdgcn_exp2f(p1[r]);
                    p0[r] = __uint_as_float(__float_as_uint(e0) & (unsigned)__builtin_amdgcn_sbfe((int)mlo, bp, 1));
                    p1[r] = __uint_as_float(__float_as_uint(e1) & (unsigned)__builtin_amdgcn_sbfe((int)mhi, bp, 1));
                    sacc += p0[r] + p1[r];
                }
                l_reg += sacc;
                u32x4 pw0, pw1, pw2, pw3;
                pw0 = (u32x4){pk2(p0[0], p0[1]), pk2(p0[2], p0[3]), pk2(p0[4], p0[5]), pk2(p0[6], p0[7])};
                pw1 = (u32x4){pk2(p0[8], p0[9]), pk2(p0[10], p0[11]), pk2(p0[12], p0[13]), pk2(p0[14], p0[15])};
                pw2 = (u32x4){pk2(p1[0], p1[1]), pk2(p1[2], p1[3]), pk2(p1[4], p1[5]), pk2(p1[6], p1[7])};
                pw3 = (u32x4){pk2(p1[8], p1[9]), pk2(p1[10], p1[11]), pk2(p1[12], p1[13]), pk2(p1[14], p1[15])};
                pv(o, vb0 + slot, __builtin_bit_cast(bf16x8, pw0), __builtin_bit_cast(bf16x8, pw1), __builtin_bit_cast(bf16x8, pw2), __builtin_bit_cast(bf16x8, pw3));
            }
            if (t + 1 < NT) { *(LAS u32x4*)(lds + kdst + (SLOTB - slot)) = kreg; *(LAS u32x4*)(lds + vdst + (SLOTB - slot)) = vreg; mw = mwn; }
            __syncthreads();
        }
        { auto rr = __builtin_amdgcn_permlane32_swap(__float_as_uint(l_reg), __float_as_uint(l_reg), false, false); l_reg = __uint_as_float(rr[0]) + __uint_as_float(rr[1]); }
        if (hi == 0) wsf[32 + r32] = l_reg;
        LDS_WAIT();
        float rli[16];
#pragma unroll
        for (int r = 0; r < 16; ++r) rli[r] = __builtin_amdgcn_rcpf(wsf[32 + crow(r, hi)]);
        LAS bf16* stg = (LAS bf16*)(lds + L_OST) + wid * 2048;
#pragma unroll
        for (int r = 0; r < 16; ++r) { const int orow = crow(r, hi);
#pragma unroll
            for (int d0 = 0; d0 < 2; ++d0) stg[orow * 64 + d0 * 32 + r32] = (bf16)(pk2(o[d0][r] * rli[r], 0.f) & 0xffffu); }
        LDS_WAIT();
#pragma unroll
        for (int i = 0; i < 4; ++i) { const int row = i * 8 + (lane >> 3), ch = lane & 7; const u32x4 v = *(const LAS u32x4*)(stg + row * 64 + ch * 8); *(u32x4*)(Qw + (size_t)row * 512 + ch * 8) = v; }
        LDS_WAIT();
    }
}
#undef SBAR
}

__device__ __forceinline__ void peer_route_phase(LAS unsigned char* lds, const bf16* PQ, const bf16* SK, unsigned short* EIDX, float* EG, int G, int blk) {
    const int tid = threadIdx.x, lane = tid & 63, r32 = lane & 31, hi = lane >> 5, wave = __builtin_amdgcn_readfirstlane(tid >> 6);
    LAS unsigned* win = (LAS unsigned*)(lds + wave * 12288);
    LAS unsigned* fwn = win + 2 * 16 * 64;
    const int gw = blk * NWAVES + wave, NGW = G * NWAVES, h = gw & 7;
    for (int tg = gw >> 3; tg < T / 32; tg += NGW >> 3) {
        const size_t t0 = (size_t)tg * 32;
#pragma unroll 1
        for (int half = 0; half < 2; ++half) {
            const int p = 2 * h + half;
            bf16x8 bq[4];
#pragma unroll
            for (int d0 = 0; d0 < 4; ++d0) bq[d0] = *(const bf16x8*)(PQ + (t0 + r32) * 1024 + 128 * h + 64 * half + 16 * d0 + 8 * hi);
            unsigned ck[64];
#pragma unroll
            for (int nb = 0; nb < 4; ++nb) {
                f32x16 acc = {};
#pragma unroll
                for (int d0 = 0; d0 < 4; ++d0) { const bf16x8 a = *(const bf16x8*)(SK + ((size_t)p * 128 + 32 * nb + r32) * 64 + 16 * d0 + 8 * hi); acc = __builtin_amdgcn_mfma_f32_32x32x16_bf16(a, bq[d0], acc, 0, 0, 0); }
#pragma unroll
                for (int r = 0; r < 16; ++r) ck[nb * 16 + r] = (ordf(acc[r]) & ~0x7fu) | (unsigned)(127 - (32 * nb + att::crow(r, hi)));
            }
#pragma unroll 1
            for (int rd = 0; rd < 16; ++rd) {
                unsigned m = ck[0];
#pragma unroll
                for (int i = 1; i < 64; ++i) m = m > ck[i] ? m : ck[i];
                auto rr = __builtin_amdgcn_permlane32_swap(m, m, false, false);
                const unsigned W = rr[0] > rr[1] ? rr[0] : rr[1];
                win[(half * 16 + rd) * 64 + lane] = W;
#pragma unroll
                for (int i = 0; i < 64; ++i) ck[i] = (ck[i] == W) ? 0u : ck[i];
            }
        }
        LDS_WAIT();
        float v0[16], v1[16];
#pragma unroll
        for (int i = 0; i < 16; ++i) { v0[i] = unordf(win[i * 64 + lane] & ~0x7fu); v1[i] = unordf(win[(16 + i) * 64 + lane] & ~0x7fu); }
        unsigned c2[16][16];
#pragma unroll
        for (int i = 0; i < 16; ++i)
#pragma unroll
            for (int j = 0; j < 16; ++j) if ((i + 1) * (j + 1) <= 16) c2[i][j] = (ordf(v0[i] + v1[j]) & ~0xffu) | (unsigned)(255 - (16 * i + j));
#pragma unroll 1
        for (int rd = 0; rd < 16; ++rd) {
            unsigned m = 0u;
#pragma unroll
            for (int i = 0; i < 16; ++i)
#pragma unroll
                for (int j = 0; j < 16; ++j) if ((i + 1) * (j + 1) <= 16) m = m > c2[i][j] ? m : c2[i][j];
            fwn[rd * 64 + lane] = m;
#pragma unroll
            for (int i = 0; i < 16; ++i)
#pragma unroll
                for (int j = 0; j < 16; ++j) if ((i + 1) * (j + 1) <= 16) c2[i][j] = (c2[i][j] == m) ? 0u : c2[i][j];
        }
        LDS_WAIT();
        float sc[16]; unsigned ex[16];
#pragma unroll
        for (int k = 0; k < 16; ++k) {
            const unsigned f = fwn[k * 64 + lane]; const int idx = 255 - (int)(f & 0xffu), i = idx >> 4, j = idx & 15;
            const unsigned w0 = win[i * 64 + lane], w1 = win[(16 + j) * 64 + lane];
            ex[k] = (127u - (w0 & 0x7fu)) * 128u + (127u - (w1 & 0x7fu));
            sc[k] = unordf(w0 & ~0x7fu) + unordf(w1 & ~0x7fu);
        }
        const float mx = sc[0];
        float sum = 0.f;
#pragma unroll
        for (int k = 0; k < 16; ++k) { sc[k] = __expf(sc[k] - mx); sum += sc[k]; }
        const float inv = 1.f / sum;
#pragma unroll
        for (int k = 0; k < 16; ++k) sc[k] *= inv;
        if (hi == 0) {
            unsigned short* ep = EIDX + (t0 + r32) * 128 + h * 16; float* gp = EG + (t0 + r32) * 128 + h * 16;
            *(u32x4*)ep = (u32x4){ex[0] | (ex[1] << 16), ex[2] | (ex[3] << 16), ex[4] | (ex[5] << 16), ex[6] | (ex[7] << 16)};
            *(u32x4*)(ep + 8) = (u32x4){ex[8] | (ex[9] << 16), ex[10] | (ex[11] << 16), ex[12] | (ex[13] << 16), ex[14] | (ex[15] << 16)};
#pragma unroll
            for (int q = 0; q < 4; ++q) *(f32x4*)(gp + 4 * q) = (f32x4){sc[4 * q], sc[4 * q + 1], sc[4 * q + 2], sc[4 * q + 3]};
        }
        LDS_WAIT();
    }
}

__device__ __forceinline__ float dot16(const float* hv, u32x4 a, u32x4 b) {
    float s0 = hv[0] * bflo(a.x), s1 = hv[1] * bfhi(a.x);
    s0 += hv[2] * bflo(a.y); s1 += hv[3] * bfhi(a.y); s0 += hv[4] * bflo(a.z); s1 += hv[5] * bfhi(a.z); s0 += hv[6] * bflo(a.w); s1 += hv[7] * bfhi(a.w);
    s0 += hv[8] * bflo(b.x); s1 += hv[9] * bfhi(b.x); s0 += hv[10] * bflo(b.y); s1 += hv[11] * bfhi(b.y); s0 += hv[12] * bflo(b.z); s1 += hv[13] * bfhi(b.z); s0 += hv[14] * bflo(b.w); s1 += hv[15] * bfhi(b.w);
    return s0 + s1;
}
__device__ __forceinline__ void axpy16(float* o, float c, u32x4 a, u32x4 b) {
    o[0] += c * bflo(a.x); o[1] += c * bfhi(a.x); o[2] += c * bflo(a.y); o[3] += c * bfhi(a.y); o[4] += c * bflo(a.z); o[5] += c * bfhi(a.z); o[6] += c * bflo(a.w); o[7] += c * bfhi(a.w);
    o[8] += c * bflo(b.x); o[9] += c * bfhi(b.x); o[10] += c * bflo(b.y); o[11] += c * bfhi(b.y); o[12] += c * bflo(b.z); o[13] += c * bfhi(b.z); o[14] += c * bflo(b.w); o[15] += c * bfhi(b.w);
}
__device__ __forceinline__ void peer_gather_phase(const bf16* H2, const bf16* PU, const bf16* PV, const unsigned short* EIDX, const float* EG, const float* MOD, float* OUT, int G, int blk) {
    const int lane = threadIdx.x & 63, wave = __builtin_amdgcn_readfirstlane(threadIdx.x >> 6);
    const int kk = 8 * ((lane >> 5) & 1) + 4 * ((lane >> 4) & 1) + 2 * ((lane >> 3) & 1) + ((lane >> 2) & 1);
    for (int t = blk * NWAVES + wave; t < T; t += G * NWAVES) {
        float hv[16], out[16];
        { const u32x4 a = *(const u32x4*)(H2 + (size_t)t * 1024 + 8 * lane), b = *(const u32x4*)(H2 + (size_t)t * 1024 + 512 + 8 * lane);
          hv[0] = bflo(a.x); hv[1] = bfhi(a.x); hv[2] = bflo(a.y); hv[3] = bfhi(a.y); hv[4] = bflo(a.z); hv[5] = bfhi(a.z); hv[6] = bflo(a.w); hv[7] = bfhi(a.w);
          hv[8] = bflo(b.x); hv[9] = bfhi(b.x); hv[10] = bflo(b.y); hv[11] = bfhi(b.y); hv[12] = bflo(b.z); hv[13] = bfhi(b.z); hv[14] = bflo(b.w); hv[15] = bfhi(b.w); }
#pragma unroll
        for (int j = 0; j < 16; ++j) out[j] = 0.f;
#pragma unroll 1
        for (int h = 0; h < 8; ++h) {
            const u32x4 ia = *(const u32x4*)(EIDX + (size_t)t * 128 + h * 16), ib = *(const u32x4*)(EIDX + (size_t)t * 128 + h * 16 + 8);
            unsigned e[16];
            e[0] = ia.x & 0xffffu; e[1] = ia.x >> 16; e[2] = ia.y & 0xffffu; e[3] = ia.y >> 16; e[4] = ia.z & 0xffffu; e[5] = ia.z >> 16; e[6] = ia.w & 0xffffu; e[7] = ia.w >> 16;
            e[8] = ib.x & 0xffffu; e[9] = ib.x >> 16; e[10] = ib.y & 0xffffu; e[11] = ib.y >> 16; e[12] = ib.z & 0xffffu; e[13] = ib.z >> 16; e[14] = ib.w & 0xffffu; e[15] = ib.w >> 16;
#pragma unroll
            for (int k = 0; k < 16; ++k) e[k] = (unsigned)__builtin_amdgcn_readfirstlane((int)e[k]);
            const float gk = EG[(size_t)t * 128 + h * 16 + kk];
            float d[16];
#pragma unroll
            for (int k = 0; k < 16; ++k) { const bf16* ur = PU + (size_t)e[k] * 1024 + 8 * lane; d[k] = dot16(hv, *(const u32x4*)ur, *(const u32x4*)(ur + 512)); }
#pragma unroll
            for (int i = 0; i < 8; ++i) { const bool up = lane & 32; const float keep = up ? d[i + 8] : d[i], send = up ? d[i] : d[i + 8]; d[i] = keep + __shfl_xor(send, 32); }
#pragma unroll
            for (int i = 0; i < 4; ++i) { const bool up = lane & 16; const float keep = up ? d[i + 4] : d[i], send = up ? d[i] : d[i + 4]; d[i] = keep + __shfl_xor(send, 16); }
#pragma unroll
            for (int i = 0; i < 2; ++i) { const bool up = lane & 8; const float keep = up ? d[i + 2] : d[i], send = up ? d[i] : d[i + 2]; d[i] = keep + __shfl_xor(send, 8); }
            { const bool up = lane & 4; const float keep = up ? d[1] : d[0], send = up ? d[0] : d[1]; d[0] = keep + __shfl_xor(send, 4); }
            d[0] += __shfl_xor(d[0], 2); d[0] += __shfl_xor(d[0], 1);
            const float x = d[0];
            const float coef = gk * 0.5f * x * (1.f + erff(x * 0.70710678118654752f));
#pragma unroll
            for (int k = 0; k < 16; ++k) {
                const int src = 32 * ((k >> 3) & 1) + 16 * ((k >> 2) & 1) + 8 * ((k >> 1) & 1) + 4 * (k & 1);
                const float ck = __uint_as_float((unsigned)__builtin_amdgcn_readlane((int)__float_as_uint(coef), src));
                const bf16* vr = PV + (size_t)e[k] * 1024 + 8 * lane;
                axpy16(out, ck, *(const u32x4*)vr, *(const u32x4*)(vr + 512));
            }
        }
        const float* g2 = MOD + (size_t)(t >> 12) * 6144 + 5120;
        float* op = OUT + (size_t)t * 1024;
#pragma unroll
        for (int q = 0; q < 4; ++q) {
            const int col = (q >> 1) * 512 + 8 * lane + 4 * (q & 1);
            const f32x4 g = *(const f32x4*)(g2 + col), x1 = *(const f32x4*)(op + col);
            *(f32x4*)(op + col) = x1 + g * (f32x4){out[4 * q], out[4 * q + 1], out[4 * q + 2], out[4 * q + 3]};
        }
    }
}

constexpr int N_PHASES = 12;
__global__ void __launch_bounds__(NWAVES * 64, 2) mk_fwd(Args a) {
    extern __shared__ __attribute__((aligned(16))) unsigned char lds_raw[];
    LAS unsigned char* lds = (LAS unsigned char*)lds_raw;
    cg::grid_group grid = cg::this_grid();
    const int G = gridDim.x, blk = blockIdx.x;
    unsigned char* ws = a.ws;
    float* MOD = (float*)(ws + WS_MOD);
    bf16* H = (bf16*)(ws + WS_H);
    bf16 *CB = (bf16*)(ws + WS_CB), *CC = (bf16*)(ws + WS_CC), *CX = (bf16*)(ws + WS_CX), *Qb = (bf16*)(ws + WS_Q), *Kb = (bf16*)(ws + WS_K), *Vb = (bf16*)(ws + WS_V), *QI = (bf16*)(ws + WS_QI);
    bf16 *GC = (bf16*)(ws + WS_GC), *GA = (bf16*)(ws + WS_GA), *KI = (bf16*)(ws + WS_KI); float* WI = (float*)(ws + WS_WI);
    unsigned long long* MASK = (unsigned long long*)(ws + WS_MASK);
    bf16* PQ = (bf16*)(ws + WS_PQ); unsigned short* EIDX = (unsigned short*)(ws + WS_EIDX); float* EG = (float*)(ws + WS_EG);
#define IN(k) (a.ph_lo <= (k) && (k) < a.ph_hi)
#define SEAM(k) do { if (IN(k) && IN((k) + 1)) grid.sync(); } while (0)
    if (IN(0)) p0_prologue(lds, a, G, blk);
    SEAM(0);
    if (IN(1)) norm_phase(a.in[0], a.in[4], MOD, 0, H, G, blk);
    SEAM(1);
    if (IN(2)) {
        pg8::Gemm g{H, (const bf16*)(ws + WS_WIN), T, NIN_PAD, DM}; pg8::StaticOrder S; S.init(T, NIN_PAD, G, blk);
        EpiInProj E{CB, CC, CX, Qb, Kb, Vb, QI, GC, GA, KI, WI, a.in[8], a.in[9]};
        pg8::gemm_phase<EpiInProj, true, true>(lds, g, S, E);
    }
    SEAM(2);
    if (IN(3)) { conv_phase(CB, CC, CX, a.in[6], G, blk); indexer_phase(lds, QI, KI, WI, MASK, G, blk); }
    SEAM(3);
    if (IN(4)) att::attn_phase(lds, Qb, Kb, Vb, MASK, a.in[8], a.in[9], G, blk);
    SEAM(4);
    if (IN(5)) {
        pg8::Gemm g{CB, (const bf16*)(ws + WS_WCO), T, DM, 512}; pg8::StaticOrder S; S.init(T, DM, G, blk);
        EpiMix<false> E{GC, H};
        pg8::gemm_phase<EpiMix<false>, true, true>(lds, g, S, E);
    }
    SEAM(5);
    if (IN(6)) {
        pg8::Gemm g{Qb, (const bf16*)(ws + WS_WAO), T, DM, 512}; pg8::StaticOrder S; S.init(T, DM, G, blk);
        EpiMix<true> E{GA, H};
        pg8::gemm_phase<EpiMix<true>, true, true>(lds, g, S, E);
    }
    SEAM(6);
    if (IN(7)) {
        pg8::Gemm g{H, (const bf16*)(ws + WS_WO), T, DM, DM}; pg8::StaticOrder S; S.init(T, DM, G, blk);
        EpiRes E{a.in[0], MOD, a.out};
        pg8::gemm_phase<EpiRes, true, true>(lds, g, S, E);
    }
    SEAM(7);
    if (IN(8)) norm_phase(a.out, a.in[12], MOD, 3072, H, G, blk);
    SEAM(8);
    if (IN(9)) {
        pg8::Gemm g{H, (const bf16*)(ws + WS_WPQ), T, DM, DM}; pg8::StaticOrder S; S.init(T, DM, G, blk);
        EpiPlain E{PQ};
        pg8::gemm_phase<EpiPlain, true, true>(lds, g, S, E);
    }
    SEAM(9);
    if (IN(10)) peer_route_phase(lds, PQ, (const bf16*)(ws + WS_SK), EIDX, EG, G, blk);
    SEAM(10);
    if (IN(11)) peer_gather_phase(H, (const bf16*)(ws + WS_PU), (const bf16*)(ws + WS_PV), EIDX, EG, MOD, a.out, G, blk);
#undef IN
#undef SEAM
}

#ifndef MK_N_LAUNCHES
#define MK_N_LAUNCHES 12
#endif
extern "C" void kernel_launch(void* const* d_in, const int* in_sizes, int n_in, void* d_out, int out_size, void* d_ws, size_t ws_size, hipStream_t stream) {
    static int grid = 0;
    if (grid == 0) {
        if (n_in != 17 || in_sizes[0] != T * DM || out_size != T * DM || ws_size < WS_END) {
            fprintf(stderr, "kernel_launch: unexpected problem: n_in %d in0 %d out %d ws %zu (need %zu); nothing launched\n", n_in, n_in > 0 ? in_sizes[0] : -1, out_size, ws_size, (size_t)WS_END); grid = -1; return; }
        int dev = 0, cus = 0, per_cu = 0;
        hipGetDevice(&dev); hipDeviceGetAttribute(&cus, hipDeviceAttributeMultiprocessorCount, dev);
        if (hipFuncSetAttribute((const void*)mk_fwd, hipFuncAttributeMaxDynamicSharedMemorySize, LDS_BYTES) != hipSuccess) { fprintf(stderr, "kernel_launch: hipFuncSetAttribute failed\n"); grid = -1; return; }
        if (hipOccupancyMaxActiveBlocksPerMultiprocessor(&per_cu, (const void*)mk_fwd, NWAVES * 64, LDS_BYTES) != hipSuccess || per_cu < 1) { fprintf(stderr, "kernel_launch: occupancy query says %d blocks per CU\n", per_cu); grid = -1; return; }
        grid = cus;
    }
    if (grid < 0) return;
    Args a{};
    for (int i = 0; i < 17; ++i) a.in[i] = (const float*)d_in[i];
    a.out = (float*)d_out; a.ws = (unsigned char*)d_ws;
    for (int li = 0; li < MK_N_LAUNCHES; ++li) {
        a.ph_lo = li * (N_PHASES / MK_N_LAUNCHES); a.ph_hi = (li + 1) * (N_PHASES / MK_N_LAUNCHES);
        void* args[] = {&a};
        hipError_t e = hipLaunchCooperativeKernel((const void*)mk_fwd, dim3(grid), dim3(NWAVES * 64), args, LDS_BYTES, stream);
        if (e != hipSuccess) { fprintf(stderr, "kernel_launch: cooperative launch %d failed: %s (grid %d)\n", li, hipGetErrorString(e), grid); break; }
    }
}
```

```cpp
#include <hip/hip_runtime.h>
#include <hip/hip_cooperative_groups.h>
#include <cstdio>
#include <cstdint>
namespace cg = cooperative_groups;

#define LAS __attribute__((address_space(3)))
typedef unsigned short bf16;
typedef short bf16x8 __attribute__((ext_vector_type(8)));
typedef short s16x4 __attribute__((ext_vector_type(4)));
typedef float f32x2 __attribute__((ext_vector_type(2)));
typedef float f32x4 __attribute__((ext_vector_type(4)));
typedef float f32x16 __attribute__((ext_vector_type(16)));
typedef unsigned u32x2 __attribute__((ext_vector_type(2)));
typedef unsigned u32x4 __attribute__((ext_vector_type(4)));
typedef __bf16 bf16x2_t __attribute__((ext_vector_type(2)));

__device__ __forceinline__ unsigned pk2(float lo, float hi) { f32x2 v = {lo, hi}; bf16x2_t b = __builtin_convertvector(v, bf16x2_t); return __builtin_bit_cast(unsigned, b); }
__device__ __forceinline__ float bflo(unsigned u) { return __uint_as_float(u << 16); }
__device__ __forceinline__ float bfhi(unsigned u) { return __uint_as_float(u & 0xffff0000u); }
__device__ __forceinline__ float wave_sum(float v) {
#pragma unroll
    for (int o = 1; o < 64; o <<= 1) v += __shfl_xor(v, o);
    return v;
}
__device__ __forceinline__ unsigned ordf(float f) { unsigned u = __float_as_uint(f); return u ^ ((u & 0x80000000u) ? 0xffffffffu : 0x80000000u); }
__device__ __forceinline__ float unordf(unsigned u) { return __uint_as_float((u & 0x80000000u) ? (u ^ 0x80000000u) : ~u); }
#define LDS_WAIT() asm volatile("s_waitcnt lgkmcnt(0)" ::: "memory")

constexpr int NB = 16, SEQ = 4096, DM = 1024, T = NB * SEQ;
constexpr int NIN_PAD = 5888;
constexpr float EPS = 1e-6f;
constexpr float C2 = 0.125f * 1.4426950408889634f;
constexpr int NWAVES = 8;

constexpr size_t MiB = 1u << 20;
constexpr size_t WS_MOD = 1 * MiB;
constexpr size_t WS_WIN = 2 * MiB;
constexpr size_t WS_WCO = 14 * MiB;
constexpr size_t WS_WAO = 15 * MiB;
constexpr size_t WS_WO = 16 * MiB;
constexpr size_t WS_WPQ = 18 * MiB;
constexpr size_t WS_SK = 20 * MiB;
constexpr size_t WS_PU = 32 * MiB;
constexpr size_t WS_PV = 64 * MiB;
constexpr size_t WS_H = 96 * MiB;
constexpr size_t WS_CB = 224 * MiB;
constexpr size_t WS_CC = 288 * MiB;
constexpr size_t WS_CX = 352 * MiB;
constexpr size_t WS_Q = 416 * MiB;
constexpr size_t WS_K = 480 * MiB;
constexpr size_t WS_V = 544 * MiB;
constexpr size_t WS_QI = 608 * MiB;
constexpr size_t WS_GC = 672 * MiB;
constexpr size_t WS_GA = 800 * MiB;
constexpr size_t WS_KI = 928 * MiB;
constexpr size_t WS_WI = 936 * MiB;
constexpr size_t WS_MASK = 938 * MiB;
constexpr size_t WS_END = 970 * MiB;
constexpr size_t WS_PQ = WS_CC;
constexpr size_t WS_EIDX = WS_K;
constexpr size_t WS_EG = WS_K + 16 * MiB;

constexpr int LDS_BYTES = 147456;

namespace pg8 {
constexpr int BM = 256, BK = 64, HALF = 128, HTB = HALF * BK * 2, STAGE_BYTES = 8 * HTB, NXCD = 8, WGM = 8;
__host__ __device__ __forceinline__ int lds_byte(int r, int c) { const int st = (r >> 4) * 2 + (c >> 5), rr = r & 15, cc = c & 31, ob = rr * 64 + cc * 2; return st * 1024 + (ob ^ (((ob >> 9) & 1) << 5)); }
__host__ __device__ __forceinline__ void stage_rc(int b, int& R, int& C) { const int st = b / 1024, sb = b % 1024, swz = sb ^ (((sb >> 9) & 1) << 5); R = (st >> 1) * 16 + swz / 64; C = (st & 1) * 32 + (swz % 64) / 2; }
__host__ __device__ __forceinline__ int perm32(int rho) { const int n = rho >> 4, i = rho & 15; return 8 * (i >> 2) + 4 * n + (i & 3); }
struct Unit { int pm, pn; };
struct Gemm { const bf16* A; const bf16* Bt; int M, N, K; };
struct StaticOrder {
    int nM, nN, nwg, G, c;
    __device__ void init(int M, int N, int G_, int c_) { nM = M / BM; nN = N / BM; nwg = nM * nN; G = G_; c = c_; }
    __device__ bool next(int i, Unit& u) const {
        const long L = (long)i * G + c; if (L >= nwg) return false;
        int wgid = (int)L; { const int q = nwg / NXCD, r = nwg % NXCD, xcd = wgid % NXCD, off = wgid / NXCD; wgid = (xcd < r ? xcd * (q + 1) : r * (q + 1) + (xcd - r) * q) + off; }
        const int nig = WGM * nN, gid = wgid / nig, fm = gid * WGM, gsz = (nM - fm) < WGM ? (nM - fm) : WGM;
        u.pm = fm + ((wgid % nig) % gsz); u.pn = (wgid % nig) / gsz; return true;
    }
};

template <class Epi, bool ALIGN_EPI, bool SP2>
__device__ __forceinline__ void gemm_phase(LAS unsigned char* lds, const Gemm g, const StaticOrder& S, const Epi& E) {
    const int tid = threadIdx.x, wid = __builtin_amdgcn_readfirstlane(tid >> 6), lane = tid & 63, wr = wid >> 2, wc = wid & 3, fr = lane & 15, fq = lane >> 4;
    const int K = g.K, nt = K / BK;
    unsigned voffA[2], voffB[2];
#pragma unroll
    for (int i = 0; i < 2; ++i) { int R, C; stage_rc(tid * 16 + i * 8192, R, C); const int Rb = Epi::PERM ? ((R & ~31) + perm32(R & 31)) : R;
        voffA[i] = (unsigned)(R * K + C) * 2u; voffB[i] = (unsigned)(Rb * K + C) * 2u; }
    const size_t kstep = (size_t)(BK * 2);
    const size_t hstep = (size_t)HALF * K * 2;
    const size_t tstep = 2 * hstep;
    const unsigned ldsw = (unsigned)wid * 1024u;
    const int aoff = lds_byte(wr * 64 + fr, fq * 8), boff = lds_byte(wc * 32 + fr, fq * 8);
#define PG8_SA(b, h) (((b) * 2 + (h)) * HTB)
#define PG8_SB(b, h) ((4 + (b) * 2 + (h)) * HTB)
#define PG8_STAGE(bufoff, gbase, voff) do { _Pragma("unroll") for (int _i = 0; _i < 2; ++_i) \
        __builtin_amdgcn_global_load_lds((const unsigned*)((const char*)(gbase) + (voff)[_i]), (LAS unsigned*)(lds + (bufoff) + ldsw + _i * 8192), 16, 0, 0); } while (0)
#define PG8_LDA(dst, b, h) do { _Pragma("unroll") for (int m = 0; m < 4; ++m) _Pragma("unroll") for (int k = 0; k < 2; ++k) dst[m][k] = *(const LAS bf16x8*)(lds + PG8_SA(b, h) + aoff + m * 2048 + k * 1024); } while (0)
#define PG8_LDB(dst, b, h) do { _Pragma("unroll") for (int n = 0; n < 2; ++n) _Pragma("unroll") for (int k = 0; k < 2; ++k) dst[n][k] = *(const LAS bf16x8*)(lds + PG8_SB(b, h) + boff + n * 2048 + k * 1024); } while (0)
#define PG8_MMA(ai, bj, At, Bt) do { __builtin_amdgcn_s_setprio(1); _Pragma("unroll") for (int m = 0; m < 4; ++m) _Pragma("unroll") for (int n = 0; n < 2; ++n) _Pragma("unroll") for (int k = 0; k < 2; ++k) \
        acc[ai][bj][m][n] = __builtin_amdgcn_mfma_f32_16x16x32_bf16(Bt[n][k], At[m][k], acc[ai][bj][m][n], 0, 0, 0); __builtin_amdgcn_s_setprio(0); } while (0)
#define PG8_WAIT_V(n) asm volatile("s_waitcnt vmcnt(" #n ")" ::: "memory")
#define PG8_WAIT_L(n) asm volatile("s_waitcnt lgkmcnt(" #n ")" ::: "memory")
#define PG8_BAR __builtin_amdgcn_s_barrier()
#define PG8_SCHED __builtin_amdgcn_sched_barrier(0)
    Unit cur, nxt; int ui = 0;
    if (!S.next(0, cur)) return;
    f32x4 acc[2][2][4][2];
#pragma unroll
    for (int a = 0; a < 2; ++a)
#pragma unroll
        for (int b = 0; b < 2; ++b)
#pragma unroll
            for (int m = 0; m < 4; ++m)
#pragma unroll
                for (int n = 0; n < 2; ++n) acc[a][b][m][n] = (f32x4){0.f, 0.f, 0.f, 0.f};
    bf16x8 At[4][2], B0[2][2], B1[2][2];
    const char* cA = (const char*)g.A + (size_t)cur.pm * tstep; const char* cB = (const char*)g.Bt + (size_t)cur.pn * tstep;
    if constexpr (SP2) {
        PG8_STAGE(PG8_SB(0, 0), cB, voffB); PG8_STAGE(PG8_SB(0, 1), cB + hstep, voffB); PG8_STAGE(PG8_SA(0, 0), cA, voffA); PG8_STAGE(PG8_SA(0, 1), cA + hstep, voffA);
        if (wr == 1) PG8_BAR;
        PG8_WAIT_V(2); PG8_BAR;
        PG8_STAGE(PG8_SB(1, 0), cB + kstep, voffB); PG8_STAGE(PG8_SA(1, 0), cA + kstep, voffA); PG8_STAGE(PG8_SB(1, 1), cB + hstep + kstep, voffB);
        PG8_WAIT_V(6); PG8_BAR;
    } else {
        PG8_STAGE(PG8_SB(0, 0), cB, voffB); PG8_STAGE(PG8_SA(0, 0), cA, voffA); PG8_STAGE(PG8_SB(0, 1), cB + hstep, voffB); PG8_STAGE(PG8_SA(0, 1), cA + hstep, voffA);
        if (wr == 1) PG8_BAR;
        PG8_WAIT_V(4); PG8_BAR;
        PG8_STAGE(PG8_SB(1, 0), cB + kstep, voffB); PG8_STAGE(PG8_SA(1, 0), cA + kstep, voffA); PG8_STAGE(PG8_SB(1, 1), cB + hstep + kstep, voffB);
        PG8_WAIT_V(6); PG8_BAR;
    }
    for (;;) {
        const bool has_next = S.next(ui + 1, nxt);
        const char* nA = has_next ? (const char*)g.A + (size_t)nxt.pm * tstep : cA; const char* nB = has_next ? (const char*)g.Bt + (size_t)nxt.pn * tstep : cB;
        for (int t = 0; t < nt; t += 2) {
            const bool last = (t == nt - 2);
            const char* a1 = cA + (size_t)(t + 1) * kstep;
            const char* a2 = last ? nA : cA + (size_t)(t + 2) * kstep; const char* b2 = last ? nB : cB + (size_t)(t + 2) * kstep;
            const char* a3 = a2 + kstep; const char* b3 = b2 + kstep;
            if constexpr (SP2) {
            PG8_LDB(B0, 0, 0); PG8_LDB(B1, 0, 1); PG8_SCHED; PG8_LDA(At, 0, 0); PG8_STAGE(PG8_SA(1, 1), a1 + hstep, voffA);
            PG8_WAIT_V(8); PG8_WAIT_L(0); PG8_BAR; PG8_MMA(0, 0, At, B0); PG8_MMA(0, 1, At, B1); PG8_BAR; PG8_SCHED;
            PG8_LDA(At, 0, 1); PG8_STAGE(PG8_SB(0, 0), b2, voffB); PG8_STAGE(PG8_SB(0, 1), b2 + hstep, voffB); PG8_STAGE(PG8_SA(0, 0), a2, voffA);
            PG8_WAIT_V(8); PG8_WAIT_L(0); PG8_BAR; PG8_MMA(1, 0, At, B0); PG8_MMA(1, 1, At, B1); PG8_BAR; PG8_SCHED;
            PG8_LDB(B0, 1, 0); PG8_LDB(B1, 1, 1); PG8_SCHED; PG8_LDA(At, 1, 0); PG8_STAGE(PG8_SA(0, 1), a2 + hstep, voffA);
            PG8_WAIT_V(8); PG8_WAIT_L(0); PG8_BAR; PG8_MMA(0, 0, At, B0); PG8_MMA(0, 1, At, B1); PG8_BAR; PG8_SCHED;
            PG8_LDA(At, 1, 1); PG8_STAGE(PG8_SB(1, 0), b3, voffB); PG8_STAGE(PG8_SB(1, 1), b3 + hstep, voffB); PG8_STAGE(PG8_SA(1, 0), a3, voffA);
            PG8_WAIT_V(8); PG8_WAIT_L(0); PG8_BAR; PG8_MMA(1, 0, At, B0); PG8_MMA(1, 1, At, B1); PG8_BAR; PG8_SCHED;
            } else {
            PG8_LDB(B0, 0, 0); PG8_SCHED; PG8_LDA(At, 0, 0); PG8_STAGE(PG8_SA(1, 1), a1 + hstep, voffA);
            PG8_WAIT_L(8); PG8_BAR; PG8_WAIT_L(0); PG8_MMA(0, 0, At, B0); PG8_BAR; PG8_SCHED;
            PG8_LDB(B1, 0, 1); PG8_STAGE(PG8_SB(0, 0), b2, voffB);
            PG8_BAR; PG8_WAIT_L(0); PG8_MMA(0, 1, At, B1); PG8_BAR;
            PG8_LDA(At, 0, 1); PG8_STAGE(PG8_SA(0, 0), a2, voffA);
            PG8_BAR; PG8_WAIT_L(0); PG8_MMA(1, 0, At, B0); PG8_BAR; PG8_SCHED;
            PG8_STAGE(PG8_SB(0, 1), b2 + hstep, voffB);
            PG8_WAIT_V(6); PG8_BAR; PG8_MMA(1, 1, At, B1); PG8_BAR;
            PG8_LDB(B0, 1, 0); PG8_SCHED; PG8_LDA(At, 1, 0); PG8_STAGE(PG8_SA(0, 1), a2 + hstep, voffA);
            PG8_WAIT_L(8); PG8_BAR; PG8_WAIT_L(0); PG8_MMA(0, 0, At, B0); PG8_BAR; PG8_SCHED;
            PG8_LDB(B1, 1, 1); PG8_STAGE(PG8_SB(1, 0), b3, voffB);
            PG8_BAR; PG8_WAIT_L(0); PG8_MMA(0, 1, At, B1); PG8_BAR;
            PG8_LDA(At, 1, 1); PG8_STAGE(PG8_SA(1, 0), a3, voffA);
            PG8_BAR; PG8_WAIT_L(0); PG8_MMA(1, 0, At, B0); PG8_BAR; PG8_SCHED;
            PG8_STAGE(PG8_SB(1, 1), b3 + hstep, voffB);
            PG8_WAIT_V(6); PG8_BAR; PG8_MMA(1, 1, At, B1); PG8_BAR;
            }
        }
        if constexpr (ALIGN_EPI) { if (wr == 0) PG8_BAR; }
        E(acc, cur, wr, wc, fr, fq);
        if (!has_next) break;
#pragma unroll
        for (int a = 0; a < 2; ++a)
#pragma unroll
            for (int b = 0; b < 2; ++b)
#pragma unroll
                for (int m = 0; m < 4; ++m)
#pragma unroll
                    for (int n = 0; n < 2; ++n) acc[a][b][m][n] = (f32x4){0.f, 0.f, 0.f, 0.f};
        cur = nxt; cA = nA; cB = nB; ++ui;
        if constexpr (ALIGN_EPI) { if (wr == 1) PG8_BAR; }
    }
    PG8_WAIT_V(0);
    if constexpr (!ALIGN_EPI) { if (wr == 0) PG8_BAR; }
    PG8_BAR;
#undef PG8_SA
#undef PG8_SB
#undef PG8_STAGE
#undef PG8_LDA
#undef PG8_LDB
#undef PG8_MMA
#undef PG8_WAIT_V
#undef PG8_WAIT_L
#undef PG8_BAR
#undef PG8_SCHED
}
}

typedef const f32x4 (&AccRef)[2][2][4][2];

__device__ __forceinline__ u32x4 pack8(f32x4 v0, f32x4 v1) { u32x4 w; w.x = pk2(v0[0], v0[1]); w.y = pk2(v0[2], v0[3]); w.z = pk2(v1[0], v1[1]); w.w = pk2(v1[2], v1[3]); return w; }
__device__ __forceinline__ float sigm(float x) { return __builtin_amdgcn_rcpf(1.f + __builtin_amdgcn_exp2f(-1.4426950408889634f * x)); }

struct EpiInProj {
    static constexpr bool PERM = true;
    bf16 *CB, *CC, *CX, *Q, *K, *V, *QI, *GC, *GA, *KI; float* WI; const float* qnw; const float* knw;
    __device__ __forceinline__ void operator()(AccRef acc, const pg8::Unit& u, int wr, int wc, int fr, int fq) const {
        const int pn = u.pn; const size_t row0 = (size_t)u.pm * 256 + wr * 64 + fr;
        if (pn < 6 || (pn >= 10 && pn < 14)) {
            bf16* base = pn < 2 ? CB : pn < 4 ? CC : pn < 6 ? CX : pn < 12 ? V : QI;
            const int col0 = (pn & 1) * 256 + wc * 32 + 8 * fq;
#pragma unroll
            for (int ai = 0; ai < 2; ++ai)
#pragma unroll
                for (int m = 0; m < 4; ++m) { bf16* rowp = base + (row0 + ai * 128 + m * 16) * 512 + col0;
#pragma unroll
                    for (int bj = 0; bj < 2; ++bj) *(u32x4*)(rowp + bj * 128) = pack8(acc[ai][bj][m][0], acc[ai][bj][m][1]); }
        } else if (pn < 10) {
            const bool isq = pn < 8; bf16* base = isq ? Q : K; const float* nw = isq ? qnw : knw; const float sc = isq ? C2 : 1.f;
            const int head = 4 * (pn & 1) + wc;
            f32x4 w[2][2];
#pragma unroll
            for (int bj = 0; bj < 2; ++bj)
#pragma unroll
                for (int n = 0; n < 2; ++n) w[bj][n] = *(const f32x4*)(nw + 32 * bj + 8 * fq + 4 * n) * sc;
#pragma unroll
            for (int ai = 0; ai < 2; ++ai)
#pragma unroll
                for (int m = 0; m < 4; ++m) {
                    float ss = 0.f;
#pragma unroll
                    for (int bj = 0; bj < 2; ++bj)
#pragma unroll
                        for (int n = 0; n < 2; ++n) { const f32x4 x = acc[ai][bj][m][n]; ss += (x[0] * x[0] + x[1] * x[1]) + (x[2] * x[2] + x[3] * x[3]); }
                    ss += __shfl_xor(ss, 16); ss += __shfl_xor(ss, 32);
                    const float r = __builtin_amdgcn_rsqf(ss * (1.f / 64.f) + EPS);
                    bf16* rowp = base + (row0 + ai * 128 + m * 16) * 512 + head * 64 + 8 * fq;
#pragma unroll
                    for (int bj = 0; bj < 2; ++bj) *(u32x4*)(rowp + bj * 32) = pack8(acc[ai][bj][m][0] * r * w[bj][0], acc[ai][bj][m][1] * r * w[bj][1]);
                }
        } else if (pn < 22) {
            bf16* base = pn < 18 ? GC : GA; const int col0 = ((pn - 14) & 3) * 256 + wc * 32 + 8 * fq;
#pragma unroll
            for (int ai = 0; ai < 2; ++ai)
#pragma unroll
                for (int m = 0; m < 4; ++m) { bf16* rowp = base + (row0 + ai * 128 + m * 16) * 1024 + col0;
#pragma unroll
                    for (int bj = 0; bj < 2; ++bj) { f32x4 a = acc[ai][bj][m][0], b = acc[ai][bj][m][1];
#pragma unroll
                        for (int j = 0; j < 4; ++j) { a[j] = sigm(a[j]); b[j] = sigm(b[j]); }
                        *(u32x4*)(rowp + bj * 128) = pack8(a, b); } }
        } else {
            if (wc < 2) {
#pragma unroll
                for (int ai = 0; ai < 2; ++ai)
#pragma unroll
                    for (int m = 0; m < 4; ++m) *(u32x4*)(KI + (row0 + ai * 128 + m * 16) * 64 + wc * 32 + 8 * fq) = pack8(acc[ai][0][m][0], acc[ai][0][m][1]);
            } else if (wc == 2 && fq == 0) {
#pragma unroll
                for (int ai = 0; ai < 2; ++ai)
#pragma unroll
                    for (int m = 0; m < 4; ++m) { float* p = WI + (row0 + ai * 128 + m * 16) * 8; *(f32x4*)p = acc[ai][0][m][0]; *(f32x4*)(p + 4) = acc[ai][0][m][1]; }
            }
        }
    }
};

template <bool ADD> struct EpiMix {
    static constexpr bool PERM = true;
    const bf16* G; bf16* MIX;
    __device__ __forceinline__ void operator()(AccRef acc, const pg8::Unit& u, int wr, int wc, int fr, int fq) const {
        const size_t row0 = (size_t)u.pm * 256 + wr * 64 + fr; const int col0 = u.pn * 256 + wc * 32 + 8 * fq;
#pragma unroll
        for (int ai = 0; ai < 2; ++ai)
#pragma unroll
            for (int m = 0; m < 4; ++m) { const size_t off = (row0 + ai * 128 + m * 16) * 1024 + col0;
#pragma unroll
                for (int bj = 0; bj < 2; ++bj) {
                    const u32x4 g = *(const u32x4*)(G + off + bj * 128);
                    f32x4 a = acc[ai][bj][m][0], b = acc[ai][bj][m][1];
                    a[0] *= bflo(g.x); a[1] *= bfhi(g.x); a[2] *= bflo(g.y); a[3] *= bfhi(g.y); b[0] *= bflo(g.z); b[1] *= bfhi(g.z); b[2] *= bflo(g.w); b[3] *= bfhi(g.w);
                    if (ADD) { const u32x4 p = *(const u32x4*)(MIX + off + bj * 128);
                        a[0] += bflo(p.x); a[1] += bfhi(p.x); a[2] += bflo(p.y); a[3] += bfhi(p.y); b[0] += bflo(p.z); b[1] += bfhi(p.z); b[2] += bflo(p.w); b[3] += bfhi(p.w); }
                    *(u32x4*)(MIX + off + bj * 128) = pack8(a, b); } }
    }
};

struct EpiRes {
    static constexpr bool PERM = false;
    const float* X; const float* MOD; float* OUT;
    __device__ __forceinline__ void operator()(AccRef acc, const pg8::Unit& u, int wr, int wc, int fr, int fq) const {
        const size_t row0 = (size_t)u.pm * 256 + wr * 64 + fr; const int col0 = u.pn * 256 + wc * 32 + 4 * fq;
        const float* g1 = MOD + (size_t)(u.pm >> 4) * 6144 + 2048;
        f32x4 gv[2][2];
#pragma unroll
        for (int bj = 0; bj < 2; ++bj)
#pragma unroll
            for (int n = 0; n < 2; ++n) gv[bj][n] = *(const f32x4*)(g1 + col0 + bj * 128 + n * 16);
#pragma unroll
        for (int ai = 0; ai < 2; ++ai)
#pragma unroll
            for (int m = 0; m < 4; ++m) { const size_t off = (row0 + ai * 128 + m * 16) * 1024 + col0;
#pragma unroll
                for (int bj = 0; bj < 2; ++bj)
#pragma unroll
                    for (int n = 0; n < 2; ++n) *(f32x4*)(OUT + off + bj * 128 + n * 16) = *(const f32x4*)(X + off + bj * 128 + n * 16) + gv[bj][n] * acc[ai][bj][m][n]; }
    }
};

struct EpiPlain {
    static constexpr bool PERM = true;
    bf16* O;
    __device__ __forceinline__ void operator()(AccRef acc, const pg8::Unit& u, int wr, int wc, int fr, int fq) const {
        const size_t row0 = (size_t)u.pm * 256 + wr * 64 + fr; const int col0 = u.pn * 256 + wc * 32 + 8 * fq;
#pragma unroll
        for (int ai = 0; ai < 2; ++ai)
#pragma unroll
            for (int m = 0; m < 4; ++m) { bf16* rowp = O + (row0 + ai * 128 + m * 16) * 1024 + col0;
#pragma unroll
                for (int bj = 0; bj < 2; ++bj) *(u32x4*)(rowp + bj * 128) = pack8(acc[ai][bj][m][0], acc[ai][bj][m][1]); }
    }
};

struct Args { const float* in[17]; float* out; unsigned char* ws; int ph_lo, ph_hi; };

__device__ __forceinline__ void transpose_item(const float* W, int ldw, int k0, int n0, int ncols, bf16* WT, int K, int drow0, LAS float* scr, int lane) {
#pragma unroll 8
    for (int i = 0; i < 32; ++i) { const int kk = 2 * i + (lane >> 5), n = lane & 31; scr[kk * 33 + n] = (n < ncols) ? W[(size_t)(k0 + kk) * ldw + n0 + n] : 0.f; }
    LDS_WAIT(); asm volatile("" ::: "memory");
    const int c = lane & 7;
#pragma unroll
    for (int j = 0; j < 4; ++j) { const int n = (lane >> 3) + 8 * j; const LAS float* s = scr + (8 * c) * 33 + n;
        u32x4 o; o.x = pk2(s[0 * 33], s[1 * 33]); o.y = pk2(s[2 * 33], s[3 * 33]); o.z = pk2(s[4 * 33], s[5 * 33]); o.w = pk2(s[6 * 33], s[7 * 33]);
        *(u32x4*)(WT + (size_t)(drow0 + n) * K + k0 + 8 * c) = o; }
    LDS_WAIT(); asm volatile("" ::: "memory");
}
__device__ __forceinline__ void cvt_stream(const float* src, bf16* dst, size_t n8, size_t i0, size_t stride) {
    for (size_t i = i0; i < n8; i += stride) { const f32x4 a = *(const f32x4*)(src + 8 * i), b = *(const f32x4*)(src + 8 * i + 4); *(u32x4*)(dst + 8 * i) = pack8(a, b); }
}

__device__ __forceinline__ void p0_prologue(LAS unsigned char* lds, const Args& a, int G, int blk) {
    const int tid = threadIdx.x, lane = tid & 63, wave = __builtin_amdgcn_readfirstlane(tid >> 6);
    unsigned char* ws = a.ws;
    for (int task = blk; task < 96; task += G) {
        LAS float* sl = (LAS float*)(lds + 67584);
        for (int i = tid; i < NB * DM; i += 512) { const float v = a.in[1][i]; sl[i] = v * __builtin_amdgcn_rcpf(1.f + __expf(-v)); }
        __syncthreads();
        const int col = task * 64 + lane, kb = wave * 128;
        float acc[16];
#pragma unroll
        for (int b = 0; b < 16; ++b) acc[b] = 0.f;
        const float* wp = a.in[2] + col;
        for (int k = kb; k < kb + 128; k += 4) {
            const float w0 = wp[(size_t)(k + 0) * 6144], w1 = wp[(size_t)(k + 1) * 6144], w2 = wp[(size_t)(k + 2) * 6144], w3 = wp[(size_t)(k + 3) * 6144];
#pragma unroll
            for (int b = 0; b < 16; ++b) { const f32x4 s = *(const LAS f32x4*)(sl + b * 1024 + k); acc[b] += (s[0] * w0 + s[1] * w1) + (s[2] * w2 + s[3] * w3); }
        }
        LAS float* red = (LAS float*)lds;
#pragma unroll
        for (int b = 0; b < 16; ++b) red[(wave * 16 + b) * 64 + lane] = acc[b];
        __syncthreads();
        for (int o = tid; o < 1024; o += 512) { const int b = o >> 6, cl = o & 63; float s = 0.f;
#pragma unroll
            for (int w = 0; w < 8; ++w) s += red[(w * 16 + b) * 64 + cl];
            ((float*)(ws + WS_MOD))[b * 6144 + task * 64 + cl] = s + a.in[3][task * 64 + cl]; }
        __syncthreads();
    }
    LAS float* scr = (LAS float*)(lds + wave * 8448);
    const int gw = blk * NWAVES + wave, NGW = G * NWAVES;
    constexpr int I_IN = 184 * 16, I_CO = 8 * 32, I_AO = 8 * 32, I_O = 16 * 32, I_PQ = 16 * 32;
    for (int it = gw; it < I_IN + I_CO + I_AO + I_O + I_PQ; it += NGW) {
        int r = it;
        if (r < I_IN) {
            const int dg = r >> 4, kb = r & 15, tile = dg >> 3, gi = dg & 7; int src, nc = 32;
            if (tile < 6 || (tile >= 10 && tile < 14)) src = 32 * dg;
            else if (tile < 10) src = tile * 256 + 32 * (2 * (gi & 3) + (gi >> 2));
            else if (tile < 22) src = 3656 + 32 * (dg - 112);
            else { if (gi < 2) src = 3584 + 32 * gi; else if (gi == 2) { src = 3648; nc = 8; } else { src = 0; nc = 0; } }
            transpose_item(a.in[5], 5704, kb * 64, src, nc, (bf16*)(ws + WS_WIN), 1024, dg * 32, scr, lane); continue; }
        r -= I_IN;
        if (r < I_CO) { transpose_item(a.in[7], 1024, (r >> 5) * 64, (r & 31) * 32, 32, (bf16*)(ws + WS_WCO), 512, (r & 31) * 32, scr, lane); continue; } r -= I_CO;
        if (r < I_AO) { transpose_item(a.in[10], 1024, (r >> 5) * 64, (r & 31) * 32, 32, (bf16*)(ws + WS_WAO), 512, (r & 31) * 32, scr, lane); continue; } r -= I_AO;
        if (r < I_O) { transpose_item(a.in[11], 1024, (r >> 5) * 64, (r & 31) * 32, 32, (bf16*)(ws + WS_WO), 1024, (r & 31) * 32, scr, lane); continue; } r -= I_O;
        transpose_item(a.in[13], 1024, (r >> 5) * 64, (r & 31) * 32, 32, (bf16*)(ws + WS_WPQ), 1024, (r & 31) * 32, scr, lane);
    }
    const size_t gt = (size_t)blk * 512 + tid, NT_ = (size_t)G * 512;
    cvt_stream(a.in[14], (bf16*)(ws + WS_SK), (size_t)16 * 128 * 64 / 8, gt, NT_);
    cvt_stream(a.in[15], (bf16*)(ws + WS_PU), (size_t)16384 * 1024 / 8, gt, NT_);
    cvt_stream(a.in[16], (bf16*)(ws + WS_PV), (size_t)16384 * 1024 / 8, gt, NT_);
}

__device__ __forceinline__ void norm_mod_row(const float* xrow, const float* nw, const float* sh, const float* sc, bf16* orow, int lane) {
    const f32x4* xr = (const f32x4*)xrow + lane;
    f32x4 v[4]; float s = 0.f;
#pragma unroll
    for (int j = 0; j < 4; ++j) { v[j] = xr[64 * j]; s += (v[j].x * v[j].x + v[j].y * v[j].y) + (v[j].z * v[j].z + v[j].w * v[j].w); }
    const float r = __builtin_amdgcn_rsqf(wave_sum(s) * (1.f / DM) + EPS);
    unsigned long long* o8 = (unsigned long long*)orow + lane;
#pragma unroll
    for (int j = 0; j < 4; ++j) {
        const f32x4 w = ((const f32x4*)nw)[lane + 64 * j], a = ((const f32x4*)sc)[lane + 64 * j], b = ((const f32x4*)sh)[lane + 64 * j];
        const f32x4 h = (v[j] * r * w) * (a + 1.f) + b;
        o8[64 * j] = (unsigned long long)pk2(h.x, h.y) | ((unsigned long long)pk2(h.z, h.w) << 32);
    }
}
__device__ __forceinline__ void norm_phase(const float* X, const float* nw, const float* MOD, int sh_off, bf16* O, int G, int blk) {
    const int lane = threadIdx.x & 63, wave = __builtin_amdgcn_readfirstlane(threadIdx.x >> 6);
    for (int m = blk * NWAVES + wave; m < T; m += G * NWAVES) {
        const float* md = MOD + (size_t)(m >> 12) * 6144 + sh_off;
        norm_mod_row(X + (size_t)m * DM, nw, md, md + 1024, O + (size_t)m * DM, lane);
    }
}

__device__ __forceinline__ void conv_phase(bf16* CB, const bf16* CC, const bf16* CX, const float* cw, int G, int blk) {
    const size_t n = (size_t)T * 64;
    for (size_t i = (size_t)blk * 512 + threadIdx.x; i < n; i += (size_t)G * 512) {
        const int c8 = (int)(i & 63) * 8; const size_t row = i >> 6; const int t = (int)(row & (SEQ - 1));
        float accv[8];
#pragma unroll
        for (int e = 0; e < 8; ++e) accv[e] = 0.f;
#pragma unroll
        for (int j = 0; j < 3; ++j) {
            if (t - 2 + j >= 0) {
                const size_t off = (row - 2 + j) * 512 + c8;
                const u32x4 a = *(const u32x4*)(CC + off), b = *(const u32x4*)(CX + off);
                const f32x4 w0 = *(const f32x4*)(cw + j * 512 + c8), w1 = *(const f32x4*)(cw + j * 512 + c8 + 4);
                accv[0] += w0[0] * bflo(a.x) * bflo(b.x); accv[1] += w0[1] * bfhi(a.x) * bfhi(b.x);
                accv[2] += w0[2] * bflo(a.y) * bflo(b.y); accv[3] += w0[3] * bfhi(a.y) * bfhi(b.y);
                accv[4] += w1[0] * bflo(a.z) * bflo(b.z); accv[5] += w1[1] * bfhi(a.z) * bfhi(b.z);
                accv[6] += w1[2] * bflo(a.w) * bflo(b.w); accv[7] += w1[3] * bfhi(a.w) * bfhi(b.w);
            }
        }
        const u32x4 g = *(const u32x4*)(CB + row * 512 + c8);
        u32x4 o; o.x = pk2(accv[0] * bflo(g.x), accv[1] * bfhi(g.x)); o.y = pk2(accv[2] * bflo(g.y), accv[3] * bfhi(g.y));
        o.z = pk2(accv[4] * bflo(g.z), accv[5] * bfhi(g.z)); o.w = pk2(accv[6] * bflo(g.w), accv[7] * bfhi(g.w));
        *(u32x4*)(CB + row * 512 + c8) = o;
    }
}

template <int NR> __device__ __forceinline__ void select_query(const LAS unsigned* row, int nvalid, int tq, unsigned long long* mrow, int lane) {
    unsigned k[NR];
#pragma unroll
    for (int r = 0; r < NR; ++r) { const int idx = 64 * r + lane; k[r] = idx < nvalid ? row[idx] : 0u; }
    unsigned tau = 0u;
    if (tq >= 256) {
        for (int bit = 31; bit >= 0; --bit) {
            const unsigned cand = tau | (1u << bit);
            int cnt = 0;
#pragma unroll
            for (int r = 0; r < NR; ++r) cnt += __popcll(__ballot(k[r] >= cand));
            if (cnt >= 256) tau = cand;
            if (cnt == 256) break;
        }
    }
    if (tau == 0u) tau = 1u;
    unsigned long long mine = 0ull;
#pragma unroll
    for (int r = 0; r < NR; ++r) { const unsigned long long m = __ballot(k[r] >= tau); if (lane == r) mine = m; }
    mrow[lane] = mine;
}

__device__ __forceinline__ void indexer_phase(LAS unsigned char* lds, const bf16* QI, const bf16* KI, const float* WI, unsigned long long* MASK, int G, int blk) {
    LAS unsigned* sc = (LAS unsigned*)lds;
    const int tid = threadIdx.x, lane = tid & 63, wave = __builtin_amdgcn_readfirstlane(tid >> 6), r32 = lane & 31, hi = lane >> 5;
    const int ra = (r32 >> 4) & 1, rb = (r32 >> 3) & 1, rc = (r32 >> 2) & 1, rd = r32 & 3;
    for (int uid = blk; uid < T / 8; uid += G) {
        const int b = uid >> 9; int j = uid & 511; if (j >= 256) j = 767 - j;
        const int tq0 = 8 * j; const size_t row0 = (size_t)b * SEQ + tq0;
        const int nkt = (tq0 + 8 + 31) >> 5;
        bf16x8 aq[2][4]; f32x4 wv[2][2][2];
#pragma unroll
        for (int rt = 0; rt < 2; ++rt) {
            const bf16* qp = QI + (row0 + rt * 4 + 2 * rc + ra) * 512 + (4 * rb + rd) * 64 + hi * 8;
#pragma unroll
            for (int d0 = 0; d0 < 4; ++d0) aq[rt][d0] = *(const bf16x8*)(qp + d0 * 16);
#pragma unroll
            for (int a2 = 0; a2 < 2; ++a2) { const float* wp = WI + (row0 + rt * 4 + 2 * hi + a2) * 8; wv[rt][a2][0] = *(const f32x4*)wp; wv[rt][a2][1] = *(const f32x4*)(wp + 4); }
        }
        for (int kt = wave; kt < nkt; kt += NWAVES) {
            const int key = 32 * kt + r32;
            const bf16* kp = KI + ((size_t)b * SEQ + key) * 64 + hi * 8;
            bf16x8 bk[4];
#pragma unroll
            for (int d0 = 0; d0 < 4; ++d0) bk[d0] = *(const bf16x8*)(kp + d0 * 16);
#pragma unroll
            for (int rt = 0; rt < 2; ++rt) {
                f32x16 acc = {};
#pragma unroll
                for (int d0 = 0; d0 < 4; ++d0) acc = __builtin_amdgcn_mfma_f32_32x32x16_bf16(aq[rt][d0], bk[d0], acc, 0, 0, 0);
#pragma unroll
                for (int a2 = 0; a2 < 2; ++a2) {
                    float s = 0.f;
#pragma unroll
                    for (int i = 0; i < 8; ++i) s += fmaxf(acc[8 * a2 + i], 0.f) * wv[rt][a2][i >> 2][i & 3];
                    const int ql = rt * 4 + 2 * hi + a2;
                    const unsigned ck = (key <= tq0 + ql) ? ((ordf(s) & 0xfffff000u) | (unsigned)(4095 - key)) : 0u;
                    sc[ql * 4096 + key] = ck;
                }
            }
        }
        __syncthreads();
        {
            const int tq = tq0 + wave, nvalid = 32 * nkt;
            unsigned long long* mrow = MASK + (row0 + wave) * 64;
            const LAS unsigned* rowp = sc + wave * 4096;
            if (nvalid <= 1024) select_query<16>(rowp, nvalid, tq, mrow, lane);
            else if (nvalid <= 2048) select_query<32>(rowp, nvalid, tq, mrow, lane);
            else if (nvalid <= 3072) select_query<48>(rowp, nvalid, tq, mrow, lane);
            else select_query<64>(rowp, nvalid, tq, mrow, lane);
        }
        __syncthreads();
    }
}

namespace att {
constexpr int SLOTB = 8192;
constexpr int L_K = 0, L_V = 2 * SLOTB, L_WS = 4 * SLOTB, L_OST = L_WS + NWAVES * 256, L_END = L_OST + NWAVES * 4096;
__device__ __forceinline__ int crow(int r, int hi) { return (r & 3) + 8 * (r >> 2) + 4 * hi; }
#define SBAR() __builtin_amdgcn_sched_barrier(0)
__device__ __forceinline__ void qkt(f32x16& p0, f32x16& p1, const LAS unsigned char* kb, const bf16x8* qr, const f32x16& negm) {
#pragma unroll
    for (int d0 = 0; d0 < 4; ++d0) {
        const bf16x8 b0 = *(const LAS bf16x8*)(kb + d0 * 2048);
        const bf16x8 b1 = *(const LAS bf16x8*)(kb + d0 * 2048 + 512);
        if (d0 == 0) { p0 = __builtin_amdgcn_mfma_f32_32x32x16_bf16(b0, qr[0], negm, 0, 0, 0); p1 = __builtin_amdgcn_mfma_f32_32x32x16_bf16(b1, qr[0], negm, 0, 0, 0); }
        else { p0 = __builtin_amdgcn_mfma_f32_32x32x16_bf16(b0, qr[d0], p0, 0, 0, 0); p1 = __builtin_amdgcn_mfma_f32_32x32x16_bf16(b1, qr[d0], p1, 0, 0, 0); } }
}
__device__ __forceinline__ void pv(f32x16* o, int vb, bf16x8 pa0, bf16x8 pa1, bf16x8 pa2, bf16x8 pa3) {
#pragma unroll
    for (int d0 = 0; d0 < 2; ++d0) { s16x4 lo[4], hi[4];
#pragma unroll
        for (int ks = 0; ks < 4; ++ks) {
            asm volatile("ds_read_b64_tr_b16 %0,%1 offset:%c2" : "=&v"(lo[ks]) : "v"(vb), "i"(d0 * 4096 + ks * 1024) : "memory");
            asm volatile("ds_read_b64_tr_b16 %0,%1 offset:%c2" : "=&v"(hi[ks]) : "v"(vb), "i"(d0 * 4096 + ks * 1024 + 512) : "memory"); }
        asm volatile("s_waitcnt lgkmcnt(0)" ::: "memory"); SBAR();
#define PK(k) (bf16x8){lo[k][0], lo[k][1], lo[k][2], lo[k][3], hi[k][0], hi[k][1], hi[k][2], hi[k][3]}
        o[d0] = __builtin_amdgcn_mfma_f32_32x32x16_bf16(pa0, PK(0), o[d0], 0, 0, 0);
        o[d0] = __builtin_amdgcn_mfma_f32_32x32x16_bf16(pa1, PK(1), o[d0], 0, 0, 0);
        o[d0] = __builtin_amdgcn_mfma_f32_32x32x16_bf16(pa2, PK(2), o[d0], 0, 0, 0);
        o[d0] = __builtin_amdgcn_mfma_f32_32x32x16_bf16(pa3, PK(3), o[d0], 0, 0, 0);
#undef PK
    }
}

__device__ __forceinline__ void attn_phase(LAS unsigned char* lds, bf16* Q, const bf16* K, const bf16* V, const unsigned long long* MASK, const float* qnw, const float* knw, int G, int blk) {
    const int tid = threadIdx.x, lane = tid & 63, r32 = lane & 31, hi = lane >> 5, wid = __builtin_amdgcn_readfirstlane(tid >> 6);
    float mq = fabsf(qnw[lane]), mk = fabsf(knw[lane]);
#pragma unroll
    for (int o = 1; o < 64; o <<= 1) { mq = fmaxf(mq, __shfl_xor(mq, o)); mk = fmaxf(mk, __shfl_xor(mk, o)); }
    const float nb = -(8.f * 1.4426950408889634f) * mq * mk;
    f32x16 negm;
#pragma unroll
    for (int r = 0; r < 16; ++r) negm[r] = nb;
    LAS float* wsf = (LAS float*)(lds + L_WS) + wid * 64;
    const unsigned kdst = L_K + wid * 1024 + lane * 16, vdst = L_V + wid * 1024 + lane * 16;
    const LAS unsigned char* kp0 = lds + L_K + hi * 1024 + r32 * 16;
    const int vb0 = (int)(uintptr_t)(lds + L_V) + ((lane >> 4) & 1) * 32 + (lane & 3) * 8 + (4 * hi + ((lane & 15) >> 2)) * 64;
    for (int uid = blk; uid < 2048; uid += G) {
        const int ui = uid >> 8; int c = uid & 255; c = (c & 7) * 32 + (c >> 3);
        const int bh = c >> 1, s = c & 1, pp = ui >> 1, qb = (ui & 1) ? 15 - (2 * pp + s) : (2 * pp + s);
        const int b = bh >> 3, h = bh & 7, q0 = qb * 256;
        const size_t rowbase = (size_t)b * SEQ;
        bf16* Qw = Q + (rowbase + q0 + wid * 32) * 512 + h * 64;
        bf16x8 qr[4];
#pragma unroll
        for (int d0 = 0; d0 < 4; ++d0) qr[d0] = *(const bf16x8*)(Qw + (size_t)r32 * 512 + d0 * 16 + hi * 8);
        const int NT = 4 * (qb + 1);
        const unsigned long long* mptr = MASK + (rowbase + q0 + wid * 32 + r32) * 64;
        const bf16* ksrc = K + (rowbase + lane) * 512 + h * 64 + wid * 8;
        const bf16* vsrc = V + (rowbase + 16 * (wid & 3) + (lane >> 2)) * 512 + h * 64 + (wid >> 2) * 32 + (lane & 3) * 8;
        f32x16 o[2]; o[0] = f32x16{}; o[1] = f32x16{};
        float l_reg = 0.f;
        u32x4 kreg = *(const u32x4*)ksrc, vreg = *(const u32x4*)vsrc;
        unsigned long long mw = mptr[0], mwn = 0ull;
        *(LAS u32x4*)(lds + kdst) = kreg; *(LAS u32x4*)(lds + vdst) = vreg;
        __syncthreads();
        const int qmax = q0 + wid * 32 + 31;
        for (int t = 0; t < NT; ++t) {
            const int slot = (t & 1) * SLOTB;
            if (t + 1 < NT) { kreg = *(const u32x4*)(ksrc + (size_t)(t + 1) * 64 * 512); vreg = *(const u32x4*)(vsrc + (size_t)(t + 1) * 64 * 512); mwn = mptr[t + 1]; }
            if (64 * t <= qmax) {
                f32x16 p0, p1;
                qkt(p0, p1, kp0 + slot, qr, negm);
                const unsigned mlo = (unsigned)mw >> (4 * hi), mhi = (unsigned)(mw >> 32) >> (4 * hi);
                float sacc = 0.f;
#pragma unroll
                for (int r = 0; r < 16; ++r) {
                    const int bp = (r & 3) + 8 * (r >> 2);
                    const float e0 = __builtin_amdgcn_exp2f(p0[r]), e1 = __builtin_amdgcn_exp2f(p1[r]);
                    p0[r] = __uint_as_float(__float_as_uint(e0) & (unsigned)__builtin_amdgcn_sbfe((int)mlo, bp, 1));
                    p1[r] = __uint_as_float(__float_as_uint(e1) & (unsigned)__builtin_amdgcn_sbfe((int)mhi, bp, 1));
                    sacc += p0[r] + p1[r];
                }
                l_reg += sacc;
                u32x4 pw0, pw1, pw2, pw3;
                pw0 = (u32x4){pk2(p0[0], p0[1]), pk2(p0[2], p0[3]), pk2(p0[4], p0[5]), pk2(p0[6], p0[7])};
                pw1 = (u32x4){pk2(p0[8], p0[9]), pk2(p0[10], p0[11]), pk2(p0[12], p0[13]), pk2(p0[14], p0[15])};
                pw2 = (u32x4){pk2(p1[0], p1[1]), pk2(p1[2], p1[3]), pk2(p1[4], p1[5]), pk2(p1[6], p1[7])};
                pw3 = (u32x4){pk2(p1[8], p1[9]), pk2(p1[10], p1[11]), pk2(p1[12], p1[13]), pk2(p1[14], p1[15])};
                pv(o, vb0 + slot, __builtin_bit_cast(bf16x8, pw0), __builtin_bit_cast(bf16x8, pw1), __builtin_bit_cast(bf16x8, pw2), __builtin_bit_cast(bf16x8, pw3));
            }
            if (t + 1 < NT) { *(LAS u32x4*)(lds + kdst + (SLOTB - slot)) = kreg; *(LAS u32x4*)(lds + vdst + (SLOTB - slot)) = vreg; mw = mwn; }
            __syncthreads();
        }
        { auto rr = __builtin_amdgcn_permlane32_swap(__float_as_uint(l_reg), __float_as_uint(l_reg), false, false); l_reg = __uint_as_float(rr[0]) + __uint_as_float(rr[1]); }
        if (hi == 0) wsf[32 + r32] = l_reg;
        LDS_WAIT();
        float rli[16];
#pragma unroll
        for (int r = 0; r < 16; ++r) rli[r] = __builtin_amdgcn_rcpf(wsf[32 + crow(r, hi)]);
        LAS bf16* stg = (LAS bf16*)(lds + L_OST) + wid * 2048;
#pragma unroll
        for (int r = 0; r < 16; ++r) { const int orow = crow(r, hi);
#pragma unroll
            for (int d0 = 0; d0 < 2; ++d0) stg[orow * 64 + d0 * 32 + r32] = (bf16)(pk2(o[d0][r] * rli[r], 0.f) & 0xffffu); }
        LDS_WAIT();
#pragma unroll
        for (int i = 0; i < 4; ++i) { const int row = i * 8 + (lane >> 3), ch = lane & 7; const u32x4 v = *(const LAS u32x4*)(stg + row * 64 + ch * 8); *(u32x4*)(Qw + (size_t)row * 512 + ch * 8) = v; }
        LDS_WAIT();
    }
}
#undef SBAR
}

__device__ __forceinline__ void peer_route_phase(LAS unsigned char* lds, const bf16* PQ, const bf16* SK, unsigned short* EIDX, float* EG, int G, int blk) {
    const int tid = threadIdx.x, lane = tid & 63, r32 = lane & 31, hi = lane >> 5, wave = __builtin_amdgcn_readfirstlane(tid >> 6);
    LAS unsigned* win = (LAS unsigned*)(lds + wave * 12288);
    LAS unsigned* fwn = win + 2 * 16 * 64;
    const int gw = blk * NWAVES + wave, NGW = G * NWAVES, h = gw & 7;
    for (int tg = gw >> 3; tg < T / 32; tg += NGW >> 3) {
        const size_t t0 = (size_t)tg * 32;
#pragma unroll 1
        for (int half = 0; half < 2; ++half) {
            const int p = 2 * h + half;
            bf16x8 bq[4];
#pragma unroll
            for (int d0 = 0; d0 < 4; ++d0) bq[d0] = *(const bf16x8*)(PQ + (t0 + r32) * 1024 + 128 * h + 64 * half + 16 * d0 + 8 * hi);
            unsigned ck[64];
#pragma unroll
            for (int nb = 0; nb < 4; ++nb) {
                f32x16 acc = {};
#pragma unroll
                for (int d0 = 0; d0 < 4; ++d0) { const bf16x8 a = *(const bf16x8*)(SK + ((size_t)p * 128 + 32 * nb + r32) * 64 + 16 * d0 + 8 * hi); acc = __builtin_amdgcn_mfma_f32_32x32x16_bf16(a, bq[d0], acc, 0, 0, 0); }
#pragma unroll
                for (int r = 0; r < 16; ++r) ck[nb * 16 + r] = (ordf(acc[r]) & ~0x7fu) | (unsigned)(127 - (32 * nb + att::crow(r, hi)));
            }
#pragma unroll 1
            for (int rd = 0; rd < 16; ++rd) {
                unsigned m = ck[0];
#pragma unroll
                for (int i = 1; i < 64; ++i) m = m > ck[i] ? m : ck[i];
                auto rr = __builtin_amdgcn_permlane32_swap(m, m, false, false);
                const unsigned W = rr[0] > rr[1] ? rr[0] : rr[1];
                win[(half * 16 + rd) * 64 + lane] = W;
#pragma unroll
                for (int i = 0; i < 64; ++i) ck[i] = (ck[i] == W) ? 0u : ck[i];
            }
        }
        LDS_WAIT();
        float v0[16], v1[16];
#pragma unroll
        for (int i = 0; i < 16; ++i) { v0[i] = unordf(win[i * 64 + lane] & ~0x7fu); v1[i] = unordf(win[(16 + i) * 64 + lane] & ~0x7fu); }
        unsigned c2[16][16];
#pragma unroll
        for (int i = 0; i < 16; ++i)
#pragma unroll
            for (int j = 0; j < 16; ++j) if ((i + 1) * (j + 1) <= 16) c2[i][j] = (ordf(v0[i] + v1[j]) & ~0xffu) | (unsigned)(255 - (16 * i + j));
#pragma unroll 1
        for (int rd = 0; rd < 16; ++rd) {
            unsigned m = 0u;
#pragma unroll
            for (int i = 0; i < 16; ++i)
#pragma unroll
                for (int j = 0; j < 16; ++j) if ((i + 1) * (j + 1) <= 16) m = m > c2[i][j] ? m : c2[i][j];
            fwn[rd * 64 + lane] = m;
#pragma unroll
            for (int i = 0; i < 16; ++i)
#pragma unroll
                for (int j = 0; j < 16; ++j) if ((i + 1) * (j + 1) <= 16) c2[i][j] = (c2[i][j] == m) ? 0u : c2[i][j];
        }
        LDS_WAIT();
        float sc[16]; unsigned ex[16];
#pragma unroll
        for (int k = 0; k < 16; ++k) {
            const unsigned f = fwn[k * 64 + lane]; const int idx = 255 - (int)(f & 0xffu), i = idx >> 4, j = idx & 15;
            const unsigned w0 = win[i * 64 + lane], w1 = win[(16 + j) * 64 + lane];
            ex[k] = (127u - (w0 & 0x7fu)) * 128u + (127u - (w1 & 0x7fu));
            sc[k] = unordf(w0 & ~0x7fu) + unordf(w1 & ~0x7fu);
        }
        const float mx = sc[0];
        float sum = 0.f;
#pragma unroll
        for (int k = 0; k < 16; ++k) { sc[k] = __expf(sc[k] - mx); sum += sc[k]; }
        const float inv = 1.f / sum;
#pragma unroll
        for (int k = 0; k < 16; ++k) sc[k] *= inv;
        if (hi == 0) {
            unsigned short* ep = EIDX + (t0 + r32) * 128 + h * 16; float* gp = EG + (t0 + r32) * 128 + h * 16;
            *(u32x4*)ep = (u32x4){ex[0] | (ex[1] << 16), ex[2] | (ex[3] << 16), ex[4] | (ex[5] << 16), ex[6] | (ex[7] << 16)};
            *(u32x4*)(ep + 8) = (u32x4){ex[8] | (ex[9] << 16), ex[10] | (ex[11] << 16), ex[12] | (ex[13] << 16), ex[14] | (ex[15] << 16)};
#pragma unroll
            for (int q = 0; q < 4; ++q) *(f32x4*)(gp + 4 * q) = (f32x4){sc[4 * q], sc[4 * q + 1], sc[4 * q + 2], sc[4 * q + 3]};
        }
        LDS_WAIT();
    }
}

__device__ __forceinline__ float dot16(const float* hv, u32x4 a, u32x4 b) {
    float s0 = hv[0] * bflo(a.x), s1 = hv[1] * bfhi(a.x);
    s0 += hv[2] * bflo(a.y); s1 += hv[3] * bfhi(a.y); s0 += hv[4] * bflo(a.z); s1 += hv[5] * bfhi(a.z); s0 += hv[6] * bflo(a.w); s1 += hv[7] * bfhi(a.w);
    s0 += hv[8] * bflo(b.x); s1 += hv[9] * bfhi(b.x); s0 += hv[10] * bflo(b.y); s1 += hv[11] * bfhi(b.y); s0 += hv[12] * bflo(b.z); s1 += hv[13] * bfhi(b.z); s0 += hv[14] * bflo(b.w); s1 += hv[15] * bfhi(b.w);
    return s0 + s1;
}
__device__ __forceinline__ void axpy16(float* o, float c, u32x4 a, u32x4 b) {
    o[0] += c * bflo(a.x); o[1] += c * bfhi(a.x); o[2] += c * bflo(a.y); o[3] += c * bfhi(a.y); o[4] += c * bflo(a.z); o[5] += c * bfhi(a.z); o[6] += c * bflo(a.w); o[7] += c * bfhi(a.w);
    o[8] += c * bflo(b.x); o[9] += c * bfhi(b.x); o[10] += c * bflo(b.y); o[11] += c * bfhi(b.y); o[12] += c * bflo(b.z); o[13] += c * bfhi(b.z); o[14] += c * bflo(b.w); o[15] += c * bfhi(b.w);
}
__device__ __forceinline__ void peer_gather_phase(const bf16* H2, const bf16* PU, const bf16* PV, const unsigned short* EIDX, const float* EG, const float* MOD, float* OUT, int G, int blk) {
    const int lane = threadIdx.x & 63, wave = __builtin_amdgcn_readfirstlane(threadIdx.x >> 6);
    const int kk = 8 * ((lane >> 5) & 1) + 4 * ((lane >> 4) & 1) + 2 * ((lane >> 3) & 1) + ((lane >> 2) & 1);
    for (int t = blk * NWAVES + wave; t < T; t += G * NWAVES) {
        float hv[16], out[16];
        { const u32x4 a = *(const u32x4*)(H2 + (size_t)t * 1024 + 8 * lane), b = *(const u32x4*)(H2 + (size_t)t * 1024 + 512 + 8 * lane);
          hv[0] = bflo(a.x); hv[1] = bfhi(a.x); hv[2] = bflo(a.y); hv[3] = bfhi(a.y); hv[4] = bflo(a.z); hv[5] = bfhi(a.z); hv[6] = bflo(a.w); hv[7] = bfhi(a.w);
          hv[8] = bflo(b.x); hv[9] = bfhi(b.x); hv[10] = bflo(b.y); hv[11] = bfhi(b.y); hv[12] = bflo(b.z); hv[13] = bfhi(b.z); hv[14] = bflo(b.w); hv[15] = bfhi(b.w); }
#pragma unroll
        for (int j = 0; j < 16; ++j) out[j] = 0.f;
#pragma unroll 1
        for (int h = 0; h < 8; ++h) {
            const u32x4 ia = *(const u32x4*)(EIDX + (size_t)t * 128 + h * 16), ib = *(const u32x4*)(EIDX + (size_t)t * 128 + h * 16 + 8);
            unsigned e[16];
            e[0] = ia.x & 0xffffu; e[1] = ia.x >> 16; e[2] = ia.y & 0xffffu; e[3] = ia.y >> 16; e[4] = ia.z & 0xffffu; e[5] = ia.z >> 16; e[6] = ia.w & 0xffffu; e[7] = ia.w >> 16;
            e[8] = ib.x & 0xffffu; e[9] = ib.x >> 16; e[10] = ib.y & 0xffffu; e[11] = ib.y >> 16; e[12] = ib.z & 0xffffu; e[13] = ib.z >> 16; e[14] = ib.w & 0xffffu; e[15] = ib.w >> 16;
#pragma unroll
            for (int k = 0; k < 16; ++k) e[k] = (unsigned)__builtin_amdgcn_readfirstlane((int)e[k]);
            const float gk = EG[(size_t)t * 128 + h * 16 + kk];
            float d[16];
#pragma unroll
            for (int k = 0; k < 16; ++k) { const bf16* ur = PU + (size_t)e[k] * 1024 + 8 * lane; d[k] = dot16(hv, *(const u32x4*)ur, *(const u32x4*)(ur + 512)); }
#pragma unroll
            for (int i = 0; i < 8; ++i) { const bool up = lane & 32; const float keep = up ? d[i + 8] : d[i], send = up ? d[i] : d[i + 8]; d[i] = keep + __shfl_xor(send, 32); }
#pragma unroll
            for (int i = 0; i < 4; ++i) { const bool up = lane & 16; const float keep = up ? d[i + 4] : d[i], send = up ? d[i] : d[i + 4]; d[i] = keep + __shfl_xor(send, 16); }
#pragma unroll
            for (int i = 0; i < 2; ++i) { const bool up = lane & 8; const float keep = up ? d[i + 2] : d[i], send = up ? d[i] : d[i + 2]; d[i] = keep + __shfl_xor(send, 8); }
            { const bool up = lane & 4; const float keep = up ? d[1] : d[0], send = up ? d[0] : d[1]; d[0] = keep + __shfl_xor(send, 4); }
            d[0] += __shfl_xor(d[0], 2); d[0] += __shfl_xor(d[0], 1);
            const float x = d[0];
            const float coef = gk * 0.5f * x * (1.f + erff(x * 0.70710678118654752f));
#pragma unroll
            for (int k = 0; k < 16; ++k) {
                const int src = 32 * ((k >> 3) & 1) + 16 * ((k >> 2) & 1) + 8 * ((k >> 1) & 1) + 4 * (k & 1);
                const float ck = __uint_as_float((unsigned)__builtin_amdgcn_readlane((int)__float_as_uint(coef), src));
                const bf16* vr = PV + (size_t)e[k] * 1024 + 8 * lane;
                axpy16(out, ck, *(const u32x4*)vr, *(const u32x4*)(vr + 512));
            }
        }
        const float* g2 = MOD + (size_t)(t >> 12) * 6144 + 5120;
        float* op = OUT + (size_t)t * 1024;
#pragma unroll
        for (int q = 0; q < 4; ++q) {
            const int col = (q >> 1) * 512 + 8 * lane + 4 * (q & 1);
            const f32x4 g = *(const f32x4*)(g2 + col), x1 = *(const f32x4*)(op + col);
            *(f32x4*)(op + col) = x1 + g * (f32x4){out[4 * q], out[4 * q + 1], out[4 * q + 2], out[4 * q + 3]};
        }
    }
}

constexpr int N_PHASES = 12;
__global__ void __launch_bounds__(NWAVES * 64, 2) mk_fwd(Args a) {
    extern __shared__ __attribute__((aligned(16))) unsigned char lds_raw[];
    LAS unsigned char* lds = (LAS unsigned char*)lds_raw;
    cg::grid_group grid = cg::this_grid();
    const int G = gridDim.x, blk = blockIdx.x;
    unsigned char* ws = a.ws;
    float* MOD = (float*)(ws + WS_MOD);
    bf16* H = (bf16*)(ws + WS_H);
    bf16 *CB = (bf16*)(ws + WS_CB), *CC = (bf16*)(ws + WS_CC), *CX = (bf16*)(ws + WS_CX), *Qb = (bf16*)(ws + WS_Q), *Kb = (bf16*)(ws + WS_K), *Vb = (bf16*)(ws + WS_V), *QI = (bf16*)(ws + WS_QI);
    bf16 *GC = (bf16*)(ws + WS_GC), *GA = (bf16*)(ws + WS_GA), *KI = (bf16*)(ws + WS_KI); float* WI = (float*)(ws + WS_WI);
    unsigned long long* MASK = (unsigned long long*)(ws + WS_MASK);
    bf16* PQ = (bf16*)(ws + WS_PQ); unsigned short* EIDX = (unsigned short*)(ws + WS_EIDX); float* EG = (float*)(ws + WS_EG);
#define IN(k) (a.ph_lo <= (k) && (k) < a.ph_hi)
#define SEAM(k) do { if (IN(k) && IN((k) + 1)) grid.sync(); } while (0)
    if (IN(0)) p0_prologue(lds, a, G, blk);
    SEAM(0);
    if (IN(1)) norm_phase(a.in[0], a.in[4], MOD, 0, H, G, blk);
    SEAM(1);
    if (IN(2)) {
        pg8::Gemm g{H, (const bf16*)(ws + WS_WIN), T, NIN_PAD, DM}; pg8::StaticOrder S; S.init(T, NIN_PAD, G, blk);
        EpiInProj E{CB, CC, CX, Qb, Kb, Vb, QI, GC, GA, KI, WI, a.in[8], a.in[9]};
        pg8::gemm_phase<EpiInProj, true, true>(lds, g, S, E);
    }
    SEAM(2);
    if (IN(3)) { conv_phase(CB, CC, CX, a.in[6], G, blk); indexer_phase(lds, QI, KI, WI, MASK, G, blk); }
    SEAM(3);
    if (IN(4)) att::attn_phase(lds, Qb, Kb, Vb, MASK, a.in[8], a.in[9], G, blk);
    SEAM(4);
    if (IN(5)) {
        pg8::Gemm g{CB, (const bf16*)(ws + WS_WCO), T, DM, 512}; pg8::StaticOrder S; S.init(T, DM, G, blk);
        EpiMix<false> E{GC, H};
        pg8::gemm_phase<EpiMix<false>, true, true>(lds, g, S, E);
    }
    SEAM(5);
    if (IN(6)) {
        pg8::Gemm g{Qb, (const bf16*)(ws + WS_WAO), T, DM, 512}; pg8::StaticOrder S; S.init(T, DM, G, blk);
        EpiMix<true> E{GA, H};
        pg8::gemm_phase<EpiMix<true>, true, true>(lds, g, S, E);
    }
    SEAM(6);
    if (IN(7)) {
        pg8::Gemm g{H, (const bf16*)(ws + WS_WO), T, DM, DM}; pg8::StaticOrder S; S.init(T, DM, G, blk);
        EpiRes E{a.in[0], MOD, a.out};
        pg8::gemm_phase<EpiRes, true, true>(lds, g, S, E);
    }
    SEAM(7);
    if (IN(8)) norm_phase(a.out, a.in[12], MOD, 3072, H, G, blk);
    SEAM(8);
    if (IN(9)) {
        pg8::Gemm g{H, (const bf16*)(ws + WS_WPQ), T, DM, DM}; pg8::StaticOrder S; S.init(T, DM, G, blk);
        EpiPlain E{PQ};
        pg8::gemm_phase<EpiPlain, true, true>(lds, g, S, E);
    }
    SEAM(9);
    if (IN(10)) peer_route_phase(lds, PQ, (const bf16*)(ws + WS_SK), EIDX, EG, G, blk);
    SEAM(10);
    if (IN(11)) peer_gather_phase(H, (const bf16*)(ws + WS_PU), (const bf16*)(ws + WS_PV), EIDX, EG, MOD, a.out, G, blk);
#undef IN
#undef SEAM
}

#ifndef MK_N_LAUNCHES
#define MK_N_LAUNCHES 1
#endif
extern "C" void kernel_launch(void* const* d_in, const int* in_sizes, int n_in, void* d_out, int out_size, void* d_ws, size_t ws_size, hipStream_t stream) {
    static int grid = 0;
    if (grid == 0) {
        if (n_in != 17 || in_sizes[0] != T * DM || out_size != T * DM || ws_size < WS_END) {
            fprintf(stderr, "kernel_launch: unexpected problem: n_in %d in0 %d out %d ws %zu (need %zu); nothing launched\n", n_in, n_in > 0 ? in_sizes[0] : -1, out_size, ws_size, (size_t)WS_END); grid = -1; return; }
        int dev = 0, cus = 0, per_cu = 0;
        hipGetDevice(&dev); hipDeviceGetAttribute(&cus, hipDeviceAttributeMultiprocessorCount, dev);
        if (hipFuncSetAttribute((const void*)mk_fwd, hipFuncAttributeMaxDynamicSharedMemorySize, LDS_BYTES) != hipSuccess) { fprintf(stderr, "kernel_launch: hipFuncSetAttribute failed\n"); grid = -1; return; }
        if (hipOccupancyMaxActiveBlocksPerMultiprocessor(&per_cu, (const void*)mk_fwd, NWAVES * 64, LDS_BYTES) != hipSuccess || per_cu < 1) { fprintf(stderr, "kernel_launch: occupancy query says %d blocks per CU\n", per_cu); grid = -1; return; }
        grid = cus;
    }
    if (grid < 0) return;
    Args a{};
    for (int i = 0; i < 17; ++i) a.in[i] = (const float*)d_in[i];
    a.out = (float*)d_out; a.ws = (unsigned char*)d_ws;
    for (int li = 0; li < MK_N_LAUNCHES; ++li) {
        a.ph_lo = li * (N_PHASES / MK_N_LAUNCHES); a.ph_hi = (li + 1) * (N_PHASES / MK_N_LAUNCHES);
        void* args[] = {&a};
        hipError_t e = hipLaunchCooperativeKernel((const void*)mk_fwd, dim3(grid), dim3(NWAVES * 64), args, LDS_BYTES, stream);
        if (e != hipSuccess) { fprintf(stderr, "kernel_launch: cooperative launch %d failed: %s (grid %d)\n", li, hipGetErrorString(e), grid); break; }
    }
}
```

```cpp
#include <hip/hip_runtime.h>
#include <hip/hip_cooperative_groups.h>
#include <cstdio>
#include <cstdint>
namespace cg = cooperative_groups;

#define LAS __attribute__((address_space(3)))
typedef unsigned short bf16;
typedef short bf16x8 __attribute__((ext_vector_type(8)));
typedef short s16x4 __attribute__((ext_vector_type(4)));
typedef float f32x2 __attribute__((ext_vector_type(2)));
typedef float f32x4 __attribute__((ext_vector_type(4)));
typedef float f32x16 __attribute__((ext_vector_type(16)));
typedef unsigned u32x2 __attribute__((ext_vector_type(2)));
typedef unsigned u32x4 __attribute__((ext_vector_type(4)));
typedef __bf16 bf16x2_t __attribute__((ext_vector_type(2)));

__device__ __forceinline__ unsigned pk2(float lo, float hi) { f32x2 v = {lo, hi}; bf16x2_t b = __builtin_convertvector(v, bf16x2_t); return __builtin_bit_cast(unsigned, b); }
__device__ __forceinline__ float bflo(unsigned u) { return __uint_as_float(u << 16); }
__device__ __forceinline__ float bfhi(unsigned u) { return __uint_as_float(u & 0xffff0000u); }
__device__ __forceinline__ unsigned ordf(float f) { unsigned u = __float_as_uint(f); return u ^ ((u & 0x80000000u) ? 0xffffffffu : 0x80000000u); }
__device__ __forceinline__ float unordf(unsigned u) { return __uint_as_float((u & 0x80000000u) ? (u ^ 0x80000000u) : ~u); }
#define LDS_WAIT() asm volatile("s_waitcnt lgkmcnt(0)" ::: "memory")
__device__ __forceinline__ int phase_tid() { int t = (int)threadIdx.x; asm volatile("" : "+v"(t)); return t; }

constexpr int PEER_ROWB = 768;
typedef const unsigned char* tab_ptr;
constexpr int NB = 16, SEQ = 4096, DM = 1024, T = NB * SEQ;
constexpr int NIN_PAD = 5888;
constexpr float EPS = 1e-6f;
constexpr float C2 = 0.125f * 1.4426950408889634f;
constexpr int NWAVES = 8;

constexpr size_t MiB = 1u << 20;
constexpr size_t WS_MOD = 1 * MiB;
constexpr size_t WS_RSU = 1 * MiB + 512 * 1024, WS_RSV = 1 * MiB + 640 * 1024;
constexpr size_t WS_WIN = 2 * MiB;
constexpr size_t WS_WCO = 14 * MiB;
constexpr size_t WS_WAO = 15 * MiB;
constexpr size_t WS_WO = 16 * MiB;
constexpr size_t WS_WPQ = 18 * MiB;
constexpr size_t WS_SK = 20 * MiB;
constexpr size_t WS_PU = 32 * MiB;
constexpr size_t WS_PV = 64 * MiB;
constexpr size_t WS_H = 96 * MiB;
constexpr size_t WS_CB = 224 * MiB;
constexpr size_t WS_CC = 288 * MiB;
constexpr size_t WS_CX = 352 * MiB;
constexpr size_t WS_Q = 416 * MiB;
constexpr size_t WS_K = 480 * MiB;
constexpr size_t WS_V = 544 * MiB;
constexpr size_t WS_QI = 608 * MiB;
constexpr size_t WS_GC = 672 * MiB;
constexpr size_t WS_GA = 800 * MiB;
constexpr size_t WS_KI = 928 * MiB;
constexpr size_t WS_WI = 936 * MiB;
constexpr size_t WS_MASK = 938 * MiB;
constexpr size_t WS_END = 970 * MiB;
constexpr size_t WS_PQ = WS_CC;
constexpr size_t WS_EIDX = WS_K;
constexpr size_t WS_EG = WS_K + 16 * MiB;
constexpr size_t WS_COEF = WS_V;
constexpr size_t WS_CTL = 0;
constexpr size_t CTL_BYTES = 32768;

constexpr int LDS_BYTES = 147456;

namespace pg8 {
constexpr int BM = 256, BK = 64, HALF = 128, HTB = HALF * BK * 2, STAGE_BYTES = 8 * HTB, NXCD = 8, WGM = 8;
__host__ __device__ __forceinline__ int lds_byte(int r, int c) { const int st = (r >> 4) * 2 + (c >> 5), rr = r & 15, cc = c & 31, ob = rr * 64 + cc * 2; return st * 1024 + (ob ^ (((ob >> 9) & 1) << 5)); }
__host__ __device__ __forceinline__ void stage_rc(int b, int& R, int& C) { const int st = b / 1024, sb = b % 1024, swz = sb ^ (((sb >> 9) & 1) << 5); R = (st >> 1) * 16 + swz / 64; C = (st & 1) * 32 + (swz % 64) / 2; }
__host__ __device__ __forceinline__ int perm32(int rho) { const int n = rho >> 4, i = rho & 15; return 8 * (i >> 2) + 4 * n + (i & 3); }
struct Unit { int pm, pn; };
struct Gemm { const bf16* A; const bf16* Bt; int M, N, K; };
struct StaticOrder {
    int nM, nN, nwg, G, c;
    __device__ void init(int M, int N, int G_, int c_) { nM = M / BM; nN = N / BM; nwg = nM * nN; G = G_; c = c_; }
    __device__ bool next(int i, Unit& u) const {
        const long L = (long)i * G + c; if (L >= nwg) return false;
        int wgid = (int)L; { const int q = nwg / NXCD, r = nwg % NXCD, xcd = wgid % NXCD, off = wgid / NXCD; wgid = (xcd < r ? xcd * (q + 1) : r * (q + 1) + (xcd - r) * q) + off; }
        const int nig = WGM * nN, gid = wgid / nig, fm = gid * WGM, gsz = (nM - fm) < WGM ? (nM - fm) : WGM;
        u.pm = fm + ((wgid % nig) % gsz); u.pn = (wgid % nig) / gsz; return true;
    }
};

template <class Epi, bool ALIGN_EPI, bool SP2>
__device__ __forceinline__ void gemm_phase(LAS unsigned char* lds, const Gemm g, const StaticOrder& S, const Epi& E) {
    const int tid = phase_tid(), wid = __builtin_amdgcn_readfirstlane(tid >> 6), lane = tid & 63, wr = wid >> 2, wc = wid & 3, fr = lane & 15, fq = lane >> 4;
    const int K = g.K, nt = K / BK;
    unsigned voffA[2], voffB[2];
#pragma unroll
    for (int i = 0; i < 2; ++i) { int R, C; stage_rc(tid * 16 + i * 8192, R, C); const int Rb = Epi::PERM ? ((R & ~31) + perm32(R & 31)) : R;
        voffA[i] = (unsigned)(R * K + C) * 2u; voffB[i] = (unsigned)(Rb * K + C) * 2u; }
    const size_t kstep = (size_t)(BK * 2);
    const size_t hstep = (size_t)HALF * K * 2;
    const size_t tstep = 2 * hstep;
    const unsigned ldsw = (unsigned)wid * 1024u;
    const int aoff = lds_byte(wr * 64 + fr, fq * 8), boff = lds_byte(wc * 32 + fr, fq * 8);
#define PG8_SA(b, h) (((b) * 2 + (h)) * HTB)
#define PG8_SB(b, h) ((4 + (b) * 2 + (h)) * HTB)
#define PG8_STAGE(bufoff, gbase, voff) do { _Pragma("unroll") for (int _i = 0; _i < 2; ++_i) \
        __builtin_amdgcn_global_load_lds((const unsigned*)((const char*)(gbase) + (voff)[_i]), (LAS unsigned*)(lds + (bufoff) + ldsw + _i * 8192), 16, 0, 0); } while (0)
#define PG8_LDA(dst, b, h) do { _Pragma("unroll") for (int m = 0; m < 4; ++m) _Pragma("unroll") for (int k = 0; k < 2; ++k) dst[m][k] = *(const LAS bf16x8*)(lds + PG8_SA(b, h) + aoff + m * 2048 + k * 1024); } while (0)
#define PG8_LDB(dst, b, h) do { _Pragma("unroll") for (int n = 0; n < 2; ++n) _Pragma("unroll") for (int k = 0; k < 2; ++k) dst[n][k] = *(const LAS bf16x8*)(lds + PG8_SB(b, h) + boff + n * 2048 + k * 1024); } while (0)
#define PG8_MMA(ai, bj, At, Bt) do { __builtin_amdgcn_s_setprio(1); _Pragma("unroll") for (int m = 0; m < 4; ++m) _Pragma("unroll") for (int n = 0; n < 2; ++n) _Pragma("unroll") for (int k = 0; k < 2; ++k) \
        acc[ai][bj][m][n] = __builtin_amdgcn_mfma_f32_16x16x32_bf16(Bt[n][k], At[m][k], acc[ai][bj][m][n], 0, 0, 0); __builtin_amdgcn_s_setprio(0); } while (0)
#define PG8_WAIT_V(n) asm volatile("s_waitcnt vmcnt(" #n ")" ::: "memory")
#define PG8_WAIT_L(n) asm volatile("s_waitcnt lgkmcnt(" #n ")" ::: "memory")
#define PG8_BAR __builtin_amdgcn_s_barrier()
#define PG8_SCHED __builtin_amdgcn_sched_barrier(0)
    Unit cur, nxt; int ui = 0;
    if (!S.next(0, cur)) return;
    f32x4 acc[2][2][4][2];
#pragma unroll
    for (int a = 0; a < 2; ++a)
#pragma unroll
        for (int b = 0; b < 2; ++b)
#pragma unroll
            for (int m = 0; m < 4; ++m)
#pragma unroll
                for (int n = 0; n < 2; ++n) acc[a][b][m][n] = (f32x4){0.f, 0.f, 0.f, 0.f};
    bf16x8 At[4][2], B0[2][2], B1[2][2];
    const char* cA = (const char*)g.A + (size_t)cur.pm * tstep; const char* cB = (const char*)g.Bt + (size_t)cur.pn * tstep;
    if constexpr (SP2) {
        PG8_STAGE(PG8_SB(0, 0), cB, voffB); PG8_STAGE(PG8_SB(0, 1), cB + hstep, voffB); PG8_STAGE(PG8_SA(0, 0), cA, voffA); PG8_STAGE(PG8_SA(0, 1), cA + hstep, voffA);
        if (wr == 1) PG8_BAR;
        PG8_WAIT_V(2); PG8_BAR;
        PG8_STAGE(PG8_SB(1, 0), cB + kstep, voffB); PG8_STAGE(PG8_SA(1, 0), cA + kstep, voffA); PG8_STAGE(PG8_SB(1, 1), cB + hstep + kstep, voffB);
        PG8_WAIT_V(6); PG8_BAR;
    } else {
        PG8_STAGE(PG8_SB(0, 0), cB, voffB); PG8_STAGE(PG8_SA(0, 0), cA, voffA); PG8_STAGE(PG8_SB(0, 1), cB + hstep, voffB); PG8_STAGE(PG8_SA(0, 1), cA + hstep, voffA);
        if (wr == 1) PG8_BAR;
        PG8_WAIT_V(4); PG8_BAR;
        PG8_STAGE(PG8_SB(1, 0), cB + kstep, voffB); PG8_STAGE(PG8_SA(1, 0), cA + kstep, voffA); PG8_STAGE(PG8_SB(1, 1), cB + hstep + kstep, voffB);
        PG8_WAIT_V(6); PG8_BAR;
    }
    for (;;) {
        const bool has_next = S.next(ui + 1, nxt);
        const char* nA = has_next ? (const char*)g.A + (size_t)nxt.pm * tstep : cA; const char* nB = has_next ? (const char*)g.Bt + (size_t)nxt.pn * tstep : cB;
        for (int t = 0; t < nt; t += 2) {
            if constexpr (Epi::MIDK) { if (t == nt / 2) E.mid(acc, cur, wr, wc, fr, fq); }
            const bool last = (t == nt - 2);
            const char* a1 = cA + (size_t)(t + 1) * kstep;
            const char* a2 = last ? nA : cA + (size_t)(t + 2) * kstep; const char* b2 = last ? nB : cB + (size_t)(t + 2) * kstep;
            const char* a3 = a2 + kstep; const char* b3 = b2 + kstep;
            if constexpr (SP2) {
            PG8_LDB(B0, 0, 0); PG8_LDB(B1, 0, 1); PG8_SCHED; PG8_LDA(At, 0, 0); PG8_STAGE(PG8_SA(1, 1), a1 + hstep, voffA);
            PG8_WAIT_V(8); PG8_WAIT_L(0); PG8_BAR; PG8_MMA(0, 0, At, B0); PG8_MMA(0, 1, At, B1); PG8_BAR; PG8_SCHED;
            PG8_LDA(At, 0, 1); PG8_STAGE(PG8_SB(0, 0), b2, voffB); PG8_STAGE(PG8_SB(0, 1), b2 + hstep, voffB); PG8_STAGE(PG8_SA(0, 0), a2, voffA);
            PG8_WAIT_V(8); PG8_WAIT_L(0); PG8_BAR; PG8_MMA(1, 0, At, B0); PG8_MMA(1, 1, At, B1); PG8_BAR; PG8_SCHED;
            PG8_LDB(B0, 1, 0); PG8_LDB(B1, 1, 1); PG8_SCHED; PG8_LDA(At, 1, 0); PG8_STAGE(PG8_SA(0, 1), a2 + hstep, voffA);
            PG8_WAIT_V(8); PG8_WAIT_L(0); PG8_BAR; PG8_MMA(0, 0, At, B0); PG8_MMA(0, 1, At, B1); PG8_BAR; PG8_SCHED;
            PG8_LDA(At, 1, 1); PG8_STAGE(PG8_SB(1, 0), b3, voffB); PG8_STAGE(PG8_SB(1, 1), b3 + hstep, voffB); PG8_STAGE(PG8_SA(1, 0), a3, voffA);
            PG8_WAIT_V(8); PG8_WAIT_L(0); PG8_BAR; PG8_MMA(1, 0, At, B0); PG8_MMA(1, 1, At, B1); PG8_BAR; PG8_SCHED;
            } else {
            PG8_LDB(B0, 0, 0); PG8_SCHED; PG8_LDA(At, 0, 0); PG8_STAGE(PG8_SA(1, 1), a1 + hstep, voffA);
            PG8_WAIT_L(8); PG8_BAR; PG8_WAIT_L(0); PG8_MMA(0, 0, At, B0); PG8_BAR; PG8_SCHED;
            PG8_LDB(B1, 0, 1); PG8_STAGE(PG8_SB(0, 0), b2, voffB);
            PG8_BAR; PG8_WAIT_L(0); PG8_MMA(0, 1, At, B1); PG8_BAR;
            PG8_LDA(At, 0, 1); PG8_STAGE(PG8_SA(0, 0), a2, voffA);
            PG8_BAR; PG8_WAIT_L(0); PG8_MMA(1, 0, At, B0); PG8_BAR; PG8_SCHED;
            PG8_STAGE(PG8_SB(0, 1), b2 + hstep, voffB);
            PG8_WAIT_V(6); PG8_BAR; PG8_MMA(1, 1, At, B1); PG8_BAR;
            PG8_LDB(B0, 1, 0); PG8_SCHED; PG8_LDA(At, 1, 0); PG8_STAGE(PG8_SA(0, 1), a2 + hstep, voffA);
            PG8_WAIT_L(8); PG8_BAR; PG8_WAIT_L(0); PG8_MMA(0, 0, At, B0); PG8_BAR; PG8_SCHED;
            PG8_LDB(B1, 1, 1); PG8_STAGE(PG8_SB(1, 0), b3, voffB);
            PG8_BAR; PG8_WAIT_L(0); PG8_MMA(0, 1, At, B1); PG8_BAR;
            PG8_LDA(At, 1, 1); PG8_STAGE(PG8_SA(1, 0), a3, voffA);
            PG8_BAR; PG8_WAIT_L(0); PG8_MMA(1, 0, At, B0); PG8_BAR; PG8_SCHED;
            PG8_STAGE(PG8_SB(1, 1), b3 + hstep, voffB);
            PG8_WAIT_V(6); PG8_BAR; PG8_MMA(1, 1, At, B1); PG8_BAR;
            }
        }
        if constexpr (ALIGN_EPI) { if (wr == 0) PG8_BAR; }
        E(acc, cur, wr, wc, fr, fq);
        if (!has_next) break;
#pragma unroll
        for (int a = 0; a < 2; ++a)
#pragma unroll
            for (int b = 0; b < 2; ++b)
#pragma unroll
                for (int m = 0; m < 4; ++m)
#pragma unroll
                    for (int n = 0; n < 2; ++n) acc[a][b][m][n] = (f32x4){0.f, 0.f, 0.f, 0.f};
        cur = nxt; cA = nA; cB = nB; ++ui;
        if constexpr (ALIGN_EPI) { if (wr == 1) PG8_BAR; }
    }
    PG8_WAIT_V(0);
    if constexpr (!ALIGN_EPI) { if (wr == 0) PG8_BAR; }
    PG8_BAR;
#undef PG8_SA
#undef PG8_SB
#undef PG8_STAGE
#undef PG8_LDA
#undef PG8_LDB
#undef PG8_MMA
#undef PG8_WAIT_V
#undef PG8_WAIT_L
#undef PG8_BAR
#undef PG8_SCHED
}
}

typedef const f32x4 (&AccRef)[2][2][4][2];

__device__ __forceinline__ u32x4 pack8(f32x4 v0, f32x4 v1) { u32x4 w; w.x = pk2(v0[0], v0[1]); w.y = pk2(v0[2], v0[3]); w.z = pk2(v1[0], v1[1]); w.w = pk2(v1[2], v1[3]); return w; }
__device__ __forceinline__ float sigm(float x) { return __builtin_amdgcn_rcpf(1.f + __builtin_amdgcn_exp2f(-1.4426950408889634f * x)); }

struct EpiInProj {
    static constexpr bool PERM = true; static constexpr bool MIDK = false;
    unsigned char* ws; const float* qnw; const float* knw;
    __device__ __forceinline__ void operator()(AccRef acc, const pg8::Unit& u, int wr, int wc, int fr, int fq) const {
        const int pn = u.pn; const size_t row0 = (size_t)u.pm * 256 + wr * 64 + fr;
        bf16* const V = (bf16*)(ws + WS_V); bf16* const KI = (bf16*)(ws + WS_KI); float* const WI = (float*)(ws + WS_WI);
        if (pn == 10 || pn == 11) {
            bf16* vb = V + ((size_t)((u.pm >> 4) * 8 + 4 * (pn & 1) + (wc >> 1)) * 4096 + (u.pm & 15) * 256 + wr * 64 + fr) * 64 + 32 * (wc & 1) + 8 * fq;
#pragma unroll
            for (int ai = 0; ai < 2; ++ai)
#pragma unroll
                for (int m = 0; m < 4; ++m)
#pragma unroll
                    for (int bj = 0; bj < 2; ++bj) *(u32x4*)(vb + (size_t)(2 * bj * 4096 + ai * 128 + m * 16) * 64) = pack8(acc[ai][bj][m][0], acc[ai][bj][m][1]);
        } else if (pn < 6 || (pn >= 12 && pn < 14)) {
            bf16* base = (bf16*)(ws + (pn < 6 ? WS_CB + (size_t)(pn >> 1) * (64 * MiB) : WS_QI));
            static_assert(WS_CC == WS_CB + 64 * MiB && WS_CX == WS_CB + 128 * MiB, "cb | cc | cx are consecutive 64 MiB regions");
            const int col0 = (pn & 1) * 256 + wc * 32 + 8 * fq;
#pragma unroll
            for (int ai = 0; ai < 2; ++ai)
#pragma unroll
                for (int m = 0; m < 4; ++m) { bf16* rowp = base + (row0 + ai * 128 + m * 16) * 512 + col0;
#pragma unroll
                    for (int bj = 0; bj < 2; ++bj) *(u32x4*)(rowp + bj * 128) = pack8(acc[ai][bj][m][0], acc[ai][bj][m][1]); }
        } else if (pn < 10) {
            const bool isq = pn < 8; bf16* base = (bf16*)(ws + (isq ? WS_Q : WS_K)); const float* nw = isq ? qnw : knw; const float sc = isq ? C2 : 1.f;
            const int head = 4 * (pn & 1) + wc;
            f32x4 w[2][2];
#pragma unroll
            for (int bj = 0; bj < 2; ++bj)
#pragma unroll
                for (int n = 0; n < 2; ++n) w[bj][n] = *(const f32x4*)(nw + 32 * bj + 8 * fq + 4 * n) * sc;
#pragma unroll
            for (int ai = 0; ai < 2; ++ai)
#pragma unroll
                for (int m = 0; m < 4; ++m) {
                    float ss = 0.f;
#pragma unroll
                    for (int bj = 0; bj < 2; ++bj)
#pragma unroll
                        for (int n = 0; n < 2; ++n) { const f32x4 x = acc[ai][bj][m][n]; ss += (x[0] * x[0] + x[1] * x[1]) + (x[2] * x[2] + x[3] * x[3]); }
                    ss += __shfl_xor(ss, 16); ss += __shfl_xor(ss, 32);
                    const float r = __builtin_amdgcn_rsqf(ss * (1.f / 64.f) + EPS);
                    bf16* rowp = isq ? base + (row0 + ai * 128 + m * 16) * 512 + head * 64 + 8 * fq
                                     : base + ((size_t)((u.pm >> 4) * 8 + head) * 4096 + (u.pm & 15) * 256 + wr * 64 + fr + ai * 128 + m * 16) * 64 + 8 * fq;
#pragma unroll
                    for (int bj = 0; bj < 2; ++bj) *(u32x4*)(rowp + bj * 32) = pack8(acc[ai][bj][m][0] * r * w[bj][0], acc[ai][bj][m][1] * r * w[bj][1]);
                }
        } else if (pn < 22) {
            bf16* base = (bf16*)(ws + (pn < 18 ? WS_GC : WS_GA)); const int col0 = ((pn - 14) & 3) * 256 + wc * 32 + 8 * fq;
#pragma unroll
            for (int ai = 0; ai < 2; ++ai)
#pragma unroll
                for (int m = 0; m < 4; ++m) { bf16* rowp = base + (row0 + ai * 128 + m * 16) * 1024 + col0;
#pragma unroll
                    for (int bj = 0; bj < 2; ++bj) { f32x4 a = acc[ai][bj][m][0], b = acc[ai][bj][m][1];
#pragma unroll
                        for (int j = 0; j < 4; ++j) { a[j] = sigm(a[j]); b[j] = sigm(b[j]); }
                        *(u32x4*)(rowp + bj * 128) = pack8(a, b); } }
        } else {
            if (wc < 2) {
#pragma unroll
                for (int ai = 0; ai < 2; ++ai)
#pragma unroll
                    for (int m = 0; m < 4; ++m) *(u32x4*)(KI + (row0 + ai * 128 + m * 16) * 64 + wc * 32 + 8 * fq) = pack8(acc[ai][0][m][0], acc[ai][0][m][1]);
            } else if (wc == 2 && fq == 0) {
#pragma unroll
                for (int ai = 0; ai < 2; ++ai)
#pragma unroll
                    for (int m = 0; m < 4; ++m) { float* p = WI + (row0 + ai * 128 + m * 16) * 8; *(f32x4*)p = acc[ai][0][m][0]; *(f32x4*)(p + 4) = acc[ai][0][m][1]; }
            }
        }
    }
};

struct EpiMixFused {
    static constexpr bool PERM = true; static constexpr bool MIDK = true;
    const bf16* GC; const bf16* GA; bf16* MIX;
    __device__ __forceinline__ void mid(f32x4 (&acc)[2][2][4][2], const pg8::Unit& u, int wr, int wc, int fr, int fq) const {
        unsigned base = (unsigned)((u.pm * 256 + wr * 64 + fr) * 1024 + u.pn * 256 + wc * 32 + 8 * fq);
        asm volatile("" : "+v"(base));
#define MIX_R(GCV, GAV) ((GCV) * __builtin_amdgcn_rcpf(fmaxf((GAV), 1e-20f)))
#pragma unroll
        for (int ai = 0; ai < 2; ++ai)
#pragma unroll
            for (int mh = 0; mh < 2; ++mh) {
                u32x4 gc[2][2], ga[2][2];
#pragma unroll
                for (int mm = 0; mm < 2; ++mm)
#pragma unroll
                    for (int bj = 0; bj < 2; ++bj) { const size_t off = (size_t)base + (size_t)(ai * 128 + (2 * mh + mm) * 16) * 1024 + bj * 128; gc[mm][bj] = *(const u32x4*)(GC + off); ga[mm][bj] = *(const u32x4*)(GA + off); }
#pragma unroll
                for (int mm = 0; mm < 2; ++mm)
#pragma unroll
                    for (int bj = 0; bj < 2; ++bj) { f32x4& a = acc[ai][bj][2 * mh + mm][0]; f32x4& b = acc[ai][bj][2 * mh + mm][1]; const u32x4 c = gc[mm][bj], g = ga[mm][bj];
                        a[0] *= MIX_R(bflo(c.x), bflo(g.x)); a[1] *= MIX_R(bfhi(c.x), bfhi(g.x)); a[2] *= MIX_R(bflo(c.y), bflo(g.y)); a[3] *= MIX_R(bfhi(c.y), bfhi(g.y));
                        b[0] *= MIX_R(bflo(c.z), bflo(g.z)); b[1] *= MIX_R(bfhi(c.z), bfhi(g.z)); b[2] *= MIX_R(bflo(c.w), bflo(g.w)); b[3] *= MIX_R(bfhi(c.w), bfhi(g.w)); }
                asm volatile("" ::: "memory");
            }
#undef MIX_R
    }
    __device__ __forceinline__ void operator()(AccRef acc, const pg8::Unit& u, int wr, int wc, int fr, int fq) const {
        const size_t row0 = (size_t)u.pm * 256 + wr * 64 + fr; const int col0 = u.pn * 256 + wc * 32 + 8 * fq;
#pragma unroll
        for (int ai = 0; ai < 2; ++ai)
#pragma unroll
            for (int m = 0; m < 4; ++m) { const size_t off = (row0 + ai * 128 + m * 16) * 1024 + col0;
#pragma unroll
                for (int bj = 0; bj < 2; ++bj) {
                    const u32x4 g = *(const u32x4*)(GA + off + bj * 128);
                    f32x4 a = acc[ai][bj][m][0], b = acc[ai][bj][m][1];
                    a[0] *= fmaxf(bflo(g.x), 1e-20f); a[1] *= fmaxf(bfhi(g.x), 1e-20f); a[2] *= fmaxf(bflo(g.y), 1e-20f); a[3] *= fmaxf(bfhi(g.y), 1e-20f);
                    b[0] *= fmaxf(bflo(g.z), 1e-20f); b[1] *= fmaxf(bfhi(g.z), 1e-20f); b[2] *= fmaxf(bflo(g.w), 1e-20f); b[3] *= fmaxf(bfhi(g.w), 1e-20f);
                    *(u32x4*)(MIX + off + bj * 128) = pack8(a, b); } }
    }
};

struct EpiDelta {
    static constexpr bool PERM = true; static constexpr bool MIDK = false;
    const float* MOD; bf16* O;
    __device__ __forceinline__ void operator()(AccRef acc, const pg8::Unit& u, int wr, int wc, int fr, int fq) const {
        const size_t row0 = (size_t)u.pm * 256 + wr * 64 + fr; const int col0 = u.pn * 256 + wc * 32 + 8 * fq;
        const float* g1 = MOD + (size_t)(u.pm >> 4) * 6144 + 2048;
        f32x4 gv[2][2];
#pragma unroll
        for (int bj = 0; bj < 2; ++bj)
#pragma unroll
            for (int n = 0; n < 2; ++n) gv[bj][n] = *(const f32x4*)(g1 + col0 + bj * 128 + 4 * n);
#pragma unroll
        for (int ai = 0; ai < 2; ++ai)
#pragma unroll
            for (int m = 0; m < 4; ++m) { bf16* rowp = O + (row0 + ai * 128 + m * 16) * 1024 + col0;
#pragma unroll
                for (int bj = 0; bj < 2; ++bj) *(u32x4*)(rowp + bj * 128) = pack8(acc[ai][bj][m][0] * gv[bj][0], acc[ai][bj][m][1] * gv[bj][1]); }
    }
};

struct EpiPlain {
    static constexpr bool PERM = true; static constexpr bool MIDK = false;
    bf16* O;
    __device__ __forceinline__ void operator()(AccRef acc, const pg8::Unit& u, int wr, int wc, int fr, int fq) const {
        const size_t row0 = (size_t)u.pm * 256 + wr * 64 + fr; const int col0 = u.pn * 256 + wc * 32 + 8 * fq;
#pragma unroll
        for (int ai = 0; ai < 2; ++ai)
#pragma unroll
            for (int m = 0; m < 4; ++m) { bf16* rowp = O + (row0 + ai * 128 + m * 16) * 1024 + col0;
#pragma unroll
                for (int bj = 0; bj < 2; ++bj) *(u32x4*)(rowp + bj * 128) = pack8(acc[ai][bj][m][0], acc[ai][bj][m][1]); }
    }
};

struct Args { const float* in[17]; float* out; unsigned char* ws; int ph_lo, ph_hi; };

__device__ __forceinline__ void transpose_item(const float* W, int ldw, int k0, int n0, int ncols, bf16* WT, int K, int drow0, LAS float* scr, int lane) {
#pragma unroll 8
    for (int i = 0; i < 32; ++i) { const int kk = 2 * i + (lane >> 5), n = lane & 31; scr[kk * 33 + n] = (n < ncols) ? W[(size_t)(k0 + kk) * ldw + n0 + n] : 0.f; }
    LDS_WAIT(); asm volatile("" ::: "memory");
    const int c = lane & 7;
#pragma unroll
    for (int j = 0; j < 4; ++j) { const int n = (lane >> 3) + 8 * j; const LAS float* s = scr + (8 * c) * 33 + n;
        u32x4 o; o.x = pk2(s[0 * 33], s[1 * 33]); o.y = pk2(s[2 * 33], s[3 * 33]); o.z = pk2(s[4 * 33], s[5 * 33]); o.w = pk2(s[6 * 33], s[7 * 33]);
        *(u32x4*)(WT + (size_t)(drow0 + n) * K + k0 + 8 * c) = o; }
    LDS_WAIT(); asm volatile("" ::: "memory");
}
__device__ __forceinline__ void cvt_stream(const float* src, bf16* dst, size_t n8, size_t i0, size_t stride) {
    for (size_t i = i0; i < n8; i += stride) { const f32x4 a = *(const f32x4*)(src + 8 * i), b = *(const f32x4*)(src + 8 * i + 4); *(u32x4*)(dst + 8 * i) = pack8(a, b); }
}

typedef unsigned v6u_t __attribute__((ext_vector_type(6)));
typedef float v32f_t __attribute__((ext_vector_type(32)));
typedef __bf16 v32bf_t __attribute__((ext_vector_type(32)));
struct __attribute__((packed, aligned(4))) U3 { unsigned x, y, z; };
__device__ __forceinline__ unsigned enc_e2m3(float y) {
    const float a = fminf(fabsf(y), 7.5f);
    const float r = a < 2.f ? a * 8.f : (a < 4.f ? a * 4.f + 8.f : a * 2.f + 16.f);
    unsigned c = (unsigned)__builtin_rintf(r); c = c > 31u ? 31u : c;
    return c | ((__float_as_uint(y) >> 26) & 32u);
}
__device__ __forceinline__ void cvt_rows_fp6(const float* src, unsigned char* dst, float* rs, int gw, int nw, int lane) {
#pragma unroll 2
    for (int row = gw; row < 16384; row += nw) {
        const float* sp = src + (size_t)row * 1024 + 16 * lane;
        const f32x4 a = *(const f32x4*)sp, b = *(const f32x4*)(sp + 4), c = *(const f32x4*)(sp + 8), d = *(const f32x4*)(sp + 12);
        const float v[16] = {a[0], a[1], a[2], a[3], b[0], b[1], b[2], b[3], c[0], c[1], c[2], c[3], d[0], d[1], d[2], d[3]};
        float m = 0.f;
#pragma unroll
        for (int j = 0; j < 16; ++j) m = fmaxf(m, fabsf(v[j]));
#pragma unroll
        for (int o = 32; o; o >>= 1) m = fmaxf(m, __shfl_xor(m, o));
        const float sc = m > 0.f ? 7.5f / m : 0.f;
        unsigned q[16];
#pragma unroll
        for (int j = 0; j < 16; ++j) q[j] = enc_e2m3(v[j] * sc);
        U3 w;
        w.x = q[0] | (q[1] << 6) | (q[2] << 12) | (q[3] << 18) | (q[4] << 24) | (q[5] << 30);
        w.y = (q[5] >> 2) | (q[6] << 4) | (q[7] << 10) | (q[8] << 16) | (q[9] << 22) | (q[10] << 28);
        w.z = (q[10] >> 4) | (q[11] << 2) | (q[12] << 8) | (q[13] << 14) | (q[14] << 20) | (q[15] << 26);
        *(U3*)(dst + (size_t)row * PEER_ROWB + 12 * lane) = w;
        if (lane == 0) rs[row] = m * (1.f / 7.5f);
    }
}
__device__ __forceinline__ void p0_prologue(LAS unsigned char* lds, const Args& a, int G, int blk) {
    const int tid = threadIdx.x, lane = tid & 63, wave = __builtin_amdgcn_readfirstlane(tid >> 6);
    unsigned char* ws = a.ws;
    for (int task = blk; task < 96; task += G) {
        LAS float* sl = (LAS float*)(lds + 67584);
        for (int i = tid; i < NB * DM; i += 512) { const float v = a.in[1][i]; sl[i] = v * __builtin_amdgcn_rcpf(1.f + __expf(-v)); }
        __syncthreads();
        const int col = task * 64 + lane, kb = wave * 128;
        float acc[16];
#pragma unroll
        for (int b = 0; b < 16; ++b) acc[b] = 0.f;
        const float* wp = a.in[2] + col;
        for (int k = kb; k < kb + 128; k += 4) {
            const float w0 = wp[(size_t)(k + 0) * 6144], w1 = wp[(size_t)(k + 1) * 6144], w2 = wp[(size_t)(k + 2) * 6144], w3 = wp[(size_t)(k + 3) * 6144];
#pragma unroll
            for (int b = 0; b < 16; ++b) { const f32x4 s = *(const LAS f32x4*)(sl + b * 1024 + k); acc[b] += (s[0] * w0 + s[1] * w1) + (s[2] * w2 + s[3] * w3); }
        }
        LAS float* red = (LAS float*)lds;
#pragma unroll
        for (int b = 0; b < 16; ++b) red[(wave * 16 + b) * 64 + lane] = acc[b];
        __syncthreads();
        for (int o = tid; o < 1024; o += 512) { const int b = o >> 6, cl = o & 63; float s = 0.f;
#pragma unroll
            for (int w = 0; w < 8; ++w) s += red[(w * 16 + b) * 64 + cl];
            ((float*)(ws + WS_MOD))[b * 6144 + task * 64 + cl] = s + a.in[3][task * 64 + cl]; }
        __syncthreads();
    }
    LAS float* scr = (LAS float*)(lds + wave * 8448);
    const int gw = blk * NWAVES + wave, NGW = G * NWAVES;
    constexpr int I_IN = 184 * 16, I_CO = 8 * 32, I_AO = 8 * 32, I_O = 16 * 32, I_PQ = 16 * 32;
    for (int it = gw; it < I_IN + I_CO + I_AO + I_O + I_PQ; it += NGW) {
        int r = it;
        if (r < I_IN) {
            const int dg = r >> 4, kb = r & 15, tile = dg >> 3, gi = dg & 7; int src, nc = 32;
            if (tile < 6 || (tile >= 10 && tile < 14)) src = 32 * dg;
            else if (tile < 10) src = tile * 256 + 32 * (2 * (gi & 3) + (gi >> 2));
            else if (tile < 22) src = 3656 + 32 * (dg - 112);
            else { if (gi < 2) src = 3584 + 32 * gi; else if (gi == 2) { src = 3648; nc = 8; } else { src = 0; nc = 0; } }
            transpose_item(a.in[5], 5704, kb * 64, src, nc, (bf16*)(ws + WS_WIN), 1024, dg * 32, scr, lane); continue; }
        r -= I_IN;
        if (r < I_CO) { transpose_item(a.in[7], 1024, (r >> 5) * 64, (r & 31) * 32, 32, (bf16*)(ws + WS_WCO), 1024, (r & 31) * 32, scr, lane); continue; } r -= I_CO;
        if (r < I_AO) { transpose_item(a.in[10], 1024, (r >> 5) * 64, (r & 31) * 32, 32, (bf16*)(ws + WS_WCO) + 512, 1024, (r & 31) * 32, scr, lane); continue; } r -= I_AO;
        if (r < I_O) { transpose_item(a.in[11], 1024, (r >> 5) * 64, (r & 31) * 32, 32, (bf16*)(ws + WS_WO), 1024, (r & 31) * 32, scr, lane); continue; } r -= I_O;
        transpose_item(a.in[13], 1024, (r >> 5) * 64, (r & 31) * 32, 32, (bf16*)(ws + WS_WPQ), 1024, (r & 31) * 32, scr, lane);
    }
    const size_t gt = (size_t)blk * 512 + tid, NT_ = (size_t)G * 512;
    cvt_stream(a.in[14], (bf16*)(ws + WS_SK), (size_t)16 * 128 * 64 / 8, gt, NT_);
    cvt_rows_fp6(a.in[15], ws + WS_PU, (float*)(ws + WS_RSU), gw, NGW, lane);
    cvt_rows_fp6(a.in[16], ws + WS_PV, (float*)(ws + WS_RSV), gw, NGW, lane);
}

__device__ __forceinline__ float wave_sum_dpp(float x) {
    x += __uint_as_float((unsigned)__builtin_amdgcn_update_dpp(0, (int)__float_as_uint(x), 0x141, 0xF, 0xF, false));
    x += __uint_as_float((unsigned)__builtin_amdgcn_update_dpp(0, (int)__float_as_uint(x), 0x1B, 0xF, 0xF, false));
    x += __uint_as_float((unsigned)__builtin_amdgcn_update_dpp(0, (int)__float_as_uint(x), 0xB1, 0xF, 0xF, false));
    x += __uint_as_float((unsigned)__builtin_amdgcn_update_dpp(0, (int)__float_as_uint(x), 0x128, 0xF, 0xF, false));
    const int xi = (int)__float_as_uint(x);
    return (__uint_as_float((unsigned)__builtin_amdgcn_readlane(xi, 0)) + __uint_as_float((unsigned)__builtin_amdgcn_readlane(xi, 16))) +
           (__uint_as_float((unsigned)__builtin_amdgcn_readlane(xi, 32)) + __uint_as_float((unsigned)__builtin_amdgcn_readlane(xi, 48)));
}
template <bool RESID> __device__ __forceinline__ void norm_phase(const float* X, const float* nw, const float* MOD, int sh_off, bf16* O, int G, int blk, float* OUT = nullptr) {
    const int tid_ = phase_tid(); const int lane = tid_ & 63, wave = __builtin_amdgcn_readfirstlane(tid_ >> 6);
    const int stride = G * NWAVES;
    for (int m0 = blk * NWAVES + wave; m0 < T; m0 += 2 * stride) {
        const int m1 = (m0 + stride < T) ? m0 + stride : m0;
        f32x4 va[4], vb[4]; float sa = 0.f, sbb = 0.f;
        const f32x4* xa = (const f32x4*)(X + (size_t)m0 * DM) + lane; const f32x4* xb = (const f32x4*)(X + (size_t)m1 * DM) + lane;
#pragma unroll
        for (int j = 0; j < 4; ++j) { va[j] = xa[64 * j]; vb[j] = xb[64 * j]; }
        if (RESID) {
            const unsigned long long* da = (const unsigned long long*)(O + (size_t)m0 * DM) + lane; const unsigned long long* db = (const unsigned long long*)(O + (size_t)m1 * DM) + lane;
            f32x4* oa4 = (f32x4*)(OUT + (size_t)m0 * DM) + lane; f32x4* ob4 = (f32x4*)(OUT + (size_t)m1 * DM) + lane;
#pragma unroll
            for (int j = 0; j < 4; ++j) { const unsigned long long pa = da[64 * j], pb = db[64 * j];
                va[j] += (f32x4){bflo((unsigned)pa), bfhi((unsigned)pa), bflo((unsigned)(pa >> 32)), bfhi((unsigned)(pa >> 32))};
                vb[j] += (f32x4){bflo((unsigned)pb), bfhi((unsigned)pb), bflo((unsigned)(pb >> 32)), bfhi((unsigned)(pb >> 32))};
                oa4[64 * j] = va[j]; ob4[64 * j] = vb[j]; }
        }
#pragma unroll
        for (int j = 0; j < 4; ++j) { sa += (va[j].x * va[j].x + va[j].y * va[j].y) + (va[j].z * va[j].z + va[j].w * va[j].w); sbb += (vb[j].x * vb[j].x + vb[j].y * vb[j].y) + (vb[j].z * vb[j].z + vb[j].w * vb[j].w); }
        const float ra = __builtin_amdgcn_rsqf(wave_sum_dpp(sa) * (1.f / DM) + EPS), rb = __builtin_amdgcn_rsqf(wave_sum_dpp(sbb) * (1.f / DM) + EPS);
        const float* mda = MOD + (size_t)(m0 >> 12) * 6144 + sh_off; const float* mdb = MOD + (size_t)(m1 >> 12) * 6144 + sh_off;
        unsigned long long* oa = (unsigned long long*)(O + (size_t)m0 * DM) + lane; unsigned long long* ob = (unsigned long long*)(O + (size_t)m1 * DM) + lane;
#pragma unroll
        for (int j = 0; j < 4; ++j) {
            const f32x4 w = ((const f32x4*)nw)[lane + 64 * j];
            const f32x4 ha = (va[j] * ra * w) * (((const f32x4*)(mda + 1024))[lane + 64 * j] + 1.f) + ((const f32x4*)mda)[lane + 64 * j];
            const f32x4 hb = (vb[j] * rb * w) * (((const f32x4*)(mdb + 1024))[lane + 64 * j] + 1.f) + ((const f32x4*)mdb)[lane + 64 * j];
            oa[64 * j] = (unsigned long long)pk2(ha.x, ha.y) | ((unsigned long long)pk2(ha.z, ha.w) << 32);
            ob[64 * j] = (unsigned long long)pk2(hb.x, hb.y) | ((unsigned long long)pk2(hb.z, hb.w) << 32);
        }
    }
}

__device__ __forceinline__ void conv_phase(const bf16* CB, const bf16* CC, const bf16* CX, const float* cw, bf16* UA, int G, int blk) {
    const size_t n = (size_t)T * 64;
    const int ctid = phase_tid();
#pragma unroll 4
    for (size_t i = (size_t)blk * 512 + ctid; i < n; i += (size_t)G * 512) {
        const int c8 = (int)(i & 63) * 8; const size_t row = i >> 6; const int t = (int)(row & (SEQ - 1));
        float accv[8];
#pragma unroll
        for (int e = 0; e < 8; ++e) accv[e] = 0.f;
#pragma unroll
        for (int j = 0; j < 3; ++j) {
            if (t - 2 + j >= 0) {
                const size_t off = (row - 2 + j) * 512 + c8;
                const u32x4 a = *(const u32x4*)(CC + off), b = *(const u32x4*)(CX + off);
                const f32x4 w0 = *(const f32x4*)(cw + j * 512 + c8), w1 = *(const f32x4*)(cw + j * 512 + c8 + 4);
                accv[0] += w0[0] * bflo(a.x) * bflo(b.x); accv[1] += w0[1] * bfhi(a.x) * bfhi(b.x);
                accv[2] += w0[2] * bflo(a.y) * bflo(b.y); accv[3] += w0[3] * bfhi(a.y) * bfhi(b.y);
                accv[4] += w1[0] * bflo(a.z) * bflo(b.z); accv[5] += w1[1] * bfhi(a.z) * bfhi(b.z);
                accv[6] += w1[2] * bflo(a.w) * bflo(b.w); accv[7] += w1[3] * bfhi(a.w) * bfhi(b.w);
            }
        }
        const u32x4 g = *(const u32x4*)(CB + row * 512 + c8);
        u32x4 o; o.x = pk2(accv[0] * bflo(g.x), accv[1] * bfhi(g.x)); o.y = pk2(accv[2] * bflo(g.y), accv[3] * bfhi(g.y));
        o.z = pk2(accv[4] * bflo(g.z), accv[5] * bfhi(g.z)); o.w = pk2(accv[6] * bflo(g.w), accv[7] * bfhi(g.w));
        *(u32x4*)(UA + row * 1024 + c8) = o;
    }
}

template <int N> __device__ __forceinline__ void bitonic_sort_desc(unsigned* a) {
#pragma unroll
    for (int k = 2; k <= N; k <<= 1)
#pragma unroll
        for (int j = k >> 1; j > 0; j >>= 1)
#pragma unroll
            for (int i = 0; i < N; ++i) { const int l = i ^ j; if (l > i) { const bool desc = (i & k) == 0; const unsigned x = a[i], y = a[l]; const unsigned mx = x > y ? x : y, mn = x > y ? y : x; a[i] = desc ? mx : mn; a[l] = desc ? mn : mx; } }
}
__device__ __forceinline__ void merge_top16(unsigned* a, const unsigned* b) {
#pragma unroll
    for (int i = 0; i < 16; ++i) { const unsigned y = b[15 - i]; a[i] = a[i] > y ? a[i] : y; }
#pragma unroll
    for (int j = 8; j > 0; j >>= 1)
#pragma unroll
        for (int i = 0; i < 16; ++i) if ((i & j) == 0) { const unsigned x = a[i], y = a[i + j]; a[i] = x > y ? x : y; a[i + j] = x > y ? y : x; }
}
__device__ __forceinline__ void top16_of_64(unsigned* a) {
    bitonic_sort_desc<16>(a); bitonic_sort_desc<16>(a + 16); bitonic_sort_desc<16>(a + 32); bitonic_sort_desc<16>(a + 48);
    merge_top16(a, a + 16); merge_top16(a + 32, a + 48); merge_top16(a, a + 32);
}
template <int NR> __device__ __forceinline__ int count_ge(const unsigned* k, unsigned cand) {
    int cv = 0;
#pragma unroll
    for (int r = 0; r < NR; ++r) cv += (k[r] >= cand) ? 1 : 0;
    cv += __builtin_amdgcn_update_dpp(0, cv, 0x141, 0xF, 0xF, false); cv += __builtin_amdgcn_update_dpp(0, cv, 0x1B, 0xF, 0xF, false);
    cv += __builtin_amdgcn_update_dpp(0, cv, 0xB1, 0xF, 0xF, false); cv += __builtin_amdgcn_update_dpp(0, cv, 0x128, 0xF, 0xF, false);
    return __builtin_amdgcn_readlane(cv, 0) + __builtin_amdgcn_readlane(cv, 16) + __builtin_amdgcn_readlane(cv, 32) + __builtin_amdgcn_readlane(cv, 48);
}
template <int NR> __device__ __forceinline__ unsigned descent256(const unsigned* k) {
    unsigned tau = 0u;
    for (int bit = 31; bit >= 0; --bit) {
        const unsigned cand = tau | (1u << bit);
        const int cnt = count_ge<NR>(k, cand);
        if (cnt >= 256) tau = cand;
        if (cnt == 256) break;
    }
    return tau;
}
template <int NR> __device__ __forceinline__ void select_query(const LAS unsigned* row, int nvalid, int tq, LAS unsigned long long* mrow, int lane) {
    unsigned k[NR];
    const bool lowhalf = lane < 32;
#define SEL_LOAD() _Pragma("unroll") for (int r = 0; r < NR; ++r) { const unsigned v = row[64 * r + lane]; k[r] = (64 * r + 64 <= nvalid) ? v : ((64 * r < nvalid && lowhalf) ? v : 0u); }
    SEL_LOAD()
    unsigned tau = 0u;
    if (tq >= 256) {
        if constexpr (NR > 16) {
#pragma unroll
            for (int g = 0; g < NR / 16; ++g) bitonic_sort_desc<16>(k + 16 * g);
            if constexpr (NR == 64) { merge_top16(k, k + 16); merge_top16(k + 32, k + 48); merge_top16(k, k + 32); }
            else if constexpr (NR == 48) { merge_top16(k, k + 16); merge_top16(k, k + 32); }
            else merge_top16(k, k + 16);
            tau = descent256<16>(k);
            const bool bad = __ballot(k[15] >= tau) != 0ull;
            SEL_LOAD()
            if (bad) tau = descent256<NR>(k);
        } else tau = descent256<NR>(k);
    }
#undef SEL_LOAD
    if (tau == 0u) tau = 1u;
#pragma unroll
    for (int r = 0; r < 64; ++r) { const unsigned long long m = r < NR ? __ballot(k[r < NR ? r : 0] >= tau) : 0ull; if (lane == 0) mrow[r * 8] = m; }
}

#ifndef PROBE_SUB
#define PROBE_SUB 0
#endif
__device__ __forceinline__ void indexer_phase(LAS unsigned char* lds, const bf16* QI, const bf16* KI, const float* WI, unsigned long long* MASK, int G, int blk) {
    volatile LAS unsigned long long* pst = (volatile LAS unsigned long long*)(lds + LDS_BYTES - 48);
    LAS unsigned* sc = (LAS unsigned*)lds;
    const int tid = phase_tid(), lane = tid & 63, wave = __builtin_amdgcn_readfirstlane(tid >> 6), r32 = lane & 31, hi = lane >> 5;
    const int ra = (r32 >> 4) & 1, rb = (r32 >> 3) & 1, rc = (r32 >> 2) & 1, rd = r32 & 3;
    bf16x8 aq[2][4]; f32x4 wv[2][2][2]; bf16x8 bk[3][4];
#define IDX_UNIT_GEOM(uid_) const int b = (uid_) >> 9; int j = (uid_) & 511; if (j >= 256) j = 767 - j; const int tq0 = 8 * j; const size_t row0 = (size_t)b * SEQ + tq0; const int nkt = (tq0 + 8 + 31) >> 5; \
        const bf16* kbase = KI + ((size_t)b * SEQ + r32) * 64 + hi * 8;
#define IDX_UNIT_LOAD() do { \
        _Pragma("unroll") for (int rt = 0; rt < 2; ++rt) { \
            const bf16* qp = QI + (row0 + rt * 4 + 2 * rc + ra) * 512 + (4 * rb + rd) * 64 + hi * 8; \
            _Pragma("unroll") for (int d0 = 0; d0 < 4; ++d0) aq[rt][d0] = *(const bf16x8*)(qp + d0 * 16); } } while (0)
    if (blk < T / 8) { IDX_UNIT_GEOM(blk) IDX_UNIT_LOAD(); }
    for (int uid = blk; uid < T / 8; uid += G) {
        IDX_UNIT_GEOM(uid)
#pragma unroll
        for (int rt = 0; rt < 2; ++rt)
#pragma unroll
            for (int a2 = 0; a2 < 2; ++a2) { const float* wp = WI + (row0 + rt * 4 + 2 * hi + a2) * 8; wv[rt][a2][0] = *(const f32x4*)wp; wv[rt][a2][1] = *(const f32x4*)(wp + 4); }
#pragma unroll
        for (int jj = 0; jj < 3; ++jj) { int kt = wave + NWAVES * jj; if (kt >= nkt) kt = nkt - 1;
#pragma unroll
            for (int d0 = 0; d0 < 4; ++d0) bk[jj][d0] = *(const bf16x8*)(kbase + (size_t)kt * 32 * 64 + d0 * 16); }
        if (PROBE_SUB && threadIdx.x == 0) pst[3] = __builtin_amdgcn_s_memrealtime();
#define IDX_TILE(JT) { \
                constexpr int jj = (JT) % 3; \
                int kt = wave + NWAVES * (JT); asm volatile("" : "+s"(kt));       \
                const bool live = kt < nkt; \
                const int key = 32 * kt + r32; \
                f32x16 acc0 = {}, acc1 = {}; \
                _Pragma("unroll") for (int d0 = 0; d0 < 4; ++d0) { acc0 = __builtin_amdgcn_mfma_f32_32x32x16_bf16(aq[0][d0], bk[jj][d0], acc0, 0, 0, 0); acc1 = __builtin_amdgcn_mfma_f32_32x32x16_bf16(aq[1][d0], bk[jj][d0], acc1, 0, 0, 0); } \
                if ((JT) + 3 < NTW) { int ktn = kt + 3 * NWAVES; if (ktn >= nkt) ktn = nkt - 1; \
                    _Pragma("unroll") for (int d0 = 0; d0 < 4; ++d0) bk[jj][d0] = *(const bf16x8*)(kbase + (size_t)ktn * 32 * 64 + d0 * 16); } \
                _Pragma("unroll") for (int rt = 0; rt < 2; ++rt) \
                    _Pragma("unroll") for (int a2 = 0; a2 < 2; ++a2) { \
                        float sv = 0.f; \
                        _Pragma("unroll") for (int i = 0; i < 8; ++i) { const int xb = (int)__float_as_uint(rt ? acc1[8 * a2 + i] : acc0[8 * a2 + i]); sv += __uint_as_float((unsigned)(xb > 0 ? xb : 0)) * wv[rt][a2][i >> 2][i & 3]; } \
                        const int ql = rt * 4 + 2 * hi + a2; \
                        const unsigned ck = (key <= tq0 + ql) ? ((ordf(sv) & 0xfffff000u) | (unsigned)(4095 - key)) : 0u; \
                        sc[live ? ql * 4096 + key : 33792 + lane] = ck; \
                    } \
                __builtin_amdgcn_sched_barrier(0); }
#define IDX_TILES4(J0) IDX_TILE((J0)) IDX_TILE((J0) + 1) IDX_TILE((J0) + 2) IDX_TILE((J0) + 3)
        if (nkt <= 32) { constexpr int NTW = 4; IDX_TILES4(0) }
        else if (nkt <= 64) { constexpr int NTW = 8; IDX_TILES4(0) IDX_TILES4(4) }
        else if (nkt <= 96) { constexpr int NTW = 12; IDX_TILES4(0) IDX_TILES4(4) IDX_TILES4(8) }
        else { constexpr int NTW = 16; IDX_TILES4(0) IDX_TILES4(4) IDX_TILES4(8) IDX_TILES4(12) }
#undef IDX_TILES4
#undef IDX_TILE
        __syncthreads();
        if (uid + G < T / 8) { IDX_UNIT_GEOM(uid + G) IDX_UNIT_LOAD(); }
        if (PROBE_SUB == 1 && threadIdx.x == 0) pst[2] += __builtin_amdgcn_s_memrealtime() - pst[3];
        if (PROBE_SUB == 2 && threadIdx.x == 0) pst[3] = __builtin_amdgcn_s_memrealtime();
        {
            const int tq = tq0 + wave, nvalid = 32 * nkt;
            LAS unsigned long long* mrow = (LAS unsigned long long*)(lds + 131072) + wave;
            const LAS unsigned* rowp = sc + wave * 4096;
            if (nvalid <= 1024) select_query<16>(rowp, nvalid, tq, mrow, lane);
            else if (nvalid <= 2048) select_query<32>(rowp, nvalid, tq, mrow, lane);
            else if (nvalid <= 3072) select_query<48>(rowp, nvalid, tq, mrow, lane);
            else select_query<64>(rowp, nvalid, tq, mrow, lane);
        }
        __syncthreads();
        __hip_atomic_store(MASK + ((size_t)b * 64 + (tid >> 3)) * SEQ + tq0 + (tid & 7), ((const LAS unsigned long long*)(lds + 131072))[tid], __ATOMIC_RELAXED, __HIP_MEMORY_SCOPE_AGENT);
        if (PROBE_SUB == 2 && threadIdx.x == 0) pst[2] += __builtin_amdgcn_s_memrealtime() - pst[3];
    }
}

namespace att {
constexpr int KCP = 1040, KSLOT = 8 * KCP, VDH = 4160, VSLOT = 2 * VDH;
constexpr int L_K = 0, L_V = 4 * KSLOT, L_OST = L_V + 4 * VSLOT, L_END = L_OST + NWAVES * 4096;
__device__ __forceinline__ int crow(int r, int hi) { return (r & 3) + 8 * (r >> 2) + 4 * hi; }
#define SBAR() __builtin_amdgcn_sched_barrier(0)
__device__ __forceinline__ void qkt(f32x16& p0, f32x16& p1, const LAS unsigned char* kb, const bf16x8* qr, const f32x16& negm) {
#pragma unroll
    for (int d0 = 0; d0 < 4; ++d0) {
        const bf16x8 b0 = *(const LAS bf16x8*)(kb + d0 * 2 * KCP);
        const bf16x8 b1 = *(const LAS bf16x8*)(kb + d0 * 2 * KCP + 512);
        if (d0 == 0) { p0 = __builtin_amdgcn_mfma_f32_32x32x16_bf16(b0, qr[0], negm, 0, 0, 0); p1 = __builtin_amdgcn_mfma_f32_32x32x16_bf16(b1, qr[0], negm, 0, 0, 0); }
        else { p0 = __builtin_amdgcn_mfma_f32_32x32x16_bf16(b0, qr[d0], p0, 0, 0, 0); p1 = __builtin_amdgcn_mfma_f32_32x32x16_bf16(b1, qr[d0], p1, 0, 0, 0); } }
}
__device__ __forceinline__ void pv(f32x16* o, f32x16& osum, int vb, bf16x8 pa0, bf16x8 pa1, bf16x8 pa2, bf16x8 pa3) {
    {
        const bf16x8 ones = {0x3f80, 0x3f80, 0x3f80, 0x3f80, 0x3f80, 0x3f80, 0x3f80, 0x3f80};
        osum = __builtin_amdgcn_mfma_f32_32x32x16_bf16(pa0, ones, osum, 0, 0, 0); osum = __builtin_amdgcn_mfma_f32_32x32x16_bf16(pa1, ones, osum, 0, 0, 0);
        osum = __builtin_amdgcn_mfma_f32_32x32x16_bf16(pa2, ones, osum, 0, 0, 0); osum = __builtin_amdgcn_mfma_f32_32x32x16_bf16(pa3, ones, osum, 0, 0, 0);
    }
#pragma unroll
    for (int d0 = 0; d0 < 2; ++d0) { s16x4 lo[4], hi[4];
#pragma unroll
        for (int ks = 0; ks < 4; ++ks) {
            asm volatile("ds_read_b64_tr_b16 %0,%1 offset:%c2" : "=&v"(lo[ks]) : "v"(vb), "i"(d0 * VDH + ks * 1024) : "memory");
            asm volatile("ds_read_b64_tr_b16 %0,%1 offset:%c2" : "=&v"(hi[ks]) : "v"(vb), "i"(d0 * VDH + ks * 1024 + 512) : "memory"); }
        asm volatile("s_waitcnt lgkmcnt(0)" ::: "memory"); SBAR();
#define PK(k) (bf16x8){lo[k][0], lo[k][1], lo[k][2], lo[k][3], hi[k][0], hi[k][1], hi[k][2], hi[k][3]}
        o[d0] = __builtin_amdgcn_mfma_f32_32x32x16_bf16(pa0, PK(0), o[d0], 0, 0, 0);
        o[d0] = __builtin_amdgcn_mfma_f32_32x32x16_bf16(pa1, PK(1), o[d0], 0, 0, 0);
        o[d0] = __builtin_amdgcn_mfma_f32_32x32x16_bf16(pa2, PK(2), o[d0], 0, 0, 0);
        o[d0] = __builtin_amdgcn_mfma_f32_32x32x16_bf16(pa3, PK(3), o[d0], 0, 0, 0);
#undef PK
    }
}

__device__ __forceinline__ void attn_phase(LAS unsigned char* lds, const bf16* Q, const bf16* K, const bf16* V, const unsigned long long* MASK, const float* qnw, const float* knw, bf16* UA, int G, int blk) {
    const int tid = phase_tid(), lane = tid & 63, r32 = lane & 31, hi = lane >> 5, wid = __builtin_amdgcn_readfirstlane(tid >> 6);
    float mq = fabsf(qnw[lane]), mk = fabsf(knw[lane]);
#pragma unroll
    for (int o = 1; o < 64; o <<= 1) { mq = fmaxf(mq, __shfl_xor(mq, o)); mk = fmaxf(mk, __shfl_xor(mk, o)); }
    const float nb = -(8.f * 1.4426950408889634f) * mq * mk;
    f32x16 negm;
#pragma unroll
    for (int r = 0; r < 16; ++r) negm[r] = nb;
    const unsigned kdst = L_K + (tid & 7) * KCP + (tid >> 3) * 16;
    const unsigned vdst = L_V + ((tid & 7) >> 2) * VDH + ((tid >> 3) >> 4) * 1024 + ((tid >> 3) & 15) * 64 + (tid & 3) * 16;
    const LAS unsigned char* kp0 = lds + L_K + hi * KCP + r32 * 16;
    const int vb0 = (int)(uintptr_t)(lds + L_V) + ((lane >> 4) & 1) * 32 + (lane & 3) * 8 + (4 * hi + ((lane & 15) >> 2)) * 64;
    for (int uid = blk; uid < 2048; uid += G) {
        const int ui = uid >> 8; int c = uid & 255; c = (c & 7) * 32 + (c >> 3);
        const int bh = c >> 1, s = c & 1, pp = ui >> 1, qb = (ui & 1) ? 15 - (2 * pp + s) : (2 * pp + s);
        const int b = bh >> 3, h = bh & 7, q0 = qb * 256;
        const size_t rowbase = (size_t)b * SEQ;
        const bf16* Qw = Q + (rowbase + q0 + wid * 32) * 512 + h * 64;
        bf16* Ow = UA + (rowbase + q0 + wid * 32) * 1024 + 512 + h * 64;
        bf16x8 qr[4];
#pragma unroll
        for (int d0 = 0; d0 < 4; ++d0) qr[d0] = *(const bf16x8*)(Qw + (size_t)r32 * 512 + d0 * 16 + hi * 8);
        const int NT = 4 * (qb + 1);
        const unsigned long long* mptr = MASK + (size_t)b * 64 * SEQ + q0 + wid * 32 + r32;
        const bf16* ksrc = K + ((size_t)bh * SEQ) * 64 + tid * 8;
        const bf16* vsrc = V + ((size_t)bh * SEQ) * 64 + tid * 8;
        f32x16 o[2]; o[0] = f32x16{}; o[1] = f32x16{};
        f32x16 osum = f32x16{};
        const int T2 = NT / 2;
        u32x4 kreg[2][2], vreg[2][2]; unsigned long long mwq[2][2], mw[2];
#pragma unroll
        for (int sb_ = 0; sb_ < 2; ++sb_) {
            kreg[0][sb_] = *(const u32x4*)(ksrc + (size_t)sb_ * 4096); vreg[0][sb_] = *(const u32x4*)(vsrc + (size_t)sb_ * 4096); mw[sb_] = mptr[(size_t)sb_ * SEQ];
            kreg[1][sb_] = *(const u32x4*)(ksrc + (size_t)(2 + sb_) * 4096); vreg[1][sb_] = *(const u32x4*)(vsrc + (size_t)(2 + sb_) * 4096); mwq[1][sb_] = mptr[(size_t)(2 + sb_) * SEQ]; mwq[0][sb_] = 0ull;
            *(LAS u32x4*)(lds + kdst + sb_ * KSLOT) = kreg[0][sb_]; *(LAS u32x4*)(lds + vdst + sb_ * VSLOT) = vreg[0][sb_];
        }
        __syncthreads();
        const int qmax = q0 + wid * 32 + 31;
#define ATT_SUB(P, SB) if (64 * (2 * t + (SB)) <= qmax) { \
                f32x16 p0, p1; \
                qkt(p0, p1, kp0 + ((P) * 2 + (SB)) * KSLOT, qr, negm); \
                const unsigned mlo = (unsigned)mw[SB] >> (4 * hi), mhi = (unsigned)(mw[SB] >> 32) >> (4 * hi); \
                _Pragma("unroll") for (int r = 0; r < 16; ++r) { p0[r] = __builtin_amdgcn_exp2f(p0[r]); p1[r] = __builtin_amdgcn_exp2f(p1[r]); } \
                  \
                unsigned pk_[16]; \
                _Pragma("unroll") for (int i = 0; i < 8; ++i) { const int bp = ((2 * i) & 3) + 8 * ((2 * i) >> 2); \
                    const unsigned m0a = (unsigned)__builtin_amdgcn_sbfe((int)mlo, bp, 1), m0b = (unsigned)__builtin_amdgcn_sbfe((int)mlo, bp + 1, 1); \
                    const unsigned m1a = (unsigned)__builtin_amdgcn_sbfe((int)mhi, bp, 1), m1b = (unsigned)__builtin_amdgcn_sbfe((int)mhi, bp + 1, 1); \
                    pk_[i] = pk2(p0[2 * i], p0[2 * i + 1]) & __builtin_amdgcn_perm(m0b, m0a, 0x05040100u); \
                    pk_[8 + i] = pk2(p1[2 * i], p1[2 * i + 1]) & __builtin_amdgcn_perm(m1b, m1a, 0x05040100u); } \
                const u32x4 pw0 = (u32x4){pk_[0], pk_[1], pk_[2], pk_[3]}, pw1 = (u32x4){pk_[4], pk_[5], pk_[6], pk_[7]}; \
                const u32x4 pw2 = (u32x4){pk_[8], pk_[9], pk_[10], pk_[11]}, pw3 = (u32x4){pk_[12], pk_[13], pk_[14], pk_[15]}; \
                pv(o, osum, vb0 + ((P) * 2 + (SB)) * VSLOT, __builtin_bit_cast(bf16x8, pw0), __builtin_bit_cast(bf16x8, pw1), __builtin_bit_cast(bf16x8, pw2), __builtin_bit_cast(bf16x8, pw3)); \
            }
#define ATT_STEP(P)    \
        { \
            { const int tp = (t + 2 < T2) ? t + 2 : T2 - 1; \
              _Pragma("unroll") for (int sb_ = 0; sb_ < 2; ++sb_) { kreg[P][sb_] = *(const u32x4*)(ksrc + (size_t)(2 * tp + sb_) * 4096); vreg[P][sb_] = *(const u32x4*)(vsrc + (size_t)(2 * tp + sb_) * 4096); mwq[P][sb_] = mptr[(size_t)(2 * tp + sb_) * SEQ]; } } \
            ATT_SUB(P, 0) \
            ATT_SUB(P, 1) \
            _Pragma("unroll") for (int sb_ = 0; sb_ < 2; ++sb_) { *(LAS u32x4*)(lds + kdst + ((1 - (P)) * 2 + sb_) * KSLOT) = kreg[1 - (P)][sb_]; *(LAS u32x4*)(lds + vdst + ((1 - (P)) * 2 + sb_) * VSLOT) = vreg[1 - (P)][sb_]; mw[sb_] = mwq[1 - (P)][sb_]; } \
            __syncthreads(); \
        }
        for (int t = 0; t < T2; t += 2) {
            ATT_STEP(0)
            ++t;
            ATT_STEP(1)
            --t;
        }
#undef ATT_STEP
#undef ATT_SUB
        float rli[16];
#pragma unroll
        for (int r = 0; r < 16; ++r) rli[r] = __builtin_amdgcn_rcpf(osum[r]);
        LAS bf16* stg = (LAS bf16*)(lds + L_OST) + wid * 2048;
#pragma unroll
        for (int r = 0; r < 16; ++r) { const int orow = crow(r, hi);
#pragma unroll
            for (int d0 = 0; d0 < 2; ++d0) stg[orow * 64 + d0 * 32 + r32] = (bf16)(pk2(o[d0][r] * rli[r], 0.f) & 0xffffu); }
        LDS_WAIT();
#pragma unroll
        for (int i = 0; i < 4; ++i) { const int row = i * 8 + (lane >> 3), ch = lane & 7; const u32x4 v = *(const LAS u32x4*)(stg + row * 64 + ch * 8); *(u32x4*)(Ow + (size_t)row * 1024 + ch * 8) = v; }
        LDS_WAIT();
    }
}
#undef SBAR
}

__device__ __forceinline__ void peer_route_phase(LAS unsigned char* lds, const bf16* PQ, const bf16* SK, unsigned short* EIDX, float* EG, int G, int blk) {
    const int tid = phase_tid(), lane = tid & 63, r32 = lane & 31, hi = lane >> 5, wave = __builtin_amdgcn_readfirstlane(tid >> 6);
    LAS unsigned* win = (LAS unsigned*)(lds + wave * 12288);
    LAS unsigned* fwn = win + 2 * 16 * 64;
    const int gw = blk * NWAVES + wave, NGW = G * NWAVES, h = gw & 7;
    for (int tg = gw >> 3; tg < T / 32; tg += NGW >> 3) {
        const size_t t0 = (size_t)tg * 32;
#pragma unroll 1
        for (int half = 0; half < 2; ++half) {
            const int p = 2 * h + half;
            bf16x8 bq[4];
#pragma unroll
            for (int d0 = 0; d0 < 4; ++d0) bq[d0] = *(const bf16x8*)(PQ + (t0 + r32) * 1024 + 128 * h + 64 * half + 16 * d0 + 8 * hi);
            unsigned ck[64];
#pragma unroll
            for (int nb = 0; nb < 4; ++nb) {
                f32x16 acc = {};
#pragma unroll
                for (int d0 = 0; d0 < 4; ++d0) { const bf16x8 a = *(const bf16x8*)(SK + ((size_t)p * 128 + 32 * nb + r32) * 64 + 16 * d0 + 8 * hi); acc = __builtin_amdgcn_mfma_f32_32x32x16_bf16(a, bq[d0], acc, 0, 0, 0); }
#pragma unroll
                for (int r = 0; r < 16; ++r) ck[nb * 16 + r] = (ordf(acc[r]) & ~0x7fu) | (unsigned)(127 - (32 * nb + att::crow(r, hi)));
            }
            top16_of_64(ck);
            unsigned pb[16];
#pragma unroll
            for (int i = 0; i < 16; ++i) { auto rr = __builtin_amdgcn_permlane32_swap(ck[i], ck[i], false, false); pb[i] = hi ? rr[0] : rr[1]; }
            merge_top16(ck, pb);
#pragma unroll
            for (int i = 0; i < 16; ++i) win[(half * 16 + i) * 64 + lane] = ck[i];
        }
        LDS_WAIT();
        float v0[16], v1[16];
#pragma unroll
        for (int i = 0; i < 16; ++i) { v0[i] = unordf(win[i * 64 + lane] & ~0x7fu); v1[i] = unordf(win[(16 + i) * 64 + lane] & ~0x7fu); }
        unsigned c2[64];
        {
            int n = 0;
#pragma unroll
            for (int i = 0; i < 16; ++i)
#pragma unroll
                for (int j = 0; j < 16; ++j) if ((i + 1) * (j + 1) <= 16) { c2[n] = (ordf(v0[i] + v1[j]) & ~0xffu) | (unsigned)(255 - (16 * i + j)); ++n; }
#pragma unroll
            for (int q = 50; q < 64; ++q) c2[q] = 0u;
        }
        top16_of_64(c2);
        float sc[16]; unsigned ex[16];
#pragma unroll
        for (int k = 0; k < 16; ++k) {
            const unsigned f = c2[k]; const int idx = 255 - (int)(f & 0xffu), i = idx >> 4, j = idx & 15;
            const unsigned w0 = win[i * 64 + lane], w1 = win[(16 + j) * 64 + lane];
            ex[k] = (127u - (w0 & 0x7fu)) * 128u + (127u - (w1 & 0x7fu));
            sc[k] = unordf(w0 & ~0x7fu) + unordf(w1 & ~0x7fu);
        }
        const float mx = sc[0];
        float sum = 0.f;
#pragma unroll
        for (int k = 0; k < 16; ++k) { sc[k] = __expf(sc[k] - mx); sum += sc[k]; }
        const float inv = 1.f / sum;
#pragma unroll
        for (int k = 0; k < 16; ++k) sc[k] *= inv;
        if (hi == 0) {
            unsigned short* ep = EIDX + (t0 + r32) * 128 + h * 16; float* gp = EG + (t0 + r32) * 128 + h * 16;
            *(u32x4*)ep = (u32x4){ex[0] | (ex[1] << 16), ex[2] | (ex[3] << 16), ex[4] | (ex[5] << 16), ex[6] | (ex[7] << 16)};
            *(u32x4*)(ep + 8) = (u32x4){ex[8] | (ex[9] << 16), ex[10] | (ex[11] << 16), ex[12] | (ex[13] << 16), ex[14] | (ex[15] << 16)};
#pragma unroll
            for (int q = 0; q < 4; ++q) *(f32x4*)(gp + 4 * q) = (f32x4){sc[4 * q], sc[4 * q + 1], sc[4 * q + 2], sc[4 * q + 3]};
        }
        LDS_WAIT();
    }
}

__device__ __forceinline__ f32x2 gelu_pk(f32x2 v) {
    const f32x2 av = __builtin_elementwise_abs(v), dd = av * 0.2316418882f + 1.0f;
    f32x2 tt; tt.x = __builtin_amdgcn_rcpf(dd.x); tt.y = __builtin_amdgcn_rcpf(dd.y);
    f32x2 q = tt * 0.5307027145f + (-0.7265760135f); q = q * tt + 0.7107068705f; q = q * tt + (-0.142248368f); q = q * tt + 0.127414796f; q = q * tt;
    const f32x2 sq = (v * v) * (-0.72134752044f);
    f32x2 ee; ee.x = __builtin_amdgcn_exp2f(sq.x); ee.y = __builtin_amdgcn_exp2f(sq.y);
    const f32x2 mm = v * (q * ee), rr = v - mm;
    f32x2 o; o.x = v.x < 0.f ? mm.x : rr.x; o.y = v.y < 0.f ? mm.y : rr.y; return o;
}
__device__ __forceinline__ float dpp_f(float x, const int ctrl_sel) {
    const int xi = (int)__float_as_uint(x); int r;
    if (ctrl_sel == 0) r = __builtin_amdgcn_update_dpp(0, xi, 0x128, 0xF, 0xF, false);
    else if (ctrl_sel == 1) r = __builtin_amdgcn_update_dpp(0, xi, 0x141, 0xF, 0xF, false);
    else if (ctrl_sel == 2) r = __builtin_amdgcn_update_dpp(0, xi, 0x1B, 0xF, 0xF, false);
    else r = __builtin_amdgcn_update_dpp(0, xi, 0xB1, 0xF, 0xF, false);
    return __uint_as_float((unsigned)r);
}
__device__ __forceinline__ float reduce8_rows(float* d, int lane) {
#pragma unroll
    for (int i = 0; i < 4; ++i) { auto r = __builtin_amdgcn_permlane32_swap(__float_as_uint(d[i]), __float_as_uint(d[i + 4]), false, false); d[i] = __uint_as_float(r[0]) + __uint_as_float(r[1]); }
#pragma unroll
    for (int i = 0; i < 2; ++i) { auto r = __builtin_amdgcn_permlane16_swap(__float_as_uint(d[i]), __float_as_uint(d[i + 2]), false, false); d[i] = __uint_as_float(r[0]) + __uint_as_float(r[1]); }
    const bool up = lane & 8; const float keep = up ? d[1] : d[0], send = up ? d[0] : d[1];
    float x = keep + dpp_f(send, 0);
    x += dpp_f(x, 1); x += dpp_f(x, 2); x += dpp_f(x, 3);
    return x;
}
typedef int v8i_t __attribute__((ext_vector_type(8)));
#define HSC_TEST 0
__device__ __forceinline__ void peer_u_simple(LAS unsigned char* lds, const bf16* H2, tab_ptr PU, const float* RSU, const float* RSV, unsigned short* EIDX, const float* EG, float* COEF, int G, int blk) {
    const int tid_ = phase_tid(); const int lane = tid_ & 63, wave = __builtin_amdgcn_readfirstlane(tid_ >> 6);
    LAS unsigned char* wl = lds + wave * 17664;
    constexpr int RP = 776;
    LAS int* sid = (LAS int*)(wl + 12416);
    LAS float* sgt = (LAS float*)(wl + 12416 + 512);
    LAS float* res = (LAS float*)(wl + 12416 + 1024);
    LAS float* sul = (LAS float*)(wl + 13504);
    LAS float* gtl = (LAS float*)(wl + 13504 + 2048);
    const unsigned long long lt = (1ull << lane) - 1ull;
    const int n16 = lane & 15, g4 = lane >> 4;
    const int stride = G * NWAVES;
    for (int tb = blk * NWAVES + wave; tb < T; tb += 4 * stride) {
        int idlo[4], idhi[4]; float clo[4], chi[4]; int tt[4]; int tcl[4]; int hsc[4];
        int lp = (int)threadIdx.x; asm volatile("" : "+v"(lp)); lp &= 63;
#pragma unroll
        for (int i = 0; i < 4; ++i) {
            const bool act_i = tb + i * stride < T; const int t = act_i ? tb + i * stride : tb; tt[i] = act_i ? t : -1; tcl[i] = t;
            unsigned short* ep = EIDX + (size_t)t * 128;
            int il = ep[lp], ih = ep[64 + lp]; float gl = EG[(size_t)t * 128 + lp], gh = EG[(size_t)t * 128 + 64 + lp];
            {
                const u32x4 ha = *(const u32x4*)(H2 + (size_t)t * 1024 + 16 * lp), hb = *(const u32x4*)(H2 + (size_t)t * 1024 + 16 * lp + 8);
                typedef unsigned short u16x2_t __attribute__((ext_vector_type(2)));
                u16x2_t mx = {0, 0};
                const unsigned hw[8] = {ha.x, ha.y, ha.z, ha.w, hb.x, hb.y, hb.z, hb.w};
#pragma unroll
                for (int j = 0; j < 8; ++j) mx = __builtin_elementwise_max(mx, __builtin_bit_cast(u16x2_t, hw[j] & 0x7fff7fffu));
                unsigned m = mx.x > mx.y ? mx.x : mx.y;
#pragma unroll
                for (int o = 32; o; o >>= 1) { const unsigned y = (unsigned)__shfl_xor((int)m, o); m = m > y ? m : y; }
                const float tq = __uint_as_float(m << 16) * (1.f / 7.5f);
                const int e = tq > 1.f ? (int)((__float_as_uint(tq) - 1u) >> 23) - 126 + HSC_TEST : HSC_TEST;
                hsc[i] = __builtin_amdgcn_readfirstlane(e);
            }
            {
                const int blo = il >> 10, bhi = ih >> 10; int plo = 0, phi = 0, base = 0;
#pragma unroll
                for (int bb = 0; bb < 16; ++bb) {
                    const unsigned long long ml = __ballot(blo == bb), mh = __ballot(bhi == bb);
                    const int nl = __popcll(ml);
                    plo = (blo == bb) ? base + __popcll(ml & lt) : plo;
                    phi = (bhi == bb) ? base + nl + __popcll(mh & lt) : phi;
                    base += nl + __popcll(mh);
                }
                sid[plo] = il; sid[phi] = ih; sgt[plo] = gl; sgt[phi] = gh;
                il = sid[lane]; ih = sid[64 + lane]; gl = sgt[lane]; gh = sgt[64 + lane];
                if (act_i) { ep[lp] = (unsigned short)il; ep[64 + lp] = (unsigned short)ih; }
            }
            { const float hs = __uint_as_float((unsigned)(127 + hsc[i]) << 23); sul[i * 128 + lp] = RSU[il] * hs; sul[i * 128 + 64 + lp] = RSU[ih] * hs; }
            gtl[i * 128 + lp] = gl * RSV[il]; gtl[i * 128 + 64 + lp] = gh * RSV[ih];
            idlo[i] = il; idhi[i] = ih; clo[i] = 0.f; chi[i] = 0.f;
        }
        v8i_t hB[8];
        {
            const int tl = (n16 & 2) ? ((n16 & 1) ? tcl[3] : tcl[2]) : ((n16 & 1) ? tcl[1] : tcl[0]);
            const int el = (n16 & 2) ? ((n16 & 1) ? hsc[3] : hsc[2]) : ((n16 & 1) ? hsc[1] : hsc[0]);
            const float hdiv = __uint_as_float((unsigned)(127 + el) << 23);
            const bf16* hp = H2 + (size_t)tl * 1024 + 32 * g4;
#pragma unroll
            for (int s8 = 0; s8 < 8; ++s8) {
                const u32x4 q0 = *(const u32x4*)(hp + 128 * s8), q1 = *(const u32x4*)(hp + 128 * s8 + 8), q2 = *(const u32x4*)(hp + 128 * s8 + 16), q3 = *(const u32x4*)(hp + 128 * s8 + 24);
                const unsigned w[16] = {q0.x, q0.y, q0.z, q0.w, q1.x, q1.y, q1.z, q1.w, q2.x, q2.y, q2.z, q2.w, q3.x, q3.y, q3.z, q3.w};
                typedef unsigned v16u_t __attribute__((ext_vector_type(16)));
                const v16u_t wv = {w[0], w[1], w[2], w[3], w[4], w[5], w[6], w[7], w[8], w[9], w[10], w[11], w[12], w[13], w[14], w[15]};
                const v6u_t e6 = __builtin_amdgcn_cvt_scalef32_pk32_fp6_bf16(__builtin_bit_cast(v32bf_t, wv), hdiv);
                hB[s8] = (v8i_t){(int)e6[0], (int)e6[1], (int)e6[2], (int)e6[3], (int)e6[4], (int)e6[5], 0, 0};
            }
        }
#define PU_LOAD(RB, HH, P) do { const int hh_ = (HH), l0_ = (hh_ & 7) * 8; \
            const int idA_ = hh_ < 8 ? idlo[2 * (P)] : idhi[2 * (P)], idB_ = hh_ < 8 ? idlo[2 * (P) + 1] : idhi[2 * (P) + 1]; \
            _Pragma("unroll") for (int k = 0; k < 8; ++k) { const unsigned e = (unsigned)__builtin_amdgcn_readlane(idA_, l0_ + k); RB[k] = *(const U3*)(PU + (size_t)e * PEER_ROWB + 12 * lane); } \
            _Pragma("unroll") for (int k = 0; k < 8; ++k) { const unsigned e = (unsigned)__builtin_amdgcn_readlane(idB_, l0_ + k); RB[8 + k] = *(const U3*)(PU + (size_t)e * PEER_ROWB + 12 * lane); } } while (0)
#define PU_TOLDS(RB) do { _Pragma("unroll") for (int k = 0; k < 16; ++k) { LAS unsigned* q_ = (LAS unsigned*)(wl + k * RP + 12 * lane); q_[0] = RB[k].x; q_[1] = RB[k].y; q_[2] = RB[k].z; } } while (0)
#define PU_COMP(HH, P) do { const int hh_ = (HH), l0_ = (hh_ & 7) * 8; \
            f32x4 acc_ = {0.f, 0.f, 0.f, 0.f}; const LAS unsigned char* ap_ = wl + n16 * RP + 24 * g4; \
            _Pragma("unroll") for (int s8 = 0; s8 < 8; ++s8) { \
                const u32x2 a0_ = *(const LAS u32x2*)(ap_ + 96 * s8), a1_ = *(const LAS u32x2*)(ap_ + 96 * s8 + 8), a2_ = *(const LAS u32x2*)(ap_ + 96 * s8 + 16); \
                const v8i_t A_ = {(int)a0_.x, (int)a0_.y, (int)a1_.x, (int)a1_.y, (int)a2_.x, (int)a2_.y, 0, 0}; \
                acc_ = __builtin_amdgcn_mfma_scale_f32_16x16x128_f8f6f4(A_, hB[s8], acc_, 2, 2, 0, 0x7f7f7f7f, 0, 0x7f7f7f7f); } \
            asm volatile("s_nop 15\n\ts_nop 15" : "+v"(acc_));                                          \
            if (g4 < 2 ? n16 == 2 * (P) : n16 == 2 * (P) + 1) *(LAS f32x4*)(res + 4 * g4) = acc_;        \
            const int r = (lane - l0_) & 7;                                         \
            const float a0 = res[r], a1 = res[8 + r]; \
            const int so_ = (hh_ < 8 ? 0 : 64) + lane; \
            const f32x2 gg = gelu_pk((f32x2){a0 * sul[2 * (P) * 128 + so_], a1 * sul[(2 * (P) + 1) * 128 + so_]}); \
            const float gA_ = gtl[2 * (P) * 128 + so_], gB_ = gtl[(2 * (P) + 1) * 128 + so_]; \
            const bool mine = (lane >> 3) == (hh_ & 7); \
            if (hh_ < 8) { clo[2 * (P)] = mine ? gA_ * gg.x : clo[2 * (P)]; clo[2 * (P) + 1] = mine ? gB_ * gg.y : clo[2 * (P) + 1]; } \
            else         { chi[2 * (P)] = mine ? gA_ * gg.x : chi[2 * (P)]; chi[2 * (P) + 1] = mine ? gB_ * gg.y : chi[2 * (P) + 1]; } } while (0)
        {
            U3 rb[16];
            PU_LOAD(rb, 0, 0);
#pragma unroll 1
            for (int h = 0; h < 16; ++h) {
                PU_TOLDS(rb);
                __builtin_amdgcn_sched_barrier(0);
                PU_LOAD(rb, h, 1);
                __builtin_amdgcn_sched_barrier(0);
                PU_COMP(h, 0);
                __builtin_amdgcn_sched_barrier(0);
                PU_TOLDS(rb);
                __builtin_amdgcn_sched_barrier(0);
                PU_LOAD(rb, h < 15 ? h + 1 : 15, 0);
                __builtin_amdgcn_sched_barrier(0);
                PU_COMP(h, 1);
                __builtin_amdgcn_sched_barrier(0);
            }
        }
#undef PU_LOAD
#undef PU_TOLDS
#undef PU_COMP
        int le = (int)threadIdx.x; asm volatile("" : "+v"(le)); le &= 63;
#pragma unroll
        for (int i = 0; i < 4; ++i) if (tt[i] >= 0) { COEF[(size_t)tt[i] * 128 + le] = clo[i]; COEF[(size_t)tt[i] * 128 + 64 + le] = chi[i]; }
    }
}
__device__ __forceinline__ void peer_v_phase(tab_ptr PV, const unsigned short* EIDX, const float* COEF, const float* MOD, float* OUT, int G, int blk) {
    const int tid_ = phase_tid(); const int lane = tid_ & 63, wave = __builtin_amdgcn_readfirstlane(tid_ >> 6);
    const int stride = G * NWAVES;
    for (int tb = blk * NWAVES + wave; tb < T; tb += 4 * stride) {
        float out[4][16]; int idlo[4], idhi[4]; float clo[4], chi[4]; int tt[4]; bool act[4];
        int ln = lane; asm volatile("" : "+v"(ln));
#pragma unroll
        for (int i = 0; i < 4; ++i) {
            act[i] = tb + i * stride < T; const int t = act[i] ? tb + i * stride : tb; tt[i] = t;
#pragma unroll
            for (int j = 0; j < 16; ++j) out[i][j] = 0.f;
            const unsigned short* ep = EIDX + (size_t)t * 128;
            idlo[i] = ep[ln]; idhi[i] = ep[64 + ln];
            clo[i] = COEF[(size_t)t * 128 + ln]; chi[i] = COEF[(size_t)t * 128 + 64 + ln];
        }
#pragma unroll 1
        for (int h = 0; h < 16; ++h) {
            const int l0 = (h & 7) * 8;
#pragma unroll
            for (int p = 0; p < 2; ++p) {
                const int idA = h < 8 ? idlo[2 * p] : idhi[2 * p], idB = h < 8 ? idlo[2 * p + 1] : idhi[2 * p + 1];
                const float cA = h < 8 ? clo[2 * p] : chi[2 * p], cB = h < 8 ? clo[2 * p + 1] : chi[2 * p + 1];
                float ck[16]; U3 ra[16];
#pragma unroll
                for (int k = 0; k < 8; ++k) {
                    const unsigned e = (unsigned)__builtin_amdgcn_readlane(idA, l0 + k);
                    ck[k] = __uint_as_float((unsigned)__builtin_amdgcn_readlane((int)__float_as_uint(cA), l0 + k));
                    ra[k] = *(const U3*)(PV + (size_t)e * PEER_ROWB + 12 * lane);
                }
#pragma unroll
                for (int k = 0; k < 8; ++k) {
                    const unsigned e = (unsigned)__builtin_amdgcn_readlane(idB, l0 + k);
                    ck[8 + k] = __uint_as_float((unsigned)__builtin_amdgcn_readlane((int)__float_as_uint(cB), l0 + k));
                    ra[8 + k] = *(const U3*)(PV + (size_t)e * PEER_ROWB + 12 * lane);
                }
#pragma unroll
                for (int k = 0; k < 16; k += 2) {
                    const v6u_t w = {ra[k].x, ra[k].y, ra[k].z, ra[k + 1].x, ra[k + 1].y, ra[k + 1].z};
                    const v32f_t f = __builtin_amdgcn_cvt_scalef32_pk32_f32_fp6(w, 1.0f);
                    float* o = out[2 * p + (k >> 3)];
#pragma unroll
                    for (int j = 0; j < 16; ++j) o[j] += ck[k] * f[j];
#pragma unroll
                    for (int j = 0; j < 16; ++j) o[j] += ck[k + 1] * f[16 + j];
                }
                __builtin_amdgcn_sched_barrier(0);
            }
        }
        int le = lane; asm volatile("" : "+v"(le));
#pragma unroll
        for (int i = 0; i < 4; ++i) {
            if (act[i]) {
                const float* g2 = MOD + (size_t)(tt[i] >> 12) * 6144 + 5120;
                float* op = OUT + (size_t)tt[i] * 1024;
#pragma unroll
                for (int q = 0; q < 4; ++q) {
                    const int col = 16 * le + 4 * q;
                    const f32x4 g = *(const f32x4*)(g2 + col), x1 = *(const f32x4*)(op + col);
                    *(f32x4*)(op + col) = x1 + g * (f32x4){out[i][4 * q], out[i][4 * q + 1], out[i][4 * q + 2], out[i][4 * q + 3]};
                }
            }
        }
    }
}

#define XB_TMO      128
#define XB_XCNT(j)  (256  + 64 * (j))
#define XB_XSUB(j)  (1280 + 64 * (j))
#define XB_XGEN(j)  (2304 + 64 * (j))
#define XB_TOP      3328
#define XB_TOPGEN   3392
#define XCD_BAR_WORDS 3456
#define XB_SPIN_CAP (1u << 20)
__device__ __forceinline__ unsigned xb_ld(unsigned* p)              { return __hip_atomic_load(p, __ATOMIC_RELAXED, __HIP_MEMORY_SCOPE_AGENT); }
__device__ __forceinline__ unsigned xb_add(unsigned* p, unsigned v) { return __hip_atomic_fetch_add(p, v, __ATOMIC_RELAXED, __HIP_MEMORY_SCOPE_AGENT); }
__device__ __forceinline__ unsigned xb_xcc_id() { return (unsigned)__builtin_amdgcn_s_getreg((3 << 11) | 20) & 0xFu; }
#define XB_SPIN(cond, bar) do { unsigned _sp = 0; while (cond) { __builtin_amdgcn_s_sleep(1); \
    if ((++_sp & 255u) == 0u) { if (xb_ld(&(bar)[XB_TMO])) break; if (_sp > XB_SPIN_CAP) { atomicAdd(&(bar)[XB_TMO], 1u); break; } } } } while (0)
struct XcdBarrier { unsigned* bar; unsigned x; volatile LAS unsigned* st; };
__device__ __forceinline__ XcdBarrier xcd_barrier_post(unsigned* bar, volatile LAS unsigned* st) {
    XcdBarrier b; b.bar = bar; b.x = xb_xcc_id(); b.st = st;
    if (threadIdx.x == 0) (void)xb_add(&bar[XB_XCNT(b.x)], 1u);
    return b;
}
__device__ __forceinline__ void xcd_barrier_complete(unsigned* bar, unsigned x, unsigned& nloc, unsigned& nx) {
    const unsigned G = gridDim.x * gridDim.y * gridDim.z;
    unsigned sum, cnt, mine, sp = 0u;
    for (;;) {
        sum = 0u; cnt = 0u; mine = 0u;
#pragma unroll
        for (unsigned j = 0; j < 16; ++j) { const unsigned c = xb_ld(&bar[XB_XCNT(j)]); sum += c; cnt += (c > 0u) ? 1u : 0u; mine = (j == x) ? c : mine; }
        if (sum == G) break;
        __builtin_amdgcn_s_sleep(1);
        if ((++sp & 255u) == 0u) { if (xb_ld(&bar[XB_TMO])) break; if (sp > XB_SPIN_CAP) { atomicAdd(&bar[XB_TMO], 1u); break; } }
    }
    nloc = mine > 0u ? mine : 1u; nx = cnt > 0u ? cnt : 1u;
}
__device__ __forceinline__ void xcd_barrier(const XcdBarrier& b) {
    asm volatile("s_waitcnt vmcnt(0)" ::: "memory");
    __syncthreads();
    if (threadIdx.x == 0) {
        unsigned* bar = b.bar;
        __builtin_amdgcn_s_waitcnt(0);
        unsigned nloc = b.st[0], nx = b.st[1];
        if (nloc == 0u) { xcd_barrier_complete(bar, b.x, nloc, nx); b.st[0] = nloc; b.st[1] = nx; }
        const unsigned old = xb_add(&bar[XB_XSUB(b.x)], 1u);
        const unsigned gen = old / nloc;
        if (old + 1u == (gen + 1u) * nloc) {
            __builtin_amdgcn_fence(__ATOMIC_RELEASE, "agent");
            asm volatile("s_waitcnt vmcnt(0)" ::: "memory");
            const unsigned og = xb_add(&bar[XB_TOP], 1u);
            const unsigned tg = og / nx;
            if (og + 1u == (tg + 1u) * nx) xb_add(&bar[XB_TOPGEN], 1u);
            else XB_SPIN(xb_ld(&bar[XB_TOPGEN]) == tg, bar);
            __builtin_amdgcn_fence(__ATOMIC_ACQUIRE, "agent");
            xb_add(&bar[XB_XGEN(b.x)], 1u);
            asm volatile("s_waitcnt vmcnt(0)" ::: "memory");
        } else {
            XB_SPIN(xb_ld(&bar[XB_XGEN(b.x)]) == gen, bar);
            __builtin_amdgcn_fence(__ATOMIC_ACQUIRE, "agent");
            asm volatile("s_waitcnt vmcnt(0)" ::: "memory");
        }
    }
    __syncthreads();
}

constexpr int N_PHASES = 12;
#ifndef PROBE_K
#define PROBE_K -1
#endif
__global__ void __launch_bounds__(NWAVES * 64, 2) mk_fwd(Args a) {
    extern __shared__ __attribute__((aligned(16))) unsigned char lds_raw[];
    LAS unsigned char* lds = (LAS unsigned char*)lds_raw;
    cg::grid_group grid = cg::this_grid();
    const int G = gridDim.x, blk = blockIdx.x;
    unsigned char* ws = a.ws;
    float* MOD = (float*)(ws + WS_MOD);
    bf16* H = (bf16*)(ws + WS_H);
    bf16 *CB = (bf16*)(ws + WS_CB), *CC = (bf16*)(ws + WS_CC), *CX = (bf16*)(ws + WS_CX), *Qb = (bf16*)(ws + WS_Q), *Kb = (bf16*)(ws + WS_K), *Vb = (bf16*)(ws + WS_V), *QI = (bf16*)(ws + WS_QI);
    bf16 *GC = (bf16*)(ws + WS_GC), *GA = (bf16*)(ws + WS_GA), *KI = (bf16*)(ws + WS_KI); float* WI = (float*)(ws + WS_WI);
    unsigned long long* MASK = (unsigned long long*)(ws + WS_MASK);
    bf16* PQ = (bf16*)(ws + WS_PQ); unsigned short* EIDX = (unsigned short*)(ws + WS_EIDX); float* EG = (float*)(ws + WS_EG); float* COEF = (float*)(ws + WS_COEF);
#define IN(k) (a.ph_lo <= (k) && (k) < a.ph_hi)
#define SEAM(k) do { if (IN(k) && IN((k) + 1)) { if ((k) == 0) grid.sync(); else xcd_barrier(xbar); } if (PROBE_K == (k) && threadIdx.x == 0) pst[1] = __builtin_amdgcn_s_memrealtime(); if (PROBE_K == (k) + 1 && threadIdx.x == 0) pst[0] = __builtin_amdgcn_s_memrealtime(); } while (0)
    volatile LAS unsigned* xst = (volatile LAS unsigned*)(lds + LDS_BYTES - 64);
    if (threadIdx.x < 4) xst[threadIdx.x] = 0u;
    __syncthreads();
    const XcdBarrier xbar = xcd_barrier_post((unsigned*)(ws + WS_CTL), xst);

    volatile LAS unsigned long long* pst = (volatile LAS unsigned long long*)(lds + LDS_BYTES - 48);
    if (PROBE_K >= 0 && threadIdx.x == 0) { pst[0] = 0; pst[1] = 0; pst[2] = 0; pst[3] = 0; }
    if (PROBE_K == 0 && threadIdx.x == 0) pst[0] = __builtin_amdgcn_s_memrealtime();
    if (IN(0)) p0_prologue(lds, a, G, blk);
    SEAM(0);
    if (IN(1)) norm_phase<false>(a.in[0], a.in[4], MOD, 0, H, G, blk);
    SEAM(1);
    if (IN(2)) {
        pg8::Gemm g{H, (const bf16*)(ws + WS_WIN), T, NIN_PAD, DM}; pg8::StaticOrder S; S.init(T, NIN_PAD, G, blk);
        EpiInProj E{ws, a.in[8], a.in[9]};
        pg8::gemm_phase<EpiInProj, true, true>(lds, g, S, E);
    }
    SEAM(2);
    if (IN(3)) { if (PROBE_SUB == 3 && threadIdx.x == 0) pst[3] = __builtin_amdgcn_s_memrealtime(); conv_phase(CB, CC, CX, a.in[6], H, G, blk); if (PROBE_SUB == 3) { __syncthreads(); if (threadIdx.x == 0) pst[2] += __builtin_amdgcn_s_memrealtime() - pst[3]; }
        indexer_phase(lds, QI, KI, WI, MASK, G, blk); }
    SEAM(3);
    if (IN(4)) att::attn_phase(lds, Qb, Kb, Vb, MASK, a.in[8], a.in[9], H, G, blk);
    SEAM(4);
    if (IN(5)) {
        pg8::Gemm g{H, (const bf16*)(ws + WS_WCO), T, DM, DM}; pg8::StaticOrder S; S.init(T, DM, G, blk);
        EpiMixFused E{GC, GA, CB};
        pg8::gemm_phase<EpiMixFused, true, true>(lds, g, S, E);
    }
    SEAM(5);
    if (IN(6)) {
        pg8::Gemm g{CB, (const bf16*)(ws + WS_WO), T, DM, DM}; pg8::StaticOrder S; S.init(T, DM, G, blk);
        EpiDelta E{MOD, H};
        pg8::gemm_phase<EpiDelta, true, true>(lds, g, S, E);
    }
    SEAM(6);
    if (IN(7)) norm_phase<true>(a.in[0], a.in[12], MOD, 3072, H, G, blk, a.out);
    SEAM(7);
    if (IN(8)) {
        pg8::Gemm g{H, (const bf16*)(ws + WS_WPQ), T, DM, DM}; pg8::StaticOrder S; S.init(T, DM, G, blk);
        EpiPlain E{PQ};
        pg8::gemm_phase<EpiPlain, true, true>(lds, g, S, E);
    }
    SEAM(8);
    if (IN(9)) peer_route_phase(lds, PQ, (const bf16*)(ws + WS_SK), EIDX, EG, G, blk);
    SEAM(9);
    if (IN(10)) peer_u_simple(lds, H, (tab_ptr)(ws + WS_PU), (const float*)(ws + WS_RSU), (const float*)(ws + WS_RSV), EIDX, EG, COEF, G, blk);
    SEAM(10);
    if (IN(11)) peer_v_phase((tab_ptr)(ws + WS_PV), EIDX, COEF, MOD, a.out, G, blk);
    if (PROBE_K >= 0) {
        xcd_barrier(xbar);
        if (blk != 0 || threadIdx.x != 0) return;
        if (PROBE_K == 11) pst[1] = __builtin_amdgcn_s_memrealtime();
        const unsigned long long te = __builtin_amdgcn_s_memrealtime();
        const unsigned long long span = PROBE_SUB ? pst[2] : pst[1] - pst[0];
        while (__builtin_amdgcn_s_memrealtime() - te < span) __builtin_amdgcn_s_sleep(20);
    }
#undef IN
#undef SEAM
}

#ifndef MK_N_LAUNCHES
#define MK_N_LAUNCHES 1
#endif
extern "C" void kernel_launch(void* const* d_in, const int* in_sizes, int n_in, void* d_out, int out_size, void* d_ws, size_t ws_size, hipStream_t stream) {
    static int grid = 0;
    if (grid == 0) {
        if (n_in != 17 || in_sizes[0] != T * DM || out_size != T * DM || ws_size < WS_END) {
            fprintf(stderr, "kernel_launch: unexpected problem: n_in %d in0 %d out %d ws %zu (need %zu); nothing launched\n", n_in, n_in > 0 ? in_sizes[0] : -1, out_size, ws_size, (size_t)WS_END); grid = -1; return; }
        int dev = 0, cus = 0, per_cu = 0;
        hipGetDevice(&dev); hipDeviceGetAttribute(&cus, hipDeviceAttributeMultiprocessorCount, dev);
        if (hipFuncSetAttribute((const void*)mk_fwd, hipFuncAttributeMaxDynamicSharedMemorySize, LDS_BYTES) != hipSuccess) { fprintf(stderr, "kernel_launch: hipFuncSetAttribute failed\n"); grid = -1; return; }
        if (hipOccupancyMaxActiveBlocksPerMultiprocessor(&per_cu, (const void*)mk_fwd, NWAVES * 64, LDS_BYTES) != hipSuccess || per_cu < 1) { fprintf(stderr, "kernel_launch: occupancy query says %d blocks per CU\n", per_cu); grid = -1; return; }
        grid = cus;
    }
    if (grid < 0) return;
    if (hipMemsetAsync((char*)d_ws + WS_CTL, 0, CTL_BYTES, stream) != hipSuccess) { fprintf(stderr, "kernel_launch: hipMemsetAsync failed\n"); return; }
    Args a{};
    for (int i = 0; i < 17; ++i) a.in[i] = (const float*)d_in[i];
    a.out = (float*)d_out; a.ws = (unsigned char*)d_ws;
    for (int li = 0; li < MK_N_LAUNCHES; ++li) {
        a.ph_lo = li * (N_PHASES / MK_N_LAUNCHES); a.ph_hi = (li + 1) * (N_PHASES / MK_N_LAUNCHES);
        void* args[] = {&a};
        hipError_t e = hipLaunchCooperativeKernel((const void*)mk_fwd, dim3(grid), dim3(NWAVES * 64), args, LDS_BYTES, stream);
        if (e != hipSuccess) { fprintf(stderr, "kernel_launch: cooperative launch %d failed: %s (grid %d)\n", li, hipGetErrorString(e), grid); break; }
    }
}
```

```cpp
#include <hip/hip_runtime.h>
#include <hip/hip_cooperative_groups.h>
#include <cstdio>
#include <cstdint>
namespace cg = cooperative_groups;

#define LAS __attribute__((address_space(3)))
typedef unsigned short bf16;
typedef short bf16x8 __attribute__((ext_vector_type(8)));
typedef short s16x4 __attribute__((ext_vector_type(4)));
typedef float f32x2 __attribute__((ext_vector_type(2)));
typedef float f32x4 __attribute__((ext_vector_type(4)));
typedef float f32x16 __attribute__((ext_vector_type(16)));
typedef unsigned u32x2 __attribute__((ext_vector_type(2)));
typedef unsigned u32x4 __attribute__((ext_vector_type(4)));
typedef __bf16 bf16x2_t __attribute__((ext_vector_type(2)));

__device__ __forceinline__ unsigned pk2(float lo, float hi) { f32x2 v = {lo, hi}; bf16x2_t b = __builtin_convertvector(v, bf16x2_t); return __builtin_bit_cast(unsigned, b); }
__device__ __forceinline__ float bflo(unsigned u) { return __uint_as_float(u << 16); }
__device__ __forceinline__ float bfhi(unsigned u) { return __uint_as_float(u & 0xffff0000u); }
__device__ __forceinline__ unsigned ordf(float f) { unsigned u = __float_as_uint(f); return u ^ ((u & 0x80000000u) ? 0xffffffffu : 0x80000000u); }
__device__ __forceinline__ float unordf(unsigned u) { return __uint_as_float((u & 0x80000000u) ? (u ^ 0x80000000u) : ~u); }
#define LDS_WAIT() asm volatile("s_waitcnt lgkmcnt(0)" ::: "memory")
__device__ __forceinline__ int phase_tid() { int t = (int)threadIdx.x; asm volatile("" : "+v"(t)); return t; }

constexpr int PEER_ROWB = 768;
typedef const unsigned char* tab_ptr;
constexpr int NB = 16, SEQ = 4096, DM = 1024, T = NB * SEQ;
constexpr int NIN_PAD = 5888;
constexpr float EPS = 1e-6f;
constexpr float C2 = 0.125f * 1.4426950408889634f;
constexpr int NWAVES = 8;

constexpr size_t MiB = 1u << 20;
constexpr size_t WS_MOD = 1 * MiB;
constexpr size_t WS_RSU = 1 * MiB + 512 * 1024, WS_RSV = 1 * MiB + 640 * 1024;
constexpr size_t WS_WIN = 2 * MiB;
constexpr size_t WS_WCO = 14 * MiB;
constexpr size_t WS_WAO = 15 * MiB;
constexpr size_t WS_WO = 16 * MiB;
constexpr size_t WS_WPQ = 18 * MiB;
constexpr size_t WS_SK = 20 * MiB;
constexpr size_t WS_PU = 32 * MiB;
constexpr size_t WS_PV = 64 * MiB;
constexpr size_t WS_H = 96 * MiB;
constexpr size_t WS_CB = 224 * MiB;
constexpr size_t WS_CC = 288 * MiB;
constexpr size_t WS_CX = 352 * MiB;
constexpr size_t WS_Q = 416 * MiB;
constexpr size_t WS_K = 480 * MiB;
constexpr size_t WS_V = 544 * MiB;
constexpr size_t WS_QI = 608 * MiB;
constexpr size_t WS_GC = 672 * MiB;
constexpr size_t WS_GA = 800 * MiB;
constexpr size_t WS_KI = 928 * MiB;
constexpr size_t WS_WI = 936 * MiB;
constexpr size_t WS_MASK = 938 * MiB;
constexpr size_t WS_END = 970 * MiB;
constexpr size_t WS_PQ = WS_CC;
constexpr size_t WS_EIDX = WS_K;
constexpr size_t WS_EG = WS_K + 16 * MiB;
constexpr size_t WS_COEF = WS_V;
constexpr size_t WS_CTL = 0;
constexpr size_t CTL_BYTES = 32768;

constexpr int LDS_BYTES = 147456;

namespace pg8 {
constexpr int BM = 256, BK = 64, HALF = 128, HTB = HALF * BK * 2, STAGE_BYTES = 8 * HTB, NXCD = 8, WGM = 8;
__host__ __device__ __forceinline__ int lds_byte(int r, int c) { const int st = (r >> 4) * 2 + (c >> 5), rr = r & 15, cc = c & 31, ob = rr * 64 + cc * 2; return st * 1024 + (ob ^ (((ob >> 9) & 1) << 5)); }
__host__ __device__ __forceinline__ void stage_rc(int b, int& R, int& C) { const int st = b / 1024, sb = b % 1024, swz = sb ^ (((sb >> 9) & 1) << 5); R = (st >> 1) * 16 + swz / 64; C = (st & 1) * 32 + (swz % 64) / 2; }
__host__ __device__ __forceinline__ int perm32(int rho) { const int n = rho >> 4, i = rho & 15; return 8 * (i >> 2) + 4 * n + (i & 3); }
struct Unit { int pm, pn; };
struct Gemm { const bf16* A; const bf16* Bt; int M, N, K; };
struct StaticOrder {
    int nM, nN, nwg, G, c;
    __device__ void init(int M, int N, int G_, int c_) { nM = M / BM; nN = N / BM; nwg = nM * nN; G = G_; c = c_; }
    __device__ bool next(int i, Unit& u) const {
        const long L = (long)i * G + c; if (L >= nwg) return false;
        int wgid = (int)L; { const int q = nwg / NXCD, r = nwg % NXCD, xcd = wgid % NXCD, off = wgid / NXCD; wgid = (xcd < r ? xcd * (q + 1) : r * (q + 1) + (xcd - r) * q) + off; }
        const int nig = WGM * nN, gid = wgid / nig, fm = gid * WGM, gsz = (nM - fm) < WGM ? (nM - fm) : WGM;
        u.pm = fm + ((wgid % nig) % gsz); u.pn = (wgid % nig) / gsz; return true;
    }
};

template <class Epi, bool ALIGN_EPI, bool SP2>
__device__ __forceinline__ void gemm_phase(LAS unsigned char* lds, const Gemm g, const StaticOrder& S, const Epi& E) {
    const int tid = phase_tid(), wid = __builtin_amdgcn_readfirstlane(tid >> 6), lane = tid & 63, wr = wid >> 2, wc = wid & 3, fr = lane & 15, fq = lane >> 4;
    const int K = g.K, nt = K / BK;
    unsigned voffA[2], voffB[2];
#pragma unroll
    for (int i = 0; i < 2; ++i) { int R, C; stage_rc(tid * 16 + i * 8192, R, C); const int Rb = Epi::PERM ? ((R & ~31) + perm32(R & 31)) : R;
        voffA[i] = (unsigned)(R * K + C) * 2u; voffB[i] = (unsigned)(Rb * K + C) * 2u; }
    const size_t kstep = (size_t)(BK * 2);
    const size_t hstep = (size_t)HALF * K * 2;
    const size_t tstep = 2 * hstep;
    const unsigned ldsw = (unsigned)wid * 1024u;
    const int aoff = lds_byte(wr * 64 + fr, fq * 8), boff = lds_byte(wc * 32 + fr, fq * 8);
#define PG8_SA(b, h) (((b) * 2 + (h)) * HTB)
#define PG8_SB(b, h) ((4 + (b) * 2 + (h)) * HTB)
#define PG8_STAGE(bufoff, gbase, voff) do { _Pragma("unroll") for (int _i = 0; _i < 2; ++_i) \
        __builtin_amdgcn_global_load_lds((const unsigned*)((const char*)(gbase) + (voff)[_i]), (LAS unsigned*)(lds + (bufoff) + ldsw + _i * 8192), 16, 0, 0); } while (0)
#define PG8_LDA(dst, b, h) do { _Pragma("unroll") for (int m = 0; m < 4; ++m) _Pragma("unroll") for (int k = 0; k < 2; ++k) dst[m][k] = *(const LAS bf16x8*)(lds + PG8_SA(b, h) + aoff + m * 2048 + k * 1024); } while (0)
#define PG8_LDB(dst, b, h) do { _Pragma("unroll") for (int n = 0; n < 2; ++n) _Pragma("unroll") for (int k = 0; k < 2; ++k) dst[n][k] = *(const LAS bf16x8*)(lds + PG8_SB(b, h) + boff + n * 2048 + k * 1024); } while (0)
#define PG8_MMA(ai, bj, At, Bt) do { __builtin_amdgcn_s_setprio(1); _Pragma("unroll") for (int m = 0; m < 4; ++m) _Pragma("unroll") for (int n = 0; n < 2; ++n) _Pragma("unroll") for (int k = 0; k < 2; ++k) \
        acc[ai][bj][m][n] = __builtin_amdgcn_mfma_f32_16x16x32_bf16(Bt[n][k], At[m][k], acc[ai][bj][m][n], 0, 0, 0); __builtin_amdgcn_s_setprio(0); } while (0)
#define PG8_WAIT_V(n) asm volatile("s_waitcnt vmcnt(" #n ")" ::: "memory")
#define PG8_WAIT_L(n) asm volatile("s_waitcnt lgkmcnt(" #n ")" ::: "memory")
#define PG8_BAR __builtin_amdgcn_s_barrier()
#define PG8_SCHED __builtin_amdgcn_sched_barrier(0)
    Unit cur, nxt; int ui = 0;
    if (!S.next(0, cur)) return;
    f32x4 acc[2][2][4][2];
#pragma unroll
    for (int a = 0; a < 2; ++a)
#pragma unroll
        for (int b = 0; b < 2; ++b)
#pragma unroll
            for (int m = 0; m < 4; ++m)
#pragma unroll
                for (int n = 0; n < 2; ++n) acc[a][b][m][n] = (f32x4){0.f, 0.f, 0.f, 0.f};
    bf16x8 At[4][2], B0[2][2], B1[2][2];
    const char* cA = (const char*)g.A + (size_t)cur.pm * tstep; const char* cB = (const char*)g.Bt + (size_t)cur.pn * tstep;
    if constexpr (SP2) {
        PG8_STAGE(PG8_SB(0, 0), cB, voffB); PG8_STAGE(PG8_SB(0, 1), cB + hstep, voffB); PG8_STAGE(PG8_SA(0, 0), cA, voffA); PG8_STAGE(PG8_SA(0, 1), cA + hstep, voffA);
        if (wr == 1) PG8_BAR;
        PG8_WAIT_V(2); PG8_BAR;
        PG8_STAGE(PG8_SB(1, 0), cB + kstep, voffB); PG8_STAGE(PG8_SA(1, 0), cA + kstep, voffA); PG8_STAGE(PG8_SB(1, 1), cB + hstep + kstep, voffB);
        PG8_WAIT_V(6); PG8_BAR;
    } else {
        PG8_STAGE(PG8_SB(0, 0), cB, voffB); PG8_STAGE(PG8_SA(0, 0), cA, voffA); PG8_STAGE(PG8_SB(0, 1), cB + hstep, voffB); PG8_STAGE(PG8_SA(0, 1), cA + hstep, voffA);
        if (wr == 1) PG8_BAR;
        PG8_WAIT_V(4); PG8_BAR;
        PG8_STAGE(PG8_SB(1, 0), cB + kstep, voffB); PG8_STAGE(PG8_SA(1, 0), cA + kstep, voffA); PG8_STAGE(PG8_SB(1, 1), cB + hstep + kstep, voffB);
        PG8_WAIT_V(6); PG8_BAR;
    }
    for (;;) {
        const bool has_next = S.next(ui + 1, nxt);
        const char* nA = has_next ? (const char*)g.A + (size_t)nxt.pm * tstep : cA; const char* nB = has_next ? (const char*)g.Bt + (size_t)nxt.pn * tstep : cB;
        for (int t = 0; t < nt; t += 2) {
            if constexpr (Epi::MIDK) { if (t == nt / 2) E.mid(acc, cur, wr, wc, fr, fq); }
            const bool last = (t == nt - 2);
            const char* a1 = cA + (size_t)(t + 1) * kstep;
            const char* a2 = last ? nA : cA + (size_t)(t + 2) * kstep; const char* b2 = last ? nB : cB + (size_t)(t + 2) * kstep;
            const char* a3 = a2 + kstep; const char* b3 = b2 + kstep;
            if constexpr (SP2) {
            PG8_LDB(B0, 0, 0); PG8_LDB(B1, 0, 1); PG8_SCHED; PG8_LDA(At, 0, 0); PG8_STAGE(PG8_SA(1, 1), a1 + hstep, voffA);
            PG8_WAIT_V(8); PG8_WAIT_L(0); PG8_BAR; PG8_MMA(0, 0, At, B0); PG8_MMA(0, 1, At, B1); PG8_BAR; PG8_SCHED;
            PG8_LDA(At, 0, 1); PG8_STAGE(PG8_SB(0, 0), b2, voffB); PG8_STAGE(PG8_SB(0, 1), b2 + hstep, voffB); PG8_STAGE(PG8_SA(0, 0), a2, voffA);
            PG8_WAIT_V(8); PG8_WAIT_L(0); PG8_BAR; PG8_MMA(1, 0, At, B0); PG8_MMA(1, 1, At, B1); PG8_BAR; PG8_SCHED;
            PG8_LDB(B0, 1, 0); PG8_LDB(B1, 1, 1); PG8_SCHED; PG8_LDA(At, 1, 0); PG8_STAGE(PG8_SA(0, 1), a2 + hstep, voffA);
            PG8_WAIT_V(8); PG8_WAIT_L(0); PG8_BAR; PG8_MMA(0, 0, At, B0); PG8_MMA(0, 1, At, B1); PG8_BAR; PG8_SCHED;
            PG8_LDA(At, 1, 1); PG8_STAGE(PG8_SB(1, 0), b3, voffB); PG8_STAGE(PG8_SB(1, 1), b3 + hstep, voffB); PG8_STAGE(PG8_SA(1, 0), a3, voffA);
            PG8_WAIT_V(8); PG8_WAIT_L(0); PG8_BAR; PG8_MMA(1, 0, At, B0); PG8_MMA(1, 1, At, B1); PG8_BAR; PG8_SCHED;
            } else {
            PG8_LDB(B0, 0, 0); PG8_SCHED; PG8_LDA(At, 0, 0); PG8_STAGE(PG8_SA(1, 1), a1 + hstep, voffA);
            PG8_WAIT_L(8); PG8_BAR; PG8_WAIT_L(0); PG8_MMA(0, 0, At, B0); PG8_BAR; PG8_SCHED;
            PG8_LDB(B1, 0, 1); PG8_STAGE(PG8_SB(0, 0), b2, voffB);
            PG8_BAR; PG8_WAIT_L(0); PG8_MMA(0, 1, At, B1); PG8_BAR;
            PG8_LDA(At, 0, 1); PG8_STAGE(PG8_SA(0, 0), a2, voffA);
            PG8_BAR; PG8_WAIT_L(0); PG8_MMA(1, 0, At, B0); PG8_BAR; PG8_SCHED;
            PG8_STAGE(PG8_SB(0, 1), b2 + hstep, voffB);
            PG8_WAIT_V(6); PG8_BAR; PG8_MMA(1, 1, At, B1); PG8_BAR;
            PG8_LDB(B0, 1, 0); PG8_SCHED; PG8_LDA(At, 1, 0); PG8_STAGE(PG8_SA(0, 1), a2 + hstep, voffA);
            PG8_WAIT_L(8); PG8_BAR; PG8_WAIT_L(0); PG8_MMA(0, 0, At, B0); PG8_BAR; PG8_SCHED;
            PG8_LDB(B1, 1, 1); PG8_STAGE(PG8_SB(1, 0), b3, voffB);
            PG8_BAR; PG8_WAIT_L(0); PG8_MMA(0, 1, At, B1); PG8_BAR;
            PG8_LDA(At, 1, 1); PG8_STAGE(PG8_SA(1, 0), a3, voffA);
            PG8_BAR; PG8_WAIT_L(0); PG8_MMA(1, 0, At, B0); PG8_BAR; PG8_SCHED;
            PG8_STAGE(PG8_SB(1, 1), b3 + hstep, voffB);
            PG8_WAIT_V(6); PG8_BAR; PG8_MMA(1, 1, At, B1); PG8_BAR;
            }
        }
        if constexpr (ALIGN_EPI) { if (wr == 0) PG8_BAR; }
        E(acc, cur, wr, wc, fr, fq);
        if (!has_next) break;
#pragma unroll
        for (int a = 0; a < 2; ++a)
#pragma unroll
            for (int b = 0; b < 2; ++b)
#pragma unroll
                for (int m = 0; m < 4; ++m)
#pragma unroll
                    for (int n = 0; n < 2; ++n) acc[a][b][m][n] = (f32x4){0.f, 0.f, 0.f, 0.f};
        cur = nxt; cA = nA; cB = nB; ++ui;
        if constexpr (ALIGN_EPI) { if (wr == 1) PG8_BAR; }
    }
    PG8_WAIT_V(0);
    if constexpr (!ALIGN_EPI) { if (wr == 0) PG8_BAR; }
    PG8_BAR;
#undef PG8_SA
#undef PG8_SB
#undef PG8_STAGE
#undef PG8_LDA
#undef PG8_LDB
#undef PG8_MMA
#undef PG8_WAIT_V
#undef PG8_WAIT_L
#undef PG8_BAR
#undef PG8_SCHED
}
}

typedef const f32x4 (&AccRef)[2][2][4][2];

__device__ __forceinline__ u32x4 pack8(f32x4 v0, f32x4 v1) { u32x4 w; w.x = pk2(v0[0], v0[1]); w.y = pk2(v0[2], v0[3]); w.z = pk2(v1[0], v1[1]); w.w = pk2(v1[2], v1[3]); return w; }
__device__ __forceinline__ float sigm(float x) { return __builtin_amdgcn_rcpf(1.f + __builtin_amdgcn_exp2f(-1.4426950408889634f * x)); }

struct EpiInProj {
    static constexpr bool PERM = true; static constexpr bool MIDK = false;
    unsigned char* ws; const float* qnw; const float* knw;
    __device__ __forceinline__ void operator()(AccRef acc, const pg8::Unit& u, int wr, int wc, int fr, int fq) const {
        const int pn = u.pn; const size_t row0 = (size_t)u.pm * 256 + wr * 64 + fr;
        bf16* const V = (bf16*)(ws + WS_V); bf16* const KI = (bf16*)(ws + WS_KI); float* const WI = (float*)(ws + WS_WI);
        if (pn == 10 || pn == 11) {
            bf16* vb = V + ((size_t)((u.pm >> 4) * 8 + 4 * (pn & 1) + (wc >> 1)) * 4096 + (u.pm & 15) * 256 + wr * 64 + fr) * 64 + 32 * (wc & 1) + 8 * fq;
#pragma unroll
            for (int ai = 0; ai < 2; ++ai)
#pragma unroll
                for (int m = 0; m < 4; ++m)
#pragma unroll
                    for (int bj = 0; bj < 2; ++bj) *(u32x4*)(vb + (size_t)(2 * bj * 4096 + ai * 128 + m * 16) * 64) = pack8(acc[ai][bj][m][0], acc[ai][bj][m][1]);
        } else if (pn < 6 || (pn >= 12 && pn < 14)) {
            bf16* base = (bf16*)(ws + (pn < 6 ? WS_CB + (size_t)(pn >> 1) * (64 * MiB) : WS_QI));
            static_assert(WS_CC == WS_CB + 64 * MiB && WS_CX == WS_CB + 128 * MiB, "cb | cc | cx are consecutive 64 MiB regions");
            const int col0 = (pn & 1) * 256 + wc * 32 + 8 * fq;
#pragma unroll
            for (int ai = 0; ai < 2; ++ai)
#pragma unroll
                for (int m = 0; m < 4; ++m) { bf16* rowp = base + (row0 + ai * 128 + m * 16) * 512 + col0;
#pragma unroll
                    for (int bj = 0; bj < 2; ++bj) *(u32x4*)(rowp + bj * 128) = pack8(acc[ai][bj][m][0], acc[ai][bj][m][1]); }
        } else if (pn < 10) {
            const bool isq = pn < 8; bf16* base = (bf16*)(ws + (isq ? WS_Q : WS_K)); const float* nw = isq ? qnw : knw; const float sc = isq ? C2 : 1.f;
            const int head = 4 * (pn & 1) + wc;
            f32x4 w[2][2];
#pragma unroll
            for (int bj = 0; bj < 2; ++bj)
#pragma unroll
                for (int n = 0; n < 2; ++n) w[bj][n] = *(const f32x4*)(nw + 32 * bj + 8 * fq + 4 * n) * sc;
#pragma unroll
            for (int ai = 0; ai < 2; ++ai)
#pragma unroll
                for (int m = 0; m < 4; ++m) {
                    float ss = 0.f;
#pragma unroll
                    for (int bj = 0; bj < 2; ++bj)
#pragma unroll
                        for (int n = 0; n < 2; ++n) { const f32x4 x = acc[ai][bj][m][n]; ss += (x[0] * x[0] + x[1] * x[1]) + (x[2] * x[2] + x[3] * x[3]); }
                    ss += __shfl_xor(ss, 16); ss += __shfl_xor(ss, 32);
                    const float r = __builtin_amdgcn_rsqf(ss * (1.f / 64.f) + EPS);
                    bf16* rowp = isq ? base + (row0 + ai * 128 + m * 16) * 512 + head * 64 + 8 * fq
                                     : base + ((size_t)((u.pm >> 4) * 8 + head) * 4096 + (u.pm & 15) * 256 + wr * 64 + fr + ai * 128 + m * 16) * 64 + 8 * fq;
#pragma unroll
                    for (int bj = 0; bj < 2; ++bj) *(u32x4*)(rowp + bj * 32) = pack8(acc[ai][bj][m][0] * r * w[bj][0], acc[ai][bj][m][1] * r * w[bj][1]);
                }
        } else if (pn < 22) {
            bf16* base = (bf16*)(ws + (pn < 18 ? WS_GC : WS_GA)); const int col0 = ((pn - 14) & 3) * 256 + wc * 32 + 8 * fq;
#pragma unroll
            for (int ai = 0; ai < 2; ++ai)
#pragma unroll
                for (int m = 0; m < 4; ++m) { bf16* rowp = base + (row0 + ai * 128 + m * 16) * 1024 + col0;
#pragma unroll
                    for (int bj = 0; bj < 2; ++bj) { f32x4 a = acc[ai][bj][m][0], b = acc[ai][bj][m][1];
#pragma unroll
                        for (int j = 0; j < 4; ++j) { a[j] = sigm(a[j]); b[j] = sigm(b[j]); }
                        *(u32x4*)(rowp + bj * 128) = pack8(a, b); } }
        } else {
            if (wc < 2) {
#pragma unroll
                for (int ai = 0; ai < 2; ++ai)
#pragma unroll
                    for (int m = 0; m < 4; ++m) *(u32x4*)(KI + (row0 + ai * 128 + m * 16) * 64 + wc * 32 + 8 * fq) = pack8(acc[ai][0][m][0], acc[ai][0][m][1]);
            } else if (wc == 2 && fq == 0) {
#pragma unroll
                for (int ai = 0; ai < 2; ++ai)
#pragma unroll
                    for (int m = 0; m < 4; ++m) { float* p = WI + (row0 + ai * 128 + m * 16) * 8; *(f32x4*)p = acc[ai][0][m][0]; *(f32x4*)(p + 4) = acc[ai][0][m][1]; }
            }
        }
    }
};

struct EpiMixFused {
    static constexpr bool PERM = true; static constexpr bool MIDK = true;
    const bf16* GC; const bf16* GA; bf16* MIX;
    __device__ __forceinline__ void mid(f32x4 (&acc)[2][2][4][2], const pg8::Unit& u, int wr, int wc, int fr, int fq) const {
        unsigned base = (unsigned)((u.pm * 256 + wr * 64 + fr) * 1024 + u.pn * 256 + wc * 32 + 8 * fq);
        asm volatile("" : "+v"(base));
#define MIX_R(GCV, GAV) ((GCV) * __builtin_amdgcn_rcpf(fmaxf((GAV), 1e-20f)))
#pragma unroll
        for (int ai = 0; ai < 2; ++ai)
#pragma unroll
            for (int mh = 0; mh < 2; ++mh) {
                u32x4 gc[2][2], ga[2][2];
#pragma unroll
                for (int mm = 0; mm < 2; ++mm)
#pragma unroll
                    for (int bj = 0; bj < 2; ++bj) { const size_t off = (size_t)base + (size_t)(ai * 128 + (2 * mh + mm) * 16) * 1024 + bj * 128; gc[mm][bj] = *(const u32x4*)(GC + off); ga[mm][bj] = *(const u32x4*)(GA + off); }
#pragma unroll
                for (int mm = 0; mm < 2; ++mm)
#pragma unroll
                    for (int bj = 0; bj < 2; ++bj) { f32x4& a = acc[ai][bj][2 * mh + mm][0]; f32x4& b = acc[ai][bj][2 * mh + mm][1]; const u32x4 c = gc[mm][bj], g = ga[mm][bj];
                        a[0] *= MIX_R(bflo(c.x), bflo(g.x)); a[1] *= MIX_R(bfhi(c.x), bfhi(g.x)); a[2] *= MIX_R(bflo(c.y), bflo(g.y)); a[3] *= MIX_R(bfhi(c.y), bfhi(g.y));
                        b[0] *= MIX_R(bflo(c.z), bflo(g.z)); b[1] *= MIX_R(bfhi(c.z), bfhi(g.z)); b[2] *= MIX_R(bflo(c.w), bflo(g.w)); b[3] *= MIX_R(bfhi(c.w), bfhi(g.w)); }
                asm volatile("" ::: "memory");
            }
#undef MIX_R
    }
    __device__ __forceinline__ void operator()(AccRef acc, const pg8::Unit& u, int wr, int wc, int fr, int fq) const {
        const size_t row0 = (size_t)u.pm * 256 + wr * 64 + fr; const int col0 = u.pn * 256 + wc * 32 + 8 * fq;
#pragma unroll
        for (int ai = 0; ai < 2; ++ai)
#pragma unroll
            for (int m = 0; m < 4; ++m) { const size_t off = (row0 + ai * 128 + m * 16) * 1024 + col0;
#pragma unroll
                for (int bj = 0; bj < 2; ++bj) {
                    const u32x4 g = *(const u32x4*)(GA + off + bj * 128);
                    f32x4 a = acc[ai][bj][m][0], b = acc[ai][bj][m][1];
                    a[0] *= fmaxf(bflo(g.x), 1e-20f); a[1] *= fmaxf(bfhi(g.x), 1e-20f); a[2] *= fmaxf(bflo(g.y), 1e-20f); a[3] *= fmaxf(bfhi(g.y), 1e-20f);
                    b[0] *= fmaxf(bflo(g.z), 1e-20f); b[1] *= fmaxf(bfhi(g.z), 1e-20f); b[2] *= fmaxf(bflo(g.w), 1e-20f); b[3] *= fmaxf(bfhi(g.w), 1e-20f);
                    *(u32x4*)(MIX + off + bj * 128) = pack8(a, b); } }
    }
};

struct EpiDelta {
    static constexpr bool PERM = true; static constexpr bool MIDK = false;
    const float* MOD; bf16* O;
    __device__ __forceinline__ void operator()(AccRef acc, const pg8::Unit& u, int wr, int wc, int fr, int fq) const {
        const size_t row0 = (size_t)u.pm * 256 + wr * 64 + fr; const int col0 = u.pn * 256 + wc * 32 + 8 * fq;
        const float* g1 = MOD + (size_t)(u.pm >> 4) * 6144 + 2048;
        f32x4 gv[2][2];
#pragma unroll
        for (int bj = 0; bj < 2; ++bj)
#pragma unroll
            for (int n = 0; n < 2; ++n) gv[bj][n] = *(const f32x4*)(g1 + col0 + bj * 128 + 4 * n);
#pragma unroll
        for (int ai = 0; ai < 2; ++ai)
#pragma unroll
            for (int m = 0; m < 4; ++m) { bf16* rowp = O + (row0 + ai * 128 + m * 16) * 1024 + col0;
#pragma unroll
                for (int bj = 0; bj < 2; ++bj) *(u32x4*)(rowp + bj * 128) = pack8(acc[ai][bj][m][0] * gv[bj][0], acc[ai][bj][m][1] * gv[bj][1]); }
    }
};

struct EpiPlain {
    static constexpr bool PERM = true; static constexpr bool MIDK = false;
    bf16* O;
    __device__ __forceinline__ void operator()(AccRef acc, const pg8::Unit& u, int wr, int wc, int fr, int fq) const {
        const size_t row0 = (size_t)u.pm * 256 + wr * 64 + fr; const int col0 = u.pn * 256 + wc * 32 + 8 * fq;
#pragma unroll
        for (int ai = 0; ai < 2; ++ai)
#pragma unroll
            for (int m = 0; m < 4; ++m) { bf16* rowp = O + (row0 + ai * 128 + m * 16) * 1024 + col0;
#pragma unroll
                for (int bj = 0; bj < 2; ++bj) *(u32x4*)(rowp + bj * 128) = pack8(acc[ai][bj][m][0], acc[ai][bj][m][1]); }
    }
};

struct Args { const float* in[17]; float* out; unsigned char* ws; int ph_lo, ph_hi; };

__device__ __forceinline__ void transpose_item(const float* W, int ldw, int k0, int n0, int ncols, bf16* WT, int K, int drow0, LAS float* scr, int lane) {
#pragma unroll 8
    for (int i = 0; i < 32; ++i) { const int kk = 2 * i + (lane >> 5), n = lane & 31; scr[kk * 33 + n] = (n < ncols) ? W[(size_t)(k0 + kk) * ldw + n0 + n] : 0.f; }
    LDS_WAIT(); asm volatile("" ::: "memory");
    const int c = lane & 7;
#pragma unroll
    for (int j = 0; j < 4; ++j) { const int n = (lane >> 3) + 8 * j; const LAS float* s = scr + (8 * c) * 33 + n;
        u32x4 o; o.x = pk2(s[0 * 33], s[1 * 33]); o.y = pk2(s[2 * 33], s[3 * 33]); o.z = pk2(s[4 * 33], s[5 * 33]); o.w = pk2(s[6 * 33], s[7 * 33]);
        *(u32x4*)(WT + (size_t)(drow0 + n) * K + k0 + 8 * c) = o; }
    LDS_WAIT(); asm volatile("" ::: "memory");
}
__device__ __forceinline__ void cvt_stream(const float* src, bf16* dst, size_t n8, size_t i0, size_t stride) {
    for (size_t i = i0; i < n8; i += stride) { const f32x4 a = *(const f32x4*)(src + 8 * i), b = *(const f32x4*)(src + 8 * i + 4); *(u32x4*)(dst + 8 * i) = pack8(a, b); }
}

typedef unsigned v6u_t __attribute__((ext_vector_type(6)));
typedef float v32f_t __attribute__((ext_vector_type(32)));
typedef __bf16 v32bf_t __attribute__((ext_vector_type(32)));
struct __attribute__((packed, aligned(4))) U3 { unsigned x, y, z; };
__device__ __forceinline__ unsigned enc_e2m3(float y) {
    const float a = fminf(fabsf(y), 7.5f);
    const float r = a < 2.f ? a * 8.f : (a < 4.f ? a * 4.f + 8.f : a * 2.f + 16.f);
    unsigned c = (unsigned)__builtin_rintf(r); c = c > 31u ? 31u : c;
    return c | ((__float_as_uint(y) >> 26) & 32u);
}
__device__ __forceinline__ void cvt_rows_fp6(const float* src, unsigned char* dst, float* rs, int gw, int nw, int lane) {
#pragma unroll 2
    for (int row = gw; row < 16384; row += nw) {
        const float* sp = src + (size_t)row * 1024 + 16 * lane;
        const f32x4 a = *(const f32x4*)sp, b = *(const f32x4*)(sp + 4), c = *(const f32x4*)(sp + 8), d = *(const f32x4*)(sp + 12);
        const float v[16] = {a[0], a[1], a[2], a[3], b[0], b[1], b[2], b[3], c[0], c[1], c[2], c[3], d[0], d[1], d[2], d[3]};
        float m = 0.f;
#pragma unroll
        for (int j = 0; j < 16; ++j) m = fmaxf(m, fabsf(v[j]));
#pragma unroll
        for (int o = 32; o; o >>= 1) m = fmaxf(m, __shfl_xor(m, o));
        const float sc = m > 0.f ? 7.5f / m : 0.f;
        unsigned q[16];
#pragma unroll
        for (int j = 0; j < 16; ++j) q[j] = enc_e2m3(v[j] * sc);
        U3 w;
        w.x = q[0] | (q[1] << 6) | (q[2] << 12) | (q[3] << 18) | (q[4] << 24) | (q[5] << 30);
        w.y = (q[5] >> 2) | (q[6] << 4) | (q[7] << 10) | (q[8] << 16) | (q[9] << 22) | (q[10] << 28);
        w.z = (q[10] >> 4) | (q[11] << 2) | (q[12] << 8) | (q[13] << 14) | (q[14] << 20) | (q[15] << 26);
        *(U3*)(dst + (size_t)row * PEER_ROWB + 12 * lane) = w;
        if (lane == 0) rs[row] = m * (1.f / 7.5f);
    }
}
__device__ __forceinline__ void p0_prologue(LAS unsigned char* lds, const Args& a, int G, int blk) {
    const int tid = threadIdx.x, lane = tid & 63, wave = __builtin_amdgcn_readfirstlane(tid >> 6);
    unsigned char* ws = a.ws;
    for (int task = blk; task < 96; task += G) {
        LAS float* sl = (LAS float*)(lds + 67584);
        for (int i = tid; i < NB * DM; i += 512) { const float v = a.in[1][i]; sl[i] = v * __builtin_amdgcn_rcpf(1.f + __expf(-v)); }
        __syncthreads();
        const int col = task * 64 + lane, kb = wave * 128;
        float acc[16];
#pragma unroll
        for (int b = 0; b < 16; ++b) acc[b] = 0.f;
        const float* wp = a.in[2] + col;
        for (int k = kb; k < kb + 128; k += 4) {
            const float w0 = wp[(size_t)(k + 0) * 6144], w1 = wp[(size_t)(k + 1) * 6144], w2 = wp[(size_t)(k + 2) * 6144], w3 = wp[(size_t)(k + 3) * 6144];
#pragma unroll
            for (int b = 0; b < 16; ++b) { const f32x4 s = *(const LAS f32x4*)(sl + b * 1024 + k); acc[b] += (s[0] * w0 + s[1] * w1) + (s[2] * w2 + s[3] * w3); }
        }
        LAS float* red = (LAS float*)lds;
#pragma unroll
        for (int b = 0; b < 16; ++b) red[(wave * 16 + b) * 64 + lane] = acc[b];
        __syncthreads();
        for (int o = tid; o < 1024; o += 512) { const int b = o >> 6, cl = o & 63; float s = 0.f;
#pragma unroll
            for (int w = 0; w < 8; ++w) s += red[(w * 16 + b) * 64 + cl];
            ((float*)(ws + WS_MOD))[b * 6144 + task * 64 + cl] = s + a.in[3][task * 64 + cl]; }
        __syncthreads();
    }
    LAS float* scr = (LAS float*)(lds + wave * 8448);
    const int gw = blk * NWAVES + wave, NGW = G * NWAVES;
    constexpr int I_IN = 184 * 16, I_CO = 8 * 32, I_AO = 8 * 32, I_O = 16 * 32, I_PQ = 16 * 32;
    for (int it = gw; it < I_IN + I_CO + I_AO + I_O + I_PQ; it += NGW) {
        int r = it;
        if (r < I_IN) {
            const int dg = r >> 4, kb = r & 15, tile = dg >> 3, gi = dg & 7; int src, nc = 32;
            if (tile < 6 || (tile >= 10 && tile < 14)) src = 32 * dg;
            else if (tile < 10) src = tile * 256 + 32 * (2 * (gi & 3) + (gi >> 2));
            else if (tile < 22) src = 3656 + 32 * (dg - 112);
            else { if (gi < 2) src = 3584 + 32 * gi; else if (gi == 2) { src = 3648; nc = 8; } else { src = 0; nc = 0; } }
            transpose_item(a.in[5], 5704, kb * 64, src, nc, (bf16*)(ws + WS_WIN), 1024, dg * 32, scr, lane); continue; }
        r -= I_IN;
        if (r < I_CO) { transpose_item(a.in[7], 1024, (r >> 5) * 64, (r & 31) * 32, 32, (bf16*)(ws + WS_WCO), 1024, (r & 31) * 32, scr, lane); continue; } r -= I_CO;
        if (r < I_AO) { transpose_item(a.in[10], 1024, (r >> 5) * 64, (r & 31) * 32, 32, (bf16*)(ws + WS_WCO) + 512, 1024, (r & 31) * 32, scr, lane); continue; } r -= I_AO;
        if (r < I_O) { transpose_item(a.in[11], 1024, (r >> 5) * 64, (r & 31) * 32, 32, (bf16*)(ws + WS_WO), 1024, (r & 31) * 32, scr, lane); continue; } r -= I_O;
        transpose_item(a.in[13], 1024, (r >> 5) * 64, (r & 31) * 32, 32, (bf16*)(ws + WS_WPQ), 1024, (r & 31) * 32, scr, lane);
    }
    const size_t gt = (size_t)blk * 512 + tid, NT_ = (size_t)G * 512;
    cvt_stream(a.in[14], (bf16*)(ws + WS_SK), (size_t)16 * 128 * 64 / 8, gt, NT_);
    cvt_rows_fp6(a.in[15], ws + WS_PU, (float*)(ws + WS_RSU), gw, NGW, lane);
    cvt_rows_fp6(a.in[16], ws + WS_PV, (float*)(ws + WS_RSV), gw, NGW, lane);
}

__device__ __forceinline__ unsigned wave_max_dpp(unsigned x) {
    { const unsigned y = (unsigned)__builtin_amdgcn_update_dpp(0, (int)x, 0x141, 0xF, 0xF, false); x = x > y ? x : y; }
    { const unsigned y = (unsigned)__builtin_amdgcn_update_dpp(0, (int)x, 0x1B, 0xF, 0xF, false); x = x > y ? x : y; }
    { const unsigned y = (unsigned)__builtin_amdgcn_update_dpp(0, (int)x, 0xB1, 0xF, 0xF, false); x = x > y ? x : y; }
    { const unsigned y = (unsigned)__builtin_amdgcn_update_dpp(0, (int)x, 0x128, 0xF, 0xF, false); x = x > y ? x : y; }
    const unsigned a = (unsigned)__builtin_amdgcn_readlane((int)x, 0), b = (unsigned)__builtin_amdgcn_readlane((int)x, 16), c = (unsigned)__builtin_amdgcn_readlane((int)x, 32), d = (unsigned)__builtin_amdgcn_readlane((int)x, 48);
    const unsigned ab = a > b ? a : b, cd = c > d ? c : d; return ab > cd ? ab : cd;
}
__device__ __forceinline__ float wave_sum_dpp(float x) {
    x += __uint_as_float((unsigned)__builtin_amdgcn_update_dpp(0, (int)__float_as_uint(x), 0x141, 0xF, 0xF, false));
    x += __uint_as_float((unsigned)__builtin_amdgcn_update_dpp(0, (int)__float_as_uint(x), 0x1B, 0xF, 0xF, false));
    x += __uint_as_float((unsigned)__builtin_amdgcn_update_dpp(0, (int)__float_as_uint(x), 0xB1, 0xF, 0xF, false));
    x += __uint_as_float((unsigned)__builtin_amdgcn_update_dpp(0, (int)__float_as_uint(x), 0x128, 0xF, 0xF, false));
    const int xi = (int)__float_as_uint(x);
    return (__uint_as_float((unsigned)__builtin_amdgcn_readlane(xi, 0)) + __uint_as_float((unsigned)__builtin_amdgcn_readlane(xi, 16))) +
           (__uint_as_float((unsigned)__builtin_amdgcn_readlane(xi, 32)) + __uint_as_float((unsigned)__builtin_amdgcn_readlane(xi, 48)));
}
template <bool RESID> __device__ __forceinline__ void norm_phase(const float* X, const float* nw, const float* MOD, int sh_off, bf16* O, int G, int blk, float* OUT = nullptr) {
    const int tid_ = phase_tid(); const int lane = tid_ & 63, wave = __builtin_amdgcn_readfirstlane(tid_ >> 6);
    const int stride = G * NWAVES;
    for (int m0 = blk * NWAVES + wave; m0 < T; m0 += 2 * stride) {
        const int m1 = (m0 + stride < T) ? m0 + stride : m0;
        f32x4 va[4], vb[4]; float sa = 0.f, sbb = 0.f;
        const f32x4* xa = (const f32x4*)(X + (size_t)m0 * DM) + lane; const f32x4* xb = (const f32x4*)(X + (size_t)m1 * DM) + lane;
#pragma unroll
        for (int j = 0; j < 4; ++j) { va[j] = xa[64 * j]; vb[j] = xb[64 * j]; }
        if (RESID) {
            const unsigned long long* da = (const unsigned long long*)(O + (size_t)m0 * DM) + lane; const unsigned long long* db = (const unsigned long long*)(O + (size_t)m1 * DM) + lane;
            f32x4* oa4 = (f32x4*)(OUT + (size_t)m0 * DM) + lane; f32x4* ob4 = (f32x4*)(OUT + (size_t)m1 * DM) + lane;
#pragma unroll
            for (int j = 0; j < 4; ++j) { const unsigned long long pa = da[64 * j], pb = db[64 * j];
                va[j] += (f32x4){bflo((unsigned)pa), bfhi((unsigned)pa), bflo((unsigned)(pa >> 32)), bfhi((unsigned)(pa >> 32))};
                vb[j] += (f32x4){bflo((unsigned)pb), bfhi((unsigned)pb), bflo((unsigned)(pb >> 32)), bfhi((unsigned)(pb >> 32))};
                oa4[64 * j] = va[j]; ob4[64 * j] = vb[j]; }
        }
#pragma unroll
        for (int j = 0; j < 4; ++j) { sa += (va[j].x * va[j].x + va[j].y * va[j].y) + (va[j].z * va[j].z + va[j].w * va[j].w); sbb += (vb[j].x * vb[j].x + vb[j].y * vb[j].y) + (vb[j].z * vb[j].z + vb[j].w * vb[j].w); }
        const float ra = __builtin_amdgcn_rsqf(wave_sum_dpp(sa) * (1.f / DM) + EPS), rb = __builtin_amdgcn_rsqf(wave_sum_dpp(sbb) * (1.f / DM) + EPS);
        const float* mda = MOD + (size_t)(m0 >> 12) * 6144 + sh_off; const float* mdb = MOD + (size_t)(m1 >> 12) * 6144 + sh_off;
        unsigned long long* oa = (unsigned long long*)(O + (size_t)m0 * DM) + lane; unsigned long long* ob = (unsigned long long*)(O + (size_t)m1 * DM) + lane;
#pragma unroll
        for (int j = 0; j < 4; ++j) {
            const f32x4 w = ((const f32x4*)nw)[lane + 64 * j];
            const f32x4 ha = (va[j] * ra * w) * (((const f32x4*)(mda + 1024))[lane + 64 * j] + 1.f) + ((const f32x4*)mda)[lane + 64 * j];
            const f32x4 hb = (vb[j] * rb * w) * (((const f32x4*)(mdb + 1024))[lane + 64 * j] + 1.f) + ((const f32x4*)mdb)[lane + 64 * j];
            oa[64 * j] = (unsigned long long)pk2(ha.x, ha.y) | ((unsigned long long)pk2(ha.z, ha.w) << 32);
            ob[64 * j] = (unsigned long long)pk2(hb.x, hb.y) | ((unsigned long long)pk2(hb.z, hb.w) << 32);
        }
    }
}

__device__ __forceinline__ void conv_phase(const bf16* CB, const bf16* CC, const bf16* CX, const float* cw, bf16* UA, int G, int blk) {
    const size_t n = (size_t)T * 64;
    const int ctid = phase_tid();
#pragma unroll 4
    for (size_t i = (size_t)blk * 512 + ctid; i < n; i += (size_t)G * 512) {
        const int c8 = (int)(i & 63) * 8; const size_t row = i >> 6; const int t = (int)(row & (SEQ - 1));
        float accv[8];
#pragma unroll
        for (int e = 0; e < 8; ++e) accv[e] = 0.f;
#pragma unroll
        for (int j = 0; j < 3; ++j) {
            if (t - 2 + j >= 0) {
                const size_t off = (row - 2 + j) * 512 + c8;
                const u32x4 a = *(const u32x4*)(CC + off), b = *(const u32x4*)(CX + off);
                const f32x4 w0 = *(const f32x4*)(cw + j * 512 + c8), w1 = *(const f32x4*)(cw + j * 512 + c8 + 4);
                accv[0] += w0[0] * bflo(a.x) * bflo(b.x); accv[1] += w0[1] * bfhi(a.x) * bfhi(b.x);
                accv[2] += w0[2] * bflo(a.y) * bflo(b.y); accv[3] += w0[3] * bfhi(a.y) * bfhi(b.y);
                accv[4] += w1[0] * bflo(a.z) * bflo(b.z); accv[5] += w1[1] * bfhi(a.z) * bfhi(b.z);
                accv[6] += w1[2] * bflo(a.w) * bflo(b.w); accv[7] += w1[3] * bfhi(a.w) * bfhi(b.w);
            }
        }
        const u32x4 g = *(const u32x4*)(CB + row * 512 + c8);
        u32x4 o; o.x = pk2(accv[0] * bflo(g.x), accv[1] * bfhi(g.x)); o.y = pk2(accv[2] * bflo(g.y), accv[3] * bfhi(g.y));
        o.z = pk2(accv[4] * bflo(g.z), accv[5] * bfhi(g.z)); o.w = pk2(accv[6] * bflo(g.w), accv[7] * bfhi(g.w));
        *(u32x4*)(UA + row * 1024 + c8) = o;
    }
}

template <int N> __device__ __forceinline__ void bitonic_sort_desc(unsigned* a) {
#pragma unroll
    for (int k = 2; k <= N; k <<= 1)
#pragma unroll
        for (int j = k >> 1; j > 0; j >>= 1)
#pragma unroll
            for (int i = 0; i < N; ++i) { const int l = i ^ j; if (l > i) { const bool desc = (i & k) == 0; const unsigned x = a[i], y = a[l]; const unsigned mx = x > y ? x : y, mn = x > y ? y : x; a[i] = desc ? mx : mn; a[l] = desc ? mn : mx; } }
}
__device__ __forceinline__ void merge_top16(unsigned* a, const unsigned* b) {
#pragma unroll
    for (int i = 0; i < 16; ++i) { const unsigned y = b[15 - i]; a[i] = a[i] > y ? a[i] : y; }
#pragma unroll
    for (int j = 8; j > 0; j >>= 1)
#pragma unroll
        for (int i = 0; i < 16; ++i) if ((i & j) == 0) { const unsigned x = a[i], y = a[i + j]; a[i] = x > y ? x : y; a[i + j] = x > y ? y : x; }
}
__device__ __forceinline__ void top16_of_64(unsigned* a) {
    bitonic_sort_desc<16>(a); bitonic_sort_desc<16>(a + 16); bitonic_sort_desc<16>(a + 32); bitonic_sort_desc<16>(a + 48);
    merge_top16(a, a + 16); merge_top16(a + 32, a + 48); merge_top16(a, a + 32);
}
template <int NR> __device__ __forceinline__ int count_ge(const unsigned* k, unsigned cand) {
    int cv = 0;
#pragma unroll
    for (int r = 0; r < NR; ++r) cv += (k[r] >= cand) ? 1 : 0;
    cv += __builtin_amdgcn_update_dpp(0, cv, 0x141, 0xF, 0xF, false); cv += __builtin_amdgcn_update_dpp(0, cv, 0x1B, 0xF, 0xF, false);
    cv += __builtin_amdgcn_update_dpp(0, cv, 0xB1, 0xF, 0xF, false); cv += __builtin_amdgcn_update_dpp(0, cv, 0x128, 0xF, 0xF, false);
    return __builtin_amdgcn_readlane(cv, 0) + __builtin_amdgcn_readlane(cv, 16) + __builtin_amdgcn_readlane(cv, 32) + __builtin_amdgcn_readlane(cv, 48);
}
template <int NR> __device__ __forceinline__ unsigned descent256(const unsigned* k) {
    unsigned tau = 0u;
    for (int bit = 31; bit >= 0; --bit) {
        const unsigned cand = tau | (1u << bit);
        const int cnt = count_ge<NR>(k, cand);
        if (cnt >= 256) tau = cand;
        if (cnt == 256) break;
    }
    return tau;
}
template <int NR> __device__ __forceinline__ void select_query(const LAS unsigned* row, int nvalid, int tq, LAS unsigned long long* mrow, int lane) {
    unsigned k[NR];
    const bool lowhalf = lane < 32;
#define SEL_LOAD() _Pragma("unroll") for (int r = 0; r < NR; ++r) { const unsigned v = row[64 * r + lane]; k[r] = (64 * r + 64 <= nvalid) ? v : ((64 * r < nvalid && lowhalf) ? v : 0u); }
    SEL_LOAD()
    unsigned tau = 0u;
    if (tq >= 256) {
        if constexpr (NR > 16) {
#pragma unroll
            for (int g = 0; g < NR / 16; ++g) bitonic_sort_desc<16>(k + 16 * g);
            if constexpr (NR == 64) { merge_top16(k, k + 16); merge_top16(k + 32, k + 48); merge_top16(k, k + 32); }
            else if constexpr (NR == 48) { merge_top16(k, k + 16); merge_top16(k, k + 32); }
            else merge_top16(k, k + 16);
            tau = descent256<16>(k);
            const bool bad = __ballot(k[15] >= tau) != 0ull;
            SEL_LOAD()
            if (bad) tau = descent256<NR>(k);
        } else tau = descent256<NR>(k);
    }
#undef SEL_LOAD
    if (tau == 0u) tau = 1u;
#pragma unroll
    for (int r = 0; r < 64; ++r) { const unsigned long long m = r < NR ? __ballot(k[r < NR ? r : 0] >= tau) : 0ull; if (lane == 0) mrow[r * 8] = m; }
}

#ifndef PROBE_SUB
#define PROBE_SUB 0
#endif
__device__ __forceinline__ void indexer_phase(LAS unsigned char* lds, const bf16* QI, const bf16* KI, const float* WI, unsigned long long* MASK, int G, int blk) {
    volatile LAS unsigned long long* pst = (volatile LAS unsigned long long*)(lds + LDS_BYTES - 48);
    LAS unsigned* sc = (LAS unsigned*)lds;
    const int tid = phase_tid(), lane = tid & 63, wave = __builtin_amdgcn_readfirstlane(tid >> 6), r32 = lane & 31, hi = lane >> 5;
    const int ra = (r32 >> 4) & 1, rb = (r32 >> 3) & 1, rc = (r32 >> 2) & 1, rd = r32 & 3;
    bf16x8 aq[2][4]; f32x4 wv[2][2][2]; bf16x8 bk[3][4];
#define IDX_UNIT_GEOM(uid_) const int b = (uid_) >> 9; int j = (uid_) & 511; if (j >= 256) j = 767 - j; const int tq0 = 8 * j; const size_t row0 = (size_t)b * SEQ + tq0; const int nkt = (tq0 + 8 + 31) >> 5; \
        const bf16* kbase = KI + ((size_t)b * SEQ + r32) * 64 + hi * 8;
#define IDX_UNIT_LOAD() do { \
        _Pragma("unroll") for (int rt = 0; rt < 2; ++rt) { \
            const bf16* qp = QI + (row0 + rt * 4 + 2 * rc + ra) * 512 + (4 * rb + rd) * 64 + hi * 8; \
            _Pragma("unroll") for (int d0 = 0; d0 < 4; ++d0) aq[rt][d0] = *(const bf16x8*)(qp + d0 * 16); } } while (0)
    if (blk < T / 8) { IDX_UNIT_GEOM(blk) IDX_UNIT_LOAD(); }
    for (int uid = blk; uid < T / 8; uid += G) {
        IDX_UNIT_GEOM(uid)
#pragma unroll
        for (int rt = 0; rt < 2; ++rt)
#pragma unroll
            for (int a2 = 0; a2 < 2; ++a2) { const float* wp = WI + (row0 + rt * 4 + 2 * hi + a2) * 8; wv[rt][a2][0] = *(const f32x4*)wp; wv[rt][a2][1] = *(const f32x4*)(wp + 4); }
#pragma unroll
        for (int jj = 0; jj < 3; ++jj) { int kt = wave + NWAVES * jj; if (kt >= nkt) kt = nkt - 1;
#pragma unroll
            for (int d0 = 0; d0 < 4; ++d0) bk[jj][d0] = *(const bf16x8*)(kbase + (size_t)kt * 32 * 64 + d0 * 16); }
        if (PROBE_SUB && threadIdx.x == 0) pst[3] = __builtin_amdgcn_s_memrealtime();
#define IDX_TILE(JT) { \
                constexpr int jj = (JT) % 3; \
                int kt = wave + NWAVES * (JT); asm volatile("" : "+s"(kt));       \
                const bool live = kt < nkt; \
                const int key = 32 * kt + r32; \
                f32x16 acc0 = {}, acc1 = {}; \
                _Pragma("unroll") for (int d0 = 0; d0 < 4; ++d0) { acc0 = __builtin_amdgcn_mfma_f32_32x32x16_bf16(aq[0][d0], bk[jj][d0], acc0, 0, 0, 0); acc1 = __builtin_amdgcn_mfma_f32_32x32x16_bf16(aq[1][d0], bk[jj][d0], acc1, 0, 0, 0); } \
                if ((JT) + 3 < NTW) { int ktn = kt + 3 * NWAVES; if (ktn >= nkt) ktn = nkt - 1; \
                    _Pragma("unroll") for (int d0 = 0; d0 < 4; ++d0) bk[jj][d0] = *(const bf16x8*)(kbase + (size_t)ktn * 32 * 64 + d0 * 16); } \
                _Pragma("unroll") for (int rt = 0; rt < 2; ++rt) \
                    _Pragma("unroll") for (int a2 = 0; a2 < 2; ++a2) { \
                        float sv = 0.f; \
                        _Pragma("unroll") for (int i = 0; i < 8; ++i) { const int xb = (int)__float_as_uint(rt ? acc1[8 * a2 + i] : acc0[8 * a2 + i]); sv += __uint_as_float((unsigned)(xb > 0 ? xb : 0)) * wv[rt][a2][i >> 2][i & 3]; } \
                        const int ql = rt * 4 + 2 * hi + a2; \
                        const unsigned ck = (key <= tq0 + ql) ? ((ordf(sv) & 0xfffff000u) | (unsigned)(4095 - key)) : 0u; \
                        sc[live ? ql * 4096 + key : 33792 + lane] = ck; \
                    } \
                __builtin_amdgcn_sched_barrier(0); }
#define IDX_TILES4(J0) IDX_TILE((J0)) IDX_TILE((J0) + 1) IDX_TILE((J0) + 2) IDX_TILE((J0) + 3)
        if (nkt <= 32) { constexpr int NTW = 4; IDX_TILES4(0) }
        else if (nkt <= 64) { constexpr int NTW = 8; IDX_TILES4(0) IDX_TILES4(4) }
        else if (nkt <= 96) { constexpr int NTW = 12; IDX_TILES4(0) IDX_TILES4(4) IDX_TILES4(8) }
        else { constexpr int NTW = 16; IDX_TILES4(0) IDX_TILES4(4) IDX_TILES4(8) IDX_TILES4(12) }
#undef IDX_TILES4
#undef IDX_TILE
        __syncthreads();
        if (uid + G < T / 8) { IDX_UNIT_GEOM(uid + G) IDX_UNIT_LOAD(); }
        if (PROBE_SUB == 1 && threadIdx.x == 0) pst[2] += __builtin_amdgcn_s_memrealtime() - pst[3];
        if (PROBE_SUB == 2 && threadIdx.x == 0) pst[3] = __builtin_amdgcn_s_memrealtime();
        {
            const int tq = tq0 + wave, nvalid = 32 * nkt;
            LAS unsigned long long* mrow = (LAS unsigned long long*)(lds + 131072) + wave;
            const LAS unsigned* rowp = sc + wave * 4096;
            if (nvalid <= 1024) select_query<16>(rowp, nvalid, tq, mrow, lane);
            else if (nvalid <= 2048) select_query<32>(rowp, nvalid, tq, mrow, lane);
            else if (nvalid <= 3072) select_query<48>(rowp, nvalid, tq, mrow, lane);
            else select_query<64>(rowp, nvalid, tq, mrow, lane);
        }
        __syncthreads();
        __hip_atomic_store(MASK + ((size_t)b * 64 + (tid >> 3)) * SEQ + tq0 + (tid & 7), ((const LAS unsigned long long*)(lds + 131072))[tid], __ATOMIC_RELAXED, __HIP_MEMORY_SCOPE_AGENT);
        if (PROBE_SUB == 2 && threadIdx.x == 0) pst[2] += __builtin_amdgcn_s_memrealtime() - pst[3];
    }
}

namespace att {
constexpr int KCP = 1040, KSLOT = 8 * KCP, VDH = 4160, VSLOT = 2 * VDH;
constexpr int L_K = 0, L_V = 4 * KSLOT, L_OST = L_V + 4 * VSLOT, L_END = L_OST + NWAVES * 4096;
__device__ __forceinline__ int crow(int r, int hi) { return (r & 3) + 8 * (r >> 2) + 4 * hi; }
#define SBAR() __builtin_amdgcn_sched_barrier(0)
__device__ __forceinline__ void qkt(f32x16& p0, f32x16& p1, const LAS unsigned char* kb, const bf16x8* qr, const f32x16& negm) {
#pragma unroll
    for (int d0 = 0; d0 < 4; ++d0) {
        const bf16x8 b0 = *(const LAS bf16x8*)(kb + d0 * 2 * KCP);
        const bf16x8 b1 = *(const LAS bf16x8*)(kb + d0 * 2 * KCP + 512);
        if (d0 == 0) { p0 = __builtin_amdgcn_mfma_f32_32x32x16_bf16(b0, qr[0], negm, 0, 0, 0); p1 = __builtin_amdgcn_mfma_f32_32x32x16_bf16(b1, qr[0], negm, 0, 0, 0); }
        else { p0 = __builtin_amdgcn_mfma_f32_32x32x16_bf16(b0, qr[d0], p0, 0, 0, 0); p1 = __builtin_amdgcn_mfma_f32_32x32x16_bf16(b1, qr[d0], p1, 0, 0, 0); } }
}
__device__ __forceinline__ void pv(f32x16* o, f32x16& osum, int vb, bf16x8 pa0, bf16x8 pa1, bf16x8 pa2, bf16x8 pa3) {
    {
        const bf16x8 ones = {0x3f80, 0x3f80, 0x3f80, 0x3f80, 0x3f80, 0x3f80, 0x3f80, 0x3f80};
        osum = __builtin_amdgcn_mfma_f32_32x32x16_bf16(pa0, ones, osum, 0, 0, 0); osum = __builtin_amdgcn_mfma_f32_32x32x16_bf16(pa1, ones, osum, 0, 0, 0);
        osum = __builtin_amdgcn_mfma_f32_32x32x16_bf16(pa2, ones, osum, 0, 0, 0); osum = __builtin_amdgcn_mfma_f32_32x32x16_bf16(pa3, ones, osum, 0, 0, 0);
    }
#pragma unroll
    for (int d0 = 0; d0 < 2; ++d0) { s16x4 lo[4], hi[4];
#pragma unroll
        for (int ks = 0; ks < 4; ++ks) {
            asm volatile("ds_read_b64_tr_b16 %0,%1 offset:%c2" : "=&v"(lo[ks]) : "v"(vb), "i"(d0 * VDH + ks * 1024) : "memory");
            asm volatile("ds_read_b64_tr_b16 %0,%1 offset:%c2" : "=&v"(hi[ks]) : "v"(vb), "i"(d0 * VDH + ks * 1024 + 512) : "memory"); }
        asm volatile("s_waitcnt lgkmcnt(0)" ::: "memory"); SBAR();
#define PK(k) (bf16x8){lo[k][0], lo[k][1], lo[k][2], lo[k][3], hi[k][0], hi[k][1], hi[k][2], hi[k][3]}
        o[d0] = __builtin_amdgcn_mfma_f32_32x32x16_bf16(pa0, PK(0), o[d0], 0, 0, 0);
        o[d0] = __builtin_amdgcn_mfma_f32_32x32x16_bf16(pa1, PK(1), o[d0], 0, 0, 0);
        o[d0] = __builtin_amdgcn_mfma_f32_32x32x16_bf16(pa2, PK(2), o[d0], 0, 0, 0);
        o[d0] = __builtin_amdgcn_mfma_f32_32x32x16_bf16(pa3, PK(3), o[d0], 0, 0, 0);
#undef PK
    }
}

__device__ __forceinline__ void attn_phase(LAS unsigned char* lds, const bf16* Q, const bf16* K, const bf16* V, const unsigned long long* MASK, const float* qnw, const float* knw, bf16* UA, int G, int blk) {
    const int tid = phase_tid(), lane = tid & 63, r32 = lane & 31, hi = lane >> 5, wid = __builtin_amdgcn_readfirstlane(tid >> 6);
    float mq = fabsf(qnw[lane]), mk = fabsf(knw[lane]);
#pragma unroll
    for (int o = 1; o < 64; o <<= 1) { mq = fmaxf(mq, __shfl_xor(mq, o)); mk = fmaxf(mk, __shfl_xor(mk, o)); }
    const float nb = -(8.f * 1.4426950408889634f) * mq * mk;
    f32x16 negm;
#pragma unroll
    for (int r = 0; r < 16; ++r) negm[r] = nb;
    const unsigned kdst = L_K + (tid & 7) * KCP + (tid >> 3) * 16;
    const unsigned vdst = L_V + ((tid & 7) >> 2) * VDH + ((tid >> 3) >> 4) * 1024 + ((tid >> 3) & 15) * 64 + (tid & 3) * 16;
    const LAS unsigned char* kp0 = lds + L_K + hi * KCP + r32 * 16;
    const int vb0 = (int)(uintptr_t)(lds + L_V) + ((lane >> 4) & 1) * 32 + (lane & 3) * 8 + (4 * hi + ((lane & 15) >> 2)) * 64;
    for (int uid = blk; uid < 2048; uid += G) {
        const int ui = uid >> 8; int c = uid & 255; c = (c & 7) * 32 + (c >> 3);
        const int bh = c >> 1, s = c & 1, pp = ui >> 1, qb = (ui & 1) ? 15 - (2 * pp + s) : (2 * pp + s);
        const int b = bh >> 3, h = bh & 7, q0 = qb * 256;
        const size_t rowbase = (size_t)b * SEQ;
        const bf16* Qw = Q + (rowbase + q0 + wid * 32) * 512 + h * 64;
        bf16* Ow = UA + (rowbase + q0 + wid * 32) * 1024 + 512 + h * 64;
        bf16x8 qr[4];
#pragma unroll
        for (int d0 = 0; d0 < 4; ++d0) qr[d0] = *(const bf16x8*)(Qw + (size_t)r32 * 512 + d0 * 16 + hi * 8);
        const int NT = 4 * (qb + 1);
        const unsigned long long* mptr = MASK + (size_t)b * 64 * SEQ + q0 + wid * 32 + r32;
        const bf16* ksrc = K + ((size_t)bh * SEQ) * 64 + tid * 8;
        const bf16* vsrc = V + ((size_t)bh * SEQ) * 64 + tid * 8;
        f32x16 o[2]; o[0] = f32x16{}; o[1] = f32x16{};
        f32x16 osum = f32x16{};
        const int T2 = NT / 2;
        u32x4 kreg[2][2], vreg[2][2]; unsigned long long mwq[2][2], mw[2];
#pragma unroll
        for (int sb_ = 0; sb_ < 2; ++sb_) {
            kreg[0][sb_] = *(const u32x4*)(ksrc + (size_t)sb_ * 4096); vreg[0][sb_] = *(const u32x4*)(vsrc + (size_t)sb_ * 4096); mw[sb_] = mptr[(size_t)sb_ * SEQ];
            kreg[1][sb_] = *(const u32x4*)(ksrc + (size_t)(2 + sb_) * 4096); vreg[1][sb_] = *(const u32x4*)(vsrc + (size_t)(2 + sb_) * 4096); mwq[1][sb_] = mptr[(size_t)(2 + sb_) * SEQ]; mwq[0][sb_] = 0ull;
            *(LAS u32x4*)(lds + kdst + sb_ * KSLOT) = kreg[0][sb_]; *(LAS u32x4*)(lds + vdst + sb_ * VSLOT) = vreg[0][sb_];
        }
        __syncthreads();
        const int qmax = q0 + wid * 32 + 31;
#define ATT_SUB(P, SB) if (64 * (2 * t + (SB)) <= qmax) { \
                f32x16 p0, p1; \
                qkt(p0, p1, kp0 + ((P) * 2 + (SB)) * KSLOT, qr, negm); \
                const unsigned mlo = (unsigned)mw[SB] >> (4 * hi), mhi = (unsigned)(mw[SB] >> 32) >> (4 * hi); \
                _Pragma("unroll") for (int r = 0; r < 16; ++r) { p0[r] = __builtin_amdgcn_exp2f(p0[r]); p1[r] = __builtin_amdgcn_exp2f(p1[r]); } \
                  \
                unsigned pk_[16]; \
                _Pragma("unroll") for (int i = 0; i < 8; ++i) { const int bp = ((2 * i) & 3) + 8 * ((2 * i) >> 2); \
                    const unsigned m0a = (unsigned)__builtin_amdgcn_sbfe((int)mlo, bp, 1), m0b = (unsigned)__builtin_amdgcn_sbfe((int)mlo, bp + 1, 1); \
                    const unsigned m1a = (unsigned)__builtin_amdgcn_sbfe((int)mhi, bp, 1), m1b = (unsigned)__builtin_amdgcn_sbfe((int)mhi, bp + 1, 1); \
                    pk_[i] = pk2(p0[2 * i], p0[2 * i + 1]) & __builtin_amdgcn_perm(m0b, m0a, 0x05040100u); \
                    pk_[8 + i] = pk2(p1[2 * i], p1[2 * i + 1]) & __builtin_amdgcn_perm(m1b, m1a, 0x05040100u); } \
                const u32x4 pw0 = (u32x4){pk_[0], pk_[1], pk_[2], pk_[3]}, pw1 = (u32x4){pk_[4], pk_[5], pk_[6], pk_[7]}; \
                const u32x4 pw2 = (u32x4){pk_[8], pk_[9], pk_[10], pk_[11]}, pw3 = (u32x4){pk_[12], pk_[13], pk_[14], pk_[15]}; \
                pv(o, osum, vb0 + ((P) * 2 + (SB)) * VSLOT, __builtin_bit_cast(bf16x8, pw0), __builtin_bit_cast(bf16x8, pw1), __builtin_bit_cast(bf16x8, pw2), __builtin_bit_cast(bf16x8, pw3)); \
            }
#define ATT_STEP(P)    \
        { \
            { const int tp = (t + 2 < T2) ? t + 2 : T2 - 1; \
              _Pragma("unroll") for (int sb_ = 0; sb_ < 2; ++sb_) { kreg[P][sb_] = *(const u32x4*)(ksrc + (size_t)(2 * tp + sb_) * 4096); vreg[P][sb_] = *(const u32x4*)(vsrc + (size_t)(2 * tp + sb_) * 4096); mwq[P][sb_] = mptr[(size_t)(2 * tp + sb_) * SEQ]; } } \
            ATT_SUB(P, 0) \
            ATT_SUB(P, 1) \
            _Pragma("unroll") for (int sb_ = 0; sb_ < 2; ++sb_) { *(LAS u32x4*)(lds + kdst + ((1 - (P)) * 2 + sb_) * KSLOT) = kreg[1 - (P)][sb_]; *(LAS u32x4*)(lds + vdst + ((1 - (P)) * 2 + sb_) * VSLOT) = vreg[1 - (P)][sb_]; mw[sb_] = mwq[1 - (P)][sb_]; } \
            __syncthreads(); \
        }
        for (int t = 0; t < T2; t += 2) {
            ATT_STEP(0)
            ++t;
            ATT_STEP(1)
            --t;
        }
#undef ATT_STEP
#undef ATT_SUB
        float rli[16];
#pragma unroll
        for (int r = 0; r < 16; ++r) rli[r] = __builtin_amdgcn_rcpf(osum[r]);
        LAS bf16* stg = (LAS bf16*)(lds + L_OST) + wid * 2048;
#pragma unroll
        for (int r = 0; r < 16; ++r) { const int orow = crow(r, hi);
#pragma unroll
            for (int d0 = 0; d0 < 2; ++d0) stg[orow * 64 + d0 * 32 + r32] = (bf16)(pk2(o[d0][r] * rli[r], 0.f) & 0xffffu); }
        LDS_WAIT();
#pragma unroll
        for (int i = 0; i < 4; ++i) { const int row = i * 8 + (lane >> 3), ch = lane & 7; const u32x4 v = *(const LAS u32x4*)(stg + row * 64 + ch * 8); *(u32x4*)(Ow + (size_t)row * 1024 + ch * 8) = v; }
        LDS_WAIT();
    }
}
#undef SBAR
}

__device__ __forceinline__ void peer_route_phase(LAS unsigned char* lds, const bf16* PQ, const bf16* SK, unsigned short* EIDX, float* EG, int G, int blk) {
    const int tid = phase_tid(), lane = tid & 63, r32 = lane & 31, hi = lane >> 5, wave = __builtin_amdgcn_readfirstlane(tid >> 6);
    LAS unsigned* win = (LAS unsigned*)(lds + wave * 12288);
    LAS unsigned* fwn = win + 2 * 16 * 64;
    const int gw = blk * NWAVES + wave, NGW = G * NWAVES, h = gw & 7;
    for (int tg = gw >> 3; tg < T / 32; tg += NGW >> 3) {
        const size_t t0 = (size_t)tg * 32;
#pragma unroll 1
        for (int half = 0; half < 2; ++half) {
            const int p = 2 * h + half;
            bf16x8 bq[4];
#pragma unroll
            for (int d0 = 0; d0 < 4; ++d0) bq[d0] = *(const bf16x8*)(PQ + (t0 + r32) * 1024 + 128 * h + 64 * half + 16 * d0 + 8 * hi);
            unsigned ck[64];
#pragma unroll
            for (int nb = 0; nb < 4; ++nb) {
                f32x16 acc = {};
#pragma unroll
                for (int d0 = 0; d0 < 4; ++d0) { const bf16x8 a = *(const bf16x8*)(SK + ((size_t)p * 128 + 32 * nb + r32) * 64 + 16 * d0 + 8 * hi); acc = __builtin_amdgcn_mfma_f32_32x32x16_bf16(a, bq[d0], acc, 0, 0, 0); }
#pragma unroll
                for (int r = 0; r < 16; ++r) ck[nb * 16 + r] = (ordf(acc[r]) & ~0x7fu) | (unsigned)(127 - (32 * nb + att::crow(r, hi)));
            }
            top16_of_64(ck);
            unsigned pb[16];
#pragma unroll
            for (int i = 0; i < 16; ++i) { auto rr = __builtin_amdgcn_permlane32_swap(ck[i], ck[i], false, false); pb[i] = hi ? rr[0] : rr[1]; }
            merge_top16(ck, pb);
#pragma unroll
            for (int i = 0; i < 16; ++i) win[(half * 16 + i) * 64 + lane] = ck[i];
        }
        LDS_WAIT();
        float v0[16], v1[16];
#pragma unroll
        for (int i = 0; i < 16; ++i) { v0[i] = unordf(win[i * 64 + lane] & ~0x7fu); v1[i] = unordf(win[(16 + i) * 64 + lane] & ~0x7fu); }
        unsigned c2[64];
        {
            int n = 0;
#pragma unroll
            for (int i = 0; i < 16; ++i)
#pragma unroll
                for (int j = 0; j < 16; ++j) if ((i + 1) * (j + 1) <= 16) { c2[n] = (ordf(v0[i] + v1[j]) & ~0xffu) | (unsigned)(255 - (16 * i + j)); ++n; }
#pragma unroll
            for (int q = 50; q < 64; ++q) c2[q] = 0u;
        }
        top16_of_64(c2);
        float sc[16]; unsigned ex[16];
#pragma unroll
        for (int k = 0; k < 16; ++k) {
            const unsigned f = c2[k]; const int idx = 255 - (int)(f & 0xffu), i = idx >> 4, j = idx & 15;
            const unsigned w0 = win[i * 64 + lane], w1 = win[(16 + j) * 64 + lane];
            ex[k] = (127u - (w0 & 0x7fu)) * 128u + (127u - (w1 & 0x7fu));
            sc[k] = unordf(w0 & ~0x7fu) + unordf(w1 & ~0x7fu);
        }
        const float mx = sc[0];
        float sum = 0.f;
#pragma unroll
        for (int k = 0; k < 16; ++k) { sc[k] = __expf(sc[k] - mx); sum += sc[k]; }
        const float inv = 1.f / sum;
#pragma unroll
        for (int k = 0; k < 16; ++k) sc[k] *= inv;
        if (hi == 0) {
            unsigned short* ep = EIDX + (t0 + r32) * 128 + h * 16; float* gp = EG + (t0 + r32) * 128 + h * 16;
            *(u32x4*)ep = (u32x4){ex[0] | (ex[1] << 16), ex[2] | (ex[3] << 16), ex[4] | (ex[5] << 16), ex[6] | (ex[7] << 16)};
            *(u32x4*)(ep + 8) = (u32x4){ex[8] | (ex[9] << 16), ex[10] | (ex[11] << 16), ex[12] | (ex[13] << 16), ex[14] | (ex[15] << 16)};
#pragma unroll
            for (int q = 0; q < 4; ++q) *(f32x4*)(gp + 4 * q) = (f32x4){sc[4 * q], sc[4 * q + 1], sc[4 * q + 2], sc[4 * q + 3]};
        }
        LDS_WAIT();
    }
}

__device__ __forceinline__ f32x2 gelu_pk(f32x2 v) {
    const f32x2 av = __builtin_elementwise_abs(v), dd = av * 0.2316418882f + 1.0f;
    f32x2 tt; tt.x = __builtin_amdgcn_rcpf(dd.x); tt.y = __builtin_amdgcn_rcpf(dd.y);
    f32x2 q = tt * 0.5307027145f + (-0.7265760135f); q = q * tt + 0.7107068705f; q = q * tt + (-0.142248368f); q = q * tt + 0.127414796f; q = q * tt;
    const f32x2 sq = (v * v) * (-0.72134752044f);
    f32x2 ee; ee.x = __builtin_amdgcn_exp2f(sq.x); ee.y = __builtin_amdgcn_exp2f(sq.y);
    const f32x2 mm = v * (q * ee), rr = v - mm;
    f32x2 o; o.x = v.x < 0.f ? mm.x : rr.x; o.y = v.y < 0.f ? mm.y : rr.y; return o;
}
__device__ __forceinline__ float dpp_f(float x, const int ctrl_sel) {
    const int xi = (int)__float_as_uint(x); int r;
    if (ctrl_sel == 0) r = __builtin_amdgcn_update_dpp(0, xi, 0x128, 0xF, 0xF, false);
    else if (ctrl_sel == 1) r = __builtin_amdgcn_update_dpp(0, xi, 0x141, 0xF, 0xF, false);
    else if (ctrl_sel == 2) r = __builtin_amdgcn_update_dpp(0, xi, 0x1B, 0xF, 0xF, false);
    else r = __builtin_amdgcn_update_dpp(0, xi, 0xB1, 0xF, 0xF, false);
    return __uint_as_float((unsigned)r);
}
__device__ __forceinline__ float reduce8_rows(float* d, int lane) {
#pragma unroll
    for (int i = 0; i < 4; ++i) { auto r = __builtin_amdgcn_permlane32_swap(__float_as_uint(d[i]), __float_as_uint(d[i + 4]), false, false); d[i] = __uint_as_float(r[0]) + __uint_as_float(r[1]); }
#pragma unroll
    for (int i = 0; i < 2; ++i) { auto r = __builtin_amdgcn_permlane16_swap(__float_as_uint(d[i]), __float_as_uint(d[i + 2]), false, false); d[i] = __uint_as_float(r[0]) + __uint_as_float(r[1]); }
    const bool up = lane & 8; const float keep = up ? d[1] : d[0], send = up ? d[0] : d[1];
    float x = keep + dpp_f(send, 0);
    x += dpp_f(x, 1); x += dpp_f(x, 2); x += dpp_f(x, 3);
    return x;
}
typedef int v8i_t __attribute__((ext_vector_type(8)));
#define HSC_TEST 0
__device__ __forceinline__ void peer_u_simple(LAS unsigned char* lds, const bf16* H2, tab_ptr PU, const float* RSU, const float* RSV, unsigned short* EIDX, const float* EG, float* COEF, int G, int blk) {
    const int tid_ = phase_tid(); const int lane = tid_ & 63, wave = __builtin_amdgcn_readfirstlane(tid_ >> 6);
    LAS unsigned char* wl = lds + wave * 17728;
    constexpr int RP = 784;
    LAS int* sid = (LAS int*)(wl + 12544);
    LAS float* sgt = (LAS float*)(wl + 12544 + 512);
    LAS float* res = (LAS float*)(wl + 12544 + 1024);
    LAS float* sul = (LAS float*)(wl + 13632);
    LAS float* gtl = (LAS float*)(wl + 13632 + 2048);
    const unsigned c0 = lane < 48 ? 16u * lane : 16u * (lane - 48), c1 = lane < 32 ? 256u + 16u * lane : 16u * (lane - 32), c2 = lane < 16 ? 512u + 16u * lane : 16u * (lane - 16);
    const unsigned d0 = (lane < 48 ? 0u : 784u) + c0, d1 = (lane < 32 ? 784u : 1568u) + c1, d2 = (lane < 16 ? 1568u : 2352u) + c2;
    const unsigned long long lt = (1ull << lane) - 1ull;
    const int n16 = lane & 15, g4 = lane >> 4;
    const int stride = G * NWAVES;
    for (int tb = blk * NWAVES + wave; tb < T; tb += 4 * stride) {
        int idlo[4], idhi[4]; float clo[4], chi[4]; int tt[4]; int tcl[4]; int hsc[4];
        int lp = (int)threadIdx.x; asm volatile("" : "+v"(lp)); lp &= 63;
        float g_lo[4], g_hi[4]; u32x4 hqa[4], hqb[4];
#pragma unroll
        for (int i = 0; i < 4; ++i) {
            const bool act_i = tb + i * stride < T; const int t = act_i ? tb + i * stride : tb; tt[i] = act_i ? t : -1; tcl[i] = t;
            const unsigned short* ep = EIDX + (size_t)t * 128;
            idlo[i] = ep[lp]; idhi[i] = ep[64 + lp]; g_lo[i] = EG[(size_t)t * 128 + lp]; g_hi[i] = EG[(size_t)t * 128 + 64 + lp];
            hqa[i] = *(const u32x4*)(H2 + (size_t)t * 1024 + 16 * lp); hqb[i] = *(const u32x4*)(H2 + (size_t)t * 1024 + 16 * lp + 8);
        }
        __builtin_amdgcn_sched_barrier(0);
        u32x4 hq[8][4];
        {
            const int tl = (lp & 2) ? ((lp & 1) ? tcl[3] : tcl[2]) : ((lp & 1) ? tcl[1] : tcl[0]);
            const bf16* hp = H2 + (size_t)tl * 1024 + 32 * (lp >> 4);
#pragma unroll
            for (int s8 = 0; s8 < 8; ++s8) { hq[s8][0] = *(const u32x4*)(hp + 128 * s8); hq[s8][1] = *(const u32x4*)(hp + 128 * s8 + 8); hq[s8][2] = *(const u32x4*)(hp + 128 * s8 + 16); hq[s8][3] = *(const u32x4*)(hp + 128 * s8 + 24); }
        }
        __builtin_amdgcn_sched_barrier(0);
        float rsu_lo[4], rsu_hi[4], rsv_lo[4], rsv_hi[4];
#pragma unroll
        for (int i = 0; i < 4; ++i) {
            {
                typedef unsigned short u16x2_t __attribute__((ext_vector_type(2)));
                u16x2_t mx = {0, 0};
                const unsigned hw[8] = {hqa[i].x, hqa[i].y, hqa[i].z, hqa[i].w, hqb[i].x, hqb[i].y, hqb[i].z, hqb[i].w};
#pragma unroll
                for (int j = 0; j < 8; ++j) mx = __builtin_elementwise_max(mx, __builtin_bit_cast(u16x2_t, hw[j] & 0x7fff7fffu));
                const unsigned m = wave_max_dpp(mx.x > mx.y ? (unsigned)mx.x : (unsigned)mx.y);
                const float tq = __uint_as_float(m << 16) * (1.f / 7.5f);
                hsc[i] = tq > 1.f ? (int)((__float_as_uint(tq) - 1u) >> 23) - 126 + HSC_TEST : HSC_TEST;
            }
            int il = idlo[i], ih = idhi[i]; float gl = g_lo[i], gh = g_hi[i];
            const int blo = il >> 10, bhi = ih >> 10; int plo = 0, phi = 0, base = 0;
#pragma unroll
            for (int bb = 0; bb < 16; ++bb) {
                const unsigned long long ml = __ballot(blo == bb), mh = __ballot(bhi == bb);
                const int nl = __popcll(ml);
                plo = (blo == bb) ? base + __popcll(ml & lt) : plo;
                phi = (bhi == bb) ? base + nl + __popcll(mh & lt) : phi;
                base += nl + __popcll(mh);
            }
            sid[plo] = il; sid[phi] = ih; sgt[plo] = gl; sgt[phi] = gh;
            il = sid[lp]; ih = sid[64 + lp]; gl = sgt[lp]; gh = sgt[64 + lp];
            if (tt[i] >= 0) { unsigned short* ep = EIDX + (size_t)tcl[i] * 128; ep[lp] = (unsigned short)il; ep[64 + lp] = (unsigned short)ih; }
            rsu_lo[i] = RSU[il]; rsu_hi[i] = RSU[ih]; rsv_lo[i] = RSV[il]; rsv_hi[i] = RSV[ih];
            idlo[i] = il; idhi[i] = ih; g_lo[i] = gl; g_hi[i] = gh; clo[i] = 0.f; chi[i] = 0.f;
        }
        v8i_t hB[8];
        {
            const int el = (lp & 2) ? ((lp & 1) ? hsc[3] : hsc[2]) : ((lp & 1) ? hsc[1] : hsc[0]);
            const float hdiv = __uint_as_float((unsigned)(127 + el) << 23);
#pragma unroll
            for (int s8 = 0; s8 < 8; ++s8) {
                typedef unsigned v16u_t __attribute__((ext_vector_type(16)));
                const v16u_t wv = {hq[s8][0].x, hq[s8][0].y, hq[s8][0].z, hq[s8][0].w, hq[s8][1].x, hq[s8][1].y, hq[s8][1].z, hq[s8][1].w, hq[s8][2].x, hq[s8][2].y, hq[s8][2].z, hq[s8][2].w, hq[s8][3].x, hq[s8][3].y, hq[s8][3].z, hq[s8][3].w};
                const v6u_t e6 = __builtin_amdgcn_cvt_scalef32_pk32_fp6_bf16(__builtin_bit_cast(v32bf_t, wv), hdiv);
                hB[s8] = (v8i_t){(int)e6[0], (int)e6[1], (int)e6[2], (int)e6[3], (int)e6[4], (int)e6[5], 0, 0};
            }
        }
#pragma unroll
        for (int i = 0; i < 4; ++i) {
            const float hs = __uint_as_float((unsigned)(127 + hsc[i]) << 23);
            sul[i * 128 + lp] = rsu_lo[i] * hs; sul[i * 128 + 64 + lp] = rsu_hi[i] * hs;
            gtl[i * 128 + lp] = g_lo[i] * rsv_lo[i]; gtl[i * 128 + 64 + lp] = g_hi[i] * rsv_hi[i];
        }
#define PU_LOAD(RB, HH, P) do { const int hh_ = (HH), l0_ = (hh_ & 7) * 8; \
            const int idA_ = hh_ < 8 ? idlo[2 * (P)] : idhi[2 * (P)], idB_ = hh_ < 8 ? idlo[2 * (P) + 1] : idhi[2 * (P) + 1]; \
            _Pragma("unroll") for (int q = 0; q < 4; ++q) { const int idq_ = q < 2 ? idA_ : idB_; const int lq_ = l0_ + 4 * (q & 1); \
                const unsigned o0_ = 768u * (unsigned)__builtin_amdgcn_readlane(idq_, lq_), o1_ = 768u * (unsigned)__builtin_amdgcn_readlane(idq_, lq_ + 1), \
                               o2_ = 768u * (unsigned)__builtin_amdgcn_readlane(idq_, lq_ + 2), o3_ = 768u * (unsigned)__builtin_amdgcn_readlane(idq_, lq_ + 3); \
                RB[3 * q] = *(const u32x4*)(PU + ((lane < 48 ? o0_ : o1_) + c0)); \
                RB[3 * q + 1] = *(const u32x4*)(PU + ((lane < 32 ? o1_ : o2_) + c1)); \
                RB[3 * q + 2] = *(const u32x4*)(PU + ((lane < 16 ? o2_ : o3_) + c2)); } } while (0)
#define PU_TOLDS(RB) do { _Pragma("unroll") for (int q = 0; q < 4; ++q) { \
            *(LAS u32x4*)(wl + q * 4 * RP + d0) = RB[3 * q]; *(LAS u32x4*)(wl + q * 4 * RP + d1) = RB[3 * q + 1]; *(LAS u32x4*)(wl + q * 4 * RP + d2) = RB[3 * q + 2]; } } while (0)
#define PU_COMP(HH, P) do { const int hh_ = (HH), l0_ = (hh_ & 7) * 8; \
            f32x4 acc_ = {0.f, 0.f, 0.f, 0.f}; const LAS unsigned char* ap_ = wl + n16 * RP + 24 * g4; \
            _Pragma("unroll") for (int s8 = 0; s8 < 8; ++s8) { \
                const u32x2 a0_ = *(const LAS u32x2*)(ap_ + 96 * s8), a1_ = *(const LAS u32x2*)(ap_ + 96 * s8 + 8), a2_ = *(const LAS u32x2*)(ap_ + 96 * s8 + 16); \
                const v8i_t A_ = {(int)a0_.x, (int)a0_.y, (int)a1_.x, (int)a1_.y, (int)a2_.x, (int)a2_.y, 0, 0}; \
                acc_ = __builtin_amdgcn_mfma_scale_f32_16x16x128_f8f6f4(A_, hB[s8], acc_, 2, 2, 0, 0x7f7f7f7f, 0, 0x7f7f7f7f); } \
            asm volatile("s_nop 15\n\ts_nop 15" : "+v"(acc_));                                          \
            if (g4 < 2 ? n16 == 2 * (P) : n16 == 2 * (P) + 1) *(LAS f32x4*)(res + 4 * g4) = acc_;        \
            const int r = (lane - l0_) & 7;                                         \
            const float a0 = res[r], a1 = res[8 + r]; \
            const int so_ = (hh_ < 8 ? 0 : 64) + lane; \
            const f32x2 gg = gelu_pk((f32x2){a0 * sul[2 * (P) * 128 + so_], a1 * sul[(2 * (P) + 1) * 128 + so_]}); \
            const float gA_ = gtl[2 * (P) * 128 + so_], gB_ = gtl[(2 * (P) + 1) * 128 + so_]; \
            const bool mine = (lane >> 3) == (hh_ & 7); \
            if (hh_ < 8) { clo[2 * (P)] = mine ? gA_ * gg.x : clo[2 * (P)]; clo[2 * (P) + 1] = mine ? gB_ * gg.y : clo[2 * (P) + 1]; } \
            else         { chi[2 * (P)] = mine ? gA_ * gg.x : chi[2 * (P)]; chi[2 * (P) + 1] = mine ? gB_ * gg.y : chi[2 * (P) + 1]; } } while (0)
        {
            u32x4 rb[12];
            PU_LOAD(rb, 0, 0);
#pragma unroll 1
            for (int h = 0; h < 16; ++h) {
                PU_TOLDS(rb);
                __builtin_amdgcn_sched_barrier(0);
                PU_LOAD(rb, h, 1);
                __builtin_amdgcn_sched_barrier(0);
                PU_COMP(h, 0);
                __builtin_amdgcn_sched_barrier(0);
                PU_TOLDS(rb);
                __builtin_amdgcn_sched_barrier(0);
                PU_LOAD(rb, h < 15 ? h + 1 : 15, 0);
                __builtin_amdgcn_sched_barrier(0);
                PU_COMP(h, 1);
                __builtin_amdgcn_sched_barrier(0);
            }
        }
#undef PU_LOAD
#undef PU_TOLDS
#undef PU_COMP
        int le = (int)threadIdx.x; asm volatile("" : "+v"(le)); le &= 63;
#pragma unroll
        for (int i = 0; i < 4; ++i) if (tt[i] >= 0) { COEF[(size_t)tt[i] * 128 + le] = clo[i]; COEF[(size_t)tt[i] * 128 + 64 + le] = chi[i]; }
    }
}
__device__ __forceinline__ void peer_v_phase(tab_ptr PV, const unsigned short* EIDX, const float* COEF, const float* MOD, float* OUT, int G, int blk) {
    const int tid_ = phase_tid(); const int lane = tid_ & 63, wave = __builtin_amdgcn_readfirstlane(tid_ >> 6);
    const int stride = G * NWAVES;
    for (int tb = blk * NWAVES + wave; tb < T; tb += 4 * stride) {
        float out[4][16]; int idlo[4], idhi[4]; float clo[4], chi[4]; int tt[4]; bool act[4];
        int ln = lane; asm volatile("" : "+v"(ln));
#pragma unroll
        for (int i = 0; i < 4; ++i) {
            act[i] = tb + i * stride < T; const int t = act[i] ? tb + i * stride : tb; tt[i] = t;
#pragma unroll
            for (int j = 0; j < 16; ++j) out[i][j] = 0.f;
            const unsigned short* ep = EIDX + (size_t)t * 128;
            idlo[i] = ep[ln]; idhi[i] = ep[64 + ln];
            clo[i] = COEF[(size_t)t * 128 + ln]; chi[i] = COEF[(size_t)t * 128 + 64 + ln];
        }
#pragma unroll 1
        for (int h = 0; h < 16; ++h) {
            const int l0 = (h & 7) * 8;
#pragma unroll
            for (int p = 0; p < 2; ++p) {
                const int idA = h < 8 ? idlo[2 * p] : idhi[2 * p], idB = h < 8 ? idlo[2 * p + 1] : idhi[2 * p + 1];
                const float cA = h < 8 ? clo[2 * p] : chi[2 * p], cB = h < 8 ? clo[2 * p + 1] : chi[2 * p + 1];
                float ck[16]; U3 ra[16];
#pragma unroll
                for (int k = 0; k < 8; ++k) {
                    const unsigned e = (unsigned)__builtin_amdgcn_readlane(idA, l0 + k);
                    ck[k] = __uint_as_float((unsigned)__builtin_amdgcn_readlane((int)__float_as_uint(cA), l0 + k));
                    ra[k] = *(const U3*)(PV + (size_t)e * PEER_ROWB + 12 * lane);
                }
#pragma unroll
                for (int k = 0; k < 8; ++k) {
                    const unsigned e = (unsigned)__builtin_amdgcn_readlane(idB, l0 + k);
                    ck[8 + k] = __uint_as_float((unsigned)__builtin_amdgcn_readlane((int)__float_as_uint(cB), l0 + k));
                    ra[8 + k] = *(const U3*)(PV + (size_t)e * PEER_ROWB + 12 * lane);
                }
#pragma unroll
                for (int k = 0; k < 16; k += 2) {
                    const v6u_t w = {ra[k].x, ra[k].y, ra[k].z, ra[k + 1].x, ra[k + 1].y, ra[k + 1].z};
                    const v32f_t f = __builtin_amdgcn_cvt_scalef32_pk32_f32_fp6(w, 1.0f);
                    float* o = out[2 * p + (k >> 3)];
#pragma unroll
                    for (int j = 0; j < 16; ++j) o[j] += ck[k] * f[j];
#pragma unroll
                    for (int j = 0; j < 16; ++j) o[j] += ck[k + 1] * f[16 + j];
                }
                __builtin_amdgcn_sched_barrier(0);
            }
        }
        int le = lane; asm volatile("" : "+v"(le));
#pragma unroll
        for (int i = 0; i < 4; ++i) {
            if (act[i]) {
                const float* g2 = MOD + (size_t)(tt[i] >> 12) * 6144 + 5120;
                float* op = OUT + (size_t)tt[i] * 1024;
#pragma unroll
                for (int q = 0; q < 4; ++q) {
                    const int col = 16 * le + 4 * q;
                    const f32x4 g = *(const f32x4*)(g2 + col), x1 = *(const f32x4*)(op + col);
                    *(f32x4*)(op + col) = x1 + g * (f32x4){out[i][4 * q], out[i][4 * q + 1], out[i][4 * q + 2], out[i][4 * q + 3]};
                }
            }
        }
    }
}

#define XB_TMO      128
#define XB_XCNT(j)  (256  + 64 * (j))
#define XB_XSUB(j)  (1280 + 64 * (j))
#define XB_XGEN(j)  (2304 + 64 * (j))
#define XB_TOP      3328
#define XB_TOPGEN   3392
#define XCD_BAR_WORDS 3456
#define XB_SPIN_CAP (1u << 20)
__device__ __forceinline__ unsigned xb_ld(unsigned* p)              { return __hip_atomic_load(p, __ATOMIC_RELAXED, __HIP_MEMORY_SCOPE_AGENT); }
__device__ __forceinline__ unsigned xb_add(unsigned* p, unsigned v) { return __hip_atomic_fetch_add(p, v, __ATOMIC_RELAXED, __HIP_MEMORY_SCOPE_AGENT); }
__device__ __forceinline__ unsigned xb_xcc_id() { return (unsigned)__builtin_amdgcn_s_getreg((3 << 11) | 20) & 0xFu; }
#define XB_SPIN(cond, bar) do { unsigned _sp = 0; while (cond) { __builtin_amdgcn_s_sleep(1); \
    if ((++_sp & 255u) == 0u) { if (xb_ld(&(bar)[XB_TMO])) break; if (_sp > XB_SPIN_CAP) { atomicAdd(&(bar)[XB_TMO], 1u); break; } } } } while (0)
struct XcdBarrier { unsigned* bar; unsigned x; volatile LAS unsigned* st; };
__device__ __forceinline__ XcdBarrier xcd_barrier_post(unsigned* bar, volatile LAS unsigned* st) {
    XcdBarrier b; b.bar = bar; b.x = xb_xcc_id(); b.st = st;
    if (threadIdx.x == 0) (void)xb_add(&bar[XB_XCNT(b.x)], 1u);
    return b;
}
__device__ __forceinline__ void xcd_barrier_complete(unsigned* bar, unsigned x, unsigned& nloc, unsigned& nx) {
    const unsigned G = gridDim.x * gridDim.y * gridDim.z;
    unsigned sum, cnt, mine, sp = 0u;
    for (;;) {
        sum = 0u; cnt = 0u; mine = 0u;
#pragma unroll
        for (unsigned j = 0; j < 16; ++j) { const unsigned c = xb_ld(&bar[XB_XCNT(j)]); sum += c; cnt += (c > 0u) ? 1u : 0u; mine = (j == x) ? c : mine; }
        if (sum == G) break;
        __builtin_amdgcn_s_sleep(1);
        if ((++sp & 255u) == 0u) { if (xb_ld(&bar[XB_TMO])) break; if (sp > XB_SPIN_CAP) { atomicAdd(&bar[XB_TMO], 1u); break; } }
    }
    nloc = mine > 0u ? mine : 1u; nx = cnt > 0u ? cnt : 1u;
}
__device__ __forceinline__ void xcd_barrier(const XcdBarrier& b) {
    asm volatile("s_waitcnt vmcnt(0)" ::: "memory");
    __syncthreads();
    if (threadIdx.x == 0) {
        unsigned* bar = b.bar;
        __builtin_amdgcn_s_waitcnt(0);
        unsigned nloc = b.st[0], nx = b.st[1];
        if (nloc == 0u) { xcd_barrier_complete(bar, b.x, nloc, nx); b.st[0] = nloc; b.st[1] = nx; }
        const unsigned old = xb_add(&bar[XB_XSUB(b.x)], 1u);
        const unsigned gen = old / nloc;
        if (old + 1u == (gen + 1u) * nloc) {
            __builtin_amdgcn_fence(__ATOMIC_RELEASE, "agent");
            asm volatile("s_waitcnt vmcnt(0)" ::: "memory");
            const unsigned og = xb_add(&bar[XB_TOP], 1u);
            const unsigned tg = og / nx;
            if (og + 1u == (tg + 1u) * nx) xb_add(&bar[XB_TOPGEN], 1u);
            else XB_SPIN(xb_ld(&bar[XB_TOPGEN]) == tg, bar);
            __builtin_amdgcn_fence(__ATOMIC_ACQUIRE, "agent");
            xb_add(&bar[XB_XGEN(b.x)], 1u);
            asm volatile("s_waitcnt vmcnt(0)" ::: "memory");
        } else {
            XB_SPIN(xb_ld(&bar[XB_XGEN(b.x)]) == gen, bar);
            __builtin_amdgcn_fence(__ATOMIC_ACQUIRE, "agent");
            asm volatile("s_waitcnt vmcnt(0)" ::: "memory");
        }
    }
    __syncthreads();
}

constexpr int N_PHASES = 12;
#ifndef PROBE_K
#define PROBE_K -1
#endif
__global__ void __launch_bounds__(NWAVES * 64, 2) mk_fwd(Args a) {
    extern __shared__ __attribute__((aligned(16))) unsigned char lds_raw[];
    LAS unsigned char* lds = (LAS unsigned char*)lds_raw;
    cg::grid_group grid = cg::this_grid();
    const int G = gridDim.x, blk = blockIdx.x;
    unsigned char* ws = a.ws;
    float* MOD = (float*)(ws + WS_MOD);
    bf16* H = (bf16*)(ws + WS_H);
    bf16 *CB = (bf16*)(ws + WS_CB), *CC = (bf16*)(ws + WS_CC), *CX = (bf16*)(ws + WS_CX), *Qb = (bf16*)(ws + WS_Q), *Kb = (bf16*)(ws + WS_K), *Vb = (bf16*)(ws + WS_V), *QI = (bf16*)(ws + WS_QI);
    bf16 *GC = (bf16*)(ws + WS_GC), *GA = (bf16*)(ws + WS_GA), *KI = (bf16*)(ws + WS_KI); float* WI = (float*)(ws + WS_WI);
    unsigned long long* MASK = (unsigned long long*)(ws + WS_MASK);
    bf16* PQ = (bf16*)(ws + WS_PQ); unsigned short* EIDX = (unsigned short*)(ws + WS_EIDX); float* EG = (float*)(ws + WS_EG); float* COEF = (float*)(ws + WS_COEF);
#define IN(k) (a.ph_lo <= (k) && (k) < a.ph_hi)
#define SEAM(k) do { if (IN(k) && IN((k) + 1)) { if ((k) == 0) grid.sync(); else xcd_barrier(xbar); } if (PROBE_K == (k) && threadIdx.x == 0) pst[1] = __builtin_amdgcn_s_memrealtime(); if (PROBE_K == (k) + 1 && threadIdx.x == 0) pst[0] = __builtin_amdgcn_s_memrealtime(); } while (0)
    volatile LAS unsigned* xst = (volatile LAS unsigned*)(lds + LDS_BYTES - 64);
    if (threadIdx.x < 4) xst[threadIdx.x] = 0u;
    __syncthreads();
    const XcdBarrier xbar = xcd_barrier_post((unsigned*)(ws + WS_CTL), xst);

    volatile LAS unsigned long long* pst = (volatile LAS unsigned long long*)(lds + LDS_BYTES - 48);
    if (PROBE_K >= 0 && threadIdx.x == 0) { pst[0] = 0; pst[1] = 0; pst[2] = 0; pst[3] = 0; }
    if (PROBE_K == 0 && threadIdx.x == 0) pst[0] = __builtin_amdgcn_s_memrealtime();
    if (IN(0)) p0_prologue(lds, a, G, blk);
    SEAM(0);
    if (IN(1)) norm_phase<false>(a.in[0], a.in[4], MOD, 0, H, G, blk);
    SEAM(1);
    if (IN(2)) {
        pg8::Gemm g{H, (const bf16*)(ws + WS_WIN), T, NIN_PAD, DM}; pg8::StaticOrder S; S.init(T, NIN_PAD, G, blk);
        EpiInProj E{ws, a.in[8], a.in[9]};
        pg8::gemm_phase<EpiInProj, true, true>(lds, g, S, E);
    }
    SEAM(2);
    if (IN(3)) { if (PROBE_SUB == 3 && threadIdx.x == 0) pst[3] = __builtin_amdgcn_s_memrealtime(); conv_phase(CB, CC, CX, a.in[6], H, G, blk); if (PROBE_SUB == 3) { __syncthreads(); if (threadIdx.x == 0) pst[2] += __builtin_amdgcn_s_memrealtime() - pst[3]; }
        indexer_phase(lds, QI, KI, WI, MASK, G, blk); }
    SEAM(3);
    if (IN(4)) att::attn_phase(lds, Qb, Kb, Vb, MASK, a.in[8], a.in[9], H, G, blk);
    SEAM(4);
    if (IN(5)) {
        pg8::Gemm g{H, (const bf16*)(ws + WS_WCO), T, DM, DM}; pg8::StaticOrder S; S.init(T, DM, G, blk);
        EpiMixFused E{GC, GA, CB};
        pg8::gemm_phase<EpiMixFused, true, true>(lds, g, S, E);
    }
    SEAM(5);
    if (IN(6)) {
        pg8::Gemm g{CB, (const bf16*)(ws + WS_WO), T, DM, DM}; pg8::StaticOrder S; S.init(T, DM, G, blk);
        EpiDelta E{MOD, H};
        pg8::gemm_phase<EpiDelta, true, true>(lds, g, S, E);
    }
    SEAM(6);
    if (IN(7)) norm_phase<true>(a.in[0], a.in[12], MOD, 3072, H, G, blk, a.out);
    SEAM(7);
    if (IN(8)) {
        pg8::Gemm g{H, (const bf16*)(ws + WS_WPQ), T, DM, DM}; pg8::StaticOrder S; S.init(T, DM, G, blk);
        EpiPlain E{PQ};
        pg8::gemm_phase<EpiPlain, true, true>(lds, g, S, E);
    }
    SEAM(8);
    if (IN(9)) peer_route_phase(lds, PQ, (const bf16*)(ws + WS_SK), EIDX, EG, G, blk);
    SEAM(9);
    if (IN(10)) peer_u_simple(lds, H, (tab_ptr)(ws + WS_PU), (const float*)(ws + WS_RSU), (const float*)(ws + WS_RSV), EIDX, EG, COEF, G, blk);
    SEAM(10);
    if (IN(11)) peer_v_phase((tab_ptr)(ws + WS_PV), EIDX, COEF, MOD, a.out, G, blk);
    if (PROBE_K >= 0) {
        xcd_barrier(xbar);
        if (blk != 0 || threadIdx.x != 0) return;
        if (PROBE_K == 11) pst[1] = __builtin_amdgcn_s_memrealtime();
        const unsigned long long te = __builtin_amdgcn_s_memrealtime();
        const unsigned long long span = PROBE_SUB ? pst[2] : pst[1] - pst[0];
        while (__builtin_amdgcn_s_memrealtime() - te < span) __builtin_amdgcn_s_sleep(20);
    }
#undef IN
#undef SEAM
}

#ifndef MK_N_LAUNCHES
#define MK_N_LAUNCHES 1
#endif
extern "C" void kernel_launch(void* const* d_in, const int* in_sizes, int n_in, void* d_out, int out_size, void* d_ws, size_t ws_size, hipStream_t stream) {
    static int grid = 0;
    if (grid == 0) {
        if (n_in != 17 || in_sizes[0] != T * DM || out_size != T * DM || ws_size < WS_END) {
            fprintf(stderr, "kernel_launch: unexpected problem: n_in %d in0 %d out %d ws %zu (need %zu); nothing launched\n", n_in, n_in > 0 ? in_sizes[0] : -1, out_size, ws_size, (size_t)WS_END); grid = -1; return; }
        int dev = 0, cus = 0, per_cu = 0;
        hipGetDevice(&dev); hipDeviceGetAttribute(&cus, hipDeviceAttributeMultiprocessorCount, dev);
        if (hipFuncSetAttribute((const void*)mk_fwd, hipFuncAttributeMaxDynamicSharedMemorySize, LDS_BYTES) != hipSuccess) { fprintf(stderr, "kernel_launch: hipFuncSetAttribute failed\n"); grid = -1; return; }
        if (hipOccupancyMaxActiveBlocksPerMultiprocessor(&per_cu, (const void*)mk_fwd, NWAVES * 64, LDS_BYTES) != hipSuccess || per_cu < 1) { fprintf(stderr, "kernel_launch: occupancy query says %d blocks per CU\n", per_cu); grid = -1; return; }
        grid = cus;
    }
    if (grid < 0) return;
    if (hipMemsetAsync((char*)d_ws + WS_CTL, 0, CTL_BYTES, stream) != hipSuccess) { fprintf(stderr, "kernel_launch: hipMemsetAsync failed\n"); return; }
    Args a{};
    for (int i = 0; i < 17; ++i) a.in[i] = (const float*)d_in[i];
    a.out = (float*)d_out; a.ws = (unsigned char*)d_ws;
    for (int li = 0; li < MK_N_LAUNCHES; ++li) {
        a.ph_lo = li * (N_PHASES / MK_N_LAUNCHES); a.ph_hi = (li + 1) * (N_PHASES / MK_N_LAUNCHES);
        void* args[] = {&a};
        hipError_t e = hipLaunchCooperativeKernel((const void*)mk_fwd, dim3(grid), dim3(NWAVES * 64), args, LDS_BYTES, stream);
        if (e != hipSuccess) { fprintf(stderr, "kernel_launch: cooperative launch %d failed: %s (grid %d)\n", li, hipGetErrorString(e), grid); break; }
    }
}
```

```cpp
#include <hip/hip_runtime.h>
#include <hip/hip_cooperative_groups.h>
#include <cstdio>
#include <cstdint>
namespace cg = cooperative_groups;

#define LAS __attribute__((address_space(3)))
typedef unsigned short bf16;
typedef short bf16x8 __attribute__((ext_vector_type(8)));
typedef short s16x4 __attribute__((ext_vector_type(4)));
typedef float f32x2 __attribute__((ext_vector_type(2)));
typedef float f32x4 __attribute__((ext_vector_type(4)));
typedef float f32x16 __attribute__((ext_vector_type(16)));
typedef unsigned u32x2 __attribute__((ext_vector_type(2)));
typedef unsigned u32x4 __attribute__((ext_vector_type(4)));
typedef __bf16 bf16x2_t __attribute__((ext_vector_type(2)));

__device__ __forceinline__ unsigned pk2(float lo, float hi) { f32x2 v = {lo, hi}; bf16x2_t b = __builtin_convertvector(v, bf16x2_t); return __builtin_bit_cast(unsigned, b); }
__device__ __forceinline__ float bflo(unsigned u) { return __uint_as_float(u << 16); }
__device__ __forceinline__ float bfhi(unsigned u) { return __uint_as_float(u & 0xffff0000u); }
__device__ __forceinline__ unsigned ordf(float f) { unsigned u = __float_as_uint(f); return u ^ ((u & 0x80000000u) ? 0xffffffffu : 0x80000000u); }
__device__ __forceinline__ float unordf(unsigned u) { return __uint_as_float((u & 0x80000000u) ? (u ^ 0x80000000u) : ~u); }
#define LDS_WAIT() asm volatile("s_waitcnt lgkmcnt(0)" ::: "memory")
__device__ __forceinline__ int phase_tid() { int t = (int)threadIdx.x; asm volatile("" : "+v"(t)); return t; }

constexpr int PEER_ROWB = 768;
typedef const unsigned char* tab_ptr;
constexpr int NB = 16, SEQ = 4096, DM = 1024, T = NB * SEQ;
constexpr int NIN_PAD = 5888;
constexpr float EPS = 1e-6f;
constexpr float C2 = 0.125f * 1.4426950408889634f;
constexpr int NWAVES = 8;

constexpr size_t MiB = 1u << 20;
constexpr size_t WS_MOD = 1 * MiB;
constexpr size_t WS_RSU = 1 * MiB + 512 * 1024, WS_RSV = 1 * MiB + 640 * 1024;
constexpr size_t WS_WIN = 2 * MiB;
constexpr size_t WS_WCO = 14 * MiB;
constexpr size_t WS_WAO = 15 * MiB;
constexpr size_t WS_WO = 16 * MiB;
constexpr size_t WS_WPQ = 18 * MiB;
constexpr size_t WS_SK = 20 * MiB;
constexpr size_t WS_PU = 32 * MiB;
constexpr size_t WS_PV = 64 * MiB;
constexpr size_t WS_H = 96 * MiB;
constexpr size_t WS_CB = 224 * MiB;
constexpr size_t WS_CC = 288 * MiB;
constexpr size_t WS_CX = 352 * MiB;
constexpr size_t WS_Q = 416 * MiB;
constexpr size_t WS_K = 480 * MiB;
constexpr size_t WS_V = 544 * MiB;
constexpr size_t WS_QI = 608 * MiB;
constexpr size_t WS_GC = 672 * MiB;
constexpr size_t WS_GA = 800 * MiB;
constexpr size_t WS_KI = 928 * MiB;
constexpr size_t WS_WI = 936 * MiB;
constexpr size_t WS_MASK = 938 * MiB;
constexpr size_t WS_END = 970 * MiB;
constexpr size_t WS_PQ = WS_CC;
constexpr size_t WS_EIDX = WS_K;
constexpr size_t WS_EG = WS_K + 16 * MiB;
constexpr size_t WS_COEF = WS_V;
constexpr size_t WS_CTL = 0;
constexpr size_t CTL_BYTES = 32768;

constexpr int LDS_BYTES = 147456;

namespace pg8 {
constexpr int BM = 256, BK = 64, HALF = 128, HTB = HALF * BK * 2, STAGE_BYTES = 8 * HTB, NXCD = 8, WGM = 8;
__host__ __device__ __forceinline__ int lds_byte(int r, int c) { const int st = (r >> 4) * 2 + (c >> 5), rr = r & 15, cc = c & 31, ob = rr * 64 + cc * 2; return st * 1024 + (ob ^ (((ob >> 9) & 1) << 5)); }
__host__ __device__ __forceinline__ void stage_rc(int b, int& R, int& C) { const int st = b / 1024, sb = b % 1024, swz = sb ^ (((sb >> 9) & 1) << 5); R = (st >> 1) * 16 + swz / 64; C = (st & 1) * 32 + (swz % 64) / 2; }
__host__ __device__ __forceinline__ int perm32(int rho) { const int n = rho >> 4, i = rho & 15; return 8 * (i >> 2) + 4 * n + (i & 3); }
struct Unit { int pm, pn; };
struct Gemm { const bf16* A; const bf16* Bt; int M, N, K; };
struct StaticOrder {
    int nM, nN, nwg, G, c;
    __device__ void init(int M, int N, int G_, int c_) { nM = M / BM; nN = N / BM; nwg = nM * nN; G = G_; c = c_; }
    __device__ bool next(int i, Unit& u) const {
        const long L = (long)i * G + c; if (L >= nwg) return false;
        int wgid = (int)L; { const int q = nwg / NXCD, r = nwg % NXCD, xcd = wgid % NXCD, off = wgid / NXCD; wgid = (xcd < r ? xcd * (q + 1) : r * (q + 1) + (xcd - r) * q) + off; }
        const int nig = WGM * nN, gid = wgid / nig, fm = gid * WGM, gsz = (nM - fm) < WGM ? (nM - fm) : WGM;
        u.pm = fm + ((wgid % nig) % gsz); u.pn = (wgid % nig) / gsz; return true;
    }
};

template <class Epi, bool ALIGN_EPI, bool SP2>
__device__ __forceinline__ void gemm_phase(LAS unsigned char* lds, const Gemm g, const StaticOrder& S, const Epi& E) {
    const int tid = phase_tid(), wid = __builtin_amdgcn_readfirstlane(tid >> 6), lane = tid & 63, wr = wid >> 2, wc = wid & 3, fr = lane & 15, fq = lane >> 4;
    const int K = g.K, nt = K / BK;
    unsigned voffA[2], voffB[2];
#pragma unroll
    for (int i = 0; i < 2; ++i) { int R, C; stage_rc(tid * 16 + i * 8192, R, C); const int Rb = Epi::PERM ? ((R & ~31) + perm32(R & 31)) : R;
        voffA[i] = (unsigned)(R * K + C) * 2u; voffB[i] = (unsigned)(Rb * K + C) * 2u; }
    const size_t kstep = (size_t)(BK * 2);
    const size_t hstep = (size_t)HALF * K * 2;
    const size_t tstep = 2 * hstep;
    const unsigned ldsw = (unsigned)wid * 1024u;
    const int aoff = lds_byte(wr * 64 + fr, fq * 8), boff = lds_byte(wc * 32 + fr, fq * 8);
#define PG8_SA(b, h) (((b) * 2 + (h)) * HTB)
#define PG8_SB(b, h) ((4 + (b) * 2 + (h)) * HTB)
#define PG8_STAGE(bufoff, gbase, voff) do { _Pragma("unroll") for (int _i = 0; _i < 2; ++_i) \
        __builtin_amdgcn_global_load_lds((const unsigned*)((const char*)(gbase) + (voff)[_i]), (LAS unsigned*)(lds + (bufoff) + ldsw + _i * 8192), 16, 0, 0); } while (0)
#define PG8_LDA(dst, b, h) do { _Pragma("unroll") for (int m = 0; m < 4; ++m) _Pragma("unroll") for (int k = 0; k < 2; ++k) dst[m][k] = *(const LAS bf16x8*)(lds + PG8_SA(b, h) + aoff + m * 2048 + k * 1024); } while (0)
#define PG8_LDB(dst, b, h) do { _Pragma("unroll") for (int n = 0; n < 2; ++n) _Pragma("unroll") for (int k = 0; k < 2; ++k) dst[n][k] = *(const LAS bf16x8*)(lds + PG8_SB(b, h) + boff + n * 2048 + k * 1024); } while (0)
#define PG8_MMA(ai, bj, At, Bt) do { __builtin_amdgcn_s_setprio(1); _Pragma("unroll") for (int m = 0; m < 4; ++m) _Pragma("unroll") for (int n = 0; n < 2; ++n) _Pragma("unroll") for (int k = 0; k < 2; ++k) \
        acc[ai][bj][m][n] = __builtin_amdgcn_mfma_f32_16x16x32_bf16(Bt[n][k], At[m][k], acc[ai][bj][m][n], 0, 0, 0); __builtin_amdgcn_s_setprio(0); } while (0)
#define PG8_WAIT_V(n) asm volatile("s_waitcnt vmcnt(" #n ")" ::: "memory")
#define PG8_WAIT_L(n) asm volatile("s_waitcnt lgkmcnt(" #n ")" ::: "memory")
#define PG8_BAR __builtin_amdgcn_s_barrier()
#define PG8_SCHED __builtin_amdgcn_sched_barrier(0)
    Unit cur, nxt; int ui = 0;
    if (!S.next(0, cur)) return;
    f32x4 acc[2][2][4][2];
#pragma unroll
    for (int a = 0; a < 2; ++a)
#pragma unroll
        for (int b = 0; b < 2; ++b)
#pragma unroll
            for (int m = 0; m < 4; ++m)
#pragma unroll
                for (int n = 0; n < 2; ++n) acc[a][b][m][n] = (f32x4){0.f, 0.f, 0.f, 0.f};
    bf16x8 At[4][2], B0[2][2], B1[2][2];
    const char* cA = (const char*)g.A + (size_t)cur.pm * tstep; const char* cB = (const char*)g.Bt + (size_t)cur.pn * tstep;
    if constexpr (SP2) {
        PG8_STAGE(PG8_SB(0, 0), cB, voffB); PG8_STAGE(PG8_SB(0, 1), cB + hstep, voffB); PG8_STAGE(PG8_SA(0, 0), cA, voffA); PG8_STAGE(PG8_SA(0, 1), cA + hstep, voffA);
        if (wr == 1) PG8_BAR;
        PG8_WAIT_V(2); PG8_BAR;
        PG8_STAGE(PG8_SB(1, 0), cB + kstep, voffB); PG8_STAGE(PG8_SA(1, 0), cA + kstep, voffA); PG8_STAGE(PG8_SB(1, 1), cB + hstep + kstep, voffB);
        PG8_WAIT_V(6); PG8_BAR;
    } else {
        PG8_STAGE(PG8_SB(0, 0), cB, voffB); PG8_STAGE(PG8_SA(0, 0), cA, voffA); PG8_STAGE(PG8_SB(0, 1), cB + hstep, voffB); PG8_STAGE(PG8_SA(0, 1), cA + hstep, voffA);
        if (wr == 1) PG8_BAR;
        PG8_WAIT_V(4); PG8_BAR;
        PG8_STAGE(PG8_SB(1, 0), cB + kstep, voffB); PG8_STAGE(PG8_SA(1, 0), cA + kstep, voffA); PG8_STAGE(PG8_SB(1, 1), cB + hstep + kstep, voffB);
        PG8_WAIT_V(6); PG8_BAR;
    }
    for (;;) {
        const bool has_next = S.next(ui + 1, nxt);
        const char* nA = has_next ? (const char*)g.A + (size_t)nxt.pm * tstep : cA; const char* nB = has_next ? (const char*)g.Bt + (size_t)nxt.pn * tstep : cB;
        for (int t = 0; t < nt; t += 2) {
            if constexpr (Epi::MIDK) { if (t == nt / 2) E.mid(acc, cur, wr, wc, fr, fq); }
            const bool last = (t == nt - 2);
            const char* a1 = cA + (size_t)(t + 1) * kstep;
            const char* a2 = last ? nA : cA + (size_t)(t + 2) * kstep; const char* b2 = last ? nB : cB + (size_t)(t + 2) * kstep;
            const char* a3 = a2 + kstep; const char* b3 = b2 + kstep;
            if constexpr (SP2) {
            PG8_LDB(B0, 0, 0); PG8_LDB(B1, 0, 1); PG8_SCHED; PG8_LDA(At, 0, 0); PG8_STAGE(PG8_SA(1, 1), a1 + hstep, voffA);
            PG8_WAIT_V(8); PG8_WAIT_L(0); PG8_BAR; PG8_MMA(0, 0, At, B0); PG8_MMA(0, 1, At, B1); PG8_BAR; PG8_SCHED;
            PG8_LDA(At, 0, 1); PG8_STAGE(PG8_SB(0, 0), b2, voffB); PG8_STAGE(PG8_SB(0, 1), b2 + hstep, voffB); PG8_STAGE(PG8_SA(0, 0), a2, voffA);
            PG8_WAIT_V(8); PG8_WAIT_L(0); PG8_BAR; PG8_MMA(1, 0, At, B0); PG8_MMA(1, 1, At, B1); PG8_BAR; PG8_SCHED;
            PG8_LDB(B0, 1, 0); PG8_LDB(B1, 1, 1); PG8_SCHED; PG8_LDA(At, 1, 0); PG8_STAGE(PG8_SA(0, 1), a2 + hstep, voffA);
            PG8_WAIT_V(8); PG8_WAIT_L(0); PG8_BAR; PG8_MMA(0, 0, At, B0); PG8_MMA(0, 1, At, B1); PG8_BAR; PG8_SCHED;
            PG8_LDA(At, 1, 1); PG8_STAGE(PG8_SB(1, 0), b3, voffB); PG8_STAGE(PG8_SB(1, 1), b3 + hstep, voffB); PG8_STAGE(PG8_SA(1, 0), a3, voffA);
            PG8_WAIT_V(8); PG8_WAIT_L(0); PG8_BAR; PG8_MMA(1, 0, At, B0); PG8_MMA(1, 1, At, B1); PG8_BAR; PG8_SCHED;
            } else {
            PG8_LDB(B0, 0, 0); PG8_SCHED; PG8_LDA(At, 0, 0); PG8_STAGE(PG8_SA(1, 1), a1 + hstep, voffA);
            PG8_WAIT_L(8); PG8_BAR; PG8_WAIT_L(0); PG8_MMA(0, 0, At, B0); PG8_BAR; PG8_SCHED;
            PG8_LDB(B1, 0, 1); PG8_STAGE(PG8_SB(0, 0), b2, voffB);
            PG8_BAR; PG8_WAIT_L(0); PG8_MMA(0, 1, At, B1); PG8_BAR;
            PG8_LDA(At, 0, 1); PG8_STAGE(PG8_SA(0, 0), a2, voffA);
            PG8_BAR; PG8_WAIT_L(0); PG8_MMA(1, 0, At, B0); PG8_BAR; PG8_SCHED;
            PG8_STAGE(PG8_SB(0, 1), b2 + hstep, voffB);
            PG8_WAIT_V(6); PG8_BAR; PG8_MMA(1, 1, At, B1); PG8_BAR;
            PG8_LDB(B0, 1, 0); PG8_SCHED; PG8_LDA(At, 1, 0); PG8_STAGE(PG8_SA(0, 1), a2 + hstep, voffA);
            PG8_WAIT_L(8); PG8_BAR; PG8_WAIT_L(0); PG8_MMA(0, 0, At, B0); PG8_BAR; PG8_SCHED;
            PG8_LDB(B1, 1, 1); PG8_STAGE(PG8_SB(1, 0), b3, voffB);
            PG8_BAR; PG8_WAIT_L(0); PG8_MMA(0, 1, At, B1); PG8_BAR;
            PG8_LDA(At, 1, 1); PG8_STAGE(PG8_SA(1, 0), a3, voffA);
            PG8_BAR; PG8_WAIT_L(0); PG8_MMA(1, 0, At, B0); PG8_BAR; PG8_SCHED;
            PG8_STAGE(PG8_SB(1, 1), b3 + hstep, voffB);
            PG8_WAIT_V(6); PG8_BAR; PG8_MMA(1, 1, At, B1); PG8_BAR;
            }
        }
        if constexpr (ALIGN_EPI) { if (wr == 0) PG8_BAR; }
        E(acc, cur, wr, wc, fr, fq);
        if (!has_next) break;
#pragma unroll
        for (int a = 0; a < 2; ++a)
#pragma unroll
            for (int b = 0; b < 2; ++b)
#pragma unroll
                for (int m = 0; m < 4; ++m)
#pragma unroll
                    for (int n = 0; n < 2; ++n) acc[a][b][m][n] = (f32x4){0.f, 0.f, 0.f, 0.f};
        cur = nxt; cA = nA; cB = nB; ++ui;
        if constexpr (ALIGN_EPI) { if (wr == 1) PG8_BAR; }
    }
    PG8_WAIT_V(0);
    if constexpr (!ALIGN_EPI) { if (wr == 0) PG8_BAR; }
    PG8_BAR;
#undef PG8_SA
#undef PG8_SB
#undef PG8_STAGE
#undef PG8_LDA
#undef PG8_LDB
#undef PG8_MMA
#undef PG8_WAIT_V
#undef PG8_WAIT_L
#undef PG8_BAR
#undef PG8_SCHED
}
}

typedef const f32x4 (&AccRef)[2][2][4][2];

__device__ __forceinline__ u32x4 pack8(f32x4 v0, f32x4 v1) { u32x4 w; w.x = pk2(v0[0], v0[1]); w.y = pk2(v0[2], v0[3]); w.z = pk2(v1[0], v1[1]); w.w = pk2(v1[2], v1[3]); return w; }
__device__ __forceinline__ float sigm(float x) { return __builtin_amdgcn_rcpf(1.f + __builtin_amdgcn_exp2f(-1.4426950408889634f * x)); }

struct EpiInProj {
    static constexpr bool PERM = true; static constexpr bool MIDK = false;
    unsigned char* ws; const float* qnw; const float* knw;
    __device__ __forceinline__ void operator()(AccRef acc, const pg8::Unit& u, int wr, int wc, int fr, int fq) const {
        const int pn = u.pn; const size_t row0 = (size_t)u.pm * 256 + wr * 64 + fr;
        bf16* const V = (bf16*)(ws + WS_V); bf16* const KI = (bf16*)(ws + WS_KI); float* const WI = (float*)(ws + WS_WI);
        if (pn == 10 || pn == 11) {
            bf16* vb = V + ((size_t)((u.pm >> 4) * 8 + 4 * (pn & 1) + (wc >> 1)) * 4096 + (u.pm & 15) * 256 + wr * 64 + fr) * 64 + 32 * (wc & 1) + 8 * fq;
#pragma unroll
            for (int ai = 0; ai < 2; ++ai)
#pragma unroll
                for (int m = 0; m < 4; ++m)
#pragma unroll
                    for (int bj = 0; bj < 2; ++bj) *(u32x4*)(vb + (size_t)(2 * bj * 4096 + ai * 128 + m * 16) * 64) = pack8(acc[ai][bj][m][0], acc[ai][bj][m][1]);
        } else if (pn < 6 || (pn >= 12 && pn < 14)) {
            bf16* base = (bf16*)(ws + (pn < 6 ? WS_CB + (size_t)(pn >> 1) * (64 * MiB) : WS_QI));
            static_assert(WS_CC == WS_CB + 64 * MiB && WS_CX == WS_CB + 128 * MiB, "cb | cc | cx are consecutive 64 MiB regions");
            const int col0 = (pn & 1) * 256 + wc * 32 + 8 * fq;
#pragma unroll
            for (int ai = 0; ai < 2; ++ai)
#pragma unroll
                for (int m = 0; m < 4; ++m) { bf16* rowp = base + (row0 + ai * 128 + m * 16) * 512 + col0;
#pragma unroll
                    for (int bj = 0; bj < 2; ++bj) *(u32x4*)(rowp + bj * 128) = pack8(acc[ai][bj][m][0], acc[ai][bj][m][1]); }
        } else if (pn < 10) {
            const bool isq = pn < 8; bf16* base = (bf16*)(ws + (isq ? WS_Q : WS_K)); const float* nw = isq ? qnw : knw; const float sc = isq ? C2 : 1.f;
            const int head = 4 * (pn & 1) + wc;
            f32x4 w[2][2];
#pragma unroll
            for (int bj = 0; bj < 2; ++bj)
#pragma unroll
                for (int n = 0; n < 2; ++n) w[bj][n] = *(const f32x4*)(nw + 32 * bj + 8 * fq + 4 * n) * sc;
#pragma unroll
            for (int ai = 0; ai < 2; ++ai)
#pragma unroll
                for (int m = 0; m < 4; ++m) {
                    float ss = 0.f;
#pragma unroll
                    for (int bj = 0; bj < 2; ++bj)
#pragma unroll
                        for (int n = 0; n < 2; ++n) { const f32x4 x = acc[ai][bj][m][n]; ss += (x[0] * x[0] + x[1] * x[1]) + (x[2] * x[2] + x[3] * x[3]); }
                    ss += __shfl_xor(ss, 16); ss += __shfl_xor(ss, 32);
                    const float r = __builtin_amdgcn_rsqf(ss * (1.f / 64.f) + EPS);
                    bf16* rowp = isq ? base + (row0 + ai * 128 + m * 16) * 512 + head * 64 + 8 * fq
                                     : base + ((size_t)((u.pm >> 4) * 8 + head) * 4096 + (u.pm & 15) * 256 + wr * 64 + fr + ai * 128 + m * 16) * 64 + 8 * fq;
#pragma unroll
                    for (int bj = 0; bj < 2; ++bj) *(u32x4*)(rowp + bj * 32) = pack8(acc[ai][bj][m][0] * r * w[bj][0], acc[ai][bj][m][1] * r * w[bj][1]);
                }
        } else if (pn < 22) {
            bf16* base = (bf16*)(ws + (pn < 18 ? WS_GC : WS_GA)); const int col0 = ((pn - 14) & 3) * 256 + wc * 32 + 8 * fq;
#pragma unroll
            for (int ai = 0; ai < 2; ++ai)
#pragma unroll
                for (int m = 0; m < 4; ++m) { bf16* rowp = base + (row0 + ai * 128 + m * 16) * 1024 + col0;
#pragma unroll
                    for (int bj = 0; bj < 2; ++bj) { f32x4 a = acc[ai][bj][m][0], b = acc[ai][bj][m][1];
#pragma unroll
                        for (int j = 0; j < 4; ++j) { a[j] = sigm(a[j]); b[j] = sigm(b[j]); }
                        *(u32x4*)(rowp + bj * 128) = pack8(a, b); } }
        } else {
            if (wc < 2) {
#pragma unroll
                for (int ai = 0; ai < 2; ++ai)
#pragma unroll
                    for (int m = 0; m < 4; ++m) *(u32x4*)(KI + (row0 + ai * 128 + m * 16) * 64 + wc * 32 + 8 * fq) = pack8(acc[ai][0][m][0], acc[ai][0][m][1]);
            } else if (wc == 2 && fq == 0) {
#pragma unroll
                for (int ai = 0; ai < 2; ++ai)
#pragma unroll
                    for (int m = 0; m < 4; ++m) { float* p = WI + (row0 + ai * 128 + m * 16) * 8; *(f32x4*)p = acc[ai][0][m][0]; *(f32x4*)(p + 4) = acc[ai][0][m][1]; }
            }
        }
    }
};

struct EpiMixFused {
    static constexpr bool PERM = true; static constexpr bool MIDK = true;
    const bf16* GC; const bf16* GA; bf16* MIX;
    __device__ __forceinline__ void mid(f32x4 (&acc)[2][2][4][2], const pg8::Unit& u, int wr, int wc, int fr, int fq) const {
        unsigned base = (unsigned)((u.pm * 256 + wr * 64 + fr) * 1024 + u.pn * 256 + wc * 32 + 8 * fq);
        asm volatile("" : "+v"(base));
#define MIX_R(GCV, GAV) ((GCV) * __builtin_amdgcn_rcpf(fmaxf((GAV), 1e-20f)))
#pragma unroll
        for (int ai = 0; ai < 2; ++ai)
#pragma unroll
            for (int mh = 0; mh < 2; ++mh) {
                u32x4 gc[2][2], ga[2][2];
#pragma unroll
                for (int mm = 0; mm < 2; ++mm)
#pragma unroll
                    for (int bj = 0; bj < 2; ++bj) { const size_t off = (size_t)base + (size_t)(ai * 128 + (2 * mh + mm) * 16) * 1024 + bj * 128; gc[mm][bj] = *(const u32x4*)(GC + off); ga[mm][bj] = *(const u32x4*)(GA + off); }
#pragma unroll
                for (int mm = 0; mm < 2; ++mm)
#pragma unroll
                    for (int bj = 0; bj < 2; ++bj) { f32x4& a = acc[ai][bj][2 * mh + mm][0]; f32x4& b = acc[ai][bj][2 * mh + mm][1]; const u32x4 c = gc[mm][bj], g = ga[mm][bj];
                        a[0] *= MIX_R(bflo(c.x), bflo(g.x)); a[1] *= MIX_R(bfhi(c.x), bfhi(g.x)); a[2] *= MIX_R(bflo(c.y), bflo(g.y)); a[3] *= MIX_R(bfhi(c.y), bfhi(g.y));
                        b[0] *= MIX_R(bflo(c.z), bflo(g.z)); b[1] *= MIX_R(bfhi(c.z), bfhi(g.z)); b[2] *= MIX_R(bflo(c.w), bflo(g.w)); b[3] *= MIX_R(bfhi(c.w), bfhi(g.w)); }
                asm volatile("" ::: "memory");
            }
#undef MIX_R
    }
    __device__ __forceinline__ void operator()(AccRef acc, const pg8::Unit& u, int wr, int wc, int fr, int fq) const {
        const size_t row0 = (size_t)u.pm * 256 + wr * 64 + fr; const int col0 = u.pn * 256 + wc * 32 + 8 * fq;
#pragma unroll
        for (int ai = 0; ai < 2; ++ai)
#pragma unroll
            for (int m = 0; m < 4; ++m) { const size_t off = (row0 + ai * 128 + m * 16) * 1024 + col0;
#pragma unroll
                for (int bj = 0; bj < 2; ++bj) {
                    const u32x4 g = *(const u32x4*)(GA + off + bj * 128);
                    f32x4 a = acc[ai][bj][m][0], b = acc[ai][bj][m][1];
                    a[0] *= fmaxf(bflo(g.x), 1e-20f); a[1] *= fmaxf(bfhi(g.x), 1e-20f); a[2] *= fmaxf(bflo(g.y), 1e-20f); a[3] *= fmaxf(bfhi(g.y), 1e-20f);
                    b[0] *= fmaxf(bflo(g.z), 1e-20f); b[1] *= fmaxf(bfhi(g.z), 1e-20f); b[2] *= fmaxf(bflo(g.w), 1e-20f); b[3] *= fmaxf(bfhi(g.w), 1e-20f);
                    *(u32x4*)(MIX + off + bj * 128) = pack8(a, b); } }
    }
};

struct EpiDelta {
    static constexpr bool PERM = true; static constexpr bool MIDK = false;
    const float* MOD; bf16* O;
    __device__ __forceinline__ void operator()(AccRef acc, const pg8::Unit& u, int wr, int wc, int fr, int fq) const {
        const size_t row0 = (size_t)u.pm * 256 + wr * 64 + fr; const int col0 = u.pn * 256 + wc * 32 + 8 * fq;
        const float* g1 = MOD + (size_t)(u.pm >> 4) * 6144 + 2048;
        f32x4 gv[2][2];
#pragma unroll
        for (int bj = 0; bj < 2; ++bj)
#pragma unroll
            for (int n = 0; n < 2; ++n) gv[bj][n] = *(const f32x4*)(g1 + col0 + bj * 128 + 4 * n);
#pragma unroll
        for (int ai = 0; ai < 2; ++ai)
#pragma unroll
            for (int m = 0; m < 4; ++m) { bf16* rowp = O + (row0 + ai * 128 + m * 16) * 1024 + col0;
#pragma unroll
                for (int bj = 0; bj < 2; ++bj) *(u32x4*)(rowp + bj * 128) = pack8(acc[ai][bj][m][0] * gv[bj][0], acc[ai][bj][m][1] * gv[bj][1]); }
    }
};

struct EpiPlain {
    static constexpr bool PERM = true; static constexpr bool MIDK = false;
    bf16* O;
    __device__ __forceinline__ void operator()(AccRef acc, const pg8::Unit& u, int wr, int wc, int fr, int fq) const {
        const size_t row0 = (size_t)u.pm * 256 + wr * 64 + fr; const int col0 = u.pn * 256 + wc * 32 + 8 * fq;
#pragma unroll
        for (int ai = 0; ai < 2; ++ai)
#pragma unroll
            for (int m = 0; m < 4; ++m) { bf16* rowp = O + (row0 + ai * 128 + m * 16) * 1024 + col0;
#pragma unroll
                for (int bj = 0; bj < 2; ++bj) *(u32x4*)(rowp + bj * 128) = pack8(acc[ai][bj][m][0], acc[ai][bj][m][1]); }
    }
};

struct Args { const float* in[17]; float* out; unsigned char* ws; int ph_lo, ph_hi; };

__device__ __forceinline__ void transpose_item(const float* W, int ldw, int k0, int n0, int ncols, bf16* WT, int K, int drow0, LAS float* scr, int lane) {
#pragma unroll 8
    for (int i = 0; i < 32; ++i) { const int kk = 2 * i + (lane >> 5), n = lane & 31; scr[kk * 33 + n] = (n < ncols) ? W[(size_t)(k0 + kk) * ldw + n0 + n] : 0.f; }
    LDS_WAIT(); asm volatile("" ::: "memory");
    const int c = lane & 7;
#pragma unroll
    for (int j = 0; j < 4; ++j) { const int n = (lane >> 3) + 8 * j; const LAS float* s = scr + (8 * c) * 33 + n;
        u32x4 o; o.x = pk2(s[0 * 33], s[1 * 33]); o.y = pk2(s[2 * 33], s[3 * 33]); o.z = pk2(s[4 * 33], s[5 * 33]); o.w = pk2(s[6 * 33], s[7 * 33]);
        *(u32x4*)(WT + (size_t)(drow0 + n) * K + k0 + 8 * c) = o; }
    LDS_WAIT(); asm volatile("" ::: "memory");
}
__device__ __forceinline__ void cvt_stream(const float* src, bf16* dst, size_t n8, size_t i0, size_t stride) {
    for (size_t i = i0; i < n8; i += stride) { const f32x4 a = *(const f32x4*)(src + 8 * i), b = *(const f32x4*)(src + 8 * i + 4); *(u32x4*)(dst + 8 * i) = pack8(a, b); }
}

typedef unsigned v6u_t __attribute__((ext_vector_type(6)));
typedef float v32f_t __attribute__((ext_vector_type(32)));
typedef __bf16 v32bf_t __attribute__((ext_vector_type(32)));
struct __attribute__((packed, aligned(4))) U3 { unsigned x, y, z; };
__device__ __forceinline__ unsigned enc_e2m3(float y) {
    const float a = fminf(fabsf(y), 7.5f);
    const float r = a < 2.f ? a * 8.f : (a < 4.f ? a * 4.f + 8.f : a * 2.f + 16.f);
    unsigned c = (unsigned)__builtin_rintf(r); c = c > 31u ? 31u : c;
    return c | ((__float_as_uint(y) >> 26) & 32u);
}
__device__ __forceinline__ unsigned enc_e2m1(float y) {
    const float a = fminf(fabsf(y), 6.f);
    const float r = a < 2.f ? a * 2.f : (a < 4.f ? a + 2.f : a * 0.5f + 4.f);
    unsigned c = (unsigned)__builtin_rintf(r); c = c > 7u ? 7u : c;
    return c | ((__float_as_uint(y) >> 28) & 8u);
}
template <bool FP4>
__device__ __forceinline__ void cvt_rows_fpx(const float* src, unsigned char* dst, float* rs, int gw, int nw, int lane) {
    constexpr float VMAX = FP4 ? 6.f : 7.5f;
#pragma unroll 2
    for (int row = gw; row < 16384; row += nw) {
        const float* sp = src + (size_t)row * 1024 + 16 * lane;
        const f32x4 a = *(const f32x4*)sp, b = *(const f32x4*)(sp + 4), c = *(const f32x4*)(sp + 8), d = *(const f32x4*)(sp + 12);
        const float v[16] = {a[0], a[1], a[2], a[3], b[0], b[1], b[2], b[3], c[0], c[1], c[2], c[3], d[0], d[1], d[2], d[3]};
        float m = 0.f;
#pragma unroll
        for (int j = 0; j < 16; ++j) m = fmaxf(m, fabsf(v[j]));
#pragma unroll
        for (int o = 32; o; o >>= 1) m = fmaxf(m, __shfl_xor(m, o));
        const float sc = m > 0.f ? VMAX / m : 0.f;
        unsigned q[16];
        if constexpr (FP4) {
#pragma unroll
            for (int j = 0; j < 16; ++j) q[j] = enc_e2m1(v[j] * sc);
            u32x2 w;
            w.x = q[0] | (q[1] << 4) | (q[2] << 8) | (q[3] << 12) | (q[4] << 16) | (q[5] << 20) | (q[6] << 24) | (q[7] << 28);
            w.y = q[8] | (q[9] << 4) | (q[10] << 8) | (q[11] << 12) | (q[12] << 16) | (q[13] << 20) | (q[14] << 24) | (q[15] << 28);
            *(u32x2*)(dst + (size_t)row * 512 + 8 * lane) = w;
        } else {
#pragma unroll
            for (int j = 0; j < 16; ++j) q[j] = enc_e2m3(v[j] * sc);
            U3 w;
            w.x = q[0] | (q[1] << 6) | (q[2] << 12) | (q[3] << 18) | (q[4] << 24) | (q[5] << 30);
            w.y = (q[5] >> 2) | (q[6] << 4) | (q[7] << 10) | (q[8] << 16) | (q[9] << 22) | (q[10] << 28);
            w.z = (q[10] >> 4) | (q[11] << 2) | (q[12] << 8) | (q[13] << 14) | (q[14] << 20) | (q[15] << 26);
            *(U3*)(dst + (size_t)row * 768 + 12 * lane) = w;
        }
        if (lane == 0) rs[row] = m * (1.f / VMAX);
    }
}
__device__ __forceinline__ void p0_prologue(LAS unsigned char* lds, const Args& a, int G, int blk) {
    const int tid = threadIdx.x, lane = tid & 63, wave = __builtin_amdgcn_readfirstlane(tid >> 6);
    unsigned char* ws = a.ws;
    for (int task = blk; task < 96; task += G) {
        LAS float* sl = (LAS float*)(lds + 67584);
        for (int i = tid; i < NB * DM; i += 512) { const float v = a.in[1][i]; sl[i] = v * __builtin_amdgcn_rcpf(1.f + __expf(-v)); }
        __syncthreads();
        const int col = task * 64 + lane, kb = wave * 128;
        float acc[16];
#pragma unroll
        for (int b = 0; b < 16; ++b) acc[b] = 0.f;
        const float* wp = a.in[2] + col;
        for (int k = kb; k < kb + 128; k += 4) {
            const float w0 = wp[(size_t)(k + 0) * 6144], w1 = wp[(size_t)(k + 1) * 6144], w2 = wp[(size_t)(k + 2) * 6144], w3 = wp[(size_t)(k + 3) * 6144];
#pragma unroll
            for (int b = 0; b < 16; ++b) { const f32x4 s = *(const LAS f32x4*)(sl + b * 1024 + k); acc[b] += (s[0] * w0 + s[1] * w1) + (s[2] * w2 + s[3] * w3); }
        }
        LAS float* red = (LAS float*)lds;
#pragma unroll
        for (int b = 0; b < 16; ++b) red[(wave * 16 + b) * 64 + lane] = acc[b];
        __syncthreads();
        for (int o = tid; o < 1024; o += 512) { const int b = o >> 6, cl = o & 63; float s = 0.f;
#pragma unroll
            for (int w = 0; w < 8; ++w) s += red[(w * 16 + b) * 64 + cl];
            ((float*)(ws + WS_MOD))[b * 6144 + task * 64 + cl] = s + a.in[3][task * 64 + cl]; }
        __syncthreads();
    }
    LAS float* scr = (LAS float*)(lds + wave * 8448);
    const int gw = blk * NWAVES + wave, NGW = G * NWAVES;
    constexpr int I_IN = 184 * 16, I_CO = 8 * 32, I_AO = 8 * 32, I_O = 16 * 32, I_PQ = 16 * 32;
    for (int it = gw; it < I_IN + I_CO + I_AO + I_O + I_PQ; it += NGW) {
        int r = it;
        if (r < I_IN) {
            const int dg = r >> 4, kb = r & 15, tile = dg >> 3, gi = dg & 7; int src, nc = 32;
            if (tile < 6 || (tile >= 10 && tile < 14)) src = 32 * dg;
            else if (tile < 10) src = tile * 256 + 32 * (2 * (gi & 3) + (gi >> 2));
            else if (tile < 22) src = 3656 + 32 * (dg - 112);
            else { if (gi < 2) src = 3584 + 32 * gi; else if (gi == 2) { src = 3648; nc = 8; } else { src = 0; nc = 0; } }
            transpose_item(a.in[5], 5704, kb * 64, src, nc, (bf16*)(ws + WS_WIN), 1024, dg * 32, scr, lane); continue; }
        r -= I_IN;
        if (r < I_CO) { transpose_item(a.in[7], 1024, (r >> 5) * 64, (r & 31) * 32, 32, (bf16*)(ws + WS_WCO), 1024, (r & 31) * 32, scr, lane); continue; } r -= I_CO;
        if (r < I_AO) { transpose_item(a.in[10], 1024, (r >> 5) * 64, (r & 31) * 32, 32, (bf16*)(ws + WS_WCO) + 512, 1024, (r & 31) * 32, scr, lane); continue; } r -= I_AO;
        if (r < I_O) { transpose_item(a.in[11], 1024, (r >> 5) * 64, (r & 31) * 32, 32, (bf16*)(ws + WS_WO), 1024, (r & 31) * 32, scr, lane); continue; } r -= I_O;
        transpose_item(a.in[13], 1024, (r >> 5) * 64, (r & 31) * 32, 32, (bf16*)(ws + WS_WPQ), 1024, (r & 31) * 32, scr, lane);
    }
    const size_t gt = (size_t)blk * 512 + tid, NT_ = (size_t)G * 512;
    cvt_stream(a.in[14], (bf16*)(ws + WS_SK), (size_t)16 * 128 * 64 / 8, gt, NT_);
    cvt_rows_fpx<true>(a.in[15], ws + WS_PU, (float*)(ws + WS_RSU), gw, NGW, lane);
    cvt_rows_fpx<false>(a.in[16], ws + WS_PV, (float*)(ws + WS_RSV), gw, NGW, lane);
}

__device__ __forceinline__ unsigned wave_max_dpp(unsigned x) {
    { const unsigned y = (unsigned)__builtin_amdgcn_update_dpp(0, (int)x, 0x141, 0xF, 0xF, false); x = x > y ? x : y; }
    { const unsigned y = (unsigned)__builtin_amdgcn_update_dpp(0, (int)x, 0x1B, 0xF, 0xF, false); x = x > y ? x : y; }
    { const unsigned y = (unsigned)__builtin_amdgcn_update_dpp(0, (int)x, 0xB1, 0xF, 0xF, false); x = x > y ? x : y; }
    { const unsigned y = (unsigned)__builtin_amdgcn_update_dpp(0, (int)x, 0x128, 0xF, 0xF, false); x = x > y ? x : y; }
    const unsigned a = (unsigned)__builtin_amdgcn_readlane((int)x, 0), b = (unsigned)__builtin_amdgcn_readlane((int)x, 16), c = (unsigned)__builtin_amdgcn_readlane((int)x, 32), d = (unsigned)__builtin_amdgcn_readlane((int)x, 48);
    const unsigned ab = a > b ? a : b, cd = c > d ? c : d; return ab > cd ? ab : cd;
}
__device__ __forceinline__ float wave_sum_dpp(float x) {
    x += __uint_as_float((unsigned)__builtin_amdgcn_update_dpp(0, (int)__float_as_uint(x), 0x141, 0xF, 0xF, false));
    x += __uint_as_float((unsigned)__builtin_amdgcn_update_dpp(0, (int)__float_as_uint(x), 0x1B, 0xF, 0xF, false));
    x += __uint_as_float((unsigned)__builtin_amdgcn_update_dpp(0, (int)__float_as_uint(x), 0xB1, 0xF, 0xF, false));
    x += __uint_as_float((unsigned)__builtin_amdgcn_update_dpp(0, (int)__float_as_uint(x), 0x128, 0xF, 0xF, false));
    const int xi = (int)__float_as_uint(x);
    return (__uint_as_float((unsigned)__builtin_amdgcn_readlane(xi, 0)) + __uint_as_float((unsigned)__builtin_amdgcn_readlane(xi, 16))) +
           (__uint_as_float((unsigned)__builtin_amdgcn_readlane(xi, 32)) + __uint_as_float((unsigned)__builtin_amdgcn_readlane(xi, 48)));
}
template <bool RESID> __device__ __forceinline__ void norm_phase(const float* X, const float* nw, const float* MOD, int sh_off, bf16* O, int G, int blk, float* OUT = nullptr) {
    const int tid_ = phase_tid(); const int lane = tid_ & 63, wave = __builtin_amdgcn_readfirstlane(tid_ >> 6);
    const int stride = G * NWAVES;
    for (int m0 = blk * NWAVES + wave; m0 < T; m0 += 2 * stride) {
        const int m1 = (m0 + stride < T) ? m0 + stride : m0;
        f32x4 va[4], vb[4]; float sa = 0.f, sbb = 0.f;
        const f32x4* xa = (const f32x4*)(X + (size_t)m0 * DM) + lane; const f32x4* xb = (const f32x4*)(X + (size_t)m1 * DM) + lane;
#pragma unroll
        for (int j = 0; j < 4; ++j) { va[j] = xa[64 * j]; vb[j] = xb[64 * j]; }
        if (RESID) {
            const unsigned long long* da = (const unsigned long long*)(O + (size_t)m0 * DM) + lane; const unsigned long long* db = (const unsigned long long*)(O + (size_t)m1 * DM) + lane;
            f32x4* oa4 = (f32x4*)(OUT + (size_t)m0 * DM) + lane; f32x4* ob4 = (f32x4*)(OUT + (size_t)m1 * DM) + lane;
#pragma unroll
            for (int j = 0; j < 4; ++j) { const unsigned long long pa = da[64 * j], pb = db[64 * j];
                va[j] += (f32x4){bflo((unsigned)pa), bfhi((unsigned)pa), bflo((unsigned)(pa >> 32)), bfhi((unsigned)(pa >> 32))};
                vb[j] += (f32x4){bflo((unsigned)pb), bfhi((unsigned)pb), bflo((unsigned)(pb >> 32)), bfhi((unsigned)(pb >> 32))};
                oa4[64 * j] = va[j]; ob4[64 * j] = vb[j]; }
        }
#pragma unroll
        for (int j = 0; j < 4; ++j) { sa += (va[j].x * va[j].x + va[j].y * va[j].y) + (va[j].z * va[j].z + va[j].w * va[j].w); sbb += (vb[j].x * vb[j].x + vb[j].y * vb[j].y) + (vb[j].z * vb[j].z + vb[j].w * vb[j].w); }
        const float ra = __builtin_amdgcn_rsqf(wave_sum_dpp(sa) * (1.f / DM) + EPS), rb = __builtin_amdgcn_rsqf(wave_sum_dpp(sbb) * (1.f / DM) + EPS);
        const float* mda = MOD + (size_t)(m0 >> 12) * 6144 + sh_off; const float* mdb = MOD + (size_t)(m1 >> 12) * 6144 + sh_off;
        unsigned long long* oa = (unsigned long long*)(O + (size_t)m0 * DM) + lane; unsigned long long* ob = (unsigned long long*)(O + (size_t)m1 * DM) + lane;
#pragma unroll
        for (int j = 0; j < 4; ++j) {
            const f32x4 w = ((const f32x4*)nw)[lane + 64 * j];
            const f32x4 ha = (va[j] * ra * w) * (((const f32x4*)(mda + 1024))[lane + 64 * j] + 1.f) + ((const f32x4*)mda)[lane + 64 * j];
            const f32x4 hb = (vb[j] * rb * w) * (((const f32x4*)(mdb + 1024))[lane + 64 * j] + 1.f) + ((const f32x4*)mdb)[lane + 64 * j];
            oa[64 * j] = (unsigned long long)pk2(ha.x, ha.y) | ((unsigned long long)pk2(ha.z, ha.w) << 32);
            ob[64 * j] = (unsigned long long)pk2(hb.x, hb.y) | ((unsigned long long)pk2(hb.z, hb.w) << 32);
        }
    }
}

__device__ __forceinline__ void conv_phase(const bf16* CB, const bf16* CC, const bf16* CX, const float* cw, bf16* UA, int G, int blk) {
    const size_t n = (size_t)T * 64;
    const int ctid = phase_tid();
#pragma unroll 4
    for (size_t i = (size_t)blk * 512 + ctid; i < n; i += (size_t)G * 512) {
        const int c8 = (int)(i & 63) * 8; const size_t row = i >> 6; const int t = (int)(row & (SEQ - 1));
        float accv[8];
#pragma unroll
        for (int e = 0; e < 8; ++e) accv[e] = 0.f;
#pragma unroll
        for (int j = 0; j < 3; ++j) {
            if (t - 2 + j >= 0) {
                const size_t off = (row - 2 + j) * 512 + c8;
                const u32x4 a = *(const u32x4*)(CC + off), b = *(const u32x4*)(CX + off);
                const f32x4 w0 = *(const f32x4*)(cw + j * 512 + c8), w1 = *(const f32x4*)(cw + j * 512 + c8 + 4);
                accv[0] += w0[0] * bflo(a.x) * bflo(b.x); accv[1] += w0[1] * bfhi(a.x) * bfhi(b.x);
                accv[2] += w0[2] * bflo(a.y) * bflo(b.y); accv[3] += w0[3] * bfhi(a.y) * bfhi(b.y);
                accv[4] += w1[0] * bflo(a.z) * bflo(b.z); accv[5] += w1[1] * bfhi(a.z) * bfhi(b.z);
                accv[6] += w1[2] * bflo(a.w) * bflo(b.w); accv[7] += w1[3] * bfhi(a.w) * bfhi(b.w);
            }
        }
        const u32x4 g = *(const u32x4*)(CB + row * 512 + c8);
        u32x4 o; o.x = pk2(accv[0] * bflo(g.x), accv[1] * bfhi(g.x)); o.y = pk2(accv[2] * bflo(g.y), accv[3] * bfhi(g.y));
        o.z = pk2(accv[4] * bflo(g.z), accv[5] * bfhi(g.z)); o.w = pk2(accv[6] * bflo(g.w), accv[7] * bfhi(g.w));
        *(u32x4*)(UA + row * 1024 + c8) = o;
    }
}

template <int N> __device__ __forceinline__ void bitonic_sort_desc(unsigned* a) {
#pragma unroll
    for (int k = 2; k <= N; k <<= 1)
#pragma unroll
        for (int j = k >> 1; j > 0; j >>= 1)
#pragma unroll
            for (int i = 0; i < N; ++i) { const int l = i ^ j; if (l > i) { const bool desc = (i & k) == 0; const unsigned x = a[i], y = a[l]; const unsigned mx = x > y ? x : y, mn = x > y ? y : x; a[i] = desc ? mx : mn; a[l] = desc ? mn : mx; } }
}
__device__ __forceinline__ void merge_top16(unsigned* a, const unsigned* b) {
#pragma unroll
    for (int i = 0; i < 16; ++i) { const unsigned y = b[15 - i]; a[i] = a[i] > y ? a[i] : y; }
#pragma unroll
    for (int j = 8; j > 0; j >>= 1)
#pragma unroll
        for (int i = 0; i < 16; ++i) if ((i & j) == 0) { const unsigned x = a[i], y = a[i + j]; a[i] = x > y ? x : y; a[i + j] = x > y ? y : x; }
}
__device__ __forceinline__ void top16_of_64(unsigned* a) {
    bitonic_sort_desc<16>(a); bitonic_sort_desc<16>(a + 16); bitonic_sort_desc<16>(a + 32); bitonic_sort_desc<16>(a + 48);
    merge_top16(a, a + 16); merge_top16(a + 32, a + 48); merge_top16(a, a + 32);
}
template <int NR> __device__ __forceinline__ int count_ge(const unsigned* k, unsigned cand) {
    int cv = 0;
#pragma unroll
    for (int r = 0; r < NR; ++r) cv += (k[r] >= cand) ? 1 : 0;
    cv += __builtin_amdgcn_update_dpp(0, cv, 0x141, 0xF, 0xF, false); cv += __builtin_amdgcn_update_dpp(0, cv, 0x1B, 0xF, 0xF, false);
    cv += __builtin_amdgcn_update_dpp(0, cv, 0xB1, 0xF, 0xF, false); cv += __builtin_amdgcn_update_dpp(0, cv, 0x128, 0xF, 0xF, false);
    return __builtin_amdgcn_readlane(cv, 0) + __builtin_amdgcn_readlane(cv, 16) + __builtin_amdgcn_readlane(cv, 32) + __builtin_amdgcn_readlane(cv, 48);
}
template <int NR> __device__ __forceinline__ unsigned descent256(const unsigned* k) {
    unsigned tau = 0u;
    for (int bit = 31; bit >= 0; --bit) {
        const unsigned cand = tau | (1u << bit);
        const int cnt = count_ge<NR>(k, cand);
        if (cnt >= 256) tau = cand;
        if (cnt == 256) break;
    }
    return tau;
}
template <int NR> __device__ __forceinline__ void select_query(const LAS unsigned* row, int nvalid, int tq, LAS unsigned long long* mrow, int lane) {
    unsigned k[NR];
    const bool lowhalf = lane < 32;
#define SEL_LOAD() _Pragma("unroll") for (int r = 0; r < NR; ++r) { const unsigned v = row[64 * r + lane]; k[r] = (64 * r + 64 <= nvalid) ? v : ((64 * r < nvalid && lowhalf) ? v : 0u); }
    SEL_LOAD()
    unsigned tau = 0u;
    if (tq >= 256) {
        if constexpr (NR > 16) {
#pragma unroll
            for (int g = 0; g < NR / 16; ++g) bitonic_sort_desc<16>(k + 16 * g);
            if constexpr (NR == 64) { merge_top16(k, k + 16); merge_top16(k + 32, k + 48); merge_top16(k, k + 32); }
            else if constexpr (NR == 48) { merge_top16(k, k + 16); merge_top16(k, k + 32); }
            else merge_top16(k, k + 16);
            tau = descent256<16>(k);
            const bool bad = __ballot(k[15] >= tau) != 0ull;
            SEL_LOAD()
            if (bad) tau = descent256<NR>(k);
        } else tau = descent256<NR>(k);
    }
#undef SEL_LOAD
    if (tau == 0u) tau = 1u;
#pragma unroll
    for (int r = 0; r < 64; ++r) { const unsigned long long m = r < NR ? __ballot(k[r < NR ? r : 0] >= tau) : 0ull; if (lane == 0) mrow[r * 8] = m; }
}

#ifndef PROBE_SUB
#define PROBE_SUB 0
#endif
__device__ __forceinline__ void indexer_phase(LAS unsigned char* lds, const bf16* QI, const bf16* KI, const float* WI, unsigned long long* MASK, int G, int blk) {
    volatile LAS unsigned long long* pst = (volatile LAS unsigned long long*)(lds + LDS_BYTES - 48);
    LAS unsigned* sc = (LAS unsigned*)lds;
    const int tid = phase_tid(), lane = tid & 63, wave = __builtin_amdgcn_readfirstlane(tid >> 6), r32 = lane & 31, hi = lane >> 5;
    const int ra = (r32 >> 4) & 1, rb = (r32 >> 3) & 1, rc = (r32 >> 2) & 1, rd = r32 & 3;
    bf16x8 aq[2][4]; f32x4 wv[2][2][2]; bf16x8 bk[3][4];
#define IDX_UNIT_GEOM(uid_) const int b = (uid_) >> 9; int j = (uid_) & 511; if (j >= 256) j = 767 - j; const int tq0 = 8 * j; const size_t row0 = (size_t)b * SEQ + tq0; const int nkt = (tq0 + 8 + 31) >> 5; \
        const bf16* kbase = KI + ((size_t)b * SEQ + r32) * 64 + hi * 8;
#define IDX_UNIT_LOAD() do { \
        _Pragma("unroll") for (int rt = 0; rt < 2; ++rt) { \
            const bf16* qp = QI + (row0 + rt * 4 + 2 * rc + ra) * 512 + (4 * rb + rd) * 64 + hi * 8; \
            _Pragma("unroll") for (int d0 = 0; d0 < 4; ++d0) aq[rt][d0] = *(const bf16x8*)(qp + d0 * 16); } } while (0)
    if (blk < T / 8) { IDX_UNIT_GEOM(blk) IDX_UNIT_LOAD(); }
    for (int uid = blk; uid < T / 8; uid += G) {
        IDX_UNIT_GEOM(uid)
#pragma unroll
        for (int rt = 0; rt < 2; ++rt)
#pragma unroll
            for (int a2 = 0; a2 < 2; ++a2) { const float* wp = WI + (row0 + rt * 4 + 2 * hi + a2) * 8; wv[rt][a2][0] = *(const f32x4*)wp; wv[rt][a2][1] = *(const f32x4*)(wp + 4); }
#pragma unroll
        for (int jj = 0; jj < 3; ++jj) { int kt = wave + NWAVES * jj; if (kt >= nkt) kt = nkt - 1;
#pragma unroll
            for (int d0 = 0; d0 < 4; ++d0) bk[jj][d0] = *(const bf16x8*)(kbase + (size_t)kt * 32 * 64 + d0 * 16); }
        if (PROBE_SUB && threadIdx.x == 0) pst[3] = __builtin_amdgcn_s_memrealtime();
#define IDX_TILE(JT) { \
                constexpr int jj = (JT) % 3; \
                int kt = wave + NWAVES * (JT); asm volatile("" : "+s"(kt));       \
                const bool live = kt < nkt; \
                const int key = 32 * kt + r32; \
                f32x16 acc0 = {}, acc1 = {}; \
                _Pragma("unroll") for (int d0 = 0; d0 < 4; ++d0) { acc0 = __builtin_amdgcn_mfma_f32_32x32x16_bf16(aq[0][d0], bk[jj][d0], acc0, 0, 0, 0); acc1 = __builtin_amdgcn_mfma_f32_32x32x16_bf16(aq[1][d0], bk[jj][d0], acc1, 0, 0, 0); } \
                if ((JT) + 3 < NTW) { int ktn = kt + 3 * NWAVES; if (ktn >= nkt) ktn = nkt - 1; \
                    _Pragma("unroll") for (int d0 = 0; d0 < 4; ++d0) bk[jj][d0] = *(const bf16x8*)(kbase + (size_t)ktn * 32 * 64 + d0 * 16); } \
                _Pragma("unroll") for (int rt = 0; rt < 2; ++rt) \
                    _Pragma("unroll") for (int a2 = 0; a2 < 2; ++a2) { \
                        float sv = 0.f; \
                        _Pragma("unroll") for (int i = 0; i < 8; ++i) { const int xb = (int)__float_as_uint(rt ? acc1[8 * a2 + i] : acc0[8 * a2 + i]); sv += __uint_as_float((unsigned)(xb > 0 ? xb : 0)) * wv[rt][a2][i >> 2][i & 3]; } \
                        const int ql = rt * 4 + 2 * hi + a2; \
                        const unsigned ck = (key <= tq0 + ql) ? ((ordf(sv) & 0xfffff000u) | (unsigned)(4095 - key)) : 0u; \
                        sc[live ? ql * 4096 + key : 33792 + lane] = ck; \
                    } \
                __builtin_amdgcn_sched_barrier(0); }
#define IDX_TILES4(J0) IDX_TILE((J0)) IDX_TILE((J0) + 1) IDX_TILE((J0) + 2) IDX_TILE((J0) + 3)
        if (nkt <= 32) { constexpr int NTW = 4; IDX_TILES4(0) }
        else if (nkt <= 64) { constexpr int NTW = 8; IDX_TILES4(0) IDX_TILES4(4) }
        else if (nkt <= 96) { constexpr int NTW = 12; IDX_TILES4(0) IDX_TILES4(4) IDX_TILES4(8) }
        else { constexpr int NTW = 16; IDX_TILES4(0) IDX_TILES4(4) IDX_TILES4(8) IDX_TILES4(12) }
#undef IDX_TILES4
#undef IDX_TILE
        __syncthreads();
        if (uid + G < T / 8) { IDX_UNIT_GEOM(uid + G) IDX_UNIT_LOAD(); }
        if (PROBE_SUB == 1 && threadIdx.x == 0) pst[2] += __builtin_amdgcn_s_memrealtime() - pst[3];
        if (PROBE_SUB == 2 && threadIdx.x == 0) pst[3] = __builtin_amdgcn_s_memrealtime();
        {
            const int tq = tq0 + wave, nvalid = 32 * nkt;
            LAS unsigned long long* mrow = (LAS unsigned long long*)(lds + 131072) + wave;
            const LAS unsigned* rowp = sc + wave * 4096;
            if (nvalid <= 1024) select_query<16>(rowp, nvalid, tq, mrow, lane);
            else if (nvalid <= 2048) select_query<32>(rowp, nvalid, tq, mrow, lane);
            else if (nvalid <= 3072) select_query<48>(rowp, nvalid, tq, mrow, lane);
            else select_query<64>(rowp, nvalid, tq, mrow, lane);
        }
        __syncthreads();
        __hip_atomic_store(MASK + ((size_t)b * 64 + (tid >> 3)) * SEQ + tq0 + (tid & 7), ((const LAS unsigned long long*)(lds + 131072))[tid], __ATOMIC_RELAXED, __HIP_MEMORY_SCOPE_AGENT);
        if (PROBE_SUB == 2 && threadIdx.x == 0) pst[2] += __builtin_amdgcn_s_memrealtime() - pst[3];
    }
}

namespace att {
constexpr int KCP = 1040, KSLOT = 8 * KCP, VDH = 4160, VSLOT = 2 * VDH;
constexpr int L_K = 0, L_V = 4 * KSLOT, L_OST = L_V + 4 * VSLOT, L_END = L_OST + NWAVES * 4096;
__device__ __forceinline__ int crow(int r, int hi) { return (r & 3) + 8 * (r >> 2) + 4 * hi; }
#define SBAR() __builtin_amdgcn_sched_barrier(0)
__device__ __forceinline__ void qkt(f32x16& p0, f32x16& p1, const LAS unsigned char* kb, const bf16x8* qr, const f32x16& negm) {
#pragma unroll
    for (int d0 = 0; d0 < 4; ++d0) {
        const bf16x8 b0 = *(const LAS bf16x8*)(kb + d0 * 2 * KCP);
        const bf16x8 b1 = *(const LAS bf16x8*)(kb + d0 * 2 * KCP + 512);
        if (d0 == 0) { p0 = __builtin_amdgcn_mfma_f32_32x32x16_bf16(b0, qr[0], negm, 0, 0, 0); p1 = __builtin_amdgcn_mfma_f32_32x32x16_bf16(b1, qr[0], negm, 0, 0, 0); }
        else { p0 = __builtin_amdgcn_mfma_f32_32x32x16_bf16(b0, qr[d0], p0, 0, 0, 0); p1 = __builtin_amdgcn_mfma_f32_32x32x16_bf16(b1, qr[d0], p1, 0, 0, 0); } }
}
__device__ __forceinline__ void pv(f32x16* o, f32x16& osum, int vb, bf16x8 pa0, bf16x8 pa1, bf16x8 pa2, bf16x8 pa3) {
    {
        const bf16x8 ones = {0x3f80, 0x3f80, 0x3f80, 0x3f80, 0x3f80, 0x3f80, 0x3f80, 0x3f80};
        osum = __builtin_amdgcn_mfma_f32_32x32x16_bf16(pa0, ones, osum, 0, 0, 0); osum = __builtin_amdgcn_mfma_f32_32x32x16_bf16(pa1, ones, osum, 0, 0, 0);
        osum = __builtin_amdgcn_mfma_f32_32x32x16_bf16(pa2, ones, osum, 0, 0, 0); osum = __builtin_amdgcn_mfma_f32_32x32x16_bf16(pa3, ones, osum, 0, 0, 0);
    }
#pragma unroll
    for (int d0 = 0; d0 < 2; ++d0) { s16x4 lo[4], hi[4];
#pragma unroll
        for (int ks = 0; ks < 4; ++ks) {
            asm volatile("ds_read_b64_tr_b16 %0,%1 offset:%c2" : "=&v"(lo[ks]) : "v"(vb), "i"(d0 * VDH + ks * 1024) : "memory");
            asm volatile("ds_read_b64_tr_b16 %0,%1 offset:%c2" : "=&v"(hi[ks]) : "v"(vb), "i"(d0 * VDH + ks * 1024 + 512) : "memory"); }
        asm volatile("s_waitcnt lgkmcnt(0)" ::: "memory"); SBAR();
#define PK(k) (bf16x8){lo[k][0], lo[k][1], lo[k][2], lo[k][3], hi[k][0], hi[k][1], hi[k][2], hi[k][3]}
        o[d0] = __builtin_amdgcn_mfma_f32_32x32x16_bf16(pa0, PK(0), o[d0], 0, 0, 0);
        o[d0] = __builtin_amdgcn_mfma_f32_32x32x16_bf16(pa1, PK(1), o[d0], 0, 0, 0);
        o[d0] = __builtin_amdgcn_mfma_f32_32x32x16_bf16(pa2, PK(2), o[d0], 0, 0, 0);
        o[d0] = __builtin_amdgcn_mfma_f32_32x32x16_bf16(pa3, PK(3), o[d0], 0, 0, 0);
#undef PK
    }
}

__device__ __forceinline__ void attn_phase(LAS unsigned char* lds, const bf16* Q, const bf16* K, const bf16* V, const unsigned long long* MASK, const float* qnw, const float* knw, bf16* UA, int G, int blk) {
    const int tid = phase_tid(), lane = tid & 63, r32 = lane & 31, hi = lane >> 5, wid = __builtin_amdgcn_readfirstlane(tid >> 6);
    float mq = fabsf(qnw[lane]), mk = fabsf(knw[lane]);
#pragma unroll
    for (int o = 1; o < 64; o <<= 1) { mq = fmaxf(mq, __shfl_xor(mq, o)); mk = fmaxf(mk, __shfl_xor(mk, o)); }
    const float nb = -(8.f * 1.4426950408889634f) * mq * mk;
    f32x16 negm;
#pragma unroll
    for (int r = 0; r < 16; ++r) negm[r] = nb;
    const unsigned kdst = L_K + (tid & 7) * KCP + (tid >> 3) * 16;
    const unsigned vdst = L_V + ((tid & 7) >> 2) * VDH + ((tid >> 3) >> 4) * 1024 + ((tid >> 3) & 15) * 64 + (tid & 3) * 16;
    const LAS unsigned char* kp0 = lds + L_K + hi * KCP + r32 * 16;
    const int vb0 = (int)(uintptr_t)(lds + L_V) + ((lane >> 4) & 1) * 32 + (lane & 3) * 8 + (4 * hi + ((lane & 15) >> 2)) * 64;
    for (int uid = blk; uid < 2048; uid += G) {
        const int ui = uid >> 8; int c = uid & 255; c = (c & 7) * 32 + (c >> 3);
        const int bh = c >> 1, s = c & 1, pp = ui >> 1, qb = (ui & 1) ? 15 - (2 * pp + s) : (2 * pp + s);
        const int b = bh >> 3, h = bh & 7, q0 = qb * 256;
        const size_t rowbase = (size_t)b * SEQ;
        const bf16* Qw = Q + (rowbase + q0 + wid * 32) * 512 + h * 64;
        bf16* Ow = UA + (rowbase + q0 + wid * 32) * 1024 + 512 + h * 64;
        bf16x8 qr[4];
#pragma unroll
        for (int d0 = 0; d0 < 4; ++d0) qr[d0] = *(const bf16x8*)(Qw + (size_t)r32 * 512 + d0 * 16 + hi * 8);
        const int NT = 4 * (qb + 1);
        const unsigned long long* mptr = MASK + (size_t)b * 64 * SEQ + q0 + wid * 32 + r32;
        const bf16* ksrc = K + ((size_t)bh * SEQ) * 64 + tid * 8;
        const bf16* vsrc = V + ((size_t)bh * SEQ) * 64 + tid * 8;
        f32x16 o[2]; o[0] = f32x16{}; o[1] = f32x16{};
        f32x16 osum = f32x16{};
        const int T2 = NT / 2;
        u32x4 kreg[2][2], vreg[2][2]; unsigned long long mwq[2][2], mw[2];
#pragma unroll
        for (int sb_ = 0; sb_ < 2; ++sb_) {
            kreg[0][sb_] = *(const u32x4*)(ksrc + (size_t)sb_ * 4096); vreg[0][sb_] = *(const u32x4*)(vsrc + (size_t)sb_ * 4096); mw[sb_] = mptr[(size_t)sb_ * SEQ];
            kreg[1][sb_] = *(const u32x4*)(ksrc + (size_t)(2 + sb_) * 4096); vreg[1][sb_] = *(const u32x4*)(vsrc + (size_t)(2 + sb_) * 4096); mwq[1][sb_] = mptr[(size_t)(2 + sb_) * SEQ]; mwq[0][sb_] = 0ull;
            *(LAS u32x4*)(lds + kdst + sb_ * KSLOT) = kreg[0][sb_]; *(LAS u32x4*)(lds + vdst + sb_ * VSLOT) = vreg[0][sb_];
        }
        __syncthreads();
        const int qmax = q0 + wid * 32 + 31;
#define ATT_SUB(P, SB) if (64 * (2 * t + (SB)) <= qmax) { \
                f32x16 p0, p1; \
                qkt(p0, p1, kp0 + ((P) * 2 + (SB)) * KSLOT, qr, negm); \
                const unsigned mlo = (unsigned)mw[SB] >> (4 * hi), mhi = (unsigned)(mw[SB] >> 32) >> (4 * hi); \
                _Pragma("unroll") for (int r = 0; r < 16; ++r) { p0[r] = __builtin_amdgcn_exp2f(p0[r]); p1[r] = __builtin_amdgcn_exp2f(p1[r]); } \
                  \
                unsigned pk_[16]; \
                _Pragma("unroll") for (int i = 0; i < 8; ++i) { const int bp = ((2 * i) & 3) + 8 * ((2 * i) >> 2); \
                    const unsigned m0a = (unsigned)__builtin_amdgcn_sbfe((int)mlo, bp, 1), m0b = (unsigned)__builtin_amdgcn_sbfe((int)mlo, bp + 1, 1); \
                    const unsigned m1a = (unsigned)__builtin_amdgcn_sbfe((int)mhi, bp, 1), m1b = (unsigned)__builtin_amdgcn_sbfe((int)mhi, bp + 1, 1); \
                    pk_[i] = pk2(p0[2 * i], p0[2 * i + 1]) & __builtin_amdgcn_perm(m0b, m0a, 0x05040100u); \
                    pk_[8 + i] = pk2(p1[2 * i], p1[2 * i + 1]) & __builtin_amdgcn_perm(m1b, m1a, 0x05040100u); } \
                const u32x4 pw0 = (u32x4){pk_[0], pk_[1], pk_[2], pk_[3]}, pw1 = (u32x4){pk_[4], pk_[5], pk_[6], pk_[7]}; \
                const u32x4 pw2 = (u32x4){pk_[8], pk_[9], pk_[10], pk_[11]}, pw3 = (u32x4){pk_[12], pk_[13], pk_[14], pk_[15]}; \
                pv(o, osum, vb0 + ((P) * 2 + (SB)) * VSLOT, __builtin_bit_cast(bf16x8, pw0), __builtin_bit_cast(bf16x8, pw1), __builtin_bit_cast(bf16x8, pw2), __builtin_bit_cast(bf16x8, pw3)); \
            }
#define ATT_STEP(P)    \
        { \
            { const int tp = (t + 2 < T2) ? t + 2 : T2 - 1; \
              _Pragma("unroll") for (int sb_ = 0; sb_ < 2; ++sb_) { kreg[P][sb_] = *(const u32x4*)(ksrc + (size_t)(2 * tp + sb_) * 4096); vreg[P][sb_] = *(const u32x4*)(vsrc + (size_t)(2 * tp + sb_) * 4096); mwq[P][sb_] = mptr[(size_t)(2 * tp + sb_) * SEQ]; } } \
            ATT_SUB(P, 0) \
            ATT_SUB(P, 1) \
            _Pragma("unroll") for (int sb_ = 0; sb_ < 2; ++sb_) { *(LAS u32x4*)(lds + kdst + ((1 - (P)) * 2 + sb_) * KSLOT) = kreg[1 - (P)][sb_]; *(LAS u32x4*)(lds + vdst + ((1 - (P)) * 2 + sb_) * VSLOT) = vreg[1 - (P)][sb_]; mw[sb_] = mwq[1 - (P)][sb_]; } \
            __syncthreads(); \
        }
        for (int t = 0; t < T2; t += 2) {
            ATT_STEP(0)
            ++t;
            ATT_STEP(1)
            --t;
        }
#undef ATT_STEP
#undef ATT_SUB
        float rli[16];
#pragma unroll
        for (int r = 0; r < 16; ++r) rli[r] = __builtin_amdgcn_rcpf(osum[r]);
        LAS bf16* stg = (LAS bf16*)(lds + L_OST) + wid * 2048;
#pragma unroll
        for (int r = 0; r < 16; ++r) { const int orow = crow(r, hi);
#pragma unroll
            for (int d0 = 0; d0 < 2; ++d0) stg[orow * 64 + d0 * 32 + r32] = (bf16)(pk2(o[d0][r] * rli[r], 0.f) & 0xffffu); }
        LDS_WAIT();
#pragma unroll
        for (int i = 0; i < 4; ++i) { const int row = i * 8 + (lane >> 3), ch = lane & 7; const u32x4 v = *(const LAS u32x4*)(stg + row * 64 + ch * 8); *(u32x4*)(Ow + (size_t)row * 1024 + ch * 8) = v; }
        LDS_WAIT();
    }
}
#undef SBAR
}

__device__ __forceinline__ void peer_route_phase(LAS unsigned char* lds, const bf16* PQ, const bf16* SK, unsigned short* EIDX, float* EG, int G, int blk) {
    const int tid = phase_tid(), lane = tid & 63, r32 = lane & 31, hi = lane >> 5, wave = __builtin_amdgcn_readfirstlane(tid >> 6);
    LAS unsigned* win = (LAS unsigned*)(lds + wave * 12288);
    LAS unsigned* fwn = win + 2 * 16 * 64;
    const int gw = blk * NWAVES + wave, NGW = G * NWAVES, h = gw & 7;
    for (int tg = gw >> 3; tg < T / 32; tg += NGW >> 3) {
        const size_t t0 = (size_t)tg * 32;
#pragma unroll 1
        for (int half = 0; half < 2; ++half) {
            const int p = 2 * h + half;
            bf16x8 bq[4];
#pragma unroll
            for (int d0 = 0; d0 < 4; ++d0) bq[d0] = *(const bf16x8*)(PQ + (t0 + r32) * 1024 + 128 * h + 64 * half + 16 * d0 + 8 * hi);
            unsigned ck[64];
#pragma unroll
            for (int nb = 0; nb < 4; ++nb) {
                f32x16 acc = {};
#pragma unroll
                for (int d0 = 0; d0 < 4; ++d0) { const bf16x8 a = *(const bf16x8*)(SK + ((size_t)p * 128 + 32 * nb + r32) * 64 + 16 * d0 + 8 * hi); acc = __builtin_amdgcn_mfma_f32_32x32x16_bf16(a, bq[d0], acc, 0, 0, 0); }
#pragma unroll
                for (int r = 0; r < 16; ++r) ck[nb * 16 + r] = (ordf(acc[r]) & ~0x7fu) | (unsigned)(127 - (32 * nb + att::crow(r, hi)));
            }
            top16_of_64(ck);
            unsigned pb[16];
#pragma unroll
            for (int i = 0; i < 16; ++i) { auto rr = __builtin_amdgcn_permlane32_swap(ck[i], ck[i], false, false); pb[i] = hi ? rr[0] : rr[1]; }
            merge_top16(ck, pb);
#pragma unroll
            for (int i = 0; i < 16; ++i) win[(half * 16 + i) * 64 + lane] = ck[i];
        }
        LDS_WAIT();
        float v0[16], v1[16];
#pragma unroll
        for (int i = 0; i < 16; ++i) { v0[i] = unordf(win[i * 64 + lane] & ~0x7fu); v1[i] = unordf(win[(16 + i) * 64 + lane] & ~0x7fu); }
        unsigned c2[64];
        {
            int n = 0;
#pragma unroll
            for (int i = 0; i < 16; ++i)
#pragma unroll
                for (int j = 0; j < 16; ++j) if ((i + 1) * (j + 1) <= 16) { c2[n] = (ordf(v0[i] + v1[j]) & ~0xffu) | (unsigned)(255 - (16 * i + j)); ++n; }
#pragma unroll
            for (int q = 50; q < 64; ++q) c2[q] = 0u;
        }
        top16_of_64(c2);
        float sc[16]; unsigned ex[16];
#pragma unroll
        for (int k = 0; k < 16; ++k) {
            const unsigned f = c2[k]; const int idx = 255 - (int)(f & 0xffu), i = idx >> 4, j = idx & 15;
            const unsigned w0 = win[i * 64 + lane], w1 = win[(16 + j) * 64 + lane];
            ex[k] = (127u - (w0 & 0x7fu)) * 128u + (127u - (w1 & 0x7fu));
            sc[k] = unordf(w0 & ~0x7fu) + unordf(w1 & ~0x7fu);
        }
        const float mx = sc[0];
        float sum = 0.f;
#pragma unroll
        for (int k = 0; k < 16; ++k) { sc[k] = __expf(sc[k] - mx); sum += sc[k]; }
        const float inv = 1.f / sum;
#pragma unroll
        for (int k = 0; k < 16; ++k) sc[k] *= inv;
        if (hi == 0) {
            unsigned short* ep = EIDX + (t0 + r32) * 128 + h * 16; float* gp = EG + (t0 + r32) * 128 + h * 16;
            *(u32x4*)ep = (u32x4){ex[0] | (ex[1] << 16), ex[2] | (ex[3] << 16), ex[4] | (ex[5] << 16), ex[6] | (ex[7] << 16)};
            *(u32x4*)(ep + 8) = (u32x4){ex[8] | (ex[9] << 16), ex[10] | (ex[11] << 16), ex[12] | (ex[13] << 16), ex[14] | (ex[15] << 16)};
#pragma unroll
            for (int q = 0; q < 4; ++q) *(f32x4*)(gp + 4 * q) = (f32x4){sc[4 * q], sc[4 * q + 1], sc[4 * q + 2], sc[4 * q + 3]};
        }
        LDS_WAIT();
    }
}

__device__ __forceinline__ f32x2 gelu_pk(f32x2 v) {
    const f32x2 av = __builtin_elementwise_abs(v), dd = av * 0.2316418882f + 1.0f;
    f32x2 tt; tt.x = __builtin_amdgcn_rcpf(dd.x); tt.y = __builtin_amdgcn_rcpf(dd.y);
    f32x2 q = tt * 0.5307027145f + (-0.7265760135f); q = q * tt + 0.7107068705f; q = q * tt + (-0.142248368f); q = q * tt + 0.127414796f; q = q * tt;
    const f32x2 sq = (v * v) * (-0.72134752044f);
    f32x2 ee; ee.x = __builtin_amdgcn_exp2f(sq.x); ee.y = __builtin_amdgcn_exp2f(sq.y);
    const f32x2 mm = v * (q * ee), rr = v - mm;
    f32x2 o; o.x = v.x < 0.f ? mm.x : rr.x; o.y = v.y < 0.f ? mm.y : rr.y; return o;
}
__device__ __forceinline__ float dpp_f(float x, const int ctrl_sel) {
    const int xi = (int)__float_as_uint(x); int r;
    if (ctrl_sel == 0) r = __builtin_amdgcn_update_dpp(0, xi, 0x128, 0xF, 0xF, false);
    else if (ctrl_sel == 1) r = __builtin_amdgcn_update_dpp(0, xi, 0x141, 0xF, 0xF, false);
    else if (ctrl_sel == 2) r = __builtin_amdgcn_update_dpp(0, xi, 0x1B, 0xF, 0xF, false);
    else r = __builtin_amdgcn_update_dpp(0, xi, 0xB1, 0xF, 0xF, false);
    return __uint_as_float((unsigned)r);
}
__device__ __forceinline__ float reduce8_rows(float* d, int lane) {
#pragma unroll
    for (int i = 0; i < 4; ++i) { auto r = __builtin_amdgcn_permlane32_swap(__float_as_uint(d[i]), __float_as_uint(d[i + 4]), false, false); d[i] = __uint_as_float(r[0]) + __uint_as_float(r[1]); }
#pragma unroll
    for (int i = 0; i < 2; ++i) { auto r = __builtin_amdgcn_permlane16_swap(__float_as_uint(d[i]), __float_as_uint(d[i + 2]), false, false); d[i] = __uint_as_float(r[0]) + __uint_as_float(r[1]); }
    const bool up = lane & 8; const float keep = up ? d[1] : d[0], send = up ? d[0] : d[1];
    float x = keep + dpp_f(send, 0);
    x += dpp_f(x, 1); x += dpp_f(x, 2); x += dpp_f(x, 3);
    return x;
}
typedef int v8i_t __attribute__((ext_vector_type(8)));
#define HSC_TEST 0
__device__ __forceinline__ void peer_u_simple(LAS unsigned char* lds, const bf16* H2, tab_ptr PU, const float* RSU, const float* RSV, unsigned short* EIDX, const float* EG, float* COEF, int G, int blk) {
    const int tid_ = phase_tid(); const int lane = tid_ & 63, wave = __builtin_amdgcn_readfirstlane(tid_ >> 6);
    LAS unsigned char* wl = lds + wave * 13632;
    constexpr int RP = 528;
    LAS int* sid = (LAS int*)(wl + 8448);
    LAS float* sgt = (LAS float*)(wl + 8448 + 512);
    LAS float* res = (LAS float*)(wl + 8448 + 1024);
    LAS float* sul = (LAS float*)(wl + 9536);
    LAS float* gtl = (LAS float*)(wl + 9536 + 2048);
    const unsigned c0 = 16u * (lane & 31), d0 = (lane < 32 ? 0u : 528u) + c0;
    const unsigned long long lt = (1ull << lane) - 1ull;
    const int n16 = lane & 15, g4 = lane >> 4;
    const int stride = G * NWAVES;
    for (int tb = blk * NWAVES + wave; tb < T; tb += 4 * stride) {
        int idlo[4], idhi[4]; float clo[4], chi[4]; int tt[4]; int tcl[4]; int hsc[4];
        int lp = (int)threadIdx.x; asm volatile("" : "+v"(lp)); lp &= 63;
        float g_lo[4], g_hi[4]; u32x4 hqa[4], hqb[4];
#pragma unroll
        for (int i = 0; i < 4; ++i) {
            const bool act_i = tb + i * stride < T; const int t = act_i ? tb + i * stride : tb; tt[i] = act_i ? t : -1; tcl[i] = t;
            const unsigned short* ep = EIDX + (size_t)t * 128;
            idlo[i] = ep[lp]; idhi[i] = ep[64 + lp]; g_lo[i] = EG[(size_t)t * 128 + lp]; g_hi[i] = EG[(size_t)t * 128 + 64 + lp];
            hqa[i] = *(const u32x4*)(H2 + (size_t)t * 1024 + 16 * lp); hqb[i] = *(const u32x4*)(H2 + (size_t)t * 1024 + 16 * lp + 8);
        }
        __builtin_amdgcn_sched_barrier(0);
        u32x4 hq[8][4];
        {
            const int tl = (lp & 2) ? ((lp & 1) ? tcl[3] : tcl[2]) : ((lp & 1) ? tcl[1] : tcl[0]);
            const bf16* hp = H2 + (size_t)tl * 1024 + 32 * (lp >> 4);
#pragma unroll
            for (int s8 = 0; s8 < 8; ++s8) { hq[s8][0] = *(const u32x4*)(hp + 128 * s8); hq[s8][1] = *(const u32x4*)(hp + 128 * s8 + 8); hq[s8][2] = *(const u32x4*)(hp + 128 * s8 + 16); hq[s8][3] = *(const u32x4*)(hp + 128 * s8 + 24); }
        }
        __builtin_amdgcn_sched_barrier(0);
        float rsu_lo[4], rsu_hi[4], rsv_lo[4], rsv_hi[4];
#pragma unroll
        for (int i = 0; i < 4; ++i) {
            {
                typedef unsigned short u16x2_t __attribute__((ext_vector_type(2)));
                u16x2_t mx = {0, 0};
                const unsigned hw[8] = {hqa[i].x, hqa[i].y, hqa[i].z, hqa[i].w, hqb[i].x, hqb[i].y, hqb[i].z, hqb[i].w};
#pragma unroll
                for (int j = 0; j < 8; ++j) mx = __builtin_elementwise_max(mx, __builtin_bit_cast(u16x2_t, hw[j] & 0x7fff7fffu));
                const unsigned m = wave_max_dpp(mx.x > mx.y ? (unsigned)mx.x : (unsigned)mx.y);
                const float tq = __uint_as_float(m << 16) * (1.f / 7.5f);
                hsc[i] = tq > 1.f ? (int)((__float_as_uint(tq) - 1u) >> 23) - 126 + HSC_TEST : HSC_TEST;
            }
            int il = idlo[i], ih = idhi[i]; float gl = g_lo[i], gh = g_hi[i];
            const int blo = il >> 10, bhi = ih >> 10; int plo = 0, phi = 0, base = 0;
#pragma unroll
            for (int bb = 0; bb < 16; ++bb) {
                const unsigned long long ml = __ballot(blo == bb), mh = __ballot(bhi == bb);
                const int nl = __popcll(ml);
                plo = (blo == bb) ? base + __popcll(ml & lt) : plo;
                phi = (bhi == bb) ? base + nl + __popcll(mh & lt) : phi;
                base += nl + __popcll(mh);
            }
            sid[plo] = il; sid[phi] = ih; sgt[plo] = gl; sgt[phi] = gh;
            il = sid[lp]; ih = sid[64 + lp]; gl = sgt[lp]; gh = sgt[64 + lp];
            if (tt[i] >= 0) { unsigned short* ep = EIDX + (size_t)tcl[i] * 128; ep[lp] = (unsigned short)il; ep[64 + lp] = (unsigned short)ih; }
            rsu_lo[i] = RSU[il]; rsu_hi[i] = RSU[ih]; rsv_lo[i] = RSV[il]; rsv_hi[i] = RSV[ih];
            idlo[i] = il; idhi[i] = ih; g_lo[i] = gl; g_hi[i] = gh; clo[i] = 0.f; chi[i] = 0.f;
        }
        v8i_t hB[8];
        {
            const int el = (lp & 2) ? ((lp & 1) ? hsc[3] : hsc[2]) : ((lp & 1) ? hsc[1] : hsc[0]);
            const float hdiv = __uint_as_float((unsigned)(127 + el) << 23);
#pragma unroll
            for (int s8 = 0; s8 < 8; ++s8) {
                typedef unsigned v16u_t __attribute__((ext_vector_type(16)));
                const v16u_t wv = {hq[s8][0].x, hq[s8][0].y, hq[s8][0].z, hq[s8][0].w, hq[s8][1].x, hq[s8][1].y, hq[s8][1].z, hq[s8][1].w, hq[s8][2].x, hq[s8][2].y, hq[s8][2].z, hq[s8][2].w, hq[s8][3].x, hq[s8][3].y, hq[s8][3].z, hq[s8][3].w};
                const v6u_t e6 = __builtin_amdgcn_cvt_scalef32_pk32_fp6_bf16(__builtin_bit_cast(v32bf_t, wv), hdiv);
                hB[s8] = (v8i_t){(int)e6[0], (int)e6[1], (int)e6[2], (int)e6[3], (int)e6[4], (int)e6[5], 0, 0};
            }
        }
#pragma unroll
        for (int i = 0; i < 4; ++i) {
            const float hs = __uint_as_float((unsigned)(127 + hsc[i]) << 23);
            sul[i * 128 + lp] = rsu_lo[i] * hs; sul[i * 128 + 64 + lp] = rsu_hi[i] * hs;
            gtl[i * 128 + lp] = g_lo[i] * rsv_lo[i]; gtl[i * 128 + 64 + lp] = g_hi[i] * rsv_hi[i];
        }
#define PU_LOAD(RB, HH, P) do { const int hh_ = (HH), l0_ = (hh_ & 7) * 8; \
            const int idA_ = hh_ < 8 ? idlo[2 * (P)] : idhi[2 * (P)], idB_ = hh_ < 8 ? idlo[2 * (P) + 1] : idhi[2 * (P) + 1]; \
            _Pragma("unroll") for (int j = 0; j < 8; ++j) { const int idq_ = j < 4 ? idA_ : idB_; const int lq_ = l0_ + 2 * (j & 3); \
                const unsigned o0_ = 512u * (unsigned)__builtin_amdgcn_readlane(idq_, lq_), o1_ = 512u * (unsigned)__builtin_amdgcn_readlane(idq_, lq_ + 1); \
                RB[j] = *(const u32x4*)(PU + ((lane < 32 ? o0_ : o1_) + c0)); } } while (0)
#define PU_TOLDS(RB) do { _Pragma("unroll") for (int j = 0; j < 8; ++j) *(LAS u32x4*)(wl + j * 2 * RP + d0) = RB[j]; } while (0)
#define PU_COMP(HH, P) do { const int hh_ = (HH), l0_ = (hh_ & 7) * 8; \
            f32x4 acc_ = {0.f, 0.f, 0.f, 0.f}; const LAS unsigned char* ap_ = wl + n16 * RP + 16 * g4; \
            _Pragma("unroll") for (int s8 = 0; s8 < 8; ++s8) { \
                const u32x4 a0_ = *(const LAS u32x4*)(ap_ + 64 * s8); \
                const v8i_t A_ = {(int)a0_.x, (int)a0_.y, (int)a0_.z, (int)a0_.w, 0, 0, 0, 0}; \
                acc_ = __builtin_amdgcn_mfma_scale_f32_16x16x128_f8f6f4(A_, hB[s8], acc_, 4, 2, 0, 0x7f7f7f7f, 0, 0x7f7f7f7f); } \
            asm volatile("s_nop 15\n\ts_nop 15" : "+v"(acc_));                                          \
            if (g4 < 2 ? n16 == 2 * (P) : n16 == 2 * (P) + 1) *(LAS f32x4*)(res + 4 * g4) = acc_;        \
            const int r = (lane - l0_) & 7;                                         \
            const float a0 = res[r], a1 = res[8 + r]; \
            const int so_ = (hh_ < 8 ? 0 : 64) + lane; \
            const f32x2 gg = gelu_pk((f32x2){a0 * sul[2 * (P) * 128 + so_], a1 * sul[(2 * (P) + 1) * 128 + so_]}); \
            const float gA_ = gtl[2 * (P) * 128 + so_], gB_ = gtl[(2 * (P) + 1) * 128 + so_]; \
            const bool mine = (lane >> 3) == (hh_ & 7); \
            if (hh_ < 8) { clo[2 * (P)] = mine ? gA_ * gg.x : clo[2 * (P)]; clo[2 * (P) + 1] = mine ? gB_ * gg.y : clo[2 * (P) + 1]; } \
            else         { chi[2 * (P)] = mine ? gA_ * gg.x : chi[2 * (P)]; chi[2 * (P) + 1] = mine ? gB_ * gg.y : chi[2 * (P) + 1]; } } while (0)
        {
            u32x4 rb[8];
            PU_LOAD(rb, 0, 0);
#pragma unroll 1
            for (int h = 0; h < 16; ++h) {
                PU_TOLDS(rb);
                __builtin_amdgcn_sched_barrier(0);
                PU_LOAD(rb, h, 1);
                __builtin_amdgcn_sched_barrier(0);
                PU_COMP(h, 0);
                __builtin_amdgcn_sched_barrier(0);
                PU_TOLDS(rb);
                __builtin_amdgcn_sched_barrier(0);
                PU_LOAD(rb, h < 15 ? h + 1 : 15, 0);
                __builtin_amdgcn_sched_barrier(0);
                PU_COMP(h, 1);
                __builtin_amdgcn_sched_barrier(0);
            }
        }
#undef PU_LOAD
#undef PU_TOLDS
#undef PU_COMP
        int le = (int)threadIdx.x; asm volatile("" : "+v"(le)); le &= 63;
#pragma unroll
        for (int i = 0; i < 4; ++i) if (tt[i] >= 0) { COEF[(size_t)tt[i] * 128 + le] = clo[i]; COEF[(size_t)tt[i] * 128 + 64 + le] = chi[i]; }
    }
}
__device__ __forceinline__ void peer_v_phase(tab_ptr PV, const unsigned short* EIDX, const float* COEF, const float* MOD, float* OUT, int G, int blk) {
    const int tid_ = phase_tid(); const int lane = tid_ & 63, wave = __builtin_amdgcn_readfirstlane(tid_ >> 6);
    const int stride = G * NWAVES;
    for (int tb = blk * NWAVES + wave; tb < T; tb += 4 * stride) {
        float out[4][16]; int idlo[4], idhi[4]; float clo[4], chi[4]; int tt[4]; bool act[4];
        int ln = lane; asm volatile("" : "+v"(ln));
#pragma unroll
        for (int i = 0; i < 4; ++i) {
            act[i] = tb + i * stride < T; const int t = act[i] ? tb + i * stride : tb; tt[i] = t;
#pragma unroll
            for (int j = 0; j < 16; ++j) out[i][j] = 0.f;
            const unsigned short* ep = EIDX + (size_t)t * 128;
            idlo[i] = ep[ln]; idhi[i] = ep[64 + ln];
            clo[i] = COEF[(size_t)t * 128 + ln]; chi[i] = COEF[(size_t)t * 128 + 64 + ln];
        }
#pragma unroll 1
        for (int h = 0; h < 16; ++h) {
            const int l0 = (h & 7) * 8;
#pragma unroll
            for (int p = 0; p < 2; ++p) {
                const int idA = h < 8 ? idlo[2 * p] : idhi[2 * p], idB = h < 8 ? idlo[2 * p + 1] : idhi[2 * p + 1];
                const float cA = h < 8 ? clo[2 * p] : chi[2 * p], cB = h < 8 ? clo[2 * p + 1] : chi[2 * p + 1];
                float ck[16]; U3 ra[16];
#pragma unroll
                for (int k = 0; k < 8; ++k) {
                    const unsigned e = (unsigned)__builtin_amdgcn_readlane(idA, l0 + k);
                    ck[k] = __uint_as_float((unsigned)__builtin_amdgcn_readlane((int)__float_as_uint(cA), l0 + k));
                    ra[k] = *(const U3*)(PV + (size_t)e * PEER_ROWB + 12 * lane);
                }
#pragma unroll
                for (int k = 0; k < 8; ++k) {
                    const unsigned e = (unsigned)__builtin_amdgcn_readlane(idB, l0 + k);
                    ck[8 + k] = __uint_as_float((unsigned)__builtin_amdgcn_readlane((int)__float_as_uint(cB), l0 + k));
                    ra[8 + k] = *(const U3*)(PV + (size_t)e * PEER_ROWB + 12 * lane);
                }
#pragma unroll
                for (int k = 0; k < 16; k += 2) {
                    const v6u_t w = {ra[k].x, ra[k].y, ra[k].z, ra[k + 1].x, ra[k + 1].y, ra[k + 1].z};
                    const v32f_t f = __builtin_amdgcn_cvt_scalef32_pk32_f32_fp6(w, 1.0f);
                    float* o = out[2 * p + (k >> 3)];
#pragma unroll
                    for (int j = 0; j < 16; ++j) o[j] += ck[k] * f[j];
#pragma unroll
                    for (int j = 0; j < 16; ++j) o[j] += ck[k + 1] * f[16 + j];
                }
                __builtin_amdgcn_sched_barrier(0);
            }
        }
        int le = lane; asm volatile("" : "+v"(le));
#pragma unroll
        for (int i = 0; i < 4; ++i) {
            if (act[i]) {
                const float* g2 = MOD + (size_t)(tt[i] >> 12) * 6144 + 5120;
                float* op = OUT + (size_t)tt[i] * 1024;
#pragma unroll
                for (int q = 0; q < 4; ++q) {
                    const int col = 16 * le + 4 * q;
                    const f32x4 g = *(const f32x4*)(g2 + col), x1 = *(const f32x4*)(op + col);
                    *(f32x4*)(op + col) = x1 + g * (f32x4){out[i][4 * q], out[i][4 * q + 1], out[i][4 * q + 2], out[i][4 * q + 3]};
                }
            }
        }
    }
}

#define XB_TMO      128
#define XB_XCNT(j)  (256  + 64 * (j))
#define XB_XSUB(j)  (1280 + 64 * (j))
#define XB_XGEN(j)  (2304 + 64 * (j))
#define XB_TOP      3328
#define XB_TOPGEN   3392
#define XCD_BAR_WORDS 3456
#define XB_SPIN_CAP (1u << 20)
__device__ __forceinline__ unsigned xb_ld(unsigned* p)              { return __hip_atomic_load(p, __ATOMIC_RELAXED, __HIP_MEMORY_SCOPE_AGENT); }
__device__ __forceinline__ unsigned xb_add(unsigned* p, unsigned v) { return __hip_atomic_fetch_add(p, v, __ATOMIC_RELAXED, __HIP_MEMORY_SCOPE_AGENT); }
__device__ __forceinline__ unsigned xb_xcc_id() { return (unsigned)__builtin_amdgcn_s_getreg((3 << 11) | 20) & 0xFu; }
#define XB_SPIN(cond, bar) do { unsigned _sp = 0; while (cond) { __builtin_amdgcn_s_sleep(1); \
    if ((++_sp & 255u) == 0u) { if (xb_ld(&(bar)[XB_TMO])) break; if (_sp > XB_SPIN_CAP) { atomicAdd(&(bar)[XB_TMO], 1u); break; } } } } while (0)
struct XcdBarrier { unsigned* bar; unsigned x; volatile LAS unsigned* st; };
__device__ __forceinline__ XcdBarrier xcd_barrier_post(unsigned* bar, volatile LAS unsigned* st) {
    XcdBarrier b; b.bar = bar; b.x = xb_xcc_id(); b.st = st;
    if (threadIdx.x == 0) (void)xb_add(&bar[XB_XCNT(b.x)], 1u);
    return b;
}
__device__ __forceinline__ void xcd_barrier_complete(unsigned* bar, unsigned x, unsigned& nloc, unsigned& nx) {
    const unsigned G = gridDim.x * gridDim.y * gridDim.z;
    unsigned sum, cnt, mine, sp = 0u;
    for (;;) {
        sum = 0u; cnt = 0u; mine = 0u;
#pragma unroll
        for (unsigned j = 0; j < 16; ++j) { const unsigned c = xb_ld(&bar[XB_XCNT(j)]); sum += c; cnt += (c > 0u) ? 1u : 0u; mine = (j == x) ? c : mine; }
        if (sum == G) break;
        __builtin_amdgcn_s_sleep(1);
        if ((++sp & 255u) == 0u) { if (xb_ld(&bar[XB_TMO])) break; if (sp > XB_SPIN_CAP) { atomicAdd(&bar[XB_TMO], 1u); break; } }
    }
    nloc = mine > 0u ? mine : 1u; nx = cnt > 0u ? cnt : 1u;
}
__device__ __forceinline__ void xcd_barrier(const XcdBarrier& b) {
    asm volatile("s_waitcnt vmcnt(0)" ::: "memory");
    __syncthreads();
    if (threadIdx.x == 0) {
        unsigned* bar = b.bar;
        __builtin_amdgcn_s_waitcnt(0);
        unsigned nloc = b.st[0], nx = b.st[1];
        if (nloc == 0u) { xcd_barrier_complete(bar, b.x, nloc, nx); b.st[0] = nloc; b.st[1] = nx; }
        const unsigned old = xb_add(&bar[XB_XSUB(b.x)], 1u);
        const unsigned gen = old / nloc;
        if (old + 1u == (gen + 1u) * nloc) {
            __builtin_amdgcn_fence(__ATOMIC_RELEASE, "agent");
            asm volatile("s_waitcnt vmcnt(0)" ::: "memory");
            const unsigned og = xb_add(&bar[XB_TOP], 1u);
            const unsigned tg = og / nx;
            if (og + 1u == (tg + 1u) * nx) xb_add(&bar[XB_TOPGEN], 1u);
            else XB_SPIN(xb_ld(&bar[XB_TOPGEN]) == tg, bar);
            __builtin_amdgcn_fence(__ATOMIC_ACQUIRE, "agent");
            xb_add(&bar[XB_XGEN(b.x)], 1u);
            asm volatile("s_waitcnt vmcnt(0)" ::: "memory");
        } else {
            XB_SPIN(xb_ld(&bar[XB_XGEN(b.x)]) == gen, bar);
            __builtin_amdgcn_fence(__ATOMIC_ACQUIRE, "agent");
            asm volatile("s_waitcnt vmcnt(0)" ::: "memory");
        }
    }
    __syncthreads();
}

constexpr int N_PHASES = 12;
#ifndef PROBE_K
#define PROBE_K -1
#endif
__global__ void __launch_bounds__(NWAVES * 64, 2) mk_fwd(Args a) {
    extern __shared__ __attribute__((aligned(16))) unsigned char lds_raw[];
    LAS unsigned char* lds = (LAS unsigned char*)lds_raw;
    cg::grid_group grid = cg::this_grid();
    const int G = gridDim.x, blk = blockIdx.x;
    unsigned char* ws = a.ws;
    float* MOD = (float*)(ws + WS_MOD);
    bf16* H = (bf16*)(ws + WS_H);
    bf16 *CB = (bf16*)(ws + WS_CB), *CC = (bf16*)(ws + WS_CC), *CX = (bf16*)(ws + WS_CX), *Qb = (bf16*)(ws + WS_Q), *Kb = (bf16*)(ws + WS_K), *Vb = (bf16*)(ws + WS_V), *QI = (bf16*)(ws + WS_QI);
    bf16 *GC = (bf16*)(ws + WS_GC), *GA = (bf16*)(ws + WS_GA), *KI = (bf16*)(ws + WS_KI); float* WI = (float*)(ws + WS_WI);
    unsigned long long* MASK = (unsigned long long*)(ws + WS_MASK);
    bf16* PQ = (bf16*)(ws + WS_PQ); unsigned short* EIDX = (unsigned short*)(ws + WS_EIDX); float* EG = (float*)(ws + WS_EG); float* COEF = (float*)(ws + WS_COEF);
#define IN(k) (a.ph_lo <= (k) && (k) < a.ph_hi)
#define SEAM(k) do { if (IN(k) && IN((k) + 1)) { if ((k) == 0) grid.sync(); else xcd_barrier(xbar); } if (PROBE_K == (k) && threadIdx.x == 0) pst[1] = __builtin_amdgcn_s_memrealtime(); if (PROBE_K == (k) + 1 && threadIdx.x == 0) pst[0] = __builtin_amdgcn_s_memrealtime(); } while (0)
    volatile LAS unsigned* xst = (volatile LAS unsigned*)(lds + LDS_BYTES - 64);
    if (threadIdx.x < 4) xst[threadIdx.x] = 0u;
    __syncthreads();
    const XcdBarrier xbar = xcd_barrier_post((unsigned*)(ws + WS_CTL), xst);

    volatile LAS unsigned long long* pst = (volatile LAS unsigned long long*)(lds + LDS_BYTES - 48);
    if (PROBE_K >= 0 && threadIdx.x == 0) { pst[0] = 0; pst[1] = 0; pst[2] = 0; pst[3] = 0; }
    if (PROBE_K == 0 && threadIdx.x == 0) pst[0] = __builtin_amdgcn_s_memrealtime();
    if (IN(0)) p0_prologue(lds, a, G, blk);
    SEAM(0);
    if (IN(1)) norm_phase<false>(a.in[0], a.in[4], MOD, 0, H, G, blk);
    SEAM(1);
    if (IN(2)) {
        pg8::Gemm g{H, (const bf16*)(ws + WS_WIN), T, NIN_PAD, DM}; pg8::StaticOrder S; S.init(T, NIN_PAD, G, blk);
        EpiInProj E{ws, a.in[8], a.in[9]};
        pg8::gemm_phase<EpiInProj, true, true>(lds, g, S, E);
    }
    SEAM(2);
    if (IN(3)) { if (PROBE_SUB == 3 && threadIdx.x == 0) pst[3] = __builtin_amdgcn_s_memrealtime(); conv_phase(CB, CC, CX, a.in[6], H, G, blk); if (PROBE_SUB == 3) { __syncthreads(); if (threadIdx.x == 0) pst[2] += __builtin_amdgcn_s_memrealtime() - pst[3]; }
        indexer_phase(lds, QI, KI, WI, MASK, G, blk); }
    SEAM(3);
    if (IN(4)) att::attn_phase(lds, Qb, Kb, Vb, MASK, a.in[8], a.in[9], H, G, blk);
    SEAM(4);
    if (IN(5)) {
        pg8::Gemm g{H, (const bf16*)(ws + WS_WCO), T, DM, DM}; pg8::StaticOrder S; S.init(T, DM, G, blk);
        EpiMixFused E{GC, GA, CB};
        pg8::gemm_phase<EpiMixFused, true, true>(lds, g, S, E);
    }
    SEAM(5);
    if (IN(6)) {
        pg8::Gemm g{CB, (const bf16*)(ws + WS_WO), T, DM, DM}; pg8::StaticOrder S; S.init(T, DM, G, blk);
        EpiDelta E{MOD, H};
        pg8::gemm_phase<EpiDelta, true, true>(lds, g, S, E);
    }
    SEAM(6);
    if (IN(7)) norm_phase<true>(a.in[0], a.in[12], MOD, 3072, H, G, blk, a.out);
    SEAM(7);
    if (IN(8)) {
        pg8::Gemm g{H, (const bf16*)(ws + WS_WPQ), T, DM, DM}; pg8::StaticOrder S; S.init(T, DM, G, blk);
        EpiPlain E{PQ};
        pg8::gemm_phase<EpiPlain, true, true>(lds, g, S, E);
    }
    SEAM(8);
    if (IN(9)) peer_route_phase(lds, PQ, (const bf16*)(ws + WS_SK), EIDX, EG, G, blk);
    SEAM(9);
    if (IN(10)) peer_u_simple(lds, H, (tab_ptr)(ws + WS_PU), (const float*)(ws + WS_RSU), (const float*)(ws + WS_RSV), EIDX, EG, COEF, G, blk);
    SEAM(10);
    if (IN(11)) peer_v_phase((tab_ptr)(ws + WS_PV), EIDX, COEF, MOD, a.out, G, blk);
    if (PROBE_K >= 0) {
        xcd_barrier(xbar);
        if (blk != 0 || threadIdx.x != 0) return;
        if (PROBE_K == 11) pst[1] = __builtin_amdgcn_s_memrealtime();
        const unsigned long long te = __builtin_amdgcn_s_memrealtime();
        const unsigned long long span = PROBE_SUB ? pst[2] : pst[1] - pst[0];
        while (__builtin_amdgcn_s_memrealtime() - te < span) __builtin_amdgcn_s_sleep(20);
    }
#undef IN
#undef SEAM
}

#ifndef MK_N_LAUNCHES
#define MK_N_LAUNCHES 1
#endif
extern "C" void kernel_launch(void* const* d_in, const int* in_sizes, int n_in, void* d_out, int out_size, void* d_ws, size_t ws_size, hipStream_t stream) {
    static int grid = 0;
    if (grid == 0) {
        if (n_in != 17 || in_sizes[0] != T * DM || out_size != T * DM || ws_size < WS_END) {
            fprintf(stderr, "kernel_launch: unexpected problem: n_in %d in0 %d out %d ws %zu (need %zu); nothing launched\n", n_in, n_in > 0 ? in_sizes[0] : -1, out_size, ws_size, (size_t)WS_END); grid = -1; return; }
        int dev = 0, cus = 0, per_cu = 0;
        hipGetDevice(&dev); hipDeviceGetAttribute(&cus, hipDeviceAttributeMultiprocessorCount, dev);
        if (hipFuncSetAttribute((const void*)mk_fwd, hipFuncAttributeMaxDynamicSharedMemorySize, LDS_BYTES) != hipSuccess) { fprintf(stderr, "kernel_launch: hipFuncSetAttribute failed\n"); grid = -1; return; }
        if (hipOccupancyMaxActiveBlocksPerMultiprocessor(&per_cu, (const void*)mk_fwd, NWAVES * 64, LDS_BYTES) != hipSuccess || per_cu < 1) { fprintf(stderr, "kernel_launch: occupancy query says %d blocks per CU\n", per_cu); grid = -1; return; }
        grid = cus;
    }
    if (grid < 0) return;
    if (hipMemsetAsync((char*)d_ws + WS_CTL, 0, CTL_BYTES, stream) != hipSuccess) { fprintf(stderr, "kernel_launch: hipMemsetAsync failed\n"); return; }
    Args a{};
    for (int i = 0; i < 17; ++i) a.in[i] = (const float*)d_in[i];
    a.out = (float*)d_out; a.ws = (unsigned char*)d_ws;
    for (int li = 0; li < MK_N_LAUNCHES; ++li) {
        a.ph_lo = li * (N_PHASES / MK_N_LAUNCHES); a.ph_hi = (li + 1) * (N_PHASES / MK_N_LAUNCHES);
        void* args[] = {&a};
        hipError_t e = hipLaunchCooperativeKernel((const void*)mk_fwd, dim3(grid), dim3(NWAVES * 64), args, LDS_BYTES, stream);
        if (e != hipSuccess) { fprintf(stderr, "kernel_launch: cooperative launch %d failed: %s (grid %d)\n", li, hipGetErrorString(e), grid); break; }
    }
}
```

```cpp
#include <hip/hip_runtime.h>
#include <hip/hip_cooperative_groups.h>
#include <cstdio>
#include <cstdint>
namespace cg = cooperative_groups;

#define LAS __attribute__((address_space(3)))
typedef unsigned short bf16;
typedef short bf16x8 __attribute__((ext_vector_type(8)));
typedef short s16x4 __attribute__((ext_vector_type(4)));
typedef float f32x2 __attribute__((ext_vector_type(2)));
typedef float f32x4 __attribute__((ext_vector_type(4)));
typedef float f32x16 __attribute__((ext_vector_type(16)));
typedef unsigned u32x2 __attribute__((ext_vector_type(2)));
typedef unsigned u32x4 __attribute__((ext_vector_type(4)));
typedef __bf16 bf16x2_t __attribute__((ext_vector_type(2)));

__device__ __forceinline__ unsigned pk2(float lo, float hi) { f32x2 v = {lo, hi}; bf16x2_t b = __builtin_convertvector(v, bf16x2_t); return __builtin_bit_cast(unsigned, b); }
__device__ __forceinline__ float bflo(unsigned u) { return __uint_as_float(u << 16); }
__device__ __forceinline__ float bfhi(unsigned u) { return __uint_as_float(u & 0xffff0000u); }
__device__ __forceinline__ unsigned ordf(float f) { unsigned u = __float_as_uint(f); return u ^ ((u & 0x80000000u) ? 0xffffffffu : 0x80000000u); }
__device__ __forceinline__ float unordf(unsigned u) { return __uint_as_float((u & 0x80000000u) ? (u ^ 0x80000000u) : ~u); }
#define LDS_WAIT() asm volatile("s_waitcnt lgkmcnt(0)" ::: "memory")
__device__ __forceinline__ int phase_tid() { int t = (int)threadIdx.x; asm volatile("" : "+v"(t)); return t; }

constexpr int PEER_ROWB = 768;
typedef const unsigned char* tab_ptr;
constexpr int NB = 16, SEQ = 4096, DM = 1024, T = NB * SEQ;
constexpr int NIN_PAD = 5888;
constexpr float EPS = 1e-6f;
constexpr float C2 = 0.125f * 1.4426950408889634f;
constexpr int NWAVES = 8;

constexpr size_t MiB = 1u << 20;
constexpr size_t WS_MOD = 1 * MiB;
constexpr size_t WS_RSU = 1 * MiB + 512 * 1024, WS_RSV = 1 * MiB + 640 * 1024;
constexpr size_t WS_WIN = 2 * MiB;
constexpr size_t WS_WCO = 14 * MiB;
constexpr size_t WS_WAO = 15 * MiB;
constexpr size_t WS_WO = 16 * MiB;
constexpr size_t WS_WPQ = 18 * MiB;
constexpr size_t WS_SK = 20 * MiB;
constexpr size_t WS_PU = 32 * MiB;
constexpr size_t WS_PV = 64 * MiB;
constexpr size_t WS_H = 96 * MiB;
constexpr size_t WS_CB = 224 * MiB;
constexpr size_t WS_CC = 288 * MiB;
constexpr size_t WS_CX = 352 * MiB;
constexpr size_t WS_Q = 416 * MiB;
constexpr size_t WS_K = 480 * MiB;
constexpr size_t WS_V = 544 * MiB;
constexpr size_t WS_QI = 608 * MiB;
constexpr size_t WS_GC = 672 * MiB;
constexpr size_t WS_GA = 800 * MiB;
constexpr size_t WS_KI = 928 * MiB;
constexpr size_t WS_WI = 936 * MiB;
constexpr size_t WS_MASK = 938 * MiB;
constexpr size_t WS_END = 970 * MiB;
constexpr size_t WS_PQ = WS_CC;
constexpr size_t WS_EIDX = WS_K;
constexpr size_t WS_EG = WS_K + 16 * MiB;
constexpr size_t WS_CCODE = WS_Q, WS_CSC = WS_Q + 16 * MiB;
constexpr size_t WS_COEF = WS_V;
constexpr size_t WS_CTL = 0;
constexpr size_t CTL_BYTES = 32768;

constexpr int LDS_BYTES = 147456;

namespace pg8 {
constexpr int BM = 256, BK = 64, HALF = 128, HTB = HALF * BK * 2, STAGE_BYTES = 8 * HTB, NXCD = 8, WGM = 8;
__host__ __device__ __forceinline__ int lds_byte(int r, int c) { const int st = (r >> 4) * 2 + (c >> 5), rr = r & 15, cc = c & 31, ob = rr * 64 + cc * 2; return st * 1024 + (ob ^ (((ob >> 9) & 1) << 5)); }
__host__ __device__ __forceinline__ void stage_rc(int b, int& R, int& C) { const int st = b / 1024, sb = b % 1024, swz = sb ^ (((sb >> 9) & 1) << 5); R = (st >> 1) * 16 + swz / 64; C = (st & 1) * 32 + (swz % 64) / 2; }
__host__ __device__ __forceinline__ int perm32(int rho) { const int n = rho >> 4, i = rho & 15; return 8 * (i >> 2) + 4 * n + (i & 3); }
struct Unit { int pm, pn; };
struct Gemm { const bf16* A; const bf16* Bt; int M, N, K; };
struct StaticOrder {
    int nM, nN, nwg, G, c;
    __device__ void init(int M, int N, int G_, int c_) { nM = M / BM; nN = N / BM; nwg = nM * nN; G = G_; c = c_; }
    __device__ bool next(int i, Unit& u) const {
        const long L = (long)i * G + c; if (L >= nwg) return false;
        int wgid = (int)L; { const int q = nwg / NXCD, r = nwg % NXCD, xcd = wgid % NXCD, off = wgid / NXCD; wgid = (xcd < r ? xcd * (q + 1) : r * (q + 1) + (xcd - r) * q) + off; }
        const int nig = WGM * nN, gid = wgid / nig, fm = gid * WGM, gsz = (nM - fm) < WGM ? (nM - fm) : WGM;
        u.pm = fm + ((wgid % nig) % gsz); u.pn = (wgid % nig) / gsz; return true;
    }
};

template <class Epi, bool ALIGN_EPI, bool SP2>
__device__ __forceinline__ void gemm_phase(LAS unsigned char* lds, const Gemm g, const StaticOrder& S, const Epi& E) {
    const int tid = phase_tid(), wid = __builtin_amdgcn_readfirstlane(tid >> 6), lane = tid & 63, wr = wid >> 2, wc = wid & 3, fr = lane & 15, fq = lane >> 4;
    const int K = g.K, nt = K / BK;
    unsigned voffA[2], voffB[2];
#pragma unroll
    for (int i = 0; i < 2; ++i) { int R, C; stage_rc(tid * 16 + i * 8192, R, C); const int Rb = Epi::PERM ? ((R & ~31) + perm32(R & 31)) : R;
        voffA[i] = (unsigned)(R * K + C) * 2u; voffB[i] = (unsigned)(Rb * K + C) * 2u; }
    const size_t kstep = (size_t)(BK * 2);
    const size_t hstep = (size_t)HALF * K * 2;
    const size_t tstep = 2 * hstep;
    const unsigned ldsw = (unsigned)wid * 1024u;
    const int aoff = lds_byte(wr * 64 + fr, fq * 8), boff = lds_byte(wc * 32 + fr, fq * 8);
#define PG8_SA(b, h) (((b) * 2 + (h)) * HTB)
#define PG8_SB(b, h) ((4 + (b) * 2 + (h)) * HTB)
#define PG8_STAGE(bufoff, gbase, voff) do { _Pragma("unroll") for (int _i = 0; _i < 2; ++_i) \
        __builtin_amdgcn_global_load_lds((const unsigned*)((const char*)(gbase) + (voff)[_i]), (LAS unsigned*)(lds + (bufoff) + ldsw + _i * 8192), 16, 0, 0); } while (0)
#define PG8_LDA(dst, b, h) do { _Pragma("unroll") for (int m = 0; m < 4; ++m) _Pragma("unroll") for (int k = 0; k < 2; ++k) dst[m][k] = *(const LAS bf16x8*)(lds + PG8_SA(b, h) + aoff + m * 2048 + k * 1024); } while (0)
#define PG8_LDB(dst, b, h) do { _Pragma("unroll") for (int n = 0; n < 2; ++n) _Pragma("unroll") for (int k = 0; k < 2; ++k) dst[n][k] = *(const LAS bf16x8*)(lds + PG8_SB(b, h) + boff + n * 2048 + k * 1024); } while (0)
#define PG8_MMA(ai, bj, At, Bt) do { __builtin_amdgcn_s_setprio(1); _Pragma("unroll") for (int m = 0; m < 4; ++m) _Pragma("unroll") for (int n = 0; n < 2; ++n) _Pragma("unroll") for (int k = 0; k < 2; ++k) \
        acc[ai][bj][m][n] = __builtin_amdgcn_mfma_f32_16x16x32_bf16(Bt[n][k], At[m][k], acc[ai][bj][m][n], 0, 0, 0); __builtin_amdgcn_s_setprio(0); } while (0)
#define PG8_WAIT_V(n) asm volatile("s_waitcnt vmcnt(" #n ")" ::: "memory")
#define PG8_WAIT_L(n) asm volatile("s_waitcnt lgkmcnt(" #n ")" ::: "memory")
#define PG8_BAR __builtin_amdgcn_s_barrier()
#define PG8_SCHED __builtin_amdgcn_sched_barrier(0)
    Unit cur, nxt; int ui = 0;
    if (!S.next(0, cur)) return;
    f32x4 acc[2][2][4][2];
#pragma unroll
    for (int a = 0; a < 2; ++a)
#pragma unroll
        for (int b = 0; b < 2; ++b)
#pragma unroll
            for (int m = 0; m < 4; ++m)
#pragma unroll
                for (int n = 0; n < 2; ++n) acc[a][b][m][n] = (f32x4){0.f, 0.f, 0.f, 0.f};
    bf16x8 At[4][2], B0[2][2], B1[2][2];
    const char* cA = (const char*)g.A + (size_t)cur.pm * tstep; const char* cB = (const char*)g.Bt + (size_t)cur.pn * tstep;
    if constexpr (SP2) {
        PG8_STAGE(PG8_SB(0, 0), cB, voffB); PG8_STAGE(PG8_SB(0, 1), cB + hstep, voffB); PG8_STAGE(PG8_SA(0, 0), cA, voffA); PG8_STAGE(PG8_SA(0, 1), cA + hstep, voffA);
        if (wr == 1) PG8_BAR;
        PG8_WAIT_V(2); PG8_BAR;
        PG8_STAGE(PG8_SB(1, 0), cB + kstep, voffB); PG8_STAGE(PG8_SA(1, 0), cA + kstep, voffA); PG8_STAGE(PG8_SB(1, 1), cB + hstep + kstep, voffB);
        PG8_WAIT_V(6); PG8_BAR;
    } else {
        PG8_STAGE(PG8_SB(0, 0), cB, voffB); PG8_STAGE(PG8_SA(0, 0), cA, voffA); PG8_STAGE(PG8_SB(0, 1), cB + hstep, voffB); PG8_STAGE(PG8_SA(0, 1), cA + hstep, voffA);
        if (wr == 1) PG8_BAR;
        PG8_WAIT_V(4); PG8_BAR;
        PG8_STAGE(PG8_SB(1, 0), cB + kstep, voffB); PG8_STAGE(PG8_SA(1, 0), cA + kstep, voffA); PG8_STAGE(PG8_SB(1, 1), cB + hstep + kstep, voffB);
        PG8_WAIT_V(6); PG8_BAR;
    }
    for (;;) {
        const bool has_next = S.next(ui + 1, nxt);
        const char* nA = has_next ? (const char*)g.A + (size_t)nxt.pm * tstep : cA; const char* nB = has_next ? (const char*)g.Bt + (size_t)nxt.pn * tstep : cB;
        for (int t = 0; t < nt; t += 2) {
            if constexpr (Epi::MIDK) { if (t == nt / 2) E.mid(acc, cur, wr, wc, fr, fq); }
            const bool last = (t == nt - 2);
            const char* a1 = cA + (size_t)(t + 1) * kstep;
            const char* a2 = last ? nA : cA + (size_t)(t + 2) * kstep; const char* b2 = last ? nB : cB + (size_t)(t + 2) * kstep;
            const char* a3 = a2 + kstep; const char* b3 = b2 + kstep;
            if constexpr (SP2) {
            PG8_LDB(B0, 0, 0); PG8_LDB(B1, 0, 1); PG8_SCHED; PG8_LDA(At, 0, 0); PG8_STAGE(PG8_SA(1, 1), a1 + hstep, voffA);
            PG8_WAIT_V(8); PG8_WAIT_L(0); PG8_BAR; PG8_MMA(0, 0, At, B0); PG8_MMA(0, 1, At, B1); PG8_BAR; PG8_SCHED;
            PG8_LDA(At, 0, 1); PG8_STAGE(PG8_SB(0, 0), b2, voffB); PG8_STAGE(PG8_SB(0, 1), b2 + hstep, voffB); PG8_STAGE(PG8_SA(0, 0), a2, voffA);
            PG8_WAIT_V(8); PG8_WAIT_L(0); PG8_BAR; PG8_MMA(1, 0, At, B0); PG8_MMA(1, 1, At, B1); PG8_BAR; PG8_SCHED;
            PG8_LDB(B0, 1, 0); PG8_LDB(B1, 1, 1); PG8_SCHED; PG8_LDA(At, 1, 0); PG8_STAGE(PG8_SA(0, 1), a2 + hstep, voffA);
            PG8_WAIT_V(8); PG8_WAIT_L(0); PG8_BAR; PG8_MMA(0, 0, At, B0); PG8_MMA(0, 1, At, B1); PG8_BAR; PG8_SCHED;
            PG8_LDA(At, 1, 1); PG8_STAGE(PG8_SB(1, 0), b3, voffB); PG8_STAGE(PG8_SB(1, 1), b3 + hstep, voffB); PG8_STAGE(PG8_SA(1, 0), a3, voffA);
            PG8_WAIT_V(8); PG8_WAIT_L(0); PG8_BAR; PG8_MMA(1, 0, At, B0); PG8_MMA(1, 1, At, B1); PG8_BAR; PG8_SCHED;
            } else {
            PG8_LDB(B0, 0, 0); PG8_SCHED; PG8_LDA(At, 0, 0); PG8_STAGE(PG8_SA(1, 1), a1 + hstep, voffA);
            PG8_WAIT_L(8); PG8_BAR; PG8_WAIT_L(0); PG8_MMA(0, 0, At, B0); PG8_BAR; PG8_SCHED;
            PG8_LDB(B1, 0, 1); PG8_STAGE(PG8_SB(0, 0), b2, voffB);
            PG8_BAR; PG8_WAIT_L(0); PG8_MMA(0, 1, At, B1); PG8_BAR;
            PG8_LDA(At, 0, 1); PG8_STAGE(PG8_SA(0, 0), a2, voffA);
            PG8_BAR; PG8_WAIT_L(0); PG8_MMA(1, 0, At, B0); PG8_BAR; PG8_SCHED;
            PG8_STAGE(PG8_SB(0, 1), b2 + hstep, voffB);
            PG8_WAIT_V(6); PG8_BAR; PG8_MMA(1, 1, At, B1); PG8_BAR;
            PG8_LDB(B0, 1, 0); PG8_SCHED; PG8_LDA(At, 1, 0); PG8_STAGE(PG8_SA(0, 1), a2 + hstep, voffA);
            PG8_WAIT_L(8); PG8_BAR; PG8_WAIT_L(0); PG8_MMA(0, 0, At, B0); PG8_BAR; PG8_SCHED;
            PG8_LDB(B1, 1, 1); PG8_STAGE(PG8_SB(1, 0), b3, voffB);
            PG8_BAR; PG8_WAIT_L(0); PG8_MMA(0, 1, At, B1); PG8_BAR;
            PG8_LDA(At, 1, 1); PG8_STAGE(PG8_SA(1, 0), a3, voffA);
            PG8_BAR; PG8_WAIT_L(0); PG8_MMA(1, 0, At, B0); PG8_BAR; PG8_SCHED;
            PG8_STAGE(PG8_SB(1, 1), b3 + hstep, voffB);
            PG8_WAIT_V(6); PG8_BAR; PG8_MMA(1, 1, At, B1); PG8_BAR;
            }
        }
        if constexpr (ALIGN_EPI) { if (wr == 0) PG8_BAR; }
        E(acc, cur, wr, wc, fr, fq);
        if (!has_next) break;
#pragma unroll
        for (int a = 0; a < 2; ++a)
#pragma unroll
            for (int b = 0; b < 2; ++b)
#pragma unroll
                for (int m = 0; m < 4; ++m)
#pragma unroll
                    for (int n = 0; n < 2; ++n) acc[a][b][m][n] = (f32x4){0.f, 0.f, 0.f, 0.f};
        cur = nxt; cA = nA; cB = nB; ++ui;
        if constexpr (ALIGN_EPI) { if (wr == 1) PG8_BAR; }
    }
    PG8_WAIT_V(0);
    if constexpr (!ALIGN_EPI) { if (wr == 0) PG8_BAR; }
    PG8_BAR;
#undef PG8_SA
#undef PG8_SB
#undef PG8_STAGE
#undef PG8_LDA
#undef PG8_LDB
#undef PG8_MMA
#undef PG8_WAIT_V
#undef PG8_WAIT_L
#undef PG8_BAR
#undef PG8_SCHED
}
}

typedef const f32x4 (&AccRef)[2][2][4][2];

__device__ __forceinline__ u32x4 pack8(f32x4 v0, f32x4 v1) { u32x4 w; w.x = pk2(v0[0], v0[1]); w.y = pk2(v0[2], v0[3]); w.z = pk2(v1[0], v1[1]); w.w = pk2(v1[2], v1[3]); return w; }
__device__ __forceinline__ float sigm(float x) { return __builtin_amdgcn_rcpf(1.f + __builtin_amdgcn_exp2f(-1.4426950408889634f * x)); }

struct EpiInProj {
    static constexpr bool PERM = true; static constexpr bool MIDK = false;
    unsigned char* ws; const float* qnw; const float* knw;
    __device__ __forceinline__ void operator()(AccRef acc, const pg8::Unit& u, int wr, int wc, int fr, int fq) const {
        const int pn = u.pn; const size_t row0 = (size_t)u.pm * 256 + wr * 64 + fr;
        bf16* const V = (bf16*)(ws + WS_V); bf16* const KI = (bf16*)(ws + WS_KI); float* const WI = (float*)(ws + WS_WI);
        if (pn == 10 || pn == 11) {
            bf16* vb = V + ((size_t)((u.pm >> 4) * 8 + 4 * (pn & 1) + (wc >> 1)) * 4096 + (u.pm & 15) * 256 + wr * 64 + fr) * 64 + 32 * (wc & 1) + 8 * fq;
#pragma unroll
            for (int ai = 0; ai < 2; ++ai)
#pragma unroll
                for (int m = 0; m < 4; ++m)
#pragma unroll
                    for (int bj = 0; bj < 2; ++bj) *(u32x4*)(vb + (size_t)(2 * bj * 4096 + ai * 128 + m * 16) * 64) = pack8(acc[ai][bj][m][0], acc[ai][bj][m][1]);
        } else if (pn < 6 || (pn >= 12 && pn < 14)) {
            bf16* base = (bf16*)(ws + (pn < 6 ? WS_CB + (size_t)(pn >> 1) * (64 * MiB) : WS_QI));
            static_assert(WS_CC == WS_CB + 64 * MiB && WS_CX == WS_CB + 128 * MiB, "cb | cc | cx are consecutive 64 MiB regions");
            const int col0 = (pn & 1) * 256 + wc * 32 + 8 * fq;
#pragma unroll
            for (int ai = 0; ai < 2; ++ai)
#pragma unroll
                for (int m = 0; m < 4; ++m) { bf16* rowp = base + (row0 + ai * 128 + m * 16) * 512 + col0;
#pragma unroll
                    for (int bj = 0; bj < 2; ++bj) *(u32x4*)(rowp + bj * 128) = pack8(acc[ai][bj][m][0], acc[ai][bj][m][1]); }
        } else if (pn < 10) {
            const bool isq = pn < 8; bf16* base = (bf16*)(ws + (isq ? WS_Q : WS_K)); const float* nw = isq ? qnw : knw; const float sc = isq ? C2 : 1.f;
            const int head = 4 * (pn & 1) + wc;
            f32x4 w[2][2];
#pragma unroll
            for (int bj = 0; bj < 2; ++bj)
#pragma unroll
                for (int n = 0; n < 2; ++n) w[bj][n] = *(const f32x4*)(nw + 32 * bj + 8 * fq + 4 * n) * sc;
#pragma unroll
            for (int ai = 0; ai < 2; ++ai)
#pragma unroll
                for (int m = 0; m < 4; ++m) {
                    float ss = 0.f;
#pragma unroll
                    for (int bj = 0; bj < 2; ++bj)
#pragma unroll
                        for (int n = 0; n < 2; ++n) { const f32x4 x = acc[ai][bj][m][n]; ss += (x[0] * x[0] + x[1] * x[1]) + (x[2] * x[2] + x[3] * x[3]); }
                    ss += __shfl_xor(ss, 16); ss += __shfl_xor(ss, 32);
                    const float r = __builtin_amdgcn_rsqf(ss * (1.f / 64.f) + EPS);
                    bf16* rowp = isq ? base + (row0 + ai * 128 + m * 16) * 512 + head * 64 + 8 * fq
                                     : base + ((size_t)((u.pm >> 4) * 8 + head) * 4096 + (u.pm & 15) * 256 + wr * 64 + fr + ai * 128 + m * 16) * 64 + 8 * fq;
#pragma unroll
                    for (int bj = 0; bj < 2; ++bj) *(u32x4*)(rowp + bj * 32) = pack8(acc[ai][bj][m][0] * r * w[bj][0], acc[ai][bj][m][1] * r * w[bj][1]);
                }
        } else if (pn < 22) {
            bf16* base = (bf16*)(ws + (pn < 18 ? WS_GC : WS_GA)); const int col0 = ((pn - 14) & 3) * 256 + wc * 32 + 8 * fq;
#pragma unroll
            for (int ai = 0; ai < 2; ++ai)
#pragma unroll
                for (int m = 0; m < 4; ++m) { bf16* rowp = base + (row0 + ai * 128 + m * 16) * 1024 + col0;
#pragma unroll
                    for (int bj = 0; bj < 2; ++bj) { f32x4 a = acc[ai][bj][m][0], b = acc[ai][bj][m][1];
#pragma unroll
                        for (int j = 0; j < 4; ++j) { a[j] = sigm(a[j]); b[j] = sigm(b[j]); }
                        *(u32x4*)(rowp + bj * 128) = pack8(a, b); } }
        } else {
            if (wc < 2) {
#pragma unroll
                for (int ai = 0; ai < 2; ++ai)
#pragma unroll
                    for (int m = 0; m < 4; ++m) *(u32x4*)(KI + (row0 + ai * 128 + m * 16) * 64 + wc * 32 + 8 * fq) = pack8(acc[ai][0][m][0], acc[ai][0][m][1]);
            } else if (wc == 2 && fq == 0) {
#pragma unroll
                for (int ai = 0; ai < 2; ++ai)
#pragma unroll
                    for (int m = 0; m < 4; ++m) { float* p = WI + (row0 + ai * 128 + m * 16) * 8; *(f32x4*)p = acc[ai][0][m][0]; *(f32x4*)(p + 4) = acc[ai][0][m][1]; }
            }
        }
    }
};

struct EpiMixFused {
    static constexpr bool PERM = true; static constexpr bool MIDK = true;
    const bf16* GC; const bf16* GA; bf16* MIX;
    __device__ __forceinline__ void mid(f32x4 (&acc)[2][2][4][2], const pg8::Unit& u, int wr, int wc, int fr, int fq) const {
        unsigned base = (unsigned)((u.pm * 256 + wr * 64 + fr) * 1024 + u.pn * 256 + wc * 32 + 8 * fq);
        asm volatile("" : "+v"(base));
#define MIX_R(GCV, GAV) ((GCV) * __builtin_amdgcn_rcpf(fmaxf((GAV), 1e-20f)))
#pragma unroll
        for (int ai = 0; ai < 2; ++ai)
#pragma unroll
            for (int mh = 0; mh < 2; ++mh) {
                u32x4 gc[2][2], ga[2][2];
#pragma unroll
                for (int mm = 0; mm < 2; ++mm)
#pragma unroll
                    for (int bj = 0; bj < 2; ++bj) { const size_t off = (size_t)base + (size_t)(ai * 128 + (2 * mh + mm) * 16) * 1024 + bj * 128; gc[mm][bj] = *(const u32x4*)(GC + off); ga[mm][bj] = *(const u32x4*)(GA + off); }
#pragma unroll
                for (int mm = 0; mm < 2; ++mm)
#pragma unroll
                    for (int bj = 0; bj < 2; ++bj) { f32x4& a = acc[ai][bj][2 * mh + mm][0]; f32x4& b = acc[ai][bj][2 * mh + mm][1]; const u32x4 c = gc[mm][bj], g = ga[mm][bj];
                        a[0] *= MIX_R(bflo(c.x), bflo(g.x)); a[1] *= MIX_R(bfhi(c.x), bfhi(g.x)); a[2] *= MIX_R(bflo(c.y), bflo(g.y)); a[3] *= MIX_R(bfhi(c.y), bfhi(g.y));
                        b[0] *= MIX_R(bflo(c.z), bflo(g.z)); b[1] *= MIX_R(bfhi(c.z), bfhi(g.z)); b[2] *= MIX_R(bflo(c.w), bflo(g.w)); b[3] *= MIX_R(bfhi(c.w), bfhi(g.w)); }
                asm volatile("" ::: "memory");
            }
#undef MIX_R
    }
    __device__ __forceinline__ void operator()(AccRef acc, const pg8::Unit& u, int wr, int wc, int fr, int fq) const {
        const size_t row0 = (size_t)u.pm * 256 + wr * 64 + fr; const int col0 = u.pn * 256 + wc * 32 + 8 * fq;
#pragma unroll
        for (int ai = 0; ai < 2; ++ai)
#pragma unroll
            for (int m = 0; m < 4; ++m) { const size_t off = (row0 + ai * 128 + m * 16) * 1024 + col0;
#pragma unroll
                for (int bj = 0; bj < 2; ++bj) {
                    const u32x4 g = *(const u32x4*)(GA + off + bj * 128);
                    f32x4 a = acc[ai][bj][m][0], b = acc[ai][bj][m][1];
                    a[0] *= fmaxf(bflo(g.x), 1e-20f); a[1] *= fmaxf(bfhi(g.x), 1e-20f); a[2] *= fmaxf(bflo(g.y), 1e-20f); a[3] *= fmaxf(bfhi(g.y), 1e-20f);
                    b[0] *= fmaxf(bflo(g.z), 1e-20f); b[1] *= fmaxf(bfhi(g.z), 1e-20f); b[2] *= fmaxf(bflo(g.w), 1e-20f); b[3] *= fmaxf(bfhi(g.w), 1e-20f);
                    *(u32x4*)(MIX + off + bj * 128) = pack8(a, b); } }
    }
};

struct EpiDelta {
    static constexpr bool PERM = true; static constexpr bool MIDK = false;
    const float* MOD; bf16* O;
    __device__ __forceinline__ void operator()(AccRef acc, const pg8::Unit& u, int wr, int wc, int fr, int fq) const {
        const size_t row0 = (size_t)u.pm * 256 + wr * 64 + fr; const int col0 = u.pn * 256 + wc * 32 + 8 * fq;
        const float* g1 = MOD + (size_t)(u.pm >> 4) * 6144 + 2048;
        f32x4 gv[2][2];
#pragma unroll
        for (int bj = 0; bj < 2; ++bj)
#pragma unroll
            for (int n = 0; n < 2; ++n) gv[bj][n] = *(const f32x4*)(g1 + col0 + bj * 128 + 4 * n);
#pragma unroll
        for (int ai = 0; ai < 2; ++ai)
#pragma unroll
            for (int m = 0; m < 4; ++m) { bf16* rowp = O + (row0 + ai * 128 + m * 16) * 1024 + col0;
#pragma unroll
                for (int bj = 0; bj < 2; ++bj) *(u32x4*)(rowp + bj * 128) = pack8(acc[ai][bj][m][0] * gv[bj][0], acc[ai][bj][m][1] * gv[bj][1]); }
    }
};

struct EpiPlain {
    static constexpr bool PERM = true; static constexpr bool MIDK = false;
    bf16* O;
    __device__ __forceinline__ void operator()(AccRef acc, const pg8::Unit& u, int wr, int wc, int fr, int fq) const {
        const size_t row0 = (size_t)u.pm * 256 + wr * 64 + fr; const int col0 = u.pn * 256 + wc * 32 + 8 * fq;
#pragma unroll
        for (int ai = 0; ai < 2; ++ai)
#pragma unroll
            for (int m = 0; m < 4; ++m) { bf16* rowp = O + (row0 + ai * 128 + m * 16) * 1024 + col0;
#pragma unroll
                for (int bj = 0; bj < 2; ++bj) *(u32x4*)(rowp + bj * 128) = pack8(acc[ai][bj][m][0], acc[ai][bj][m][1]); }
    }
};

struct Args { const float* in[17]; float* out; unsigned char* ws; int ph_lo, ph_hi; };

__device__ __forceinline__ void transpose_item(const float* W, int ldw, int k0, int n0, int ncols, bf16* WT, int K, int drow0, LAS float* scr, int lane) {
#pragma unroll 8
    for (int i = 0; i < 32; ++i) { const int kk = 2 * i + (lane >> 5), n = lane & 31; scr[kk * 33 + n] = (n < ncols) ? W[(size_t)(k0 + kk) * ldw + n0 + n] : 0.f; }
    LDS_WAIT(); asm volatile("" ::: "memory");
    const int c = lane & 7;
#pragma unroll
    for (int j = 0; j < 4; ++j) { const int n = (lane >> 3) + 8 * j; const LAS float* s = scr + (8 * c) * 33 + n;
        u32x4 o; o.x = pk2(s[0 * 33], s[1 * 33]); o.y = pk2(s[2 * 33], s[3 * 33]); o.z = pk2(s[4 * 33], s[5 * 33]); o.w = pk2(s[6 * 33], s[7 * 33]);
        *(u32x4*)(WT + (size_t)(drow0 + n) * K + k0 + 8 * c) = o; }
    LDS_WAIT(); asm volatile("" ::: "memory");
}
__device__ __forceinline__ void cvt_stream(const float* src, bf16* dst, size_t n8, size_t i0, size_t stride) {
    for (size_t i = i0; i < n8; i += stride) { const f32x4 a = *(const f32x4*)(src + 8 * i), b = *(const f32x4*)(src + 8 * i + 4); *(u32x4*)(dst + 8 * i) = pack8(a, b); }
}

typedef unsigned v6u_t __attribute__((ext_vector_type(6)));
typedef float v32f_t __attribute__((ext_vector_type(32)));
typedef __bf16 v32bf_t __attribute__((ext_vector_type(32)));
struct __attribute__((packed, aligned(4))) U3 { unsigned x, y, z; };
__device__ __forceinline__ unsigned enc_e2m3(float y) {
    const float a = fminf(fabsf(y), 7.5f);
    const float r = a < 2.f ? a * 8.f : (a < 4.f ? a * 4.f + 8.f : a * 2.f + 16.f);
    unsigned c = (unsigned)__builtin_rintf(r); c = c > 31u ? 31u : c;
    return c | ((__float_as_uint(y) >> 26) & 32u);
}
__device__ __forceinline__ float dec_e2m3(unsigned c) {
    const unsigned m = c & 31u; const float fm = (float)m;
    const float v = m < 16u ? fm * 0.125f : (m < 24u ? fm * 0.25f - 2.f : fm * 0.5f - 8.f);
    return (c & 32u) ? -v : v;
}
__device__ __forceinline__ unsigned enc_e2m1(float y) {
    const float a = fminf(fabsf(y), 6.f);
    const float r = a < 2.f ? a * 2.f : (a < 4.f ? a + 2.f : a * 0.5f + 4.f);
    unsigned c = (unsigned)__builtin_rintf(r); c = c > 7u ? 7u : c;
    return c | ((__float_as_uint(y) >> 28) & 8u);
}
template <bool FP4>
__device__ __forceinline__ void cvt_rows_fpx(const float* src, unsigned char* dst, float* rs, int gw, int nw, int lane) {
    constexpr float VMAX = FP4 ? 6.f : 7.5f;
#pragma unroll 2
    for (int row = gw; row < 16384; row += nw) {
        const float* sp = src + (size_t)row * 1024 + 16 * lane;
        const f32x4 a = *(const f32x4*)sp, b = *(const f32x4*)(sp + 4), c = *(const f32x4*)(sp + 8), d = *(const f32x4*)(sp + 12);
        const float v[16] = {a[0], a[1], a[2], a[3], b[0], b[1], b[2], b[3], c[0], c[1], c[2], c[3], d[0], d[1], d[2], d[3]};
        float m = 0.f;
#pragma unroll
        for (int j = 0; j < 16; ++j) m = fmaxf(m, fabsf(v[j]));
#pragma unroll
        for (int o = 32; o; o >>= 1) m = fmaxf(m, __shfl_xor(m, o));
        const float sc = m > 0.f ? VMAX / m : 0.f;
        unsigned q[16];
        if constexpr (FP4) {
#pragma unroll
            for (int j = 0; j < 16; ++j) q[j] = enc_e2m1(v[j] * sc);
            u32x2 w;
            w.x = q[0] | (q[1] << 4) | (q[2] << 8) | (q[3] << 12) | (q[4] << 16) | (q[5] << 20) | (q[6] << 24) | (q[7] << 28);
            w.y = q[8] | (q[9] << 4) | (q[10] << 8) | (q[11] << 12) | (q[12] << 16) | (q[13] << 20) | (q[14] << 24) | (q[15] << 28);
            *(u32x2*)(dst + (size_t)row * 512 + 8 * lane) = w;
        } else {
#pragma unroll
            for (int j = 0; j < 16; ++j) q[j] = enc_e2m3(v[j] * sc);
            U3 w;
            w.x = q[0] | (q[1] << 6) | (q[2] << 12) | (q[3] << 18) | (q[4] << 24) | (q[5] << 30);
            w.y = (q[5] >> 2) | (q[6] << 4) | (q[7] << 10) | (q[8] << 16) | (q[9] << 22) | (q[10] << 28);
            w.z = (q[10] >> 4) | (q[11] << 2) | (q[12] << 8) | (q[13] << 14) | (q[14] << 20) | (q[15] << 26);
            *(U3*)(dst + (size_t)row * 768 + 12 * lane) = w;
        }
        if (lane == 0) rs[row] = m * (1.f / VMAX);
    }
}
__device__ __forceinline__ void p0_prologue(LAS unsigned char* lds, const Args& a, int G, int blk) {
    const int tid = threadIdx.x, lane = tid & 63, wave = __builtin_amdgcn_readfirstlane(tid >> 6);
    unsigned char* ws = a.ws;
    for (int task = blk; task < 96; task += G) {
        LAS float* sl = (LAS float*)(lds + 67584);
        for (int i = tid; i < NB * DM; i += 512) { const float v = a.in[1][i]; sl[i] = v * __builtin_amdgcn_rcpf(1.f + __expf(-v)); }
        __syncthreads();
        const int col = task * 64 + lane, kb = wave * 128;
        float acc[16];
#pragma unroll
        for (int b = 0; b < 16; ++b) acc[b] = 0.f;
        const float* wp = a.in[2] + col;
        for (int k = kb; k < kb + 128; k += 4) {
            const float w0 = wp[(size_t)(k + 0) * 6144], w1 = wp[(size_t)(k + 1) * 6144], w2 = wp[(size_t)(k + 2) * 6144], w3 = wp[(size_t)(k + 3) * 6144];
#pragma unroll
            for (int b = 0; b < 16; ++b) { const f32x4 s = *(const LAS f32x4*)(sl + b * 1024 + k); acc[b] += (s[0] * w0 + s[1] * w1) + (s[2] * w2 + s[3] * w3); }
        }
        LAS float* red = (LAS float*)lds;
#pragma unroll
        for (int b = 0; b < 16; ++b) red[(wave * 16 + b) * 64 + lane] = acc[b];
        __syncthreads();
        for (int o = tid; o < 1024; o += 512) { const int b = o >> 6, cl = o & 63; float s = 0.f;
#pragma unroll
            for (int w = 0; w < 8; ++w) s += red[(w * 16 + b) * 64 + cl];
            ((float*)(ws + WS_MOD))[b * 6144 + task * 64 + cl] = s + a.in[3][task * 64 + cl]; }
        __syncthreads();
    }
    LAS float* scr = (LAS float*)(lds + wave * 8448);
    const int gw = blk * NWAVES + wave, NGW = G * NWAVES;
    constexpr int I_IN = 184 * 16, I_CO = 8 * 32, I_AO = 8 * 32, I_O = 16 * 32, I_PQ = 16 * 32;
    for (int it = gw; it < I_IN + I_CO + I_AO + I_O + I_PQ; it += NGW) {
        int r = it;
        if (r < I_IN) {
            const int dg = r >> 4, kb = r & 15, tile = dg >> 3, gi = dg & 7; int src, nc = 32;
            if (tile < 6 || (tile >= 10 && tile < 14)) src = 32 * dg;
            else if (tile < 10) src = tile * 256 + 32 * (2 * (gi & 3) + (gi >> 2));
            else if (tile < 22) src = 3656 + 32 * (dg - 112);
            else { if (gi < 2) src = 3584 + 32 * gi; else if (gi == 2) { src = 3648; nc = 8; } else { src = 0; nc = 0; } }
            transpose_item(a.in[5], 5704, kb * 64, src, nc, (bf16*)(ws + WS_WIN), 1024, dg * 32, scr, lane); continue; }
        r -= I_IN;
        if (r < I_CO) { transpose_item(a.in[7], 1024, (r >> 5) * 64, (r & 31) * 32, 32, (bf16*)(ws + WS_WCO), 1024, (r & 31) * 32, scr, lane); continue; } r -= I_CO;
        if (r < I_AO) { transpose_item(a.in[10], 1024, (r >> 5) * 64, (r & 31) * 32, 32, (bf16*)(ws + WS_WCO) + 512, 1024, (r & 31) * 32, scr, lane); continue; } r -= I_AO;
        if (r < I_O) { transpose_item(a.in[11], 1024, (r >> 5) * 64, (r & 31) * 32, 32, (bf16*)(ws + WS_WO), 1024, (r & 31) * 32, scr, lane); continue; } r -= I_O;
        transpose_item(a.in[13], 1024, (r >> 5) * 64, (r & 31) * 32, 32, (bf16*)(ws + WS_WPQ), 1024, (r & 31) * 32, scr, lane);
    }
    const size_t gt = (size_t)blk * 512 + tid, NT_ = (size_t)G * 512;
    cvt_stream(a.in[14], (bf16*)(ws + WS_SK), (size_t)16 * 128 * 64 / 8, gt, NT_);
    cvt_rows_fpx<true>(a.in[15], ws + WS_PU, (float*)(ws + WS_RSU), gw, NGW, lane);
    cvt_rows_fpx<false>(a.in[16], ws + WS_PV, (float*)(ws + WS_RSV), gw, NGW, lane);
}

__device__ __forceinline__ unsigned wave_max_dpp(unsigned x) {
    { const unsigned y = (unsigned)__builtin_amdgcn_update_dpp(0, (int)x, 0x141, 0xF, 0xF, false); x = x > y ? x : y; }
    { const unsigned y = (unsigned)__builtin_amdgcn_update_dpp(0, (int)x, 0x1B, 0xF, 0xF, false); x = x > y ? x : y; }
    { const unsigned y = (unsigned)__builtin_amdgcn_update_dpp(0, (int)x, 0xB1, 0xF, 0xF, false); x = x > y ? x : y; }
    { const unsigned y = (unsigned)__builtin_amdgcn_update_dpp(0, (int)x, 0x128, 0xF, 0xF, false); x = x > y ? x : y; }
    const unsigned a = (unsigned)__builtin_amdgcn_readlane((int)x, 0), b = (unsigned)__builtin_amdgcn_readlane((int)x, 16), c = (unsigned)__builtin_amdgcn_readlane((int)x, 32), d = (unsigned)__builtin_amdgcn_readlane((int)x, 48);
    const unsigned ab = a > b ? a : b, cd = c > d ? c : d; return ab > cd ? ab : cd;
}
__device__ __forceinline__ float wave_sum_dpp(float x) {
    x += __uint_as_float((unsigned)__builtin_amdgcn_update_dpp(0, (int)__float_as_uint(x), 0x141, 0xF, 0xF, false));
    x += __uint_as_float((unsigned)__builtin_amdgcn_update_dpp(0, (int)__float_as_uint(x), 0x1B, 0xF, 0xF, false));
    x += __uint_as_float((unsigned)__builtin_amdgcn_update_dpp(0, (int)__float_as_uint(x), 0xB1, 0xF, 0xF, false));
    x += __uint_as_float((unsigned)__builtin_amdgcn_update_dpp(0, (int)__float_as_uint(x), 0x128, 0xF, 0xF, false));
    const int xi = (int)__float_as_uint(x);
    return (__uint_as_float((unsigned)__builtin_amdgcn_readlane(xi, 0)) + __uint_as_float((unsigned)__builtin_amdgcn_readlane(xi, 16))) +
           (__uint_as_float((unsigned)__builtin_amdgcn_readlane(xi, 32)) + __uint_as_float((unsigned)__builtin_amdgcn_readlane(xi, 48)));
}
template <bool RESID> __device__ __forceinline__ void norm_phase(const float* X, const float* nw, const float* MOD, int sh_off, bf16* O, int G, int blk, float* OUT = nullptr) {
    const int tid_ = phase_tid(); const int lane = tid_ & 63, wave = __builtin_amdgcn_readfirstlane(tid_ >> 6);
    const int stride = G * NWAVES;
    for (int m0 = blk * NWAVES + wave; m0 < T; m0 += 2 * stride) {
        const int m1 = (m0 + stride < T) ? m0 + stride : m0;
        f32x4 va[4], vb[4]; float sa = 0.f, sbb = 0.f;
        const f32x4* xa = (const f32x4*)(X + (size_t)m0 * DM) + lane; const f32x4* xb = (const f32x4*)(X + (size_t)m1 * DM) + lane;
#pragma unroll
        for (int j = 0; j < 4; ++j) { va[j] = xa[64 * j]; vb[j] = xb[64 * j]; }
        if (RESID) {
            const unsigned long long* da = (const unsigned long long*)(O + (size_t)m0 * DM) + lane; const unsigned long long* db = (const unsigned long long*)(O + (size_t)m1 * DM) + lane;
            f32x4* oa4 = (f32x4*)(OUT + (size_t)m0 * DM) + lane; f32x4* ob4 = (f32x4*)(OUT + (size_t)m1 * DM) + lane;
#pragma unroll
            for (int j = 0; j < 4; ++j) { const unsigned long long pa = da[64 * j], pb = db[64 * j];
                va[j] += (f32x4){bflo((unsigned)pa), bfhi((unsigned)pa), bflo((unsigned)(pa >> 32)), bfhi((unsigned)(pa >> 32))};
                vb[j] += (f32x4){bflo((unsigned)pb), bfhi((unsigned)pb), bflo((unsigned)(pb >> 32)), bfhi((unsigned)(pb >> 32))};
                oa4[64 * j] = va[j]; ob4[64 * j] = vb[j]; }
        }
#pragma unroll
        for (int j = 0; j < 4; ++j) { sa += (va[j].x * va[j].x + va[j].y * va[j].y) + (va[j].z * va[j].z + va[j].w * va[j].w); sbb += (vb[j].x * vb[j].x + vb[j].y * vb[j].y) + (vb[j].z * vb[j].z + vb[j].w * vb[j].w); }
        const float ra = __builtin_amdgcn_rsqf(wave_sum_dpp(sa) * (1.f / DM) + EPS), rb = __builtin_amdgcn_rsqf(wave_sum_dpp(sbb) * (1.f / DM) + EPS);
        const float* mda = MOD + (size_t)(m0 >> 12) * 6144 + sh_off; const float* mdb = MOD + (size_t)(m1 >> 12) * 6144 + sh_off;
        unsigned long long* oa = (unsigned long long*)(O + (size_t)m0 * DM) + lane; unsigned long long* ob = (unsigned long long*)(O + (size_t)m1 * DM) + lane;
#pragma unroll
        for (int j = 0; j < 4; ++j) {
            const f32x4 w = ((const f32x4*)nw)[lane + 64 * j];
            const f32x4 ha = (va[j] * ra * w) * (((const f32x4*)(mda + 1024))[lane + 64 * j] + 1.f) + ((const f32x4*)mda)[lane + 64 * j];
            const f32x4 hb = (vb[j] * rb * w) * (((const f32x4*)(mdb + 1024))[lane + 64 * j] + 1.f) + ((const f32x4*)mdb)[lane + 64 * j];
            oa[64 * j] = (unsigned long long)pk2(ha.x, ha.y) | ((unsigned long long)pk2(ha.z, ha.w) << 32);
            ob[64 * j] = (unsigned long long)pk2(hb.x, hb.y) | ((unsigned long long)pk2(hb.z, hb.w) << 32);
        }
    }
}

__device__ __forceinline__ void conv_phase(const bf16* CB, const bf16* CC, const bf16* CX, const float* cw, bf16* UA, int G, int blk) {
    const size_t n = (size_t)T * 64;
    const int ctid = phase_tid();
#pragma unroll 4
    for (size_t i = (size_t)blk * 512 + ctid; i < n; i += (size_t)G * 512) {
        const int c8 = (int)(i & 63) * 8; const size_t row = i >> 6; const int t = (int)(row & (SEQ - 1));
        float accv[8];
#pragma unroll
        for (int e = 0; e < 8; ++e) accv[e] = 0.f;
#pragma unroll
        for (int j = 0; j < 3; ++j) {
            if (t - 2 + j >= 0) {
                const size_t off = (row - 2 + j) * 512 + c8;
                const u32x4 a = *(const u32x4*)(CC + off), b = *(const u32x4*)(CX + off);
                const f32x4 w0 = *(const f32x4*)(cw + j * 512 + c8), w1 = *(const f32x4*)(cw + j * 512 + c8 + 4);
                accv[0] += w0[0] * bflo(a.x) * bflo(b.x); accv[1] += w0[1] * bfhi(a.x) * bfhi(b.x);
                accv[2] += w0[2] * bflo(a.y) * bflo(b.y); accv[3] += w0[3] * bfhi(a.y) * bfhi(b.y);
                accv[4] += w1[0] * bflo(a.z) * bflo(b.z); accv[5] += w1[1] * bfhi(a.z) * bfhi(b.z);
                accv[6] += w1[2] * bflo(a.w) * bflo(b.w); accv[7] += w1[3] * bfhi(a.w) * bfhi(b.w);
            }
        }
        const u32x4 g = *(const u32x4*)(CB + row * 512 + c8);
        u32x4 o; o.x = pk2(accv[0] * bflo(g.x), accv[1] * bfhi(g.x)); o.y = pk2(accv[2] * bflo(g.y), accv[3] * bfhi(g.y));
        o.z = pk2(accv[4] * bflo(g.z), accv[5] * bfhi(g.z)); o.w = pk2(accv[6] * bflo(g.w), accv[7] * bfhi(g.w));
        *(u32x4*)(UA + row * 1024 + c8) = o;
    }
}

template <int N> __device__ __forceinline__ void bitonic_sort_desc(unsigned* a) {
#pragma unroll
    for (int k = 2; k <= N; k <<= 1)
#pragma unroll
        for (int j = k >> 1; j > 0; j >>= 1)
#pragma unroll
            for (int i = 0; i < N; ++i) { const int l = i ^ j; if (l > i) { const bool desc = (i & k) == 0; const unsigned x = a[i], y = a[l]; const unsigned mx = x > y ? x : y, mn = x > y ? y : x; a[i] = desc ? mx : mn; a[l] = desc ? mn : mx; } }
}
__device__ __forceinline__ void merge_top16(unsigned* a, const unsigned* b) {
#pragma unroll
    for (int i = 0; i < 16; ++i) { const unsigned y = b[15 - i]; a[i] = a[i] > y ? a[i] : y; }
#pragma unroll
    for (int j = 8; j > 0; j >>= 1)
#pragma unroll
        for (int i = 0; i < 16; ++i) if ((i & j) == 0) { const unsigned x = a[i], y = a[i + j]; a[i] = x > y ? x : y; a[i + j] = x > y ? y : x; }
}
__device__ __forceinline__ void top16_of_64(unsigned* a) {
    bitonic_sort_desc<16>(a); bitonic_sort_desc<16>(a + 16); bitonic_sort_desc<16>(a + 32); bitonic_sort_desc<16>(a + 48);
    merge_top16(a, a + 16); merge_top16(a + 32, a + 48); merge_top16(a, a + 32);
}
template <int NR> __device__ __forceinline__ int count_ge(const unsigned* k, unsigned cand) {
    int cv = 0;
#pragma unroll
    for (int r = 0; r < NR; ++r) cv += (k[r] >= cand) ? 1 : 0;
    cv += __builtin_amdgcn_update_dpp(0, cv, 0x141, 0xF, 0xF, false); cv += __builtin_amdgcn_update_dpp(0, cv, 0x1B, 0xF, 0xF, false);
    cv += __builtin_amdgcn_update_dpp(0, cv, 0xB1, 0xF, 0xF, false); cv += __builtin_amdgcn_update_dpp(0, cv, 0x128, 0xF, 0xF, false);
    return __builtin_amdgcn_readlane(cv, 0) + __builtin_amdgcn_readlane(cv, 16) + __builtin_amdgcn_readlane(cv, 32) + __builtin_amdgcn_readlane(cv, 48);
}
template <int NR> __device__ __forceinline__ unsigned descent256(const unsigned* k) {
    unsigned tau = 0u;
    for (int bit = 31; bit >= 0; --bit) {
        const unsigned cand = tau | (1u << bit);
        const int cnt = count_ge<NR>(k, cand);
        if (cnt >= 256) tau = cand;
        if (cnt == 256) break;
    }
    return tau;
}
template <int NR> __device__ __forceinline__ void select_query(const LAS unsigned* row, int nvalid, int tq, LAS unsigned long long* mrow, int lane) {
    unsigned k[NR];
    const bool lowhalf = lane < 32;
#define SEL_LOAD() _Pragma("unroll") for (int r = 0; r < NR; ++r) { const unsigned v = row[64 * r + lane]; k[r] = (64 * r + 64 <= nvalid) ? v : ((64 * r < nvalid && lowhalf) ? v : 0u); }
    SEL_LOAD()
    unsigned tau = 0u;
    if (tq >= 256) {
        if constexpr (NR > 16) {
#pragma unroll
            for (int g = 0; g < NR / 16; ++g) bitonic_sort_desc<16>(k + 16 * g);
            if constexpr (NR == 64) { merge_top16(k, k + 16); merge_top16(k + 32, k + 48); merge_top16(k, k + 32); }
            else if constexpr (NR == 48) { merge_top16(k, k + 16); merge_top16(k, k + 32); }
            else merge_top16(k, k + 16);
            tau = descent256<16>(k);
            const bool bad = __ballot(k[15] >= tau) != 0ull;
            SEL_LOAD()
            if (bad) tau = descent256<NR>(k);
        } else tau = descent256<NR>(k);
    }
#undef SEL_LOAD
    if (tau == 0u) tau = 1u;
#pragma unroll
    for (int r = 0; r < 64; ++r) { const unsigned long long m = r < NR ? __ballot(k[r < NR ? r : 0] >= tau) : 0ull; if (lane == 0) mrow[r * 8] = m; }
}

#ifndef PROBE_SUB
#define PROBE_SUB 0
#endif
__device__ __forceinline__ void indexer_phase(LAS unsigned char* lds, const bf16* QI, const bf16* KI, const float* WI, unsigned long long* MASK, int G, int blk) {
    volatile LAS unsigned long long* pst = (volatile LAS unsigned long long*)(lds + LDS_BYTES - 48);
    LAS unsigned* sc = (LAS unsigned*)lds;
    const int tid = phase_tid(), lane = tid & 63, wave = __builtin_amdgcn_readfirstlane(tid >> 6), r32 = lane & 31, hi = lane >> 5;
    const int ra = (r32 >> 4) & 1, rb = (r32 >> 3) & 1, rc = (r32 >> 2) & 1, rd = r32 & 3;
    bf16x8 aq[2][4]; f32x4 wv[2][2][2]; bf16x8 bk[3][4];
#define IDX_UNIT_GEOM(uid_) const int b = (uid_) >> 9; int j = (uid_) & 511; if (j >= 256) j = 767 - j; const int tq0 = 8 * j; const size_t row0 = (size_t)b * SEQ + tq0; const int nkt = (tq0 + 8 + 31) >> 5; \
        const bf16* kbase = KI + ((size_t)b * SEQ + r32) * 64 + hi * 8;
#define IDX_UNIT_LOAD() do { \
        _Pragma("unroll") for (int rt = 0; rt < 2; ++rt) { \
            const bf16* qp = QI + (row0 + rt * 4 + 2 * rc + ra) * 512 + (4 * rb + rd) * 64 + hi * 8; \
            _Pragma("unroll") for (int d0 = 0; d0 < 4; ++d0) aq[rt][d0] = *(const bf16x8*)(qp + d0 * 16); } } while (0)
    if (blk < T / 8) { IDX_UNIT_GEOM(blk) IDX_UNIT_LOAD(); }
    for (int uid = blk; uid < T / 8; uid += G) {
        IDX_UNIT_GEOM(uid)
#pragma unroll
        for (int rt = 0; rt < 2; ++rt)
#pragma unroll
            for (int a2 = 0; a2 < 2; ++a2) { const float* wp = WI + (row0 + rt * 4 + 2 * hi + a2) * 8; wv[rt][a2][0] = *(const f32x4*)wp; wv[rt][a2][1] = *(const f32x4*)(wp + 4); }
#pragma unroll
        for (int jj = 0; jj < 3; ++jj) { int kt = wave + NWAVES * jj; if (kt >= nkt) kt = nkt - 1;
#pragma unroll
            for (int d0 = 0; d0 < 4; ++d0) bk[jj][d0] = *(const bf16x8*)(kbase + (size_t)kt * 32 * 64 + d0 * 16); }
        if (PROBE_SUB && threadIdx.x == 0) pst[3] = __builtin_amdgcn_s_memrealtime();
#define IDX_TILE(JT) { \
                constexpr int jj = (JT) % 3; \
                int kt = wave + NWAVES * (JT); asm volatile("" : "+s"(kt));       \
                const bool live = kt < nkt; \
                const int key = 32 * kt + r32; \
                f32x16 acc0 = {}, acc1 = {}; \
                _Pragma("unroll") for (int d0 = 0; d0 < 4; ++d0) { acc0 = __builtin_amdgcn_mfma_f32_32x32x16_bf16(aq[0][d0], bk[jj][d0], acc0, 0, 0, 0); acc1 = __builtin_amdgcn_mfma_f32_32x32x16_bf16(aq[1][d0], bk[jj][d0], acc1, 0, 0, 0); } \
                if ((JT) + 3 < NTW) { int ktn = kt + 3 * NWAVES; if (ktn >= nkt) ktn = nkt - 1; \
                    _Pragma("unroll") for (int d0 = 0; d0 < 4; ++d0) bk[jj][d0] = *(const bf16x8*)(kbase + (size_t)ktn * 32 * 64 + d0 * 16); } \
                _Pragma("unroll") for (int rt = 0; rt < 2; ++rt) \
                    _Pragma("unroll") for (int a2 = 0; a2 < 2; ++a2) { \
                        float sv = 0.f; \
                        _Pragma("unroll") for (int i = 0; i < 8; ++i) { const int xb = (int)__float_as_uint(rt ? acc1[8 * a2 + i] : acc0[8 * a2 + i]); sv += __uint_as_float((unsigned)(xb > 0 ? xb : 0)) * wv[rt][a2][i >> 2][i & 3]; } \
                        const int ql = rt * 4 + 2 * hi + a2; \
                        const unsigned ck = (key <= tq0 + ql) ? ((ordf(sv) & 0xfffff000u) | (unsigned)(4095 - key)) : 0u; \
                        sc[live ? ql * 4096 + key : 33792 + lane] = ck; \
                    } \
                __builtin_amdgcn_sched_barrier(0); }
#define IDX_TILES4(J0) IDX_TILE((J0)) IDX_TILE((J0) + 1) IDX_TILE((J0) + 2) IDX_TILE((J0) + 3)
        if (nkt <= 32) { constexpr int NTW = 4; IDX_TILES4(0) }
        else if (nkt <= 64) { constexpr int NTW = 8; IDX_TILES4(0) IDX_TILES4(4) }
        else if (nkt <= 96) { constexpr int NTW = 12; IDX_TILES4(0) IDX_TILES4(4) IDX_TILES4(8) }
        else { constexpr int NTW = 16; IDX_TILES4(0) IDX_TILES4(4) IDX_TILES4(8) IDX_TILES4(12) }
#undef IDX_TILES4
#undef IDX_TILE
        __syncthreads();
        if (uid + G < T / 8) { IDX_UNIT_GEOM(uid + G) IDX_UNIT_LOAD(); }
        if (PROBE_SUB == 1 && threadIdx.x == 0) pst[2] += __builtin_amdgcn_s_memrealtime() - pst[3];
        if (PROBE_SUB == 2 && threadIdx.x == 0) pst[3] = __builtin_amdgcn_s_memrealtime();
        {
            const int tq = tq0 + wave, nvalid = 32 * nkt;
            LAS unsigned long long* mrow = (LAS unsigned long long*)(lds + 131072) + wave;
            const LAS unsigned* rowp = sc + wave * 4096;
            if (nvalid <= 1024) select_query<16>(rowp, nvalid, tq, mrow, lane);
            else if (nvalid <= 2048) select_query<32>(rowp, nvalid, tq, mrow, lane);
            else if (nvalid <= 3072) select_query<48>(rowp, nvalid, tq, mrow, lane);
            else select_query<64>(rowp, nvalid, tq, mrow, lane);
        }
        __syncthreads();
        __hip_atomic_store(MASK + ((size_t)b * 64 + (tid >> 3)) * SEQ + tq0 + (tid & 7), ((const LAS unsigned long long*)(lds + 131072))[tid], __ATOMIC_RELAXED, __HIP_MEMORY_SCOPE_AGENT);
        if (PROBE_SUB == 2 && threadIdx.x == 0) pst[2] += __builtin_amdgcn_s_memrealtime() - pst[3];
    }
}

namespace att {
constexpr int KCP = 1040, KSLOT = 8 * KCP, VDH = 4160, VSLOT = 2 * VDH;
constexpr int L_K = 0, L_V = 4 * KSLOT, L_OST = L_V + 4 * VSLOT, L_END = L_OST + NWAVES * 4096;
__device__ __forceinline__ int crow(int r, int hi) { return (r & 3) + 8 * (r >> 2) + 4 * hi; }
#define SBAR() __builtin_amdgcn_sched_barrier(0)
__device__ __forceinline__ void qkt(f32x16& p0, f32x16& p1, const LAS unsigned char* kb, const bf16x8* qr, const f32x16& negm) {
#pragma unroll
    for (int d0 = 0; d0 < 4; ++d0) {
        const bf16x8 b0 = *(const LAS bf16x8*)(kb + d0 * 2 * KCP);
        const bf16x8 b1 = *(const LAS bf16x8*)(kb + d0 * 2 * KCP + 512);
        if (d0 == 0) { p0 = __builtin_amdgcn_mfma_f32_32x32x16_bf16(b0, qr[0], negm, 0, 0, 0); p1 = __builtin_amdgcn_mfma_f32_32x32x16_bf16(b1, qr[0], negm, 0, 0, 0); }
        else { p0 = __builtin_amdgcn_mfma_f32_32x32x16_bf16(b0, qr[d0], p0, 0, 0, 0); p1 = __builtin_amdgcn_mfma_f32_32x32x16_bf16(b1, qr[d0], p1, 0, 0, 0); } }
}
__device__ __forceinline__ void pv(f32x16* o, f32x16& osum, int vb, bf16x8 pa0, bf16x8 pa1, bf16x8 pa2, bf16x8 pa3) {
    {
        const bf16x8 ones = {0x3f80, 0x3f80, 0x3f80, 0x3f80, 0x3f80, 0x3f80, 0x3f80, 0x3f80};
        osum = __builtin_amdgcn_mfma_f32_32x32x16_bf16(pa0, ones, osum, 0, 0, 0); osum = __builtin_amdgcn_mfma_f32_32x32x16_bf16(pa1, ones, osum, 0, 0, 0);
        osum = __builtin_amdgcn_mfma_f32_32x32x16_bf16(pa2, ones, osum, 0, 0, 0); osum = __builtin_amdgcn_mfma_f32_32x32x16_bf16(pa3, ones, osum, 0, 0, 0);
    }
#pragma unroll
    for (int d0 = 0; d0 < 2; ++d0) { s16x4 lo[4], hi[4];
#pragma unroll
        for (int ks = 0; ks < 4; ++ks) {
            asm volatile("ds_read_b64_tr_b16 %0,%1 offset:%c2" : "=&v"(lo[ks]) : "v"(vb), "i"(d0 * VDH + ks * 1024) : "memory");
            asm volatile("ds_read_b64_tr_b16 %0,%1 offset:%c2" : "=&v"(hi[ks]) : "v"(vb), "i"(d0 * VDH + ks * 1024 + 512) : "memory"); }
        asm volatile("s_waitcnt lgkmcnt(0)" ::: "memory"); SBAR();
#define PK(k) (bf16x8){lo[k][0], lo[k][1], lo[k][2], lo[k][3], hi[k][0], hi[k][1], hi[k][2], hi[k][3]}
        o[d0] = __builtin_amdgcn_mfma_f32_32x32x16_bf16(pa0, PK(0), o[d0], 0, 0, 0);
        o[d0] = __builtin_amdgcn_mfma_f32_32x32x16_bf16(pa1, PK(1), o[d0], 0, 0, 0);
        o[d0] = __builtin_amdgcn_mfma_f32_32x32x16_bf16(pa2, PK(2), o[d0], 0, 0, 0);
        o[d0] = __builtin_amdgcn_mfma_f32_32x32x16_bf16(pa3, PK(3), o[d0], 0, 0, 0);
#undef PK
    }
}

__device__ __forceinline__ void attn_phase(LAS unsigned char* lds, const bf16* Q, const bf16* K, const bf16* V, const unsigned long long* MASK, const float* qnw, const float* knw, bf16* UA, int G, int blk) {
    const int tid = phase_tid(), lane = tid & 63, r32 = lane & 31, hi = lane >> 5, wid = __builtin_amdgcn_readfirstlane(tid >> 6);
    float mq = fabsf(qnw[lane]), mk = fabsf(knw[lane]);
#pragma unroll
    for (int o = 1; o < 64; o <<= 1) { mq = fmaxf(mq, __shfl_xor(mq, o)); mk = fmaxf(mk, __shfl_xor(mk, o)); }
    const float nb = -(8.f * 1.4426950408889634f) * mq * mk;
    f32x16 negm;
#pragma unroll
    for (int r = 0; r < 16; ++r) negm[r] = nb;
    const unsigned kdst = L_K + (tid & 7) * KCP + (tid >> 3) * 16;
    const unsigned vdst = L_V + ((tid & 7) >> 2) * VDH + ((tid >> 3) >> 4) * 1024 + ((tid >> 3) & 15) * 64 + (tid & 3) * 16;
    const LAS unsigned char* kp0 = lds + L_K + hi * KCP + r32 * 16;
    const int vb0 = (int)(uintptr_t)(lds + L_V) + ((lane >> 4) & 1) * 32 + (lane & 3) * 8 + (4 * hi + ((lane & 15) >> 2)) * 64;
    for (int uid = blk; uid < 2048; uid += G) {
        const int ui = uid >> 8; int c = uid & 255; c = (c & 7) * 32 + (c >> 3);
        const int bh = c >> 1, s = c & 1, pp = ui >> 1, qb = (ui & 1) ? 15 - (2 * pp + s) : (2 * pp + s);
        const int b = bh >> 3, h = bh & 7, q0 = qb * 256;
        const size_t rowbase = (size_t)b * SEQ;
        const bf16* Qw = Q + (rowbase + q0 + wid * 32) * 512 + h * 64;
        bf16* Ow = UA + (rowbase + q0 + wid * 32) * 1024 + 512 + h * 64;
        bf16x8 qr[4];
#pragma unroll
        for (int d0 = 0; d0 < 4; ++d0) qr[d0] = *(const bf16x8*)(Qw + (size_t)r32 * 512 + d0 * 16 + hi * 8);
        const int NT = 4 * (qb + 1);
        const unsigned long long* mptr = MASK + (size_t)b * 64 * SEQ + q0 + wid * 32 + r32;
        const bf16* ksrc = K + ((size_t)bh * SEQ) * 64 + tid * 8;
        const bf16* vsrc = V + ((size_t)bh * SEQ) * 64 + tid * 8;
        f32x16 o[2]; o[0] = f32x16{}; o[1] = f32x16{};
        f32x16 osum = f32x16{};
        const int T2 = NT / 2;
        u32x4 kreg[2][2], vreg[2][2]; unsigned long long mwq[2][2], mw[2];
#pragma unroll
        for (int sb_ = 0; sb_ < 2; ++sb_) {
            kreg[0][sb_] = *(const u32x4*)(ksrc + (size_t)sb_ * 4096); vreg[0][sb_] = *(const u32x4*)(vsrc + (size_t)sb_ * 4096); mw[sb_] = mptr[(size_t)sb_ * SEQ];
            kreg[1][sb_] = *(const u32x4*)(ksrc + (size_t)(2 + sb_) * 4096); vreg[1][sb_] = *(const u32x4*)(vsrc + (size_t)(2 + sb_) * 4096); mwq[1][sb_] = mptr[(size_t)(2 + sb_) * SEQ]; mwq[0][sb_] = 0ull;
            *(LAS u32x4*)(lds + kdst + sb_ * KSLOT) = kreg[0][sb_]; *(LAS u32x4*)(lds + vdst + sb_ * VSLOT) = vreg[0][sb_];
        }
        __syncthreads();
        const int qmax = q0 + wid * 32 + 31;
#define ATT_SUB(P, SB) if (64 * (2 * t + (SB)) <= qmax) { \
                f32x16 p0, p1; \
                qkt(p0, p1, kp0 + ((P) * 2 + (SB)) * KSLOT, qr, negm); \
                const unsigned mlo = (unsigned)mw[SB] >> (4 * hi), mhi = (unsigned)(mw[SB] >> 32) >> (4 * hi); \
                _Pragma("unroll") for (int r = 0; r < 16; ++r) { p0[r] = __builtin_amdgcn_exp2f(p0[r]); p1[r] = __builtin_amdgcn_exp2f(p1[r]); } \
                  \
                unsigned pk_[16]; \
                _Pragma("unroll") for (int i = 0; i < 8; ++i) { const int bp = ((2 * i) & 3) + 8 * ((2 * i) >> 2); \
                    const unsigned m0a = (unsigned)__builtin_amdgcn_sbfe((int)mlo, bp, 1), m0b = (unsigned)__builtin_amdgcn_sbfe((int)mlo, bp + 1, 1); \
                    const unsigned m1a = (unsigned)__builtin_amdgcn_sbfe((int)mhi, bp, 1), m1b = (unsigned)__builtin_amdgcn_sbfe((int)mhi, bp + 1, 1); \
                    pk_[i] = pk2(p0[2 * i], p0[2 * i + 1]) & __builtin_amdgcn_perm(m0b, m0a, 0x05040100u); \
                    pk_[8 + i] = pk2(p1[2 * i], p1[2 * i + 1]) & __builtin_amdgcn_perm(m1b, m1a, 0x05040100u); } \
                const u32x4 pw0 = (u32x4){pk_[0], pk_[1], pk_[2], pk_[3]}, pw1 = (u32x4){pk_[4], pk_[5], pk_[6], pk_[7]}; \
                const u32x4 pw2 = (u32x4){pk_[8], pk_[9], pk_[10], pk_[11]}, pw3 = (u32x4){pk_[12], pk_[13], pk_[14], pk_[15]}; \
                pv(o, osum, vb0 + ((P) * 2 + (SB)) * VSLOT, __builtin_bit_cast(bf16x8, pw0), __builtin_bit_cast(bf16x8, pw1), __builtin_bit_cast(bf16x8, pw2), __builtin_bit_cast(bf16x8, pw3)); \
            }
#define ATT_STEP(P)    \
        { \
            { const int tp = (t + 2 < T2) ? t + 2 : T2 - 1; \
              _Pragma("unroll") for (int sb_ = 0; sb_ < 2; ++sb_) { kreg[P][sb_] = *(const u32x4*)(ksrc + (size_t)(2 * tp + sb_) * 4096); vreg[P][sb_] = *(const u32x4*)(vsrc + (size_t)(2 * tp + sb_) * 4096); mwq[P][sb_] = mptr[(size_t)(2 * tp + sb_) * SEQ]; } } \
            ATT_SUB(P, 0) \
            ATT_SUB(P, 1) \
            _Pragma("unroll") for (int sb_ = 0; sb_ < 2; ++sb_) { *(LAS u32x4*)(lds + kdst + ((1 - (P)) * 2 + sb_) * KSLOT) = kreg[1 - (P)][sb_]; *(LAS u32x4*)(lds + vdst + ((1 - (P)) * 2 + sb_) * VSLOT) = vreg[1 - (P)][sb_]; mw[sb_] = mwq[1 - (P)][sb_]; } \
            __syncthreads(); \
        }
        for (int t = 0; t < T2; t += 2) {
            ATT_STEP(0)
            ++t;
            ATT_STEP(1)
            --t;
        }
#undef ATT_STEP
#undef ATT_SUB
        float rli[16];
#pragma unroll
        for (int r = 0; r < 16; ++r) rli[r] = __builtin_amdgcn_rcpf(osum[r]);
        LAS bf16* stg = (LAS bf16*)(lds + L_OST) + wid * 2048;
#pragma unroll
        for (int r = 0; r < 16; ++r) { const int orow = crow(r, hi);
#pragma unroll
            for (int d0 = 0; d0 < 2; ++d0) stg[orow * 64 + d0 * 32 + r32] = (bf16)(pk2(o[d0][r] * rli[r], 0.f) & 0xffffu); }
        LDS_WAIT();
#pragma unroll
        for (int i = 0; i < 4; ++i) { const int row = i * 8 + (lane >> 3), ch = lane & 7; const u32x4 v = *(const LAS u32x4*)(stg + row * 64 + ch * 8); *(u32x4*)(Ow + (size_t)row * 1024 + ch * 8) = v; }
        LDS_WAIT();
    }
}
#undef SBAR
}

__device__ __forceinline__ void peer_route_phase(LAS unsigned char* lds, const bf16* PQ, const bf16* SK, unsigned short* EIDX, float* EG, int G, int blk) {
    const int tid = phase_tid(), lane = tid & 63, r32 = lane & 31, hi = lane >> 5, wave = __builtin_amdgcn_readfirstlane(tid >> 6);
    LAS unsigned* win = (LAS unsigned*)(lds + wave * 12288);
    LAS unsigned* fwn = win + 2 * 16 * 64;
    const int gw = blk * NWAVES + wave, NGW = G * NWAVES, h = gw & 7;
    for (int tg = gw >> 3; tg < T / 32; tg += NGW >> 3) {
        const size_t t0 = (size_t)tg * 32;
#pragma unroll 1
        for (int half = 0; half < 2; ++half) {
            const int p = 2 * h + half;
            bf16x8 bq[4];
#pragma unroll
            for (int d0 = 0; d0 < 4; ++d0) bq[d0] = *(const bf16x8*)(PQ + (t0 + r32) * 1024 + 128 * h + 64 * half + 16 * d0 + 8 * hi);
            unsigned ck[64];
#pragma unroll
            for (int nb = 0; nb < 4; ++nb) {
                f32x16 acc = {};
#pragma unroll
                for (int d0 = 0; d0 < 4; ++d0) { const bf16x8 a = *(const bf16x8*)(SK + ((size_t)p * 128 + 32 * nb + r32) * 64 + 16 * d0 + 8 * hi); acc = __builtin_amdgcn_mfma_f32_32x32x16_bf16(a, bq[d0], acc, 0, 0, 0); }
#pragma unroll
                for (int r = 0; r < 16; ++r) ck[nb * 16 + r] = (ordf(acc[r]) & ~0x7fu) | (unsigned)(127 - (32 * nb + att::crow(r, hi)));
            }
            top16_of_64(ck);
            unsigned pb[16];
#pragma unroll
            for (int i = 0; i < 16; ++i) { auto rr = __builtin_amdgcn_permlane32_swap(ck[i], ck[i], false, false); pb[i] = hi ? rr[0] : rr[1]; }
            merge_top16(ck, pb);
#pragma unroll
            for (int i = 0; i < 16; ++i) win[(half * 16 + i) * 64 + lane] = ck[i];
        }
        LDS_WAIT();
        float v0[16], v1[16];
#pragma unroll
        for (int i = 0; i < 16; ++i) { v0[i] = unordf(win[i * 64 + lane] & ~0x7fu); v1[i] = unordf(win[(16 + i) * 64 + lane] & ~0x7fu); }
        unsigned c2[64];
        {
            int n = 0;
#pragma unroll
            for (int i = 0; i < 16; ++i)
#pragma unroll
                for (int j = 0; j < 16; ++j) if ((i + 1) * (j + 1) <= 16) { c2[n] = (ordf(v0[i] + v1[j]) & ~0xffu) | (unsigned)(255 - (16 * i + j)); ++n; }
#pragma unroll
            for (int q = 50; q < 64; ++q) c2[q] = 0u;
        }
        top16_of_64(c2);
        float sc[16]; unsigned ex[16];
#pragma unroll
        for (int k = 0; k < 16; ++k) {
            const unsigned f = c2[k]; const int idx = 255 - (int)(f & 0xffu), i = idx >> 4, j = idx & 15;
            const unsigned w0 = win[i * 64 + lane], w1 = win[(16 + j) * 64 + lane];
            ex[k] = (127u - (w0 & 0x7fu)) * 128u + (127u - (w1 & 0x7fu));
            sc[k] = unordf(w0 & ~0x7fu) + unordf(w1 & ~0x7fu);
        }
        const float mx = sc[0];
        float sum = 0.f;
#pragma unroll
        for (int k = 0; k < 16; ++k) { sc[k] = __expf(sc[k] - mx); sum += sc[k]; }
        const float inv = 1.f / sum;
#pragma unroll
        for (int k = 0; k < 16; ++k) sc[k] *= inv;
        if (hi == 0) {
            unsigned short* ep = EIDX + (t0 + r32) * 128 + h * 16; float* gp = EG + (t0 + r32) * 128 + h * 16;
            *(u32x4*)ep = (u32x4){ex[0] | (ex[1] << 16), ex[2] | (ex[3] << 16), ex[4] | (ex[5] << 16), ex[6] | (ex[7] << 16)};
            *(u32x4*)(ep + 8) = (u32x4){ex[8] | (ex[9] << 16), ex[10] | (ex[11] << 16), ex[12] | (ex[13] << 16), ex[14] | (ex[15] << 16)};
#pragma unroll
            for (int q = 0; q < 4; ++q) *(f32x4*)(gp + 4 * q) = (f32x4){sc[4 * q], sc[4 * q + 1], sc[4 * q + 2], sc[4 * q + 3]};
        }
        LDS_WAIT();
    }
}

__device__ __forceinline__ f32x2 gelu_pk(f32x2 v) {
    const f32x2 av = __builtin_elementwise_abs(v), dd = av * 0.2316418882f + 1.0f;
    f32x2 tt; tt.x = __builtin_amdgcn_rcpf(dd.x); tt.y = __builtin_amdgcn_rcpf(dd.y);
    f32x2 q = tt * 0.5307027145f + (-0.7265760135f); q = q * tt + 0.7107068705f; q = q * tt + (-0.142248368f); q = q * tt + 0.127414796f; q = q * tt;
    const f32x2 sq = (v * v) * (-0.72134752044f);
    f32x2 ee; ee.x = __builtin_amdgcn_exp2f(sq.x); ee.y = __builtin_amdgcn_exp2f(sq.y);
    const f32x2 mm = v * (q * ee), rr = v - mm;
    f32x2 o; o.x = v.x < 0.f ? mm.x : rr.x; o.y = v.y < 0.f ? mm.y : rr.y; return o;
}
__device__ __forceinline__ float dpp_f(float x, const int ctrl_sel) {
    const int xi = (int)__float_as_uint(x); int r;
    if (ctrl_sel == 0) r = __builtin_amdgcn_update_dpp(0, xi, 0x128, 0xF, 0xF, false);
    else if (ctrl_sel == 1) r = __builtin_amdgcn_update_dpp(0, xi, 0x141, 0xF, 0xF, false);
    else if (ctrl_sel == 2) r = __builtin_amdgcn_update_dpp(0, xi, 0x1B, 0xF, 0xF, false);
    else r = __builtin_amdgcn_update_dpp(0, xi, 0xB1, 0xF, 0xF, false);
    return __uint_as_float((unsigned)r);
}
__device__ __forceinline__ float reduce8_rows(float* d, int lane) {
#pragma unroll
    for (int i = 0; i < 4; ++i) { auto r = __builtin_amdgcn_permlane32_swap(__float_as_uint(d[i]), __float_as_uint(d[i + 4]), false, false); d[i] = __uint_as_float(r[0]) + __uint_as_float(r[1]); }
#pragma unroll
    for (int i = 0; i < 2; ++i) { auto r = __builtin_amdgcn_permlane16_swap(__float_as_uint(d[i]), __float_as_uint(d[i + 2]), false, false); d[i] = __uint_as_float(r[0]) + __uint_as_float(r[1]); }
    const bool up = lane & 8; const float keep = up ? d[1] : d[0], send = up ? d[0] : d[1];
    float x = keep + dpp_f(send, 0);
    x += dpp_f(x, 1); x += dpp_f(x, 2); x += dpp_f(x, 3);
    return x;
}
typedef int v8i_t __attribute__((ext_vector_type(8)));
#define HSC_TEST 0
__device__ __forceinline__ void peer_u_simple(LAS unsigned char* lds, const bf16* H2, tab_ptr PU, const float* RSU, const float* RSV, unsigned short* EIDX, const float* EG, float* COEF, unsigned short* CCODE, float* CSC, int G, int blk) {
    const int tid_ = phase_tid(); const int lane = tid_ & 63, wave = __builtin_amdgcn_readfirstlane(tid_ >> 6);
    LAS unsigned char* wl = lds + wave * 13632;
    constexpr int RP = 528;
    LAS int* sid = (LAS int*)(wl + 8448);
    LAS float* sgt = (LAS float*)(wl + 8448 + 512);
    LAS float* res = (LAS float*)(wl + 8448 + 1024);
    LAS float* sul = (LAS float*)(wl + 9536);
    LAS float* gtl = (LAS float*)(wl + 9536 + 2048);
    const unsigned c0 = 16u * (lane & 31), d0 = (lane < 32 ? 0u : 528u) + c0;
    const unsigned long long lt = (1ull << lane) - 1ull;
    const int n16 = lane & 15, g4 = lane >> 4;
    const int stride = G * NWAVES;
    for (int tb = blk * NWAVES + wave; tb < T; tb += 4 * stride) {
        int idlo[4], idhi[4]; float clo[4], chi[4]; int tt[4]; int tcl[4]; int hsc[4];
        int lp = (int)threadIdx.x; asm volatile("" : "+v"(lp)); lp &= 63;
        float g_lo[4], g_hi[4]; u32x4 hqa[4], hqb[4];
#pragma unroll
        for (int i = 0; i < 4; ++i) {
            const bool act_i = tb + i * stride < T; const int t = act_i ? tb + i * stride : tb; tt[i] = act_i ? t : -1; tcl[i] = t;
            const unsigned short* ep = EIDX + (size_t)t * 128;
            idlo[i] = ep[lp]; idhi[i] = ep[64 + lp]; g_lo[i] = EG[(size_t)t * 128 + lp]; g_hi[i] = EG[(size_t)t * 128 + 64 + lp];
            hqa[i] = *(const u32x4*)(H2 + (size_t)t * 1024 + 16 * lp); hqb[i] = *(const u32x4*)(H2 + (size_t)t * 1024 + 16 * lp + 8);
        }
        __builtin_amdgcn_sched_barrier(0);
        u32x4 hq[8][4];
        {
            const int tl = (lp & 2) ? ((lp & 1) ? tcl[3] : tcl[2]) : ((lp & 1) ? tcl[1] : tcl[0]);
            const bf16* hp = H2 + (size_t)tl * 1024 + 32 * (lp >> 4);
#pragma unroll
            for (int s8 = 0; s8 < 8; ++s8) { hq[s8][0] = *(const u32x4*)(hp + 128 * s8); hq[s8][1] = *(const u32x4*)(hp + 128 * s8 + 8); hq[s8][2] = *(const u32x4*)(hp + 128 * s8 + 16); hq[s8][3] = *(const u32x4*)(hp + 128 * s8 + 24); }
        }
        __builtin_amdgcn_sched_barrier(0);
        float rsu_lo[4], rsu_hi[4], rsv_lo[4], rsv_hi[4];
#pragma unroll
        for (int i = 0; i < 4; ++i) {
            {
                typedef unsigned short u16x2_t __attribute__((ext_vector_type(2)));
                u16x2_t mx = {0, 0};
                const unsigned hw[8] = {hqa[i].x, hqa[i].y, hqa[i].z, hqa[i].w, hqb[i].x, hqb[i].y, hqb[i].z, hqb[i].w};
#pragma unroll
                for (int j = 0; j < 8; ++j) mx = __builtin_elementwise_max(mx, __builtin_bit_cast(u16x2_t, hw[j] & 0x7fff7fffu));
                const unsigned m = wave_max_dpp(mx.x > mx.y ? (unsigned)mx.x : (unsigned)mx.y);
                const float tq = __uint_as_float(m << 16) * (1.f / 7.5f);
                hsc[i] = tq > 1.f ? (int)((__float_as_uint(tq) - 1u) >> 23) - 126 + HSC_TEST : HSC_TEST;
            }
            int il = idlo[i], ih = idhi[i]; float gl = g_lo[i], gh = g_hi[i];
            const int blo = il >> 10, bhi = ih >> 10; int plo = 0, phi = 0, base = 0;
#pragma unroll
            for (int bb = 0; bb < 16; ++bb) {
                const unsigned long long ml = __ballot(blo == bb), mh = __ballot(bhi == bb);
                const int nl = __popcll(ml);
                plo = (blo == bb) ? base + __popcll(ml & lt) : plo;
                phi = (bhi == bb) ? base + nl + __popcll(mh & lt) : phi;
                base += nl + __popcll(mh);
            }
            sid[plo] = il; sid[phi] = ih; sgt[plo] = gl; sgt[phi] = gh;
            il = sid[lp]; ih = sid[64 + lp]; gl = sgt[lp]; gh = sgt[64 + lp];
            if (tt[i] >= 0) { unsigned short* ep = EIDX + (size_t)tcl[i] * 128; ep[lp] = (unsigned short)il; ep[64 + lp] = (unsigned short)ih; }
            rsu_lo[i] = RSU[il]; rsu_hi[i] = RSU[ih]; rsv_lo[i] = RSV[il]; rsv_hi[i] = RSV[ih];
            idlo[i] = il; idhi[i] = ih; g_lo[i] = gl; g_hi[i] = gh; clo[i] = 0.f; chi[i] = 0.f;
        }
        v8i_t hB[8];
        {
            const int el = (lp & 2) ? ((lp & 1) ? hsc[3] : hsc[2]) : ((lp & 1) ? hsc[1] : hsc[0]);
            const float hdiv = __uint_as_float((unsigned)(127 + el) << 23);
#pragma unroll
            for (int s8 = 0; s8 < 8; ++s8) {
                typedef unsigned v16u_t __attribute__((ext_vector_type(16)));
                const v16u_t wv = {hq[s8][0].x, hq[s8][0].y, hq[s8][0].z, hq[s8][0].w, hq[s8][1].x, hq[s8][1].y, hq[s8][1].z, hq[s8][1].w, hq[s8][2].x, hq[s8][2].y, hq[s8][2].z, hq[s8][2].w, hq[s8][3].x, hq[s8][3].y, hq[s8][3].z, hq[s8][3].w};
                const v6u_t e6 = __builtin_amdgcn_cvt_scalef32_pk32_fp6_bf16(__builtin_bit_cast(v32bf_t, wv), hdiv);
                hB[s8] = (v8i_t){(int)e6[0], (int)e6[1], (int)e6[2], (int)e6[3], (int)e6[4], (int)e6[5], 0, 0};
            }
        }
#pragma unroll
        for (int i = 0; i < 4; ++i) {
            const float hs = __uint_as_float((unsigned)(127 + hsc[i]) << 23);
            sul[i * 128 + lp] = rsu_lo[i] * hs; sul[i * 128 + 64 + lp] = rsu_hi[i] * hs;
            gtl[i * 128 + lp] = g_lo[i] * rsv_lo[i]; gtl[i * 128 + 64 + lp] = g_hi[i] * rsv_hi[i];
        }
#define PU_LOAD(RB, HH, P) do { const int hh_ = (HH), l0_ = (hh_ & 7) * 8; \
            const int idA_ = hh_ < 8 ? idlo[2 * (P)] : idhi[2 * (P)], idB_ = hh_ < 8 ? idlo[2 * (P) + 1] : idhi[2 * (P) + 1]; \
            _Pragma("unroll") for (int j = 0; j < 8; ++j) { const int idq_ = j < 4 ? idA_ : idB_; const int lq_ = l0_ + 2 * (j & 3); \
                const unsigned o0_ = 512u * (unsigned)__builtin_amdgcn_readlane(idq_, lq_), o1_ = 512u * (unsigned)__builtin_amdgcn_readlane(idq_, lq_ + 1); \
                RB[j] = *(const u32x4*)(PU + ((lane < 32 ? o0_ : o1_) + c0)); } } while (0)
#define PU_TOLDS(RB) do { _Pragma("unroll") for (int j = 0; j < 8; ++j) *(LAS u32x4*)(wl + j * 2 * RP + d0) = RB[j]; } while (0)
#define PU_COMP(HH, P) do { const int hh_ = (HH), l0_ = (hh_ & 7) * 8; \
            f32x4 acc_ = {0.f, 0.f, 0.f, 0.f}; const LAS unsigned char* ap_ = wl + n16 * RP + 16 * g4; \
            _Pragma("unroll") for (int s8 = 0; s8 < 8; ++s8) { \
                const u32x4 a0_ = *(const LAS u32x4*)(ap_ + 64 * s8); \
                const v8i_t A_ = {(int)a0_.x, (int)a0_.y, (int)a0_.z, (int)a0_.w, 0, 0, 0, 0}; \
                acc_ = __builtin_amdgcn_mfma_scale_f32_16x16x128_f8f6f4(A_, hB[s8], acc_, 4, 2, 0, 0x7f7f7f7f, 0, 0x7f7f7f7f); } \
            asm volatile("s_nop 15\n\ts_nop 15" : "+v"(acc_));                                          \
            if (g4 < 2 ? n16 == 2 * (P) : n16 == 2 * (P) + 1) *(LAS f32x4*)(res + 4 * g4) = acc_;        \
            const int r = (lane - l0_) & 7;                                         \
            const float a0 = res[r], a1 = res[8 + r]; \
            const int so_ = (hh_ < 8 ? 0 : 64) + lane; \
            const f32x2 gg = gelu_pk((f32x2){a0 * sul[2 * (P) * 128 + so_], a1 * sul[(2 * (P) + 1) * 128 + so_]}); \
            const float gA_ = gtl[2 * (P) * 128 + so_], gB_ = gtl[(2 * (P) + 1) * 128 + so_]; \
            const bool mine = (lane >> 3) == (hh_ & 7); \
            if (hh_ < 8) { clo[2 * (P)] = mine ? gA_ * gg.x : clo[2 * (P)]; clo[2 * (P) + 1] = mine ? gB_ * gg.y : clo[2 * (P) + 1]; } \
            else         { chi[2 * (P)] = mine ? gA_ * gg.x : chi[2 * (P)]; chi[2 * (P) + 1] = mine ? gB_ * gg.y : chi[2 * (P) + 1]; } } while (0)
        {
            u32x4 rb[8];
            PU_LOAD(rb, 0, 0);
#pragma unroll 1
            for (int h = 0; h < 16; ++h) {
                PU_TOLDS(rb);
                __builtin_amdgcn_sched_barrier(0);
                PU_LOAD(rb, h, 1);
                __builtin_amdgcn_sched_barrier(0);
                PU_COMP(h, 0);
                __builtin_amdgcn_sched_barrier(0);
                PU_TOLDS(rb);
                __builtin_amdgcn_sched_barrier(0);
                PU_LOAD(rb, h < 15 ? h + 1 : 15, 0);
                __builtin_amdgcn_sched_barrier(0);
                PU_COMP(h, 1);
                __builtin_amdgcn_sched_barrier(0);
            }
        }
#undef PU_LOAD
#undef PU_TOLDS
#undef PU_COMP
        int le = (int)threadIdx.x; asm volatile("" : "+v"(le)); le &= 63;
#pragma unroll
        for (int i = 0; i < 4; ++i) {
            const unsigned mxb = wave_max_dpp(max(__float_as_uint(clo[i]) & 0x7fffffffu, __float_as_uint(chi[i]) & 0x7fffffffu));
            const float tq = __uint_as_float(mxb) * (1.f / 7.5f);
            int ec = (int)((__float_as_uint(tq) - 1u) >> 23) - 126; ec = ec < -100 ? -100 : ec;
            const float sc = __uint_as_float((unsigned)(127 + ec) << 23), isc = __uint_as_float((unsigned)(127 - ec) << 23);
            const float ql = clo[i] * isc, qh = chi[i] * isc;
            const unsigned hl = enc_e2m3(ql), hh = enc_e2m3(qh);
            const unsigned ll = enc_e2m3((ql - dec_e2m3(hl)) * 16.f), lh = enc_e2m3((qh - dec_e2m3(hh)) * 16.f);
            if (tt[i] >= 0) {
                COEF[(size_t)tt[i] * 128 + le] = clo[i]; COEF[(size_t)tt[i] * 128 + 64 + le] = chi[i];
                CCODE[(size_t)tt[i] * 128 + le] = (unsigned short)(hl | (ll << 8)); CCODE[(size_t)tt[i] * 128 + 64 + le] = (unsigned short)(hh | (lh << 8));
                if (le == 0) CSC[tt[i]] = sc;
            }
        }
    }
}
__device__ __forceinline__ void place6(unsigned code, unsigned sh, unsigned& d0, unsigned& d1, unsigned& d2) {
    const unsigned long long lo = sh < 64u ? ((unsigned long long)code << (sh & 63u)) : 0ull;
    d0 = (unsigned)lo; d1 = (unsigned)(lo >> 32);
    d2 = sh >= 64u ? code << ((sh - 64u) & 31u) : (sh > 58u ? code >> ((64u - sh) & 31u) : 0u);
}
__device__ __forceinline__ void peer_v_phase(LAS unsigned char* lds, tab_ptr PV, const unsigned short* EIDX, const unsigned short* CCODE, const float* CSC, const float* MOD, float* OUT, int G, int blk) {
    const int tid_ = phase_tid(); const int lane = tid_ & 63, wave = __builtin_amdgcn_readfirstlane(tid_ >> 6);
    LAS unsigned char* wl = lds + wave * 16640;
    constexpr int RP = 1040;
    const int m16 = lane & 15, g4 = lane >> 4;
    const unsigned sh6 = 6u * (unsigned)m16;
    const unsigned l12 = 12u * (unsigned)lane;
    const int stride = G * NWAVES;
    for (int tb = blk * NWAVES + wave; tb < T; tb += 4 * stride) {
        f32x4 acc[4][4]; unsigned idw[4], cww[4]; int tt[4]; bool act[4];
        int ln = (int)threadIdx.x; asm volatile("" : "+v"(ln)); ln &= 63;
#pragma unroll
        for (int i = 0; i < 4; ++i) {
            act[i] = tb + i * stride < T; const int t = act[i] ? tb + i * stride : tb; tt[i] = t;
#pragma unroll
            for (int j = 0; j < 4; ++j) acc[i][j] = (f32x4){0.f, 0.f, 0.f, 0.f};
            const unsigned short* ep = EIDX + (size_t)t * 128;
            idw[i] = (unsigned)ep[ln] | ((unsigned)ep[64 + ln] << 16);
            cww[i] = (unsigned)CCODE[(size_t)t * 128 + ln] | ((unsigned)CCODE[(size_t)t * 128 + 64 + ln] << 16);
        }
#define PV_LOAD(HH, P) do { const int hh_ = (HH), l0_ = (hh_ & 7) * 8; \
            const int hs_ = hh_ < 8 ? 0 : 16; \
            _Pragma("unroll") for (int k = 0; k < 8; ++k) { const unsigned e = ((unsigned)__builtin_amdgcn_readlane((int)idw[2 * (P)], l0_ + k) >> hs_) & 0xffffu; rb[k] = *(const U3*)(PV + (e * 768u + l12)); } \
            _Pragma("unroll") for (int k = 0; k < 8; ++k) { const unsigned e = ((unsigned)__builtin_amdgcn_readlane((int)idw[2 * (P) + 1], l0_ + k) >> hs_) & 0xffffu; rb[8 + k] = *(const U3*)(PV + (e * 768u + l12)); } } while (0)
#define PV_TOLDS() do { _Pragma("unroll") for (int k = 0; k < 16; ++k) { LAS unsigned* q_ = (LAS unsigned*)(wl + k * RP + 16 * lane); q_[0] = rb[k].x; q_[1] = rb[k].y; q_[2] = rb[k].z; } } while (0)
#define PV_COMP(HH, P) do { const int hh_ = (HH), l0_ = (hh_ & 7) * 8; \
            _Pragma("unroll") for (int tk = 0; tk < 2; ++tk) { \
                const unsigned cw_ = hh_ < 8 ? cww[2 * (P) + tk] & 0xffffu : cww[2 * (P) + tk] >> 16; \
                const unsigned w0_ = (unsigned)__shfl((int)cw_, l0_ + 2 * g4), w1_ = (unsigned)__shfl((int)cw_, l0_ + 2 * g4 + 1); \
                unsigned h0_, h1_, h2_, h3_, h4_, h5_, q0_, q1_, q2_, q3_, q4_, q5_; \
                place6(w0_ & 63u, sh6, h0_, h1_, h2_); place6(w1_ & 63u, sh6, h3_, h4_, h5_); \
                place6((w0_ >> 8) & 63u, sh6, q0_, q1_, q2_); place6((w1_ >> 8) & 63u, sh6, q3_, q4_, q5_); \
                const v8i_t Ah_ = {(int)h0_, (int)h1_, (int)h2_, (int)h3_, (int)h4_, (int)h5_, 0, 0}, Al_ = {(int)q0_, (int)q1_, (int)q2_, (int)q3_, (int)q4_, (int)q5_, 0, 0}; \
                const LAS unsigned char* bp_ = wl + (8 * tk + 2 * g4) * RP + 16 * m16; \
                _Pragma("unroll") for (int T4 = 0; T4 < 4; ++T4) { \
                    const u32x4 r0_ = *(const LAS u32x4*)(bp_ + 256 * T4), r1_ = *(const LAS u32x4*)(bp_ + 256 * T4 + RP); \
                    const v8i_t B_ = {(int)r0_.x, (int)r0_.y, (int)r0_.z, (int)r1_.x, (int)r1_.y, (int)r1_.z, 0, 0}; \
                    acc[2 * (P) + tk][T4] = __builtin_amdgcn_mfma_scale_f32_16x16x128_f8f6f4(Ah_, B_, acc[2 * (P) + tk][T4], 2, 2, 0, 0x7f7f7f7f, 0, 0x7f7f7f7f); \
                    acc[2 * (P) + tk][T4] = __builtin_amdgcn_mfma_scale_f32_16x16x128_f8f6f4(Al_, B_, acc[2 * (P) + tk][T4], 2, 2, 0, 0x7b7b7b7b, 0, 0x7f7f7f7f); } } } while (0)
        {
            U3 rb[16];
            PV_LOAD(0, 0);
#pragma unroll 1
            for (int h = 0; h < 16; ++h) {
                PV_TOLDS();
                __builtin_amdgcn_sched_barrier(0);
                PV_LOAD(h, 1);
                __builtin_amdgcn_sched_barrier(0);
                PV_COMP(h, 0);
                __builtin_amdgcn_sched_barrier(0);
                PV_TOLDS();
                __builtin_amdgcn_sched_barrier(0);
                PV_LOAD(h < 15 ? h + 1 : 15, 0);
                __builtin_amdgcn_sched_barrier(0);
                PV_COMP(h, 1);
                __builtin_amdgcn_sched_barrier(0);
            }
        }
#undef PV_LOAD
#undef PV_TOLDS
#undef PV_COMP
        int le = (int)threadIdx.x; asm volatile("" : "+v"(le)); le &= 63;
#pragma unroll
        for (int i = 0; i < 4; ++i) {
            if (act[i]) {
                const float* g2 = MOD + (size_t)(tt[i] >> 12) * 6144 + 5120;
                float* op = OUT + (size_t)tt[i] * 1024;
                const float csc_i = CSC[tt[i]];
#pragma unroll
                for (int T4 = 0; T4 < 4; ++T4) {
                    const int col = 256 * T4 + 16 * (le & 15) + 4 * (le >> 4);
                    const f32x4 g = *(const f32x4*)(g2 + col), x1 = *(const f32x4*)(op + col);
                    *(f32x4*)(op + col) = x1 + (g * csc_i) * acc[i][T4];
                }
            }
        }
    }
}
#define XB_TMO      128
#define XB_XCNT(j)  (256  + 64 * (j))
#define XB_XSUB(j)  (1280 + 64 * (j))
#define XB_XGEN(j)  (2304 + 64 * (j))
#define XB_TOP      3328
#define XB_TOPGEN   3392
#define XCD_BAR_WORDS 3456
#define XB_SPIN_CAP (1u << 20)
__device__ __forceinline__ unsigned xb_ld(unsigned* p)              { return __hip_atomic_load(p, __ATOMIC_RELAXED, __HIP_MEMORY_SCOPE_AGENT); }
__device__ __forceinline__ unsigned xb_add(unsigned* p, unsigned v) { return __hip_atomic_fetch_add(p, v, __ATOMIC_RELAXED, __HIP_MEMORY_SCOPE_AGENT); }
__device__ __forceinline__ unsigned xb_xcc_id() { return (unsigned)__builtin_amdgcn_s_getreg((3 << 11) | 20) & 0xFu; }
#define XB_SPIN(cond, bar) do { unsigned _sp = 0; while (cond) { __builtin_amdgcn_s_sleep(1); \
    if ((++_sp & 255u) == 0u) { if (xb_ld(&(bar)[XB_TMO])) break; if (_sp > XB_SPIN_CAP) { atomicAdd(&(bar)[XB_TMO], 1u); break; } } } } while (0)
struct XcdBarrier { unsigned* bar; unsigned x; volatile LAS unsigned* st; };
__device__ __forceinline__ XcdBarrier xcd_barrier_post(unsigned* bar, volatile LAS unsigned* st) {
    XcdBarrier b; b.bar = bar; b.x = xb_xcc_id(); b.st = st;
    if (threadIdx.x == 0) (void)xb_add(&bar[XB_XCNT(b.x)], 1u);
    return b;
}
__device__ __forceinline__ void xcd_barrier_complete(unsigned* bar, unsigned x, unsigned& nloc, unsigned& nx) {
    const unsigned G = gridDim.x * gridDim.y * gridDim.z;
    unsigned sum, cnt, mine, sp = 0u;
    for (;;) {
        sum = 0u; cnt = 0u; mine = 0u;
#pragma unroll
        for (unsigned j = 0; j < 16; ++j) { const unsigned c = xb_ld(&bar[XB_XCNT(j)]); sum += c; cnt += (c > 0u) ? 1u : 0u; mine = (j == x) ? c : mine; }
        if (sum == G) break;
        __builtin_amdgcn_s_sleep(1);
        if ((++sp & 255u) == 0u) { if (xb_ld(&bar[XB_TMO])) break; if (sp > XB_SPIN_CAP) { atomicAdd(&bar[XB_TMO], 1u); break; } }
    }
    nloc = mine > 0u ? mine : 1u; nx = cnt > 0u ? cnt : 1u;
}
__device__ __forceinline__ void xcd_barrier(const XcdBarrier& b) {
    asm volatile("s_waitcnt vmcnt(0)" ::: "memory");
    __syncthreads();
    if (threadIdx.x == 0) {
        unsigned* bar = b.bar;
        __builtin_amdgcn_s_waitcnt(0);
        unsigned nloc = b.st[0], nx = b.st[1];
        if (nloc == 0u) { xcd_barrier_complete(bar, b.x, nloc, nx); b.st[0] = nloc; b.st[1] = nx; }
        const unsigned old = xb_add(&bar[XB_XSUB(b.x)], 1u);
        const unsigned gen = old / nloc;
        if (old + 1u == (gen + 1u) * nloc) {
            __builtin_amdgcn_fence(__ATOMIC_RELEASE, "agent");
            asm volatile("s_waitcnt vmcnt(0)" ::: "memory");
            const unsigned og = xb_add(&bar[XB_TOP], 1u);
            const unsigned tg = og / nx;
            if (og + 1u == (tg + 1u) * nx) xb_add(&bar[XB_TOPGEN], 1u);
            else XB_SPIN(xb_ld(&bar[XB_TOPGEN]) == tg, bar);
            __builtin_amdgcn_fence(__ATOMIC_ACQUIRE, "agent");
            xb_add(&bar[XB_XGEN(b.x)], 1u);
            asm volatile("s_waitcnt vmcnt(0)" ::: "memory");
        } else {
            XB_SPIN(xb_ld(&bar[XB_XGEN(b.x)]) == gen, bar);
            __builtin_amdgcn_fence(__ATOMIC_ACQUIRE, "agent");
            asm volatile("s_waitcnt vmcnt(0)" ::: "memory");
        }
    }
    __syncthreads();
}

constexpr int N_PHASES = 12;
#ifndef PROBE_K
#define PROBE_K -1
#endif
__global__ void __launch_bounds__(NWAVES * 64, 2) mk_fwd(Args a) {
    extern __shared__ __attribute__((aligned(16))) unsigned char lds_raw[];
    LAS unsigned char* lds = (LAS unsigned char*)lds_raw;
    cg::grid_group grid = cg::this_grid();
    const int G = gridDim.x, blk = blockIdx.x;
    unsigned char* ws = a.ws;
    float* MOD = (float*)(ws + WS_MOD);
    bf16* H = (bf16*)(ws + WS_H);
    bf16 *CB = (bf16*)(ws + WS_CB), *CC = (bf16*)(ws + WS_CC), *CX = (bf16*)(ws + WS_CX), *Qb = (bf16*)(ws + WS_Q), *Kb = (bf16*)(ws + WS_K), *Vb = (bf16*)(ws + WS_V), *QI = (bf16*)(ws + WS_QI);
    bf16 *GC = (bf16*)(ws + WS_GC), *GA = (bf16*)(ws + WS_GA), *KI = (bf16*)(ws + WS_KI); float* WI = (float*)(ws + WS_WI);
    unsigned long long* MASK = (unsigned long long*)(ws + WS_MASK);
    bf16* PQ = (bf16*)(ws + WS_PQ); unsigned short* EIDX = (unsigned short*)(ws + WS_EIDX); float* EG = (float*)(ws + WS_EG); float* COEF = (float*)(ws + WS_COEF);
#define IN(k) (a.ph_lo <= (k) && (k) < a.ph_hi)
#define SEAM(k) do { if (IN(k) && IN((k) + 1)) { if ((k) == 0) grid.sync(); else xcd_barrier(xbar); } if (PROBE_K == (k) && threadIdx.x == 0) pst[1] = __builtin_amdgcn_s_memrealtime(); if (PROBE_K == (k) + 1 && threadIdx.x == 0) pst[0] = __builtin_amdgcn_s_memrealtime(); } while (0)
    volatile LAS unsigned* xst = (volatile LAS unsigned*)(lds + LDS_BYTES - 64);
    if (threadIdx.x < 4) xst[threadIdx.x] = 0u;
    __syncthreads();
    const XcdBarrier xbar = xcd_barrier_post((unsigned*)(ws + WS_CTL), xst);

    volatile LAS unsigned long long* pst = (volatile LAS unsigned long long*)(lds + LDS_BYTES - 48);
    if (PROBE_K >= 0 && threadIdx.x == 0) { pst[0] = 0; pst[1] = 0; pst[2] = 0; pst[3] = 0; }
    if (PROBE_K == 0 && threadIdx.x == 0) pst[0] = __builtin_amdgcn_s_memrealtime();
    if (IN(0)) p0_prologue(lds, a, G, blk);
    SEAM(0);
    if (IN(1)) norm_phase<false>(a.in[0], a.in[4], MOD, 0, H, G, blk);
    SEAM(1);
    if (IN(2)) {
        pg8::Gemm g{H, (const bf16*)(ws + WS_WIN), T, NIN_PAD, DM}; pg8::StaticOrder S; S.init(T, NIN_PAD, G, blk);
        EpiInProj E{ws, a.in[8], a.in[9]};
        pg8::gemm_phase<EpiInProj, true, true>(lds, g, S, E);
    }
    SEAM(2);
    if (IN(3)) { if (PROBE_SUB == 3 && threadIdx.x == 0) pst[3] = __builtin_amdgcn_s_memrealtime(); conv_phase(CB, CC, CX, a.in[6], H, G, blk); if (PROBE_SUB == 3) { __syncthreads(); if (threadIdx.x == 0) pst[2] += __builtin_amdgcn_s_memrealtime() - pst[3]; }
        indexer_phase(lds, QI, KI, WI, MASK, G, blk); }
    SEAM(3);
    if (IN(4)) att::attn_phase(lds, Qb, Kb, Vb, MASK, a.in[8], a.in[9], H, G, blk);
    SEAM(4);
    if (IN(5)) {
        pg8::Gemm g{H, (const bf16*)(ws + WS_WCO), T, DM, DM}; pg8::StaticOrder S; S.init(T, DM, G, blk);
        EpiMixFused E{GC, GA, CB};
        pg8::gemm_phase<EpiMixFused, true, true>(lds, g, S, E);
    }
    SEAM(5);
    if (IN(6)) {
        pg8::Gemm g{CB, (const bf16*)(ws + WS_WO), T, DM, DM}; pg8::StaticOrder S; S.init(T, DM, G, blk);
        EpiDelta E{MOD, H};
        pg8::gemm_phase<EpiDelta, true, true>(lds, g, S, E);
    }
    SEAM(6);
    if (IN(7)) norm_phase<true>(a.in[0], a.in[12], MOD, 3072, H, G, blk, a.out);
    SEAM(7);
    if (IN(8)) {
        pg8::Gemm g{H, (const bf16*)(ws + WS_WPQ), T, DM, DM}; pg8::StaticOrder S; S.init(T, DM, G, blk);
        EpiPlain E{PQ};
        pg8::gemm_phase<EpiPlain, true, true>(lds, g, S, E);
    }
    SEAM(8);
    if (IN(9)) peer_route_phase(lds, PQ, (const bf16*)(ws + WS_SK), EIDX, EG, G, blk);
    SEAM(9);
    if (IN(10)) peer_u_simple(lds, H, (tab_ptr)(ws + WS_PU), (const float*)(ws + WS_RSU), (const float*)(ws + WS_RSV), EIDX, EG, COEF, (unsigned short*)(ws + WS_CCODE), (float*)(ws + WS_CSC), G, blk);
    SEAM(10);
    if (IN(11)) peer_v_phase(lds, (tab_ptr)(ws + WS_PV), EIDX, (const unsigned short*)(ws + WS_CCODE), (const float*)(ws + WS_CSC), MOD, a.out, G, blk);
    if (PROBE_K >= 0) {
        xcd_barrier(xbar);
        if (blk != 0 || threadIdx.x != 0) return;
        if (PROBE_K == 11) pst[1] = __builtin_amdgcn_s_memrealtime();
        const unsigned long long te = __builtin_amdgcn_s_memrealtime();
        const unsigned long long span = PROBE_SUB ? pst[2] : pst[1] - pst[0];
        while (__builtin_amdgcn_s_memrealtime() - te < span) __builtin_amdgcn_s_sleep(20);
    }
#undef IN
#undef SEAM
}

#ifndef MK_N_LAUNCHES
#define MK_N_LAUNCHES 1
#endif
extern "C" void kernel_launch(void* const* d_in, const int* in_sizes, int n_in, void* d_out, int out_size, void* d_ws, size_t ws_size, hipStream_t stream) {
    static int grid = 0;
    if (grid == 0) {
        if (n_in != 17 || in_sizes[0] != T * DM || out_size != T * DM || ws_size < WS_END) {
            fprintf(stderr, "kernel_launch: unexpected problem: n_in %d in0 %d out %d ws %zu (need %zu); nothing launched\n", n_in, n_in > 0 ? in_sizes[0] : -1, out_size, ws_size, (size_t)WS_END); grid = -1; return; }
        int dev = 0, cus = 0, per_cu = 0;
        hipGetDevice(&dev); hipDeviceGetAttribute(&cus, hipDeviceAttributeMultiprocessorCount, dev);
        if (hipFuncSetAttribute((const void*)mk_fwd, hipFuncAttributeMaxDynamicSharedMemorySize, LDS_BYTES) != hipSuccess) { fprintf(stderr, "kernel_launch: hipFuncSetAttribute failed\n"); grid = -1; return; }
        if (hipOccupancyMaxActiveBlocksPerMultiprocessor(&per_cu, (const void*)mk_fwd, NWAVES * 64, LDS_BYTES) != hipSuccess || per_cu < 1) { fprintf(stderr, "kernel_launch: occupancy query says %d blocks per CU\n", per_cu); grid = -1; return; }
        grid = cus;
    }
    if (grid < 0) return;
    if (hipMemsetAsync((char*)d_ws + WS_CTL, 0, CTL_BYTES, stream) != hipSuccess) { fprintf(stderr, "kernel_launch: hipMemsetAsync failed\n"); return; }
    Args a{};
    for (int i = 0; i < 17; ++i) a.in[i] = (const float*)d_in[i];
    a.out = (float*)d_out; a.ws = (unsigned char*)d_ws;
    for (int li = 0; li < MK_N_LAUNCHES; ++li) {
        a.ph_lo = li * (N_PHASES / MK_N_LAUNCHES); a.ph_hi = (li + 1) * (N_PHASES / MK_N_LAUNCHES);
        void* args[] = {&a};
        hipError_t e = hipLaunchCooperativeKernel((const void*)mk_fwd, dim3(grid), dim3(NWAVES * 64), args, LDS_BYTES, stream);
        if (e != hipSuccess) { fprintf(stderr, "kernel_launch: cooperative launch %d failed: %s (grid %d)\n", li, hipGetErrorString(e), grid); break; }
    }
}
```

```cpp
#include <hip/hip_runtime.h>
#include <hip/hip_cooperative_groups.h>
#include <cstdio>
#include <cstdint>
namespace cg = cooperative_groups;

#define LAS __attribute__((address_space(3)))
typedef unsigned short bf16;
typedef short bf16x8 __attribute__((ext_vector_type(8)));
typedef short s16x4 __attribute__((ext_vector_type(4)));
typedef float f32x2 __attribute__((ext_vector_type(2)));
typedef float f32x4 __attribute__((ext_vector_type(4)));
typedef float f32x16 __attribute__((ext_vector_type(16)));
typedef unsigned u32x2 __attribute__((ext_vector_type(2)));
typedef unsigned u32x4 __attribute__((ext_vector_type(4)));
typedef __bf16 bf16x2_t __attribute__((ext_vector_type(2)));

__device__ __forceinline__ unsigned pk2(float lo, float hi) { f32x2 v = {lo, hi}; bf16x2_t b = __builtin_convertvector(v, bf16x2_t); return __builtin_bit_cast(unsigned, b); }
__device__ __forceinline__ float bflo(unsigned u) { return __uint_as_float(u << 16); }
__device__ __forceinline__ float bfhi(unsigned u) { return __uint_as_float(u & 0xffff0000u); }
__device__ __forceinline__ unsigned ordf(float f) { unsigned u = __float_as_uint(f); return u ^ ((u & 0x80000000u) ? 0xffffffffu : 0x80000000u); }
__device__ __forceinline__ float unordf(unsigned u) { return __uint_as_float((u & 0x80000000u) ? (u ^ 0x80000000u) : ~u); }
#define LDS_WAIT() asm volatile("s_waitcnt lgkmcnt(0)" ::: "memory")
__device__ __forceinline__ int phase_tid() { int t = (int)threadIdx.x; asm volatile("" : "+v"(t)); return t; }

constexpr int PEER_ROWB = 768;
typedef const unsigned char* tab_ptr;
constexpr int NB = 16, SEQ = 4096, DM = 1024, T = NB * SEQ;
constexpr int NIN_PAD = 5888;
constexpr float EPS = 1e-6f;
constexpr float C2 = 0.125f * 1.4426950408889634f;
constexpr int NWAVES = 8;

constexpr size_t MiB = 1u << 20;
constexpr size_t WS_MOD = 1 * MiB;
constexpr size_t WS_RSU = 1 * MiB + 512 * 1024, WS_RSV = 1 * MiB + 640 * 1024;
constexpr size_t WS_WIN = 2 * MiB;
constexpr size_t WS_WCO = 14 * MiB;
constexpr size_t WS_WAO = 15 * MiB;
constexpr size_t WS_WO = 16 * MiB;
constexpr size_t WS_WPQ = 18 * MiB;
constexpr size_t WS_SK = 20 * MiB;
constexpr size_t WS_PU = 32 * MiB;
constexpr size_t WS_PV = 64 * MiB;
constexpr size_t WS_H = 96 * MiB;
constexpr size_t WS_CB = 224 * MiB;
constexpr size_t WS_CC = 288 * MiB;
constexpr size_t WS_CX = 352 * MiB;
constexpr size_t WS_Q = 416 * MiB;
constexpr size_t WS_K = 480 * MiB;
constexpr size_t WS_V = 544 * MiB;
constexpr size_t WS_QI = 608 * MiB;
constexpr size_t WS_GC = 672 * MiB;
constexpr size_t WS_GA = 800 * MiB;
constexpr size_t WS_KI = 928 * MiB;
constexpr size_t WS_WI = 936 * MiB;
constexpr size_t WS_MASK = 938 * MiB;
constexpr size_t WS_END = 970 * MiB;
constexpr size_t WS_PQ = WS_CC;
constexpr size_t WS_EIDX = WS_K;
constexpr size_t WS_EG = WS_K + 16 * MiB;
constexpr size_t WS_CCODE = WS_Q, WS_CSC = WS_Q + 16 * MiB;
constexpr size_t WS_COEF = WS_V;
constexpr size_t WS_CTL = 0;
constexpr size_t CTL_BYTES = 32768;

constexpr int LDS_BYTES = 147456;

namespace pg8 {
constexpr int BM = 256, BK = 64, HALF = 128, HTB = HALF * BK * 2, STAGE_BYTES = 8 * HTB, NXCD = 8, WGM = 8;
__host__ __device__ __forceinline__ int lds_byte(int r, int c) { const int st = (r >> 4) * 2 + (c >> 5), rr = r & 15, cc = c & 31, ob = rr * 64 + cc * 2; return st * 1024 + (ob ^ (((ob >> 9) & 1) << 5)); }
__host__ __device__ __forceinline__ void stage_rc(int b, int& R, int& C) { const int st = b / 1024, sb = b % 1024, swz = sb ^ (((sb >> 9) & 1) << 5); R = (st >> 1) * 16 + swz / 64; C = (st & 1) * 32 + (swz % 64) / 2; }
__host__ __device__ __forceinline__ int perm32(int rho) { const int n = rho >> 4, i = rho & 15; return 8 * (i >> 2) + 4 * n + (i & 3); }
struct Unit { int pm, pn; };
struct Gemm { const bf16* A; const bf16* Bt; int M, N, K; };
struct StaticOrder {
    int nM, nN, nwg, G, c;
    __device__ void init(int M, int N, int G_, int c_) { nM = M / BM; nN = N / BM; nwg = nM * nN; G = G_; c = c_; }
    __device__ bool next(int i, Unit& u) const {
        const long L = (long)i * G + c; if (L >= nwg) return false;
        int wgid = (int)L; { const int q = nwg / NXCD, r = nwg % NXCD, xcd = wgid % NXCD, off = wgid / NXCD; wgid = (xcd < r ? xcd * (q + 1) : r * (q + 1) + (xcd - r) * q) + off; }
        const int nig = WGM * nN, gid = wgid / nig, fm = gid * WGM, gsz = (nM - fm) < WGM ? (nM - fm) : WGM;
        u.pm = fm + ((wgid % nig) % gsz); u.pn = (wgid % nig) / gsz; return true;
    }
};

template <class Epi, bool ALIGN_EPI, bool SP2>
__device__ __forceinline__ void gemm_phase(LAS unsigned char* lds, const Gemm g, const StaticOrder& S, const Epi& E) {
    const int tid = phase_tid(), wid = __builtin_amdgcn_readfirstlane(tid >> 6), lane = tid & 63, wr = wid >> 2, wc = wid & 3, fr = lane & 15, fq = lane >> 4;
    const int K = g.K, nt = K / BK;
    unsigned voffA[2], voffB[2];
#pragma unroll
    for (int i = 0; i < 2; ++i) { int R, C; stage_rc(tid * 16 + i * 8192, R, C); const int Rb = Epi::PERM ? ((R & ~31) + perm32(R & 31)) : R;
        voffA[i] = (unsigned)(R * K + C) * 2u; voffB[i] = (unsigned)(Rb * K + C) * 2u; }
    const size_t kstep = (size_t)(BK * 2);
    const size_t hstep = (size_t)HALF * K * 2;
    const size_t tstep = 2 * hstep;
    const unsigned ldsw = (unsigned)wid * 1024u;
    const int aoff = lds_byte(wr * 64 + fr, fq * 8), boff = lds_byte(wc * 32 + fr, fq * 8);
#define PG8_SA(b, h) (((b) * 2 + (h)) * HTB)
#define PG8_SB(b, h) ((4 + (b) * 2 + (h)) * HTB)
#define PG8_STAGE(bufoff, gbase, voff) do { _Pragma("unroll") for (int _i = 0; _i < 2; ++_i) \
        __builtin_amdgcn_global_load_lds((const unsigned*)((const char*)(gbase) + (voff)[_i]), (LAS unsigned*)(lds + (bufoff) + ldsw + _i * 8192), 16, 0, 0); } while (0)
#define PG8_LDA(dst, b, h) do { _Pragma("unroll") for (int m = 0; m < 4; ++m) _Pragma("unroll") for (int k = 0; k < 2; ++k) dst[m][k] = *(const LAS bf16x8*)(lds + PG8_SA(b, h) + aoff + m * 2048 + k * 1024); } while (0)
#define PG8_LDB(dst, b, h) do { _Pragma("unroll") for (int n = 0; n < 2; ++n) _Pragma("unroll") for (int k = 0; k < 2; ++k) dst[n][k] = *(const LAS bf16x8*)(lds + PG8_SB(b, h) + boff + n * 2048 + k * 1024); } while (0)
#define PG8_MMA(ai, bj, At, Bt) do { __builtin_amdgcn_s_setprio(1); _Pragma("unroll") for (int m = 0; m < 4; ++m) _Pragma("unroll") for (int n = 0; n < 2; ++n) _Pragma("unroll") for (int k = 0; k < 2; ++k) \
        acc[ai][bj][m][n] = __builtin_amdgcn_mfma_f32_16x16x32_bf16(Bt[n][k], At[m][k], acc[ai][bj][m][n], 0, 0, 0); __builtin_amdgcn_s_setprio(0); } while (0)
#define PG8_WAIT_V(n) asm volatile("s_waitcnt vmcnt(" #n ")" ::: "memory")
#define PG8_WAIT_L(n) asm volatile("s_waitcnt lgkmcnt(" #n ")" ::: "memory")
#define PG8_BAR __builtin_amdgcn_s_barrier()
#define PG8_SCHED __builtin_amdgcn_sched_barrier(0)
    Unit cur, nxt; int ui = 0;
    if (!S.next(0, cur)) return;
    f32x4 acc[2][2][4][2];
#pragma unroll
    for (int a = 0; a < 2; ++a)
#pragma unroll
        for (int b = 0; b < 2; ++b)
#pragma unroll
            for (int m = 0; m < 4; ++m)
#pragma unroll
                for (int n = 0; n < 2; ++n) acc[a][b][m][n] = (f32x4){0.f, 0.f, 0.f, 0.f};
    bf16x8 At[4][2], B0[2][2], B1[2][2];
    const char* cA = (const char*)g.A + (size_t)cur.pm * tstep; const char* cB = (const char*)g.Bt + (size_t)cur.pn * tstep;
    if constexpr (SP2) {
        PG8_STAGE(PG8_SB(0, 0), cB, voffB); PG8_STAGE(PG8_SB(0, 1), cB + hstep, voffB); PG8_STAGE(PG8_SA(0, 0), cA, voffA); PG8_STAGE(PG8_SA(0, 1), cA + hstep, voffA);
        if (wr == 1) PG8_BAR;
        PG8_WAIT_V(2); PG8_BAR;
        PG8_STAGE(PG8_SB(1, 0), cB + kstep, voffB); PG8_STAGE(PG8_SA(1, 0), cA + kstep, voffA); PG8_STAGE(PG8_SB(1, 1), cB + hstep + kstep, voffB);
        PG8_WAIT_V(6); PG8_BAR;
    } else {
        PG8_STAGE(PG8_SB(0, 0), cB, voffB); PG8_STAGE(PG8_SA(0, 0), cA, voffA); PG8_STAGE(PG8_SB(0, 1), cB + hstep, voffB); PG8_STAGE(PG8_SA(0, 1), cA + hstep, voffA);
        if (wr == 1) PG8_BAR;
        PG8_WAIT_V(4); PG8_BAR;
        PG8_STAGE(PG8_SB(1, 0), cB + kstep, voffB); PG8_STAGE(PG8_SA(1, 0), cA + kstep, voffA); PG8_STAGE(PG8_SB(1, 1), cB + hstep + kstep, voffB);
        PG8_WAIT_V(6); PG8_BAR;
    }
    for (;;) {
        const bool has_next = S.next(ui + 1, nxt);
        const char* nA = has_next ? (const char*)g.A + (size_t)nxt.pm * tstep : cA; const char* nB = has_next ? (const char*)g.Bt + (size_t)nxt.pn * tstep : cB;
        for (int t = 0; t < nt; t += 2) {
            if constexpr (Epi::MIDK) { if (t == nt / 2) E.mid(acc, cur, wr, wc, fr, fq); }
            const bool last = (t == nt - 2);
            const char* a1 = cA + (size_t)(t + 1) * kstep;
            const char* a2 = last ? nA : cA + (size_t)(t + 2) * kstep; const char* b2 = last ? nB : cB + (size_t)(t + 2) * kstep;
            const char* a3 = a2 + kstep; const char* b3 = b2 + kstep;
            if constexpr (SP2) {
            PG8_LDB(B0, 0, 0); PG8_LDB(B1, 0, 1); PG8_SCHED; PG8_LDA(At, 0, 0); PG8_STAGE(PG8_SA(1, 1), a1 + hstep, voffA);
            PG8_WAIT_V(8); PG8_WAIT_L(0); PG8_BAR; PG8_MMA(0, 0, At, B0); PG8_MMA(0, 1, At, B1); PG8_BAR; PG8_SCHED;
            PG8_LDA(At, 0, 1); PG8_STAGE(PG8_SB(0, 0), b2, voffB); PG8_STAGE(PG8_SB(0, 1), b2 + hstep, voffB); PG8_STAGE(PG8_SA(0, 0), a2, voffA);
            PG8_WAIT_V(8); PG8_WAIT_L(0); PG8_BAR; PG8_MMA(1, 0, At, B0); PG8_MMA(1, 1, At, B1); PG8_BAR; PG8_SCHED;
            PG8_LDB(B0, 1, 0); PG8_LDB(B1, 1, 1); PG8_SCHED; PG8_LDA(At, 1, 0); PG8_STAGE(PG8_SA(0, 1), a2 + hstep, voffA);
            PG8_WAIT_V(8); PG8_WAIT_L(0); PG8_BAR; PG8_MMA(0, 0, At, B0); PG8_MMA(0, 1, At, B1); PG8_BAR; PG8_SCHED;
            PG8_LDA(At, 1, 1); PG8_STAGE(PG8_SB(1, 0), b3, voffB); PG8_STAGE(PG8_SB(1, 1), b3 + hstep, voffB); PG8_STAGE(PG8_SA(1, 0), a3, voffA);
            PG8_WAIT_V(8); PG8_WAIT_L(0); PG8_BAR; PG8_MMA(1, 0, At, B0); PG8_MMA(1, 1, At, B1); PG8_BAR; PG8_SCHED;
            } else {
            PG8_LDB(B0, 0, 0); PG8_SCHED; PG8_LDA(At, 0, 0); PG8_STAGE(PG8_SA(1, 1), a1 + hstep, voffA);
            PG8_WAIT_L(8); PG8_BAR; PG8_WAIT_L(0); PG8_MMA(0, 0, At, B0); PG8_BAR; PG8_SCHED;
            PG8_LDB(B1, 0, 1); PG8_STAGE(PG8_SB(0, 0), b2, voffB);
            PG8_BAR; PG8_WAIT_L(0); PG8_MMA(0, 1, At, B1); PG8_BAR;
            PG8_LDA(At, 0, 1); PG8_STAGE(PG8_SA(0, 0), a2, voffA);
            PG8_BAR; PG8_WAIT_L(0); PG8_MMA(1, 0, At, B0); PG8_BAR; PG8_SCHED;
            PG8_STAGE(PG8_SB(0, 1), b2 + hstep, voffB);
            PG8_WAIT_V(6); PG8_BAR; PG8_MMA(1, 1, At, B1); PG8_BAR;
            PG8_LDB(B0, 1, 0); PG8_SCHED; PG8_LDA(At, 1, 0); PG8_STAGE(PG8_SA(0, 1), a2 + hstep, voffA);
            PG8_WAIT_L(8); PG8_BAR; PG8_WAIT_L(0); PG8_MMA(0, 0, At, B0); PG8_BAR; PG8_SCHED;
            PG8_LDB(B1, 1, 1); PG8_STAGE(PG8_SB(1, 0), b3, voffB);
            PG8_BAR; PG8_WAIT_L(0); PG8_MMA(0, 1, At, B1); PG8_BAR;
            PG8_LDA(At, 1, 1); PG8_STAGE(PG8_SA(1, 0), a3, voffA);
            PG8_BAR; PG8_WAIT_L(0); PG8_MMA(1, 0, At, B0); PG8_BAR; PG8_SCHED;
            PG8_STAGE(PG8_SB(1, 1), b3 + hstep, voffB);
            PG8_WAIT_V(6); PG8_BAR; PG8_MMA(1, 1, At, B1); PG8_BAR;
            }
        }
        if constexpr (ALIGN_EPI) { if (wr == 0) PG8_BAR; }
        E(acc, cur, wr, wc, fr, fq);
        if (!has_next) break;
#pragma unroll
        for (int a = 0; a < 2; ++a)
#pragma unroll
            for (int b = 0; b < 2; ++b)
#pragma unroll
                for (int m = 0; m < 4; ++m)
#pragma unroll
                    for (int n = 0; n < 2; ++n) acc[a][b][m][n] = (f32x4){0.f, 0.f, 0.f, 0.f};
        cur = nxt; cA = nA; cB = nB; ++ui;
        if constexpr (ALIGN_EPI) { if (wr == 1) PG8_BAR; }
    }
    PG8_WAIT_V(0);
    if constexpr (!ALIGN_EPI) { if (wr == 0) PG8_BAR; }
    PG8_BAR;
#undef PG8_SA
#undef PG8_SB
#undef PG8_STAGE
#undef PG8_LDA
#undef PG8_LDB
#undef PG8_MMA
#undef PG8_WAIT_V
#undef PG8_WAIT_L
#undef PG8_BAR
#undef PG8_SCHED
}
}

typedef const f32x4 (&AccRef)[2][2][4][2];

__device__ __forceinline__ u32x4 pack8(f32x4 v0, f32x4 v1) { u32x4 w; w.x = pk2(v0[0], v0[1]); w.y = pk2(v0[2], v0[3]); w.z = pk2(v1[0], v1[1]); w.w = pk2(v1[2], v1[3]); return w; }
__device__ __forceinline__ float sigm(float x) { return __builtin_amdgcn_rcpf(1.f + __builtin_amdgcn_exp2f(-1.4426950408889634f * x)); }

struct EpiInProj {
    static constexpr bool PERM = true; static constexpr bool MIDK = false;
    unsigned char* ws; const float* qnw; const float* knw;
    __device__ __forceinline__ void operator()(AccRef acc, const pg8::Unit& u, int wr, int wc, int fr, int fq) const {
        const int pn = u.pn; const size_t row0 = (size_t)u.pm * 256 + wr * 64 + fr;
        bf16* const V = (bf16*)(ws + WS_V); bf16* const KI = (bf16*)(ws + WS_KI); float* const WI = (float*)(ws + WS_WI);
        if (pn == 10 || pn == 11) {
            bf16* vb = V + ((size_t)((u.pm >> 4) * 8 + 4 * (pn & 1) + (wc >> 1)) * 4096 + (u.pm & 15) * 256 + wr * 64 + fr) * 64 + 32 * (wc & 1) + 8 * fq;
#pragma unroll
            for (int ai = 0; ai < 2; ++ai)
#pragma unroll
                for (int m = 0; m < 4; ++m)
#pragma unroll
                    for (int bj = 0; bj < 2; ++bj) *(u32x4*)(vb + (size_t)(2 * bj * 4096 + ai * 128 + m * 16) * 64) = pack8(acc[ai][bj][m][0], acc[ai][bj][m][1]);
        } else if (pn < 6 || (pn >= 12 && pn < 14)) {
            bf16* base = (bf16*)(ws + (pn < 6 ? WS_CB + (size_t)(pn >> 1) * (64 * MiB) : WS_QI));
            static_assert(WS_CC == WS_CB + 64 * MiB && WS_CX == WS_CB + 128 * MiB, "cb | cc | cx are consecutive 64 MiB regions");
            const int col0 = (pn & 1) * 256 + wc * 32 + 8 * fq;
#pragma unroll
            for (int ai = 0; ai < 2; ++ai)
#pragma unroll
                for (int m = 0; m < 4; ++m) { bf16* rowp = base + (row0 + ai * 128 + m * 16) * 512 + col0;
#pragma unroll
                    for (int bj = 0; bj < 2; ++bj) *(u32x4*)(rowp + bj * 128) = pack8(acc[ai][bj][m][0], acc[ai][bj][m][1]); }
        } else if (pn < 10) {
            const bool isq = pn < 8; bf16* base = (bf16*)(ws + (isq ? WS_Q : WS_K)); const float* nw = isq ? qnw : knw; const float sc = isq ? C2 : 1.f;
            const int head = 4 * (pn & 1) + wc;
            f32x4 w[2][2];
#pragma unroll
            for (int bj = 0; bj < 2; ++bj)
#pragma unroll
                for (int n = 0; n < 2; ++n) w[bj][n] = *(const f32x4*)(nw + 32 * bj + 8 * fq + 4 * n) * sc;
#pragma unroll
            for (int ai = 0; ai < 2; ++ai)
#pragma unroll
                for (int m = 0; m < 4; ++m) {
                    float ss = 0.f;
#pragma unroll
                    for (int bj = 0; bj < 2; ++bj)
#pragma unroll
                        for (int n = 0; n < 2; ++n) { const f32x4 x = acc[ai][bj][m][n]; ss += (x[0] * x[0] + x[1] * x[1]) + (x[2] * x[2] + x[3] * x[3]); }
                    ss += __shfl_xor(ss, 16); ss += __shfl_xor(ss, 32);
                    const float r = __builtin_amdgcn_rsqf(ss * (1.f / 64.f) + EPS);
                    bf16* rowp = isq ? base + (row0 + ai * 128 + m * 16) * 512 + head * 64 + 8 * fq
                                     : base + ((size_t)((u.pm >> 4) * 8 + head) * 4096 + (u.pm & 15) * 256 + wr * 64 + fr + ai * 128 + m * 16) * 64 + 8 * fq;
#pragma unroll
                    for (int bj = 0; bj < 2; ++bj) *(u32x4*)(rowp + bj * 32) = pack8(acc[ai][bj][m][0] * r * w[bj][0], acc[ai][bj][m][1] * r * w[bj][1]);
                }
        } else if (pn < 22) {
            bf16* base = (bf16*)(ws + (pn < 18 ? WS_GC : WS_GA)); const int col0 = ((pn - 14) & 3) * 256 + wc * 32 + 8 * fq;
#pragma unroll
            for (int ai = 0; ai < 2; ++ai)
#pragma unroll
                for (int m = 0; m < 4; ++m) { bf16* rowp = base + (row0 + ai * 128 + m * 16) * 1024 + col0;
#pragma unroll
                    for (int bj = 0; bj < 2; ++bj) { f32x4 a = acc[ai][bj][m][0], b = acc[ai][bj][m][1];
#pragma unroll
                        for (int j = 0; j < 4; ++j) { a[j] = sigm(a[j]); b[j] = sigm(b[j]); }
                        *(u32x4*)(rowp + bj * 128) = pack8(a, b); } }
        } else {
            if (wc < 2) {
#pragma unroll
                for (int ai = 0; ai < 2; ++ai)
#pragma unroll
                    for (int m = 0; m < 4; ++m) *(u32x4*)(KI + (row0 + ai * 128 + m * 16) * 64 + wc * 32 + 8 * fq) = pack8(acc[ai][0][m][0], acc[ai][0][m][1]);
            } else if (wc == 2 && fq == 0) {
#pragma unroll
                for (int ai = 0; ai < 2; ++ai)
#pragma unroll
                    for (int m = 0; m < 4; ++m) { float* p = WI + (row0 + ai * 128 + m * 16) * 8; *(f32x4*)p = acc[ai][0][m][0]; *(f32x4*)(p + 4) = acc[ai][0][m][1]; }
            }
        }
    }
};

struct EpiMixFused {
    static constexpr bool PERM = true; static constexpr bool MIDK = true;
    const bf16* GC; const bf16* GA; bf16* MIX;
    __device__ __forceinline__ void mid(f32x4 (&acc)[2][2][4][2], const pg8::Unit& u, int wr, int wc, int fr, int fq) const {
        unsigned base = (unsigned)((u.pm * 256 + wr * 64 + fr) * 1024 + u.pn * 256 + wc * 32 + 8 * fq);
        asm volatile("" : "+v"(base));
#define MIX_R(GCV, GAV) ((GCV) * __builtin_amdgcn_rcpf(fmaxf((GAV), 1e-20f)))
#pragma unroll
        for (int ai = 0; ai < 2; ++ai)
#pragma unroll
            for (int mh = 0; mh < 2; ++mh) {
                u32x4 gc[2][2], ga[2][2];
#pragma unroll
                for (int mm = 0; mm < 2; ++mm)
#pragma unroll
                    for (int bj = 0; bj < 2; ++bj) { const size_t off = (size_t)base + (size_t)(ai * 128 + (2 * mh + mm) * 16) * 1024 + bj * 128; gc[mm][bj] = *(const u32x4*)(GC + off); ga[mm][bj] = *(const u32x4*)(GA + off); }
#pragma unroll
                for (int mm = 0; mm < 2; ++mm)
#pragma unroll
                    for (int bj = 0; bj < 2; ++bj) { f32x4& a = acc[ai][bj][2 * mh + mm][0]; f32x4& b = acc[ai][bj][2 * mh + mm][1]; const u32x4 c = gc[mm][bj], g = ga[mm][bj];
                        a[0] *= MIX_R(bflo(c.x), bflo(g.x)); a[1] *= MIX_R(bfhi(c.x), bfhi(g.x)); a[2] *= MIX_R(bflo(c.y), bflo(g.y)); a[3] *= MIX_R(bfhi(c.y), bfhi(g.y));
                        b[0] *= MIX_R(bflo(c.z), bflo(g.z)); b[1] *= MIX_R(bfhi(c.z), bfhi(g.z)); b[2] *= MIX_R(bflo(c.w), bflo(g.w)); b[3] *= MIX_R(bfhi(c.w), bfhi(g.w)); }
                asm volatile("" ::: "memory");
            }
#undef MIX_R
    }
    __device__ __forceinline__ void operator()(AccRef acc, const pg8::Unit& u, int wr, int wc, int fr, int fq) const {
        const size_t row0 = (size_t)u.pm * 256 + wr * 64 + fr; const int col0 = u.pn * 256 + wc * 32 + 8 * fq;
#pragma unroll
        for (int ai = 0; ai < 2; ++ai)
#pragma unroll
            for (int m = 0; m < 4; ++m) { const size_t off = (row0 + ai * 128 + m * 16) * 1024 + col0;
#pragma unroll
                for (int bj = 0; bj < 2; ++bj) {
                    const u32x4 g = *(const u32x4*)(GA + off + bj * 128);
                    f32x4 a = acc[ai][bj][m][0], b = acc[ai][bj][m][1];
                    a[0] *= fmaxf(bflo(g.x), 1e-20f); a[1] *= fmaxf(bfhi(g.x), 1e-20f); a[2] *= fmaxf(bflo(g.y), 1e-20f); a[3] *= fmaxf(bfhi(g.y), 1e-20f);
                    b[0] *= fmaxf(bflo(g.z), 1e-20f); b[1] *= fmaxf(bfhi(g.z), 1e-20f); b[2] *= fmaxf(bflo(g.w), 1e-20f); b[3] *= fmaxf(bfhi(g.w), 1e-20f);
                    *(u32x4*)(MIX + off + bj * 128) = pack8(a, b); } }
    }
};

struct EpiDelta {
    static constexpr bool PERM = true; static constexpr bool MIDK = false;
    const float* MOD; bf16* O;
    __device__ __forceinline__ void operator()(AccRef acc, const pg8::Unit& u, int wr, int wc, int fr, int fq) const {
        const size_t row0 = (size_t)u.pm * 256 + wr * 64 + fr; const int col0 = u.pn * 256 + wc * 32 + 8 * fq;
        const float* g1 = MOD + (size_t)(u.pm >> 4) * 6144 + 2048;
        f32x4 gv[2][2];
#pragma unroll
        for (int bj = 0; bj < 2; ++bj)
#pragma unroll
            for (int n = 0; n < 2; ++n) gv[bj][n] = *(const f32x4*)(g1 + col0 + bj * 128 + 4 * n);
#pragma unroll
        for (int ai = 0; ai < 2; ++ai)
#pragma unroll
            for (int m = 0; m < 4; ++m) { bf16* rowp = O + (row0 + ai * 128 + m * 16) * 1024 + col0;
#pragma unroll
                for (int bj = 0; bj < 2; ++bj) *(u32x4*)(rowp + bj * 128) = pack8(acc[ai][bj][m][0] * gv[bj][0], acc[ai][bj][m][1] * gv[bj][1]); }
    }
};

struct EpiPlain {
    static constexpr bool PERM = true; static constexpr bool MIDK = false;
    bf16* O;
    __device__ __forceinline__ void operator()(AccRef acc, const pg8::Unit& u, int wr, int wc, int fr, int fq) const {
        const size_t row0 = (size_t)u.pm * 256 + wr * 64 + fr; const int col0 = u.pn * 256 + wc * 32 + 8 * fq;
#pragma unroll
        for (int ai = 0; ai < 2; ++ai)
#pragma unroll
            for (int m = 0; m < 4; ++m) { bf16* rowp = O + (row0 + ai * 128 + m * 16) * 1024 + col0;
#pragma unroll
                for (int bj = 0; bj < 2; ++bj) *(u32x4*)(rowp + bj * 128) = pack8(acc[ai][bj][m][0], acc[ai][bj][m][1]); }
    }
};

struct Args { const float* in[17]; float* out; unsigned char* ws; int ph_lo, ph_hi; };

__device__ __forceinline__ void transpose_item(const float* W, int ldw, int k0, int n0, int ncols, bf16* WT, int K, int drow0, LAS float* scr, int lane) {
#pragma unroll 8
    for (int i = 0; i < 32; ++i) { const int kk = 2 * i + (lane >> 5), n = lane & 31; scr[kk * 33 + n] = (n < ncols) ? W[(size_t)(k0 + kk) * ldw + n0 + n] : 0.f; }
    LDS_WAIT(); asm volatile("" ::: "memory");
    const int c = lane & 7;
#pragma unroll
    for (int j = 0; j < 4; ++j) { const int n = (lane >> 3) + 8 * j; const LAS float* s = scr + (8 * c) * 33 + n;
        u32x4 o; o.x = pk2(s[0 * 33], s[1 * 33]); o.y = pk2(s[2 * 33], s[3 * 33]); o.z = pk2(s[4 * 33], s[5 * 33]); o.w = pk2(s[6 * 33], s[7 * 33]);
        *(u32x4*)(WT + (size_t)(drow0 + n) * K + k0 + 8 * c) = o; }
    LDS_WAIT(); asm volatile("" ::: "memory");
}
__device__ __forceinline__ void cvt_stream(const float* src, bf16* dst, size_t n8, size_t i0, size_t stride) {
    for (size_t i = i0; i < n8; i += stride) { const f32x4 a = *(const f32x4*)(src + 8 * i), b = *(const f32x4*)(src + 8 * i + 4); *(u32x4*)(dst + 8 * i) = pack8(a, b); }
}

typedef unsigned v6u_t __attribute__((ext_vector_type(6)));
typedef float v32f_t __attribute__((ext_vector_type(32)));
typedef __bf16 v32bf_t __attribute__((ext_vector_type(32)));
struct __attribute__((packed, aligned(4))) U3 { unsigned x, y, z; };
__device__ __forceinline__ unsigned enc_e2m3(float y) {
    const float a = fminf(fabsf(y), 7.5f);
    const float r = a < 2.f ? a * 8.f : (a < 4.f ? a * 4.f + 8.f : a * 2.f + 16.f);
    unsigned c = (unsigned)__builtin_rintf(r); c = c > 31u ? 31u : c;
    return c | ((__float_as_uint(y) >> 26) & 32u);
}
__device__ __forceinline__ float dec_e2m3(unsigned c) {
    const unsigned m = c & 31u; const float fm = (float)m;
    const float v = m < 16u ? fm * 0.125f : (m < 24u ? fm * 0.25f - 2.f : fm * 0.5f - 8.f);
    return (c & 32u) ? -v : v;
}
__device__ __forceinline__ unsigned enc_e2m1(float y) {
    const float a = fminf(fabsf(y), 6.f);
    const float r = a < 2.f ? a * 2.f : (a < 4.f ? a + 2.f : a * 0.5f + 4.f);
    unsigned c = (unsigned)__builtin_rintf(r); c = c > 7u ? 7u : c;
    return c | ((__float_as_uint(y) >> 28) & 8u);
}
template <bool FP4>
__device__ __forceinline__ void cvt_rows_fpx(const float* src, unsigned char* dst, float* rs, int gw, int nw, int lane) {
    constexpr float VMAX = FP4 ? 6.f : 7.5f;
#pragma unroll 2
    for (int row = gw; row < 16384; row += nw) {
        const float* sp = src + (size_t)row * 1024 + 16 * lane;
        const f32x4 a = *(const f32x4*)sp, b = *(const f32x4*)(sp + 4), c = *(const f32x4*)(sp + 8), d = *(const f32x4*)(sp + 12);
        const float v[16] = {a[0], a[1], a[2], a[3], b[0], b[1], b[2], b[3], c[0], c[1], c[2], c[3], d[0], d[1], d[2], d[3]};
        float m = 0.f;
#pragma unroll
        for (int j = 0; j < 16; ++j) m = fmaxf(m, fabsf(v[j]));
#pragma unroll
        for (int o = 32; o; o >>= 1) m = fmaxf(m, __shfl_xor(m, o));
        const float sc = m > 0.f ? VMAX / m : 0.f;
        unsigned q[16];
        if constexpr (FP4) {
#pragma unroll
            for (int j = 0; j < 16; ++j) q[j] = enc_e2m1(v[j] * sc);
            u32x2 w;
            w.x = q[0] | (q[1] << 4) | (q[2] << 8) | (q[3] << 12) | (q[4] << 16) | (q[5] << 20) | (q[6] << 24) | (q[7] << 28);
            w.y = q[8] | (q[9] << 4) | (q[10] << 8) | (q[11] << 12) | (q[12] << 16) | (q[13] << 20) | (q[14] << 24) | (q[15] << 28);
            *(u32x2*)(dst + (size_t)row * 512 + 8 * lane) = w;
        } else {
#pragma unroll
            for (int j = 0; j < 16; ++j) q[j] = enc_e2m3(v[j] * sc);
            U3 w;
            w.x = q[0] | (q[1] << 6) | (q[2] << 12) | (q[3] << 18) | (q[4] << 24) | (q[5] << 30);
            w.y = (q[5] >> 2) | (q[6] << 4) | (q[7] << 10) | (q[8] << 16) | (q[9] << 22) | (q[10] << 28);
            w.z = (q[10] >> 4) | (q[11] << 2) | (q[12] << 8) | (q[13] << 14) | (q[14] << 20) | (q[15] << 26);
            *(U3*)(dst + (size_t)row * 768 + 12 * lane) = w;
        }
        if (lane == 0) rs[row] = m * (1.f / VMAX);
    }
}
__device__ __forceinline__ void p0_prologue(LAS unsigned char* lds, const Args& a, int G, int blk) {
    const int tid = threadIdx.x, lane = tid & 63, wave = __builtin_amdgcn_readfirstlane(tid >> 6);
    unsigned char* ws = a.ws;
    for (int task = blk; task < 96; task += G) {
        LAS float* sl = (LAS float*)(lds + 67584);
        for (int i = tid; i < NB * DM; i += 512) { const float v = a.in[1][i]; sl[i] = v * __builtin_amdgcn_rcpf(1.f + __expf(-v)); }
        __syncthreads();
        const int col = task * 64 + lane, kb = wave * 128;
        float acc[16];
#pragma unroll
        for (int b = 0; b < 16; ++b) acc[b] = 0.f;
        const float* wp = a.in[2] + col;
        for (int k = kb; k < kb + 128; k += 4) {
            const float w0 = wp[(size_t)(k + 0) * 6144], w1 = wp[(size_t)(k + 1) * 6144], w2 = wp[(size_t)(k + 2) * 6144], w3 = wp[(size_t)(k + 3) * 6144];
#pragma unroll
            for (int b = 0; b < 16; ++b) { const f32x4 s = *(const LAS f32x4*)(sl + b * 1024 + k); acc[b] += (s[0] * w0 + s[1] * w1) + (s[2] * w2 + s[3] * w3); }
        }
        LAS float* red = (LAS float*)lds;
#pragma unroll
        for (int b = 0; b < 16; ++b) red[(wave * 16 + b) * 64 + lane] = acc[b];
        __syncthreads();
        for (int o = tid; o < 1024; o += 512) { const int b = o >> 6, cl = o & 63; float s = 0.f;
#pragma unroll
            for (int w = 0; w < 8; ++w) s += red[(w * 16 + b) * 64 + cl];
            ((float*)(ws + WS_MOD))[b * 6144 + task * 64 + cl] = s + a.in[3][task * 64 + cl]; }
        __syncthreads();
    }
    LAS float* scr = (LAS float*)(lds + wave * 8448);
    const int gw = blk * NWAVES + wave, NGW = G * NWAVES;
    constexpr int I_IN = 184 * 16, I_CO = 8 * 32, I_AO = 8 * 32, I_O = 16 * 32, I_PQ = 16 * 32;
    for (int it = gw; it < I_IN + I_CO + I_AO + I_O + I_PQ; it += NGW) {
        int r = it;
        if (r < I_IN) {
            const int dg = r >> 4, kb = r & 15, tile = dg >> 3, gi = dg & 7; int src, nc = 32;
            if (tile < 6 || (tile >= 10 && tile < 14)) src = 32 * dg;
            else if (tile < 10) src = tile * 256 + 32 * (2 * (gi & 3) + (gi >> 2));
            else if (tile < 22) src = 3656 + 32 * (dg - 112);
            else { if (gi < 2) src = 3584 + 32 * gi; else if (gi == 2) { src = 3648; nc = 8; } else { src = 0; nc = 0; } }
            transpose_item(a.in[5], 5704, kb * 64, src, nc, (bf16*)(ws + WS_WIN), 1024, dg * 32, scr, lane); continue; }
        r -= I_IN;
        if (r < I_CO) { transpose_item(a.in[7], 1024, (r >> 5) * 64, (r & 31) * 32, 32, (bf16*)(ws + WS_WCO), 1024, (r & 31) * 32, scr, lane); continue; } r -= I_CO;
        if (r < I_AO) { transpose_item(a.in[10], 1024, (r >> 5) * 64, (r & 31) * 32, 32, (bf16*)(ws + WS_WCO) + 512, 1024, (r & 31) * 32, scr, lane); continue; } r -= I_AO;
        if (r < I_O) { transpose_item(a.in[11], 1024, (r >> 5) * 64, (r & 31) * 32, 32, (bf16*)(ws + WS_WO), 1024, (r & 31) * 32, scr, lane); continue; } r -= I_O;
        transpose_item(a.in[13], 1024, (r >> 5) * 64, (r & 31) * 32, 32, (bf16*)(ws + WS_WPQ), 1024, (r & 31) * 32, scr, lane);
    }
    const size_t gt = (size_t)blk * 512 + tid, NT_ = (size_t)G * 512;
    cvt_stream(a.in[14], (bf16*)(ws + WS_SK), (size_t)16 * 128 * 64 / 8, gt, NT_);
    cvt_rows_fpx<true>(a.in[15], ws + WS_PU, (float*)(ws + WS_RSU), gw, NGW, lane);
    cvt_rows_fpx<true>(a.in[16], ws + WS_PV, (float*)(ws + WS_RSV), gw, NGW, lane);
}

__device__ __forceinline__ unsigned wave_max_dpp(unsigned x) {
    { const unsigned y = (unsigned)__builtin_amdgcn_update_dpp(0, (int)x, 0x141, 0xF, 0xF, false); x = x > y ? x : y; }
    { const unsigned y = (unsigned)__builtin_amdgcn_update_dpp(0, (int)x, 0x1B, 0xF, 0xF, false); x = x > y ? x : y; }
    { const unsigned y = (unsigned)__builtin_amdgcn_update_dpp(0, (int)x, 0xB1, 0xF, 0xF, false); x = x > y ? x : y; }
    { const unsigned y = (unsigned)__builtin_amdgcn_update_dpp(0, (int)x, 0x128, 0xF, 0xF, false); x = x > y ? x : y; }
    const unsigned a = (unsigned)__builtin_amdgcn_readlane((int)x, 0), b = (unsigned)__builtin_amdgcn_readlane((int)x, 16), c = (unsigned)__builtin_amdgcn_readlane((int)x, 32), d = (unsigned)__builtin_amdgcn_readlane((int)x, 48);
    const unsigned ab = a > b ? a : b, cd = c > d ? c : d; return ab > cd ? ab : cd;
}
__device__ __forceinline__ float wave_sum_dpp(float x) {
    x += __uint_as_float((unsigned)__builtin_amdgcn_update_dpp(0, (int)__float_as_uint(x), 0x141, 0xF, 0xF, false));
    x += __uint_as_float((unsigned)__builtin_amdgcn_update_dpp(0, (int)__float_as_uint(x), 0x1B, 0xF, 0xF, false));
    x += __uint_as_float((unsigned)__builtin_amdgcn_update_dpp(0, (int)__float_as_uint(x), 0xB1, 0xF, 0xF, false));
    x += __uint_as_float((unsigned)__builtin_amdgcn_update_dpp(0, (int)__float_as_uint(x), 0x128, 0xF, 0xF, false));
    const int xi = (int)__float_as_uint(x);
    return (__uint_as_float((unsigned)__builtin_amdgcn_readlane(xi, 0)) + __uint_as_float((unsigned)__builtin_amdgcn_readlane(xi, 16))) +
           (__uint_as_float((unsigned)__builtin_amdgcn_readlane(xi, 32)) + __uint_as_float((unsigned)__builtin_amdgcn_readlane(xi, 48)));
}
template <bool RESID> __device__ __forceinline__ void norm_phase(const float* X, const float* nw, const float* MOD, int sh_off, bf16* O, int G, int blk, float* OUT = nullptr) {
    const int tid_ = phase_tid(); const int lane = tid_ & 63, wave = __builtin_amdgcn_readfirstlane(tid_ >> 6);
    const int stride = G * NWAVES;
    for (int m0 = blk * NWAVES + wave; m0 < T; m0 += 2 * stride) {
        const int m1 = (m0 + stride < T) ? m0 + stride : m0;
        f32x4 va[4], vb[4]; float sa = 0.f, sbb = 0.f;
        const f32x4* xa = (const f32x4*)(X + (size_t)m0 * DM) + lane; const f32x4* xb = (const f32x4*)(X + (size_t)m1 * DM) + lane;
#pragma unroll
        for (int j = 0; j < 4; ++j) { va[j] = xa[64 * j]; vb[j] = xb[64 * j]; }
        if (RESID) {
            const unsigned long long* da = (const unsigned long long*)(O + (size_t)m0 * DM) + lane; const unsigned long long* db = (const unsigned long long*)(O + (size_t)m1 * DM) + lane;
            f32x4* oa4 = (f32x4*)(OUT + (size_t)m0 * DM) + lane; f32x4* ob4 = (f32x4*)(OUT + (size_t)m1 * DM) + lane;
#pragma unroll
            for (int j = 0; j < 4; ++j) { const unsigned long long pa = da[64 * j], pb = db[64 * j];
                va[j] += (f32x4){bflo((unsigned)pa), bfhi((unsigned)pa), bflo((unsigned)(pa >> 32)), bfhi((unsigned)(pa >> 32))};
                vb[j] += (f32x4){bflo((unsigned)pb), bfhi((unsigned)pb), bflo((unsigned)(pb >> 32)), bfhi((unsigned)(pb >> 32))};
                oa4[64 * j] = va[j]; ob4[64 * j] = vb[j]; }
        }
#pragma unroll
        for (int j = 0; j < 4; ++j) { sa += (va[j].x * va[j].x + va[j].y * va[j].y) + (va[j].z * va[j].z + va[j].w * va[j].w); sbb += (vb[j].x * vb[j].x + vb[j].y * vb[j].y) + (vb[j].z * vb[j].z + vb[j].w * vb[j].w); }
        const float ra = __builtin_amdgcn_rsqf(wave_sum_dpp(sa) * (1.f / DM) + EPS), rb = __builtin_amdgcn_rsqf(wave_sum_dpp(sbb) * (1.f / DM) + EPS);
        const float* mda = MOD + (size_t)(m0 >> 12) * 6144 + sh_off; const float* mdb = MOD + (size_t)(m1 >> 12) * 6144 + sh_off;
        unsigned long long* oa = (unsigned long long*)(O + (size_t)m0 * DM) + lane; unsigned long long* ob = (unsigned long long*)(O + (size_t)m1 * DM) + lane;
#pragma unroll
        for (int j = 0; j < 4; ++j) {
            const f32x4 w = ((const f32x4*)nw)[lane + 64 * j];
            const f32x4 ha = (va[j] * ra * w) * (((const f32x4*)(mda + 1024))[lane + 64 * j] + 1.f) + ((const f32x4*)mda)[lane + 64 * j];
            const f32x4 hb = (vb[j] * rb * w) * (((const f32x4*)(mdb + 1024))[lane + 64 * j] + 1.f) + ((const f32x4*)mdb)[lane + 64 * j];
            oa[64 * j] = (unsigned long long)pk2(ha.x, ha.y) | ((unsigned long long)pk2(ha.z, ha.w) << 32);
            ob[64 * j] = (unsigned long long)pk2(hb.x, hb.y) | ((unsigned long long)pk2(hb.z, hb.w) << 32);
        }
    }
}

__device__ __forceinline__ void conv_phase(const bf16* CB, const bf16* CC, const bf16* CX, const float* cw, bf16* UA, int G, int blk) {
    const size_t n = (size_t)T * 64;
    const int ctid = phase_tid();
#pragma unroll 4
    for (size_t i = (size_t)blk * 512 + ctid; i < n; i += (size_t)G * 512) {
        const int c8 = (int)(i & 63) * 8; const size_t row = i >> 6; const int t = (int)(row & (SEQ - 1));
        float accv[8];
#pragma unroll
        for (int e = 0; e < 8; ++e) accv[e] = 0.f;
#pragma unroll
        for (int j = 0; j < 3; ++j) {
            if (t - 2 + j >= 0) {
                const size_t off = (row - 2 + j) * 512 + c8;
                const u32x4 a = *(const u32x4*)(CC + off), b = *(const u32x4*)(CX + off);
                const f32x4 w0 = *(const f32x4*)(cw + j * 512 + c8), w1 = *(const f32x4*)(cw + j * 512 + c8 + 4);
                accv[0] += w0[0] * bflo(a.x) * bflo(b.x); accv[1] += w0[1] * bfhi(a.x) * bfhi(b.x);
                accv[2] += w0[2] * bflo(a.y) * bflo(b.y); accv[3] += w0[3] * bfhi(a.y) * bfhi(b.y);
                accv[4] += w1[0] * bflo(a.z) * bflo(b.z); accv[5] += w1[1] * bfhi(a.z) * bfhi(b.z);
                accv[6] += w1[2] * bflo(a.w) * bflo(b.w); accv[7] += w1[3] * bfhi(a.w) * bfhi(b.w);
            }
        }
        const u32x4 g = *(const u32x4*)(CB + row * 512 + c8);
        u32x4 o; o.x = pk2(accv[0] * bflo(g.x), accv[1] * bfhi(g.x)); o.y = pk2(accv[2] * bflo(g.y), accv[3] * bfhi(g.y));
        o.z = pk2(accv[4] * bflo(g.z), accv[5] * bfhi(g.z)); o.w = pk2(accv[6] * bflo(g.w), accv[7] * bfhi(g.w));
        *(u32x4*)(UA + row * 1024 + c8) = o;
    }
}

template <int N> __device__ __forceinline__ void bitonic_sort_desc(unsigned* a) {
#pragma unroll
    for (int k = 2; k <= N; k <<= 1)
#pragma unroll
        for (int j = k >> 1; j > 0; j >>= 1)
#pragma unroll
            for (int i = 0; i < N; ++i) { const int l = i ^ j; if (l > i) { const bool desc = (i & k) == 0; const unsigned x = a[i], y = a[l]; const unsigned mx = x > y ? x : y, mn = x > y ? y : x; a[i] = desc ? mx : mn; a[l] = desc ? mn : mx; } }
}
__device__ __forceinline__ void merge_top16(unsigned* a, const unsigned* b) {
#pragma unroll
    for (int i = 0; i < 16; ++i) { const unsigned y = b[15 - i]; a[i] = a[i] > y ? a[i] : y; }
#pragma unroll
    for (int j = 8; j > 0; j >>= 1)
#pragma unroll
        for (int i = 0; i < 16; ++i) if ((i & j) == 0) { const unsigned x = a[i], y = a[i + j]; a[i] = x > y ? x : y; a[i + j] = x > y ? y : x; }
}
__device__ __forceinline__ void top16_of_64(unsigned* a) {
    bitonic_sort_desc<16>(a); bitonic_sort_desc<16>(a + 16); bitonic_sort_desc<16>(a + 32); bitonic_sort_desc<16>(a + 48);
    merge_top16(a, a + 16); merge_top16(a + 32, a + 48); merge_top16(a, a + 32);
}
template <int NR> __device__ __forceinline__ int count_ge(const unsigned* k, unsigned cand) {
    int cv = 0;
#pragma unroll
    for (int r = 0; r < NR; ++r) cv += (k[r] >= cand) ? 1 : 0;
    cv += __builtin_amdgcn_update_dpp(0, cv, 0x141, 0xF, 0xF, false); cv += __builtin_amdgcn_update_dpp(0, cv, 0x1B, 0xF, 0xF, false);
    cv += __builtin_amdgcn_update_dpp(0, cv, 0xB1, 0xF, 0xF, false); cv += __builtin_amdgcn_update_dpp(0, cv, 0x128, 0xF, 0xF, false);
    return __builtin_amdgcn_readlane(cv, 0) + __builtin_amdgcn_readlane(cv, 16) + __builtin_amdgcn_readlane(cv, 32) + __builtin_amdgcn_readlane(cv, 48);
}
template <int NR> __device__ __forceinline__ unsigned descent256(const unsigned* k) {
    unsigned tau = 0u;
    for (int bit = 31; bit >= 0; --bit) {
        const unsigned cand = tau | (1u << bit);
        const int cnt = count_ge<NR>(k, cand);
        if (cnt >= 256) tau = cand;
        if (cnt == 256) break;
    }
    return tau;
}
template <int NR> __device__ __forceinline__ void select_query(const LAS unsigned* row, int nvalid, int tq, LAS unsigned long long* mrow, int lane) {
    unsigned k[NR];
    const bool lowhalf = lane < 32;
#define SEL_LOAD() _Pragma("unroll") for (int r = 0; r < NR; ++r) { const unsigned v = row[64 * r + lane]; k[r] = (64 * r + 64 <= nvalid) ? v : ((64 * r < nvalid && lowhalf) ? v : 0u); }
    SEL_LOAD()
    unsigned tau = 0u;
    if (tq >= 256) {
        if constexpr (NR > 16) {
#pragma unroll
            for (int g = 0; g < NR / 16; ++g) bitonic_sort_desc<16>(k + 16 * g);
            if constexpr (NR == 64) { merge_top16(k, k + 16); merge_top16(k + 32, k + 48); merge_top16(k, k + 32); }
            else if constexpr (NR == 48) { merge_top16(k, k + 16); merge_top16(k, k + 32); }
            else merge_top16(k, k + 16);
            tau = descent256<16>(k);
            const bool bad = __ballot(k[15] >= tau) != 0ull;
            SEL_LOAD()
            if (bad) tau = descent256<NR>(k);
        } else tau = descent256<NR>(k);
    }
#undef SEL_LOAD
    if (tau == 0u) tau = 1u;
#pragma unroll
    for (int r = 0; r < 64; ++r) { const unsigned long long m = r < NR ? __ballot(k[r < NR ? r : 0] >= tau) : 0ull; if (lane == 0) mrow[r * 8] = m; }
}

#ifndef PROBE_SUB
#define PROBE_SUB 0
#endif
__device__ __forceinline__ void indexer_phase(LAS unsigned char* lds, const bf16* QI, const bf16* KI, const float* WI, unsigned long long* MASK, int G, int blk) {
    volatile LAS unsigned long long* pst = (volatile LAS unsigned long long*)(lds + LDS_BYTES - 48);
    LAS unsigned* sc = (LAS unsigned*)lds;
    const int tid = phase_tid(), lane = tid & 63, wave = __builtin_amdgcn_readfirstlane(tid >> 6), r32 = lane & 31, hi = lane >> 5;
    const int ra = (r32 >> 4) & 1, rb = (r32 >> 3) & 1, rc = (r32 >> 2) & 1, rd = r32 & 3;
    bf16x8 aq[2][4]; f32x4 wv[2][2][2]; bf16x8 bk[3][4];
#define IDX_UNIT_GEOM(uid_) const int b = (uid_) >> 9; int j = (uid_) & 511; if (j >= 256) j = 767 - j; const int tq0 = 8 * j; const size_t row0 = (size_t)b * SEQ + tq0; const int nkt = (tq0 + 8 + 31) >> 5; \
        const bf16* kbase = KI + ((size_t)b * SEQ + r32) * 64 + hi * 8;
#define IDX_UNIT_LOAD() do { \
        _Pragma("unroll") for (int rt = 0; rt < 2; ++rt) { \
            const bf16* qp = QI + (row0 + rt * 4 + 2 * rc + ra) * 512 + (4 * rb + rd) * 64 + hi * 8; \
            _Pragma("unroll") for (int d0 = 0; d0 < 4; ++d0) aq[rt][d0] = *(const bf16x8*)(qp + d0 * 16); } } while (0)
    if (blk < T / 8) { IDX_UNIT_GEOM(blk) IDX_UNIT_LOAD(); }
    for (int uid = blk; uid < T / 8; uid += G) {
        IDX_UNIT_GEOM(uid)
#pragma unroll
        for (int rt = 0; rt < 2; ++rt)
#pragma unroll
            for (int a2 = 0; a2 < 2; ++a2) { const float* wp = WI + (row0 + rt * 4 + 2 * hi + a2) * 8; wv[rt][a2][0] = *(const f32x4*)wp; wv[rt][a2][1] = *(const f32x4*)(wp + 4); }
#pragma unroll
        for (int jj = 0; jj < 3; ++jj) { int kt = wave + NWAVES * jj; if (kt >= nkt) kt = nkt - 1;
#pragma unroll
            for (int d0 = 0; d0 < 4; ++d0) bk[jj][d0] = *(const bf16x8*)(kbase + (size_t)kt * 32 * 64 + d0 * 16); }
        if (PROBE_SUB && threadIdx.x == 0) pst[3] = __builtin_amdgcn_s_memrealtime();
#define IDX_TILE(JT) { \
                constexpr int jj = (JT) % 3; \
                int kt = wave + NWAVES * (JT); asm volatile("" : "+s"(kt));       \
                const bool live = kt < nkt; \
                const int key = 32 * kt + r32; \
                f32x16 acc0 = {}, acc1 = {}; \
                _Pragma("unroll") for (int d0 = 0; d0 < 4; ++d0) { acc0 = __builtin_amdgcn_mfma_f32_32x32x16_bf16(aq[0][d0], bk[jj][d0], acc0, 0, 0, 0); acc1 = __builtin_amdgcn_mfma_f32_32x32x16_bf16(aq[1][d0], bk[jj][d0], acc1, 0, 0, 0); } \
                if ((JT) + 3 < NTW) { int ktn = kt + 3 * NWAVES; if (ktn >= nkt) ktn = nkt - 1; \
                    _Pragma("unroll") for (int d0 = 0; d0 < 4; ++d0) bk[jj][d0] = *(const bf16x8*)(kbase + (size_t)ktn * 32 * 64 + d0 * 16); } \
                _Pragma("unroll") for (int rt = 0; rt < 2; ++rt) \
                    _Pragma("unroll") for (int a2 = 0; a2 < 2; ++a2) { \
                        float sv = 0.f; \
                        _Pragma("unroll") for (int i = 0; i < 8; ++i) { const int xb = (int)__float_as_uint(rt ? acc1[8 * a2 + i] : acc0[8 * a2 + i]); sv += __uint_as_float((unsigned)(xb > 0 ? xb : 0)) * wv[rt][a2][i >> 2][i & 3]; } \
                        const int ql = rt * 4 + 2 * hi + a2; \
                        const unsigned ck = (key <= tq0 + ql) ? ((ordf(sv) & 0xfffff000u) | (unsigned)(4095 - key)) : 0u; \
                        sc[live ? ql * 4096 + key : 33792 + lane] = ck; \
                    } \
                __builtin_amdgcn_sched_barrier(0); }
#define IDX_TILES4(J0) IDX_TILE((J0)) IDX_TILE((J0) + 1) IDX_TILE((J0) + 2) IDX_TILE((J0) + 3)
        if (nkt <= 32) { constexpr int NTW = 4; IDX_TILES4(0) }
        else if (nkt <= 64) { constexpr int NTW = 8; IDX_TILES4(0) IDX_TILES4(4) }
        else if (nkt <= 96) { constexpr int NTW = 12; IDX_TILES4(0) IDX_TILES4(4) IDX_TILES4(8) }
        else { constexpr int NTW = 16; IDX_TILES4(0) IDX_TILES4(4) IDX_TILES4(8) IDX_TILES4(12) }
#undef IDX_TILES4
#undef IDX_TILE
        __syncthreads();
        if (uid + G < T / 8) { IDX_UNIT_GEOM(uid + G) IDX_UNIT_LOAD(); }
        if (PROBE_SUB == 1 && threadIdx.x == 0) pst[2] += __builtin_amdgcn_s_memrealtime() - pst[3];
        if (PROBE_SUB == 2 && threadIdx.x == 0) pst[3] = __builtin_amdgcn_s_memrealtime();
        {
            const int tq = tq0 + wave, nvalid = 32 * nkt;
            LAS unsigned long long* mrow = (LAS unsigned long long*)(lds + 131072) + wave;
            const LAS unsigned* rowp = sc + wave * 4096;
            if (nvalid <= 1024) select_query<16>(rowp, nvalid, tq, mrow, lane);
            else if (nvalid <= 2048) select_query<32>(rowp, nvalid, tq, mrow, lane);
            else if (nvalid <= 3072) select_query<48>(rowp, nvalid, tq, mrow, lane);
            else select_query<64>(rowp, nvalid, tq, mrow, lane);
        }
        __syncthreads();
        __hip_atomic_store(MASK + ((size_t)b * 64 + (tid >> 3)) * SEQ + tq0 + (tid & 7), ((const LAS unsigned long long*)(lds + 131072))[tid], __ATOMIC_RELAXED, __HIP_MEMORY_SCOPE_AGENT);
        if (PROBE_SUB == 2 && threadIdx.x == 0) pst[2] += __builtin_amdgcn_s_memrealtime() - pst[3];
    }
}

namespace att {
constexpr int KCP = 1040, KSLOT = 8 * KCP, VDH = 4160, VSLOT = 2 * VDH;
constexpr int L_K = 0, L_V = 4 * KSLOT, L_OST = L_V + 4 * VSLOT, L_END = L_OST + NWAVES * 4096;
__device__ __forceinline__ int crow(int r, int hi) { return (r & 3) + 8 * (r >> 2) + 4 * hi; }
#define SBAR() __builtin_amdgcn_sched_barrier(0)
__device__ __forceinline__ void qkt(f32x16& p0, f32x16& p1, const LAS unsigned char* kb, const bf16x8* qr, const f32x16& negm) {
#pragma unroll
    for (int d0 = 0; d0 < 4; ++d0) {
        const bf16x8 b0 = *(const LAS bf16x8*)(kb + d0 * 2 * KCP);
        const bf16x8 b1 = *(const LAS bf16x8*)(kb + d0 * 2 * KCP + 512);
        if (d0 == 0) { p0 = __builtin_amdgcn_mfma_f32_32x32x16_bf16(b0, qr[0], negm, 0, 0, 0); p1 = __builtin_amdgcn_mfma_f32_32x32x16_bf16(b1, qr[0], negm, 0, 0, 0); }
        else { p0 = __builtin_amdgcn_mfma_f32_32x32x16_bf16(b0, qr[d0], p0, 0, 0, 0); p1 = __builtin_amdgcn_mfma_f32_32x32x16_bf16(b1, qr[d0], p1, 0, 0, 0); } }
}
__device__ __forceinline__ void pv(f32x16* o, f32x16& osum, int vb, bf16x8 pa0, bf16x8 pa1, bf16x8 pa2, bf16x8 pa3) {
    {
        const bf16x8 ones = {0x3f80, 0x3f80, 0x3f80, 0x3f80, 0x3f80, 0x3f80, 0x3f80, 0x3f80};
        osum = __builtin_amdgcn_mfma_f32_32x32x16_bf16(pa0, ones, osum, 0, 0, 0); osum = __builtin_amdgcn_mfma_f32_32x32x16_bf16(pa1, ones, osum, 0, 0, 0);
        osum = __builtin_amdgcn_mfma_f32_32x32x16_bf16(pa2, ones, osum, 0, 0, 0); osum = __builtin_amdgcn_mfma_f32_32x32x16_bf16(pa3, ones, osum, 0, 0, 0);
    }
#pragma unroll
    for (int d0 = 0; d0 < 2; ++d0) { s16x4 lo[4], hi[4];
#pragma unroll
        for (int ks = 0; ks < 4; ++ks) {
            asm volatile("ds_read_b64_tr_b16 %0,%1 offset:%c2" : "=&v"(lo[ks]) : "v"(vb), "i"(d0 * VDH + ks * 1024) : "memory");
            asm volatile("ds_read_b64_tr_b16 %0,%1 offset:%c2" : "=&v"(hi[ks]) : "v"(vb), "i"(d0 * VDH + ks * 1024 + 512) : "memory"); }
        asm volatile("s_waitcnt lgkmcnt(0)" ::: "memory"); SBAR();
#define PK(k) (bf16x8){lo[k][0], lo[k][1], lo[k][2], lo[k][3], hi[k][0], hi[k][1], hi[k][2], hi[k][3]}
        o[d0] = __builtin_amdgcn_mfma_f32_32x32x16_bf16(pa0, PK(0), o[d0], 0, 0, 0);
        o[d0] = __builtin_amdgcn_mfma_f32_32x32x16_bf16(pa1, PK(1), o[d0], 0, 0, 0);
        o[d0] = __builtin_amdgcn_mfma_f32_32x32x16_bf16(pa2, PK(2), o[d0], 0, 0, 0);
        o[d0] = __builtin_amdgcn_mfma_f32_32x32x16_bf16(pa3, PK(3), o[d0], 0, 0, 0);
#undef PK
    }
}

__device__ __forceinline__ void attn_phase(LAS unsigned char* lds, const bf16* Q, const bf16* K, const bf16* V, const unsigned long long* MASK, const float* qnw, const float* knw, bf16* UA, int G, int blk) {
    const int tid = phase_tid(), lane = tid & 63, r32 = lane & 31, hi = lane >> 5, wid = __builtin_amdgcn_readfirstlane(tid >> 6);
    float mq = fabsf(qnw[lane]), mk = fabsf(knw[lane]);
#pragma unroll
    for (int o = 1; o < 64; o <<= 1) { mq = fmaxf(mq, __shfl_xor(mq, o)); mk = fmaxf(mk, __shfl_xor(mk, o)); }
    const float nb = -(8.f * 1.4426950408889634f) * mq * mk;
    f32x16 negm;
#pragma unroll
    for (int r = 0; r < 16; ++r) negm[r] = nb;
    const unsigned kdst = L_K + (tid & 7) * KCP + (tid >> 3) * 16;
    const unsigned vdst = L_V + ((tid & 7) >> 2) * VDH + ((tid >> 3) >> 4) * 1024 + ((tid >> 3) & 15) * 64 + (tid & 3) * 16;
    const LAS unsigned char* kp0 = lds + L_K + hi * KCP + r32 * 16;
    const int vb0 = (int)(uintptr_t)(lds + L_V) + ((lane >> 4) & 1) * 32 + (lane & 3) * 8 + (4 * hi + ((lane & 15) >> 2)) * 64;
    for (int uid = blk; uid < 2048; uid += G) {
        const int ui = uid >> 8; int c = uid & 255; c = (c & 7) * 32 + (c >> 3);
        const int bh = c >> 1, s = c & 1, pp = ui >> 1, qb = (ui & 1) ? 15 - (2 * pp + s) : (2 * pp + s);
        const int b = bh >> 3, h = bh & 7, q0 = qb * 256;
        const size_t rowbase = (size_t)b * SEQ;
        const bf16* Qw = Q + (rowbase + q0 + wid * 32) * 512 + h * 64;
        bf16* Ow = UA + (rowbase + q0 + wid * 32) * 1024 + 512 + h * 64;
        bf16x8 qr[4];
#pragma unroll
        for (int d0 = 0; d0 < 4; ++d0) qr[d0] = *(const bf16x8*)(Qw + (size_t)r32 * 512 + d0 * 16 + hi * 8);
        const int NT = 4 * (qb + 1);
        const unsigned long long* mptr = MASK + (size_t)b * 64 * SEQ + q0 + wid * 32 + r32;
        const bf16* ksrc = K + ((size_t)bh * SEQ) * 64 + tid * 8;
        const bf16* vsrc = V + ((size_t)bh * SEQ) * 64 + tid * 8;
        f32x16 o[2]; o[0] = f32x16{}; o[1] = f32x16{};
        f32x16 osum = f32x16{};
        const int T2 = NT / 2;
        u32x4 kreg[2][2], vreg[2][2]; unsigned long long mwq[2][2], mw[2];
#pragma unroll
        for (int sb_ = 0; sb_ < 2; ++sb_) {
            kreg[0][sb_] = *(const u32x4*)(ksrc + (size_t)sb_ * 4096); vreg[0][sb_] = *(const u32x4*)(vsrc + (size_t)sb_ * 4096); mw[sb_] = mptr[(size_t)sb_ * SEQ];
            kreg[1][sb_] = *(const u32x4*)(ksrc + (size_t)(2 + sb_) * 4096); vreg[1][sb_] = *(const u32x4*)(vsrc + (size_t)(2 + sb_) * 4096); mwq[1][sb_] = mptr[(size_t)(2 + sb_) * SEQ]; mwq[0][sb_] = 0ull;
            *(LAS u32x4*)(lds + kdst + sb_ * KSLOT) = kreg[0][sb_]; *(LAS u32x4*)(lds + vdst + sb_ * VSLOT) = vreg[0][sb_];
        }
        __syncthreads();
        const int qmax = q0 + wid * 32 + 31;
#define ATT_SUB(P, SB) if (64 * (2 * t + (SB)) <= qmax) { \
                f32x16 p0, p1; \
                qkt(p0, p1, kp0 + ((P) * 2 + (SB)) * KSLOT, qr, negm); \
                const unsigned mlo = (unsigned)mw[SB] >> (4 * hi), mhi = (unsigned)(mw[SB] >> 32) >> (4 * hi); \
                _Pragma("unroll") for (int r = 0; r < 16; ++r) { p0[r] = __builtin_amdgcn_exp2f(p0[r]); p1[r] = __builtin_amdgcn_exp2f(p1[r]); } \
                  \
                unsigned pk_[16]; \
                _Pragma("unroll") for (int i = 0; i < 8; ++i) { const int bp = ((2 * i) & 3) + 8 * ((2 * i) >> 2); \
                    const unsigned m0a = (unsigned)__builtin_amdgcn_sbfe((int)mlo, bp, 1), m0b = (unsigned)__builtin_amdgcn_sbfe((int)mlo, bp + 1, 1); \
                    const unsigned m1a = (unsigned)__builtin_amdgcn_sbfe((int)mhi, bp, 1), m1b = (unsigned)__builtin_amdgcn_sbfe((int)mhi, bp + 1, 1); \
                    pk_[i] = pk2(p0[2 * i], p0[2 * i + 1]) & __builtin_amdgcn_perm(m0b, m0a, 0x05040100u); \
                    pk_[8 + i] = pk2(p1[2 * i], p1[2 * i + 1]) & __builtin_amdgcn_perm(m1b, m1a, 0x05040100u); } \
                const u32x4 pw0 = (u32x4){pk_[0], pk_[1], pk_[2], pk_[3]}, pw1 = (u32x4){pk_[4], pk_[5], pk_[6], pk_[7]}; \
                const u32x4 pw2 = (u32x4){pk_[8], pk_[9], pk_[10], pk_[11]}, pw3 = (u32x4){pk_[12], pk_[13], pk_[14], pk_[15]}; \
                pv(o, osum, vb0 + ((P) * 2 + (SB)) * VSLOT, __builtin_bit_cast(bf16x8, pw0), __builtin_bit_cast(bf16x8, pw1), __builtin_bit_cast(bf16x8, pw2), __builtin_bit_cast(bf16x8, pw3)); \
            }
#define ATT_STEP(P)    \
        { \
            { const int tp = (t + 2 < T2) ? t + 2 : T2 - 1; \
              _Pragma("unroll") for (int sb_ = 0; sb_ < 2; ++sb_) { kreg[P][sb_] = *(const u32x4*)(ksrc + (size_t)(2 * tp + sb_) * 4096); vreg[P][sb_] = *(const u32x4*)(vsrc + (size_t)(2 * tp + sb_) * 4096); mwq[P][sb_] = mptr[(size_t)(2 * tp + sb_) * SEQ]; } } \
            ATT_SUB(P, 0) \
            ATT_SUB(P, 1) \
            _Pragma("unroll") for (int sb_ = 0; sb_ < 2; ++sb_) { *(LAS u32x4*)(lds + kdst + ((1 - (P)) * 2 + sb_) * KSLOT) = kreg[1 - (P)][sb_]; *(LAS u32x4*)(lds + vdst + ((1 - (P)) * 2 + sb_) * VSLOT) = vreg[1 - (P)][sb_]; mw[sb_] = mwq[1 - (P)][sb_]; } \
            __syncthreads(); \
        }
        for (int t = 0; t < T2; t += 2) {
            ATT_STEP(0)
            ++t;
            ATT_STEP(1)
            --t;
        }
#undef ATT_STEP
#undef ATT_SUB
        float rli[16];
#pragma unroll
        for (int r = 0; r < 16; ++r) rli[r] = __builtin_amdgcn_rcpf(osum[r]);
        LAS bf16* stg = (LAS bf16*)(lds + L_OST) + wid * 2048;
#pragma unroll
        for (int r = 0; r < 16; ++r) { const int orow = crow(r, hi);
#pragma unroll
            for (int d0 = 0; d0 < 2; ++d0) stg[orow * 64 + d0 * 32 + r32] = (bf16)(pk2(o[d0][r] * rli[r], 0.f) & 0xffffu); }
        LDS_WAIT();
#pragma unroll
        for (int i = 0; i < 4; ++i) { const int row = i * 8 + (lane >> 3), ch = lane & 7; const u32x4 v = *(const LAS u32x4*)(stg + row * 64 + ch * 8); *(u32x4*)(Ow + (size_t)row * 1024 + ch * 8) = v; }
        LDS_WAIT();
    }
}
#undef SBAR
}

__device__ __forceinline__ void peer_route_phase(LAS unsigned char* lds, const bf16* PQ, const bf16* SK, unsigned short* EIDX, float* EG, int G, int blk) {
    const int tid = phase_tid(), lane = tid & 63, r32 = lane & 31, hi = lane >> 5, wave = __builtin_amdgcn_readfirstlane(tid >> 6);
    LAS unsigned* win = (LAS unsigned*)(lds + wave * 12288);
    LAS unsigned* fwn = win + 2 * 16 * 64;
    const int gw = blk * NWAVES + wave, NGW = G * NWAVES, h = gw & 7;
    for (int tg = gw >> 3; tg < T / 32; tg += NGW >> 3) {
        const size_t t0 = (size_t)tg * 32;
#pragma unroll 1
        for (int half = 0; half < 2; ++half) {
            const int p = 2 * h + half;
            bf16x8 bq[4];
#pragma unroll
            for (int d0 = 0; d0 < 4; ++d0) bq[d0] = *(const bf16x8*)(PQ + (t0 + r32) * 1024 + 128 * h + 64 * half + 16 * d0 + 8 * hi);
            unsigned ck[64];
#pragma unroll
            for (int nb = 0; nb < 4; ++nb) {
                f32x16 acc = {};
#pragma unroll
                for (int d0 = 0; d0 < 4; ++d0) { const bf16x8 a = *(const bf16x8*)(SK + ((size_t)p * 128 + 32 * nb + r32) * 64 + 16 * d0 + 8 * hi); acc = __builtin_amdgcn_mfma_f32_32x32x16_bf16(a, bq[d0], acc, 0, 0, 0); }
#pragma unroll
                for (int r = 0; r < 16; ++r) ck[nb * 16 + r] = (ordf(acc[r]) & ~0x7fu) | (unsigned)(127 - (32 * nb + att::crow(r, hi)));
            }
            top16_of_64(ck);
            unsigned pb[16];
#pragma unroll
            for (int i = 0; i < 16; ++i) { auto rr = __builtin_amdgcn_permlane32_swap(ck[i], ck[i], false, false); pb[i] = hi ? rr[0] : rr[1]; }
            merge_top16(ck, pb);
#pragma unroll
            for (int i = 0; i < 16; ++i) win[(half * 16 + i) * 64 + lane] = ck[i];
        }
        LDS_WAIT();
        float v0[16], v1[16];
#pragma unroll
        for (int i = 0; i < 16; ++i) { v0[i] = unordf(win[i * 64 + lane] & ~0x7fu); v1[i] = unordf(win[(16 + i) * 64 + lane] & ~0x7fu); }
        unsigned c2[64];
        {
            int n = 0;
#pragma unroll
            for (int i = 0; i < 16; ++i)
#pragma unroll
                for (int j = 0; j < 16; ++j) if ((i + 1) * (j + 1) <= 16) { c2[n] = (ordf(v0[i] + v1[j]) & ~0xffu) | (unsigned)(255 - (16 * i + j)); ++n; }
#pragma unroll
            for (int q = 50; q < 64; ++q) c2[q] = 0u;
        }
        top16_of_64(c2);
        float sc[16]; unsigned ex[16];
#pragma unroll
        for (int k = 0; k < 16; ++k) {
            const unsigned f = c2[k]; const int idx = 255 - (int)(f & 0xffu), i = idx >> 4, j = idx & 15;
            const unsigned w0 = win[i * 64 + lane], w1 = win[(16 + j) * 64 + lane];
            ex[k] = (127u - (w0 & 0x7fu)) * 128u + (127u - (w1 & 0x7fu));
            sc[k] = unordf(w0 & ~0x7fu) + unordf(w1 & ~0x7fu);
        }
        const float mx = sc[0];
        float sum = 0.f;
#pragma unroll
        for (int k = 0; k < 16; ++k) { sc[k] = __expf(sc[k] - mx); sum += sc[k]; }
        const float inv = 1.f / sum;
#pragma unroll
        for (int k = 0; k < 16; ++k) sc[k] *= inv;
        if (hi == 0) {
            unsigned short* ep = EIDX + (t0 + r32) * 128 + h * 16; float* gp = EG + (t0 + r32) * 128 + h * 16;
            *(u32x4*)ep = (u32x4){ex[0] | (ex[1] << 16), ex[2] | (ex[3] << 16), ex[4] | (ex[5] << 16), ex[6] | (ex[7] << 16)};
            *(u32x4*)(ep + 8) = (u32x4){ex[8] | (ex[9] << 16), ex[10] | (ex[11] << 16), ex[12] | (ex[13] << 16), ex[14] | (ex[15] << 16)};
#pragma unroll
            for (int q = 0; q < 4; ++q) *(f32x4*)(gp + 4 * q) = (f32x4){sc[4 * q], sc[4 * q + 1], sc[4 * q + 2], sc[4 * q + 3]};
        }
        LDS_WAIT();
    }
}

__device__ __forceinline__ f32x2 gelu_pk(f32x2 v) {
    const f32x2 av = __builtin_elementwise_abs(v), dd = av * 0.2316418882f + 1.0f;
    f32x2 tt; tt.x = __builtin_amdgcn_rcpf(dd.x); tt.y = __builtin_amdgcn_rcpf(dd.y);
    f32x2 q = tt * 0.5307027145f + (-0.7265760135f); q = q * tt + 0.7107068705f; q = q * tt + (-0.142248368f); q = q * tt + 0.127414796f; q = q * tt;
    const f32x2 sq = (v * v) * (-0.72134752044f);
    f32x2 ee; ee.x = __builtin_amdgcn_exp2f(sq.x); ee.y = __builtin_amdgcn_exp2f(sq.y);
    const f32x2 mm = v * (q * ee), rr = v - mm;
    f32x2 o; o.x = v.x < 0.f ? mm.x : rr.x; o.y = v.y < 0.f ? mm.y : rr.y; return o;
}
__device__ __forceinline__ float dpp_f(float x, const int ctrl_sel) {
    const int xi = (int)__float_as_uint(x); int r;
    if (ctrl_sel == 0) r = __builtin_amdgcn_update_dpp(0, xi, 0x128, 0xF, 0xF, false);
    else if (ctrl_sel == 1) r = __builtin_amdgcn_update_dpp(0, xi, 0x141, 0xF, 0xF, false);
    else if (ctrl_sel == 2) r = __builtin_amdgcn_update_dpp(0, xi, 0x1B, 0xF, 0xF, false);
    else r = __builtin_amdgcn_update_dpp(0, xi, 0xB1, 0xF, 0xF, false);
    return __uint_as_float((unsigned)r);
}
__device__ __forceinline__ float reduce8_rows(float* d, int lane) {
#pragma unroll
    for (int i = 0; i < 4; ++i) { auto r = __builtin_amdgcn_permlane32_swap(__float_as_uint(d[i]), __float_as_uint(d[i + 4]), false, false); d[i] = __uint_as_float(r[0]) + __uint_as_float(r[1]); }
#pragma unroll
    for (int i = 0; i < 2; ++i) { auto r = __builtin_amdgcn_permlane16_swap(__float_as_uint(d[i]), __float_as_uint(d[i + 2]), false, false); d[i] = __uint_as_float(r[0]) + __uint_as_float(r[1]); }
    const bool up = lane & 8; const float keep = up ? d[1] : d[0], send = up ? d[0] : d[1];
    float x = keep + dpp_f(send, 0);
    x += dpp_f(x, 1); x += dpp_f(x, 2); x += dpp_f(x, 3);
    return x;
}
typedef int v8i_t __attribute__((ext_vector_type(8)));
#define HSC_TEST 0
__device__ __forceinline__ void peer_u_simple(LAS unsigned char* lds, const bf16* H2, tab_ptr PU, const float* RSU, const float* RSV, unsigned short* EIDX, const float* EG, float* COEF, unsigned short* CCODE, float* CSC, int G, int blk) {
    const int tid_ = phase_tid(); const int lane = tid_ & 63, wave = __builtin_amdgcn_readfirstlane(tid_ >> 6);
    LAS unsigned char* wl = lds + wave * 13632;
    constexpr int RP = 528;
    LAS int* sid = (LAS int*)(wl + 8448);
    LAS float* sgt = (LAS float*)(wl + 8448 + 512);
    LAS float* res = (LAS float*)(wl + 8448 + 1024);
    LAS float* sul = (LAS float*)(wl + 9536);
    LAS float* gtl = (LAS float*)(wl + 9536 + 2048);
    const unsigned c0 = 16u * (lane & 31), d0 = (lane < 32 ? 0u : 528u) + c0;
    const unsigned long long lt = (1ull << lane) - 1ull;
    const int n16 = lane & 15, g4 = lane >> 4;
    const int stride = G * NWAVES;
    for (int tb = blk * NWAVES + wave; tb < T; tb += 4 * stride) {
        int idlo[4], idhi[4]; float clo[4], chi[4]; int tt[4]; int tcl[4]; int hsc[4];
        int lp = (int)threadIdx.x; asm volatile("" : "+v"(lp)); lp &= 63;
        float g_lo[4], g_hi[4]; u32x4 hqa[4], hqb[4];
#pragma unroll
        for (int i = 0; i < 4; ++i) {
            const bool act_i = tb + i * stride < T; const int t = act_i ? tb + i * stride : tb; tt[i] = act_i ? t : -1; tcl[i] = t;
            const unsigned short* ep = EIDX + (size_t)t * 128;
            idlo[i] = ep[lp]; idhi[i] = ep[64 + lp]; g_lo[i] = EG[(size_t)t * 128 + lp]; g_hi[i] = EG[(size_t)t * 128 + 64 + lp];
            hqa[i] = *(const u32x4*)(H2 + (size_t)t * 1024 + 16 * lp); hqb[i] = *(const u32x4*)(H2 + (size_t)t * 1024 + 16 * lp + 8);
        }
        __builtin_amdgcn_sched_barrier(0);
        u32x4 hq[8][4];
        {
            const int tl = (lp & 2) ? ((lp & 1) ? tcl[3] : tcl[2]) : ((lp & 1) ? tcl[1] : tcl[0]);
            const bf16* hp = H2 + (size_t)tl * 1024 + 32 * (lp >> 4);
#pragma unroll
            for (int s8 = 0; s8 < 8; ++s8) { hq[s8][0] = *(const u32x4*)(hp + 128 * s8); hq[s8][1] = *(const u32x4*)(hp + 128 * s8 + 8); hq[s8][2] = *(const u32x4*)(hp + 128 * s8 + 16); hq[s8][3] = *(const u32x4*)(hp + 128 * s8 + 24); }
        }
        __builtin_amdgcn_sched_barrier(0);
        float rsu_lo[4], rsu_hi[4], rsv_lo[4], rsv_hi[4];
#pragma unroll
        for (int i = 0; i < 4; ++i) {
            {
                typedef unsigned short u16x2_t __attribute__((ext_vector_type(2)));
                u16x2_t mx = {0, 0};
                const unsigned hw[8] = {hqa[i].x, hqa[i].y, hqa[i].z, hqa[i].w, hqb[i].x, hqb[i].y, hqb[i].z, hqb[i].w};
#pragma unroll
                for (int j = 0; j < 8; ++j) mx = __builtin_elementwise_max(mx, __builtin_bit_cast(u16x2_t, hw[j] & 0x7fff7fffu));
                const unsigned m = wave_max_dpp(mx.x > mx.y ? (unsigned)mx.x : (unsigned)mx.y);
                const float tq = __uint_as_float(m << 16) * (1.f / 7.5f);
                hsc[i] = tq > 1.f ? (int)((__float_as_uint(tq) - 1u) >> 23) - 126 + HSC_TEST : HSC_TEST;
            }
            int il = idlo[i], ih = idhi[i]; float gl = g_lo[i], gh = g_hi[i];
            const int blo = il >> 10, bhi = ih >> 10; int plo = 0, phi = 0, base = 0;
#pragma unroll
            for (int bb = 0; bb < 16; ++bb) {
                const unsigned long long ml = __ballot(blo == bb), mh = __ballot(bhi == bb);
                const int nl = __popcll(ml);
                plo = (blo == bb) ? base + __popcll(ml & lt) : plo;
                phi = (bhi == bb) ? base + nl + __popcll(mh & lt) : phi;
                base += nl + __popcll(mh);
            }
            sid[plo] = il; sid[phi] = ih; sgt[plo] = gl; sgt[phi] = gh;
            il = sid[lp]; ih = sid[64 + lp]; gl = sgt[lp]; gh = sgt[64 + lp];
            if (tt[i] >= 0) { unsigned short* ep = EIDX + (size_t)tcl[i] * 128; ep[lp] = (unsigned short)il; ep[64 + lp] = (unsigned short)ih; }
            rsu_lo[i] = RSU[il]; rsu_hi[i] = RSU[ih]; rsv_lo[i] = RSV[il]; rsv_hi[i] = RSV[ih];
            idlo[i] = il; idhi[i] = ih; g_lo[i] = gl; g_hi[i] = gh; clo[i] = 0.f; chi[i] = 0.f;
        }
        v8i_t hB[8];
        {
            const int el = (lp & 2) ? ((lp & 1) ? hsc[3] : hsc[2]) : ((lp & 1) ? hsc[1] : hsc[0]);
            const float hdiv = __uint_as_float((unsigned)(127 + el) << 23);
#pragma unroll
            for (int s8 = 0; s8 < 8; ++s8) {
                typedef unsigned v16u_t __attribute__((ext_vector_type(16)));
                const v16u_t wv = {hq[s8][0].x, hq[s8][0].y, hq[s8][0].z, hq[s8][0].w, hq[s8][1].x, hq[s8][1].y, hq[s8][1].z, hq[s8][1].w, hq[s8][2].x, hq[s8][2].y, hq[s8][2].z, hq[s8][2].w, hq[s8][3].x, hq[s8][3].y, hq[s8][3].z, hq[s8][3].w};
                const v6u_t e6 = __builtin_amdgcn_cvt_scalef32_pk32_fp6_bf16(__builtin_bit_cast(v32bf_t, wv), hdiv);
                hB[s8] = (v8i_t){(int)e6[0], (int)e6[1], (int)e6[2], (int)e6[3], (int)e6[4], (int)e6[5], 0, 0};
            }
        }
#pragma unroll
        for (int i = 0; i < 4; ++i) {
            const float hs = __uint_as_float((unsigned)(127 + hsc[i]) << 23);
            sul[i * 128 + lp] = rsu_lo[i] * hs; sul[i * 128 + 64 + lp] = rsu_hi[i] * hs;
            gtl[i * 128 + lp] = g_lo[i] * rsv_lo[i]; gtl[i * 128 + 64 + lp] = g_hi[i] * rsv_hi[i];
        }
#define PU_LOAD(RB, HH, P) do { const int hh_ = (HH), l0_ = (hh_ & 7) * 8; \
            const int idA_ = hh_ < 8 ? idlo[2 * (P)] : idhi[2 * (P)], idB_ = hh_ < 8 ? idlo[2 * (P) + 1] : idhi[2 * (P) + 1]; \
            _Pragma("unroll") for (int j = 0; j < 8; ++j) { const int idq_ = j < 4 ? idA_ : idB_; const int lq_ = l0_ + 2 * (j & 3); \
                const unsigned o0_ = 512u * (unsigned)__builtin_amdgcn_readlane(idq_, lq_), o1_ = 512u * (unsigned)__builtin_amdgcn_readlane(idq_, lq_ + 1); \
                RB[j] = *(const u32x4*)(PU + ((lane < 32 ? o0_ : o1_) + c0)); } } while (0)
#define PU_TOLDS(RB) do { _Pragma("unroll") for (int j = 0; j < 8; ++j) *(LAS u32x4*)(wl + j * 2 * RP + d0) = RB[j]; } while (0)
#define PU_COMP(HH, P) do { const int hh_ = (HH), l0_ = (hh_ & 7) * 8; \
            f32x4 acc_ = {0.f, 0.f, 0.f, 0.f}; const LAS unsigned char* ap_ = wl + n16 * RP + 16 * g4; \
            _Pragma("unroll") for (int s8 = 0; s8 < 8; ++s8) { \
                const u32x4 a0_ = *(const LAS u32x4*)(ap_ + 64 * s8); \
                const v8i_t A_ = {(int)a0_.x, (int)a0_.y, (int)a0_.z, (int)a0_.w, 0, 0, 0, 0}; \
                acc_ = __builtin_amdgcn_mfma_scale_f32_16x16x128_f8f6f4(A_, hB[s8], acc_, 4, 2, 0, 0x7f7f7f7f, 0, 0x7f7f7f7f); } \
            asm volatile("s_nop 15\n\ts_nop 15" : "+v"(acc_));                                          \
            if (g4 < 2 ? n16 == 2 * (P) : n16 == 2 * (P) + 1) *(LAS f32x4*)(res + 4 * g4) = acc_;        \
            const int r = (lane - l0_) & 7;                                         \
            const float a0 = res[r], a1 = res[8 + r]; \
            const int so_ = (hh_ < 8 ? 0 : 64) + lane; \
            const f32x2 gg = gelu_pk((f32x2){a0 * sul[2 * (P) * 128 + so_], a1 * sul[(2 * (P) + 1) * 128 + so_]}); \
            const float gA_ = gtl[2 * (P) * 128 + so_], gB_ = gtl[(2 * (P) + 1) * 128 + so_]; \
            const bool mine = (lane >> 3) == (hh_ & 7); \
            if (hh_ < 8) { clo[2 * (P)] = mine ? gA_ * gg.x : clo[2 * (P)]; clo[2 * (P) + 1] = mine ? gB_ * gg.y : clo[2 * (P) + 1]; } \
            else         { chi[2 * (P)] = mine ? gA_ * gg.x : chi[2 * (P)]; chi[2 * (P) + 1] = mine ? gB_ * gg.y : chi[2 * (P) + 1]; } } while (0)
        {
            u32x4 rb[8];
            PU_LOAD(rb, 0, 0);
#pragma unroll 1
            for (int h = 0; h < 16; ++h) {
                PU_TOLDS(rb);
                __builtin_amdgcn_sched_barrier(0);
                PU_LOAD(rb, h, 1);
                __builtin_amdgcn_sched_barrier(0);
                PU_COMP(h, 0);
                __builtin_amdgcn_sched_barrier(0);
                PU_TOLDS(rb);
                __builtin_amdgcn_sched_barrier(0);
                PU_LOAD(rb, h < 15 ? h + 1 : 15, 0);
                __builtin_amdgcn_sched_barrier(0);
                PU_COMP(h, 1);
                __builtin_amdgcn_sched_barrier(0);
            }
        }
#undef PU_LOAD
#undef PU_TOLDS
#undef PU_COMP
        int le = (int)threadIdx.x; asm volatile("" : "+v"(le)); le &= 63;
#pragma unroll
        for (int i = 0; i < 4; ++i) {
            const unsigned mxb = wave_max_dpp(max(__float_as_uint(clo[i]) & 0x7fffffffu, __float_as_uint(chi[i]) & 0x7fffffffu));
            const float tq = __uint_as_float(mxb) * (1.f / 7.5f);
            int ec = (int)((__float_as_uint(tq) - 1u) >> 23) - 126; ec = ec < -100 ? -100 : ec;
            const float sc = __uint_as_float((unsigned)(127 + ec) << 23), isc = __uint_as_float((unsigned)(127 - ec) << 23);
            const float ql = clo[i] * isc, qh = chi[i] * isc;
            const unsigned hl = enc_e2m3(ql), hh = enc_e2m3(qh);
            const unsigned ll = enc_e2m3((ql - dec_e2m3(hl)) * 16.f), lh = enc_e2m3((qh - dec_e2m3(hh)) * 16.f);
            if (tt[i] >= 0) {
                COEF[(size_t)tt[i] * 128 + le] = clo[i]; COEF[(size_t)tt[i] * 128 + 64 + le] = chi[i];
                CCODE[(size_t)tt[i] * 128 + le] = (unsigned short)(hl | (ll << 8)); CCODE[(size_t)tt[i] * 128 + 64 + le] = (unsigned short)(hh | (lh << 8));
                if (le == 0) CSC[tt[i]] = sc;
            }
        }
    }
}
__device__ __forceinline__ void place6(unsigned code, unsigned sh, unsigned& d0, unsigned& d1, unsigned& d2) {
    const unsigned long long lo = sh < 64u ? ((unsigned long long)code << (sh & 63u)) : 0ull;
    d0 = (unsigned)lo; d1 = (unsigned)(lo >> 32);
    d2 = sh >= 64u ? code << ((sh - 64u) & 31u) : (sh > 58u ? code >> ((64u - sh) & 31u) : 0u);
}
__device__ __forceinline__ void peer_v_phase(LAS unsigned char* lds, tab_ptr PV, const unsigned short* EIDX, const unsigned short* CCODE, const float* CSC, const float* MOD, float* OUT, int G, int blk) {
    const int tid_ = phase_tid(); const int lane = tid_ & 63, wave = __builtin_amdgcn_readfirstlane(tid_ >> 6);
    LAS unsigned char* wl = lds + wave * 8448;
    constexpr int RP = 528;
    const unsigned c0 = 16u * (lane & 31), d0 = (lane < 32 ? 0u : 528u) + c0;
    const int m16 = lane & 15, g4 = lane >> 4;
    const unsigned sh6 = 6u * (unsigned)m16;
    const unsigned l12 = 12u * (unsigned)lane;
    const int stride = G * NWAVES;
    for (int tb = blk * NWAVES + wave; tb < T; tb += 4 * stride) {
        f32x4 acc[4][4]; unsigned idw[4], cww[4]; int tt[4]; bool act[4];
        int ln = (int)threadIdx.x; asm volatile("" : "+v"(ln)); ln &= 63;
#pragma unroll
        for (int i = 0; i < 4; ++i) {
            act[i] = tb + i * stride < T; const int t = act[i] ? tb + i * stride : tb; tt[i] = t;
#pragma unroll
            for (int j = 0; j < 4; ++j) acc[i][j] = (f32x4){0.f, 0.f, 0.f, 0.f};
            const unsigned short* ep = EIDX + (size_t)t * 128;
            idw[i] = (unsigned)ep[ln] | ((unsigned)ep[64 + ln] << 16);
            cww[i] = (unsigned)CCODE[(size_t)t * 128 + ln] | ((unsigned)CCODE[(size_t)t * 128 + 64 + ln] << 16);
        }
#define PV_LOAD(HH, P) do { const int hh_ = (HH), l0_ = (hh_ & 7) * 8; const int hs_ = hh_ < 8 ? 0 : 16; \
            _Pragma("unroll") for (int j = 0; j < 8; ++j) { const unsigned idq_ = j < 4 ? idw[2 * (P)] : idw[2 * (P) + 1]; const int lq_ = l0_ + 2 * (j & 3); \
                const unsigned o0_ = 512u * (((unsigned)__builtin_amdgcn_readlane((int)idq_, lq_) >> hs_) & 0xffffu), o1_ = 512u * (((unsigned)__builtin_amdgcn_readlane((int)idq_, lq_ + 1) >> hs_) & 0xffffu); \
                rb[j] = *(const u32x4*)(PV + ((lane < 32 ? o0_ : o1_) + c0)); } } while (0)
#define PV_TOLDS() do { _Pragma("unroll") for (int j = 0; j < 8; ++j) *(LAS u32x4*)(wl + j * 2 * RP + d0) = rb[j]; } while (0)
#define PV_COMP(HH, P) do { const int hh_ = (HH), l0_ = (hh_ & 7) * 8; \
            _Pragma("unroll") for (int tk = 0; tk < 2; ++tk) { \
                const unsigned cw_ = hh_ < 8 ? cww[2 * (P) + tk] & 0xffffu : cww[2 * (P) + tk] >> 16; \
                const unsigned w0_ = (unsigned)__shfl((int)cw_, l0_ + 2 * g4), w1_ = (unsigned)__shfl((int)cw_, l0_ + 2 * g4 + 1); \
                unsigned h0_, h1_, h2_, h3_, h4_, h5_, q0_, q1_, q2_, q3_, q4_, q5_; \
                place6(w0_ & 63u, sh6, h0_, h1_, h2_); place6(w1_ & 63u, sh6, h3_, h4_, h5_); \
                place6((w0_ >> 8) & 63u, sh6, q0_, q1_, q2_); place6((w1_ >> 8) & 63u, sh6, q3_, q4_, q5_); \
                const v8i_t Ah_ = {(int)h0_, (int)h1_, (int)h2_, (int)h3_, (int)h4_, (int)h5_, 0, 0}, Al_ = {(int)q0_, (int)q1_, (int)q2_, (int)q3_, (int)q4_, (int)q5_, 0, 0}; \
                const LAS unsigned char* bp_ = wl + (8 * tk + 2 * g4) * RP + 8 * m16; \
                _Pragma("unroll") for (int T4 = 0; T4 < 4; ++T4) { \
                    const u32x2 r0_ = *(const LAS u32x2*)(bp_ + 128 * T4), r1_ = *(const LAS u32x2*)(bp_ + 128 * T4 + RP); \
                    const v8i_t B_ = {(int)r0_.x, (int)r0_.y, (int)r1_.x, (int)r1_.y, 0, 0, 0, 0}; \
                    acc[2 * (P) + tk][T4] = __builtin_amdgcn_mfma_scale_f32_16x16x128_f8f6f4(Ah_, B_, acc[2 * (P) + tk][T4], 2, 4, 0, 0x7f7f7f7f, 0, 0x7f7f7f7f); \
                    acc[2 * (P) + tk][T4] = __builtin_amdgcn_mfma_scale_f32_16x16x128_f8f6f4(Al_, B_, acc[2 * (P) + tk][T4], 2, 4, 0, 0x7b7b7b7b, 0, 0x7f7f7f7f); } } } while (0)
        {
            u32x4 rb[8];
            PV_LOAD(0, 0);
#pragma unroll 1
            for (int h = 0; h < 16; ++h) {
                PV_TOLDS();
                __builtin_amdgcn_sched_barrier(0);
                PV_LOAD(h, 1);
                __builtin_amdgcn_sched_barrier(0);
                PV_COMP(h, 0);
                __builtin_amdgcn_sched_barrier(0);
                PV_TOLDS();
                __builtin_amdgcn_sched_barrier(0);
                PV_LOAD(h < 15 ? h + 1 : 15, 0);
                __builtin_amdgcn_sched_barrier(0);
                PV_COMP(h, 1);
                __builtin_amdgcn_sched_barrier(0);
            }
        }
#undef PV_LOAD
#undef PV_TOLDS
#undef PV_COMP
        int le = (int)threadIdx.x; asm volatile("" : "+v"(le)); le &= 63;
#pragma unroll
        for (int i = 0; i < 4; ++i) {
            if (act[i]) {
                const float* g2 = MOD + (size_t)(tt[i] >> 12) * 6144 + 5120;
                float* op = OUT + (size_t)tt[i] * 1024;
                const float csc_i = CSC[tt[i]];
#pragma unroll
                for (int T4 = 0; T4 < 4; ++T4) {
                    const int col = 256 * T4 + 16 * (le & 15) + 4 * (le >> 4);
                    const f32x4 g = *(const f32x4*)(g2 + col), x1 = *(const f32x4*)(op + col);
                    *(f32x4*)(op + col) = x1 + (g * csc_i) * acc[i][T4];
                }
            }
        }
    }
}
#define XB_TMO      128
#define XB_XCNT(j)  (256  + 64 * (j))
#define XB_XSUB(j)  (1280 + 64 * (j))
#define XB_XGEN(j)  (2304 + 64 * (j))
#define XB_TOP      3328
#define XB_TOPGEN   3392
#define XCD_BAR_WORDS 3456
#define XB_SPIN_CAP (1u << 20)
__device__ __forceinline__ unsigned xb_ld(unsigned* p)              { return __hip_atomic_load(p, __ATOMIC_RELAXED, __HIP_MEMORY_SCOPE_AGENT); }
__device__ __forceinline__ unsigned xb_add(unsigned* p, unsigned v) { return __hip_atomic_fetch_add(p, v, __ATOMIC_RELAXED, __HIP_MEMORY_SCOPE_AGENT); }
__device__ __forceinline__ unsigned xb_xcc_id() { return (unsigned)__builtin_amdgcn_s_getreg((3 << 11) | 20) & 0xFu; }
#define XB_SPIN(cond, bar) do { unsigned _sp = 0; while (cond) { __builtin_amdgcn_s_sleep(1); \
    if ((++_sp & 255u) == 0u) { if (xb_ld(&(bar)[XB_TMO])) break; if (_sp > XB_SPIN_CAP) { atomicAdd(&(bar)[XB_TMO], 1u); break; } } } } while (0)
struct XcdBarrier { unsigned* bar; unsigned x; volatile LAS unsigned* st; };
__device__ __forceinline__ XcdBarrier xcd_barrier_post(unsigned* bar, volatile LAS unsigned* st) {
    XcdBarrier b; b.bar = bar; b.x = xb_xcc_id(); b.st = st;
    if (threadIdx.x == 0) (void)xb_add(&bar[XB_XCNT(b.x)], 1u);
    return b;
}
__device__ __forceinline__ void xcd_barrier_complete(unsigned* bar, unsigned x, unsigned& nloc, unsigned& nx) {
    const unsigned G = gridDim.x * gridDim.y * gridDim.z;
    unsigned sum, cnt, mine, sp = 0u;
    for (;;) {
        sum = 0u; cnt = 0u; mine = 0u;
#pragma unroll
        for (unsigned j = 0; j < 16; ++j) { const unsigned c = xb_ld(&bar[XB_XCNT(j)]); sum += c; cnt += (c > 0u) ? 1u : 0u; mine = (j == x) ? c : mine; }
        if (sum == G) break;
        __builtin_amdgcn_s_sleep(1);
        if ((++sp & 255u) == 0u) { if (xb_ld(&bar[XB_TMO])) break; if (sp > XB_SPIN_CAP) { atomicAdd(&bar[XB_TMO], 1u); break; } }
    }
    nloc = mine > 0u ? mine : 1u; nx = cnt > 0u ? cnt : 1u;
}
__device__ __forceinline__ void xcd_barrier(const XcdBarrier& b) {
    asm volatile("s_waitcnt vmcnt(0)" ::: "memory");
    __syncthreads();
    if (threadIdx.x == 0) {
        unsigned* bar = b.bar;
        __builtin_amdgcn_s_waitcnt(0);
        unsigned nloc = b.st[0], nx = b.st[1];
        if (nloc == 0u) { xcd_barrier_complete(bar, b.x, nloc, nx); b.st[0] = nloc; b.st[1] = nx; }
        const unsigned old = xb_add(&bar[XB_XSUB(b.x)], 1u);
        const unsigned gen = old / nloc;
        if (old + 1u == (gen + 1u) * nloc) {
            __builtin_amdgcn_fence(__ATOMIC_RELEASE, "agent");
            asm volatile("s_waitcnt vmcnt(0)" ::: "memory");
            const unsigned og = xb_add(&bar[XB_TOP], 1u);
            const unsigned tg = og / nx;
            if (og + 1u == (tg + 1u) * nx) xb_add(&bar[XB_TOPGEN], 1u);
            else XB_SPIN(xb_ld(&bar[XB_TOPGEN]) == tg, bar);
            __builtin_amdgcn_fence(__ATOMIC_ACQUIRE, "agent");
            xb_add(&bar[XB_XGEN(b.x)], 1u);
            asm volatile("s_waitcnt vmcnt(0)" ::: "memory");
        } else {
            XB_SPIN(xb_ld(&bar[XB_XGEN(b.x)]) == gen, bar);
            __builtin_amdgcn_fence(__ATOMIC_ACQUIRE, "agent");
            asm volatile("s_waitcnt vmcnt(0)" ::: "memory");
        }
    }
    __syncthreads();
}

constexpr int N_PHASES = 12;
#ifndef PROBE_K
#define PROBE_K -1
#endif
__global__ void __launch_bounds__(NWAVES * 64, 2) mk_fwd(Args a) {
    extern __shared__ __attribute__((aligned(16))) unsigned char lds_raw[];
    LAS unsigned char* lds = (LAS unsigned char*)lds_raw;
    cg::grid_group grid = cg::this_grid();
    const int G = gridDim.x, blk = blockIdx.x;
    unsigned char* ws = a.ws;
    float* MOD = (float*)(ws + WS_MOD);
    bf16* H = (bf16*)(ws + WS_H);
    bf16 *CB = (bf16*)(ws + WS_CB), *CC = (bf16*)(ws + WS_CC), *CX = (bf16*)(ws + WS_CX), *Qb = (bf16*)(ws + WS_Q), *Kb = (bf16*)(ws + WS_K), *Vb = (bf16*)(ws + WS_V), *QI = (bf16*)(ws + WS_QI);
    bf16 *GC = (bf16*)(ws + WS_GC), *GA = (bf16*)(ws + WS_GA), *KI = (bf16*)(ws + WS_KI); float* WI = (float*)(ws + WS_WI);
    unsigned long long* MASK = (unsigned long long*)(ws + WS_MASK);
    bf16* PQ = (bf16*)(ws + WS_PQ); unsigned short* EIDX = (unsigned short*)(ws + WS_EIDX); float* EG = (float*)(ws + WS_EG); float* COEF = (float*)(ws + WS_COEF);
#define IN(k) (a.ph_lo <= (k) && (k) < a.ph_hi)
#define SEAM(k) do { if (IN(k) && IN((k) + 1)) { if ((k) == 0) grid.sync(); else xcd_barrier(xbar); } if (PROBE_K == (k) && threadIdx.x == 0) pst[1] = __builtin_amdgcn_s_memrealtime(); if (PROBE_K == (k) + 1 && threadIdx.x == 0) pst[0] = __builtin_amdgcn_s_memrealtime(); } while (0)
    volatile LAS unsigned* xst = (volatile LAS unsigned*)(lds + LDS_BYTES - 64);
    if (threadIdx.x < 4) xst[threadIdx.x] = 0u;
    __syncthreads();
    const XcdBarrier xbar = xcd_barrier_post((unsigned*)(ws + WS_CTL), xst);

    volatile LAS unsigned long long* pst = (volatile LAS unsigned long long*)(lds + LDS_BYTES - 48);
    if (PROBE_K >= 0 && threadIdx.x == 0) { pst[0] = 0; pst[1] = 0; pst[2] = 0; pst[3] = 0; }
    if (PROBE_K == 0 && threadIdx.x == 0) pst[0] = __builtin_amdgcn_s_memrealtime();
    if (IN(0)) p0_prologue(lds, a, G, blk);
    SEAM(0);
    if (IN(1)) norm_phase<false>(a.in[0], a.in[4], MOD, 0, H, G, blk);
    SEAM(1);
    if (IN(2)) {
        pg8::Gemm g{H, (const bf16*)(ws + WS_WIN), T, NIN_PAD, DM}; pg8::StaticOrder S; S.init(T, NIN_PAD, G, blk);
        EpiInProj E{ws, a.in[8], a.in[9]};
        pg8::gemm_phase<EpiInProj, true, true>(lds, g, S, E);
    }
    SEAM(2);
    if (IN(3)) { if (PROBE_SUB == 3 && threadIdx.x == 0) pst[3] = __builtin_amdgcn_s_memrealtime(); conv_phase(CB, CC, CX, a.in[6], H, G, blk); if (PROBE_SUB == 3) { __syncthreads(); if (threadIdx.x == 0) pst[2] += __builtin_amdgcn_s_memrealtime() - pst[3]; }
        indexer_phase(lds, QI, KI, WI, MASK, G, blk); }
    SEAM(3);
    if (IN(4)) att::attn_phase(lds, Qb, Kb, Vb, MASK, a.in[8], a.in[9], H, G, blk);
    SEAM(4);
    if (IN(5)) {
        pg8::Gemm g{H, (const bf16*)(ws + WS_WCO), T, DM, DM}; pg8::StaticOrder S; S.init(T, DM, G, blk);
        EpiMixFused E{GC, GA, CB};
        pg8::gemm_phase<EpiMixFused, true, true>(lds, g, S, E);
    }
    SEAM(5);
    if (IN(6)) {
        pg8::Gemm g{CB, (const bf16*)(ws + WS_WO), T, DM, DM}; pg8::StaticOrder S; S.init(T, DM, G, blk);
        EpiDelta E{MOD, H};
        pg8::gemm_phase<EpiDelta, true, true>(lds, g, S, E);
    }
    SEAM(6);
    if (IN(7)) norm_phase<true>(a.in[0], a.in[12], MOD, 3072, H, G, blk, a.out);
    SEAM(7);
    if (IN(8)) {
        pg8::Gemm g{H, (const bf16*)(ws + WS_WPQ), T, DM, DM}; pg8::StaticOrder S; S.init(T, DM, G, blk);
        EpiPlain E{PQ};
        pg8::gemm_phase<EpiPlain, true, true>(lds, g, S, E);
    }
    SEAM(8);
    if (IN(9)) peer_route_phase(lds, PQ, (const bf16*)(ws + WS_SK), EIDX, EG, G, blk);
    SEAM(9);
    if (IN(10)) peer_u_simple(lds, H, (tab_ptr)(ws + WS_PU), (const float*)(ws + WS_RSU), (const float*)(ws + WS_RSV), EIDX, EG, COEF, (unsigned short*)(ws + WS_CCODE), (float*)(ws + WS_CSC), G, blk);
    SEAM(10);
    if (IN(11)) peer_v_phase(lds, (tab_ptr)(ws + WS_PV), EIDX, (const unsigned short*)(ws + WS_CCODE), (const float*)(ws + WS_CSC), MOD, a.out, G, blk);
    if (PROBE_K >= 0) {
        xcd_barrier(xbar);
        if (blk != 0 || threadIdx.x != 0) return;
        if (PROBE_K == 11) pst[1] = __builtin_amdgcn_s_memrealtime();
        const unsigned long long te = __builtin_amdgcn_s_memrealtime();
        const unsigned long long span = PROBE_SUB ? pst[2] : pst[1] - pst[0];
        while (__builtin_amdgcn_s_memrealtime() - te < span) __builtin_amdgcn_s_sleep(20);
    }
#undef IN
#undef SEAM
}

#ifndef MK_N_LAUNCHES
#define MK_N_LAUNCHES 1
#endif
extern "C" void kernel_launch(void* const* d_in, const int* in_sizes, int n_in, void* d_out, int out_size, void* d_ws, size_t ws_size, hipStream_t stream) {
    static int grid = 0;
    if (grid == 0) {
        if (n_in != 17 || in_sizes[0] != T * DM || out_size != T * DM || ws_size < WS_END) {
            fprintf(stderr, "kernel_launch: unexpected problem: n_in %d in0 %d out %d ws %zu (need %zu); nothing launched\n", n_in, n_in > 0 ? in_sizes[0] : -1, out_size, ws_size, (size_t)WS_END); grid = -1; return; }
        int dev = 0, cus = 0, per_cu = 0;
        hipGetDevice(&dev); hipDeviceGetAttribute(&cus, hipDeviceAttributeMultiprocessorCount, dev);
        if (hipFuncSetAttribute((const void*)mk_fwd, hipFuncAttributeMaxDynamicSharedMemorySize, LDS_BYTES) != hipSuccess) { fprintf(stderr, "kernel_launch: hipFuncSetAttribute failed\n"); grid = -1; return; }
        if (hipOccupancyMaxActiveBlocksPerMultiprocessor(&per_cu, (const void*)mk_fwd, NWAVES * 64, LDS_BYTES) != hipSuccess || per_cu < 1) { fprintf(stderr, "kernel_launch: occupancy query says %d blocks per CU\n", per_cu); grid = -1; return; }
        grid = cus;
    }
    if (grid < 0) return;
    if (hipMemsetAsync((char*)d_ws + WS_CTL, 0, CTL_BYTES, stream) != hipSuccess) { fprintf(stderr, "kernel_launch: hipMemsetAsync failed\n"); return; }
    Args a{};
    for (int i = 0; i < 17; ++i) a.in[i] = (const float*)d_in[i];
    a.out = (float*)d_out; a.ws = (unsigned char*)d_ws;
    for (int li = 0; li < MK_N_LAUNCHES; ++li) {
        a.ph_lo = li * (N_PHASES / MK_N_LAUNCHES); a.ph_hi = (li + 1) * (N_PHASES / MK_N_LAUNCHES);
        void* args[] = {&a};
        hipError_t e = hipLaunchCooperativeKernel((const void*)mk_fwd, dim3(grid), dim3(NWAVES * 64), args, LDS_BYTES, stream);
        if (e != hipSuccess) { fprintf(stderr, "kernel_launch: cooperative launch %d failed: %s (grid %d)\n", li, hipGetErrorString(e), grid); break; }
    }
}
```

```cpp
#include <hip/hip_runtime.h>
#include <hip/hip_cooperative_groups.h>
#include <cstdio>
#include <cstdint>
namespace cg = cooperative_groups;

#define LAS __attribute__((address_space(3)))
typedef unsigned short bf16;
typedef short bf16x8 __attribute__((ext_vector_type(8)));
typedef short s16x4 __attribute__((ext_vector_type(4)));
typedef float f32x2 __attribute__((ext_vector_type(2)));
typedef float f32x4 __attribute__((ext_vector_type(4)));
typedef float f32x16 __attribute__((ext_vector_type(16)));
typedef unsigned u32x2 __attribute__((ext_vector_type(2)));
typedef unsigned u32x4 __attribute__((ext_vector_type(4)));
typedef __bf16 bf16x2_t __attribute__((ext_vector_type(2)));

__device__ __forceinline__ unsigned pk2(float lo, float hi) { f32x2 v = {lo, hi}; bf16x2_t b = __builtin_convertvector(v, bf16x2_t); return __builtin_bit_cast(unsigned, b); }
__device__ __forceinline__ float bflo(unsigned u) { return __uint_as_float(u << 16); }
__device__ __forceinline__ float bfhi(unsigned u) { return __uint_as_float(u & 0xffff0000u); }
__device__ __forceinline__ unsigned ordf(float f) { unsigned u = __float_as_uint(f); return u ^ ((u & 0x80000000u) ? 0xffffffffu : 0x80000000u); }
__device__ __forceinline__ float unordf(unsigned u) { return __uint_as_float((u & 0x80000000u) ? (u ^ 0x80000000u) : ~u); }
#define LDS_WAIT() asm volatile("s_waitcnt lgkmcnt(0)" ::: "memory")
__device__ __forceinline__ int phase_tid() { int t = (int)threadIdx.x; asm volatile("" : "+v"(t)); return t; }

constexpr int PEER_ROWB = 768;
typedef const unsigned char* tab_ptr;
constexpr int NB = 16, SEQ = 4096, DM = 1024, T = NB * SEQ;
constexpr int NIN_PAD = 5888;
constexpr float EPS = 1e-6f;
constexpr float C2 = 0.125f * 1.4426950408889634f;
constexpr int NWAVES = 8;

constexpr size_t MiB = 1u << 20;
constexpr size_t WS_MOD = 1 * MiB;
constexpr size_t WS_RSU = 1 * MiB + 512 * 1024, WS_RSV = 1 * MiB + 640 * 1024;
constexpr size_t WS_WIN = 2 * MiB;
constexpr size_t WS_WCO = 14 * MiB;
constexpr size_t WS_WAO = 15 * MiB;
constexpr size_t WS_WO = 16 * MiB;
constexpr size_t WS_WPQ = 18 * MiB;
constexpr size_t WS_SK = 20 * MiB;
constexpr size_t WS_PU = 32 * MiB;
constexpr size_t WS_PV = 64 * MiB;
constexpr size_t WS_H = 96 * MiB;
constexpr size_t WS_CB = 224 * MiB;
constexpr size_t WS_CC = 288 * MiB;
constexpr size_t WS_CX = 352 * MiB;
constexpr size_t WS_Q = 416 * MiB;
constexpr size_t WS_K = 480 * MiB;
constexpr size_t WS_V = 544 * MiB;
constexpr size_t WS_QI = 608 * MiB;
constexpr size_t WS_GC = 672 * MiB;
constexpr size_t WS_GA = 800 * MiB;
constexpr size_t WS_KI = 928 * MiB;
constexpr size_t WS_WI = 936 * MiB;
constexpr size_t WS_MASK = 938 * MiB;
constexpr size_t WS_END = 970 * MiB;
constexpr size_t WS_PQ = WS_CC;
constexpr size_t WS_EIDX = WS_K;
constexpr size_t WS_EG = WS_K + 16 * MiB;
constexpr size_t WS_CCODE = WS_Q, WS_CSC = WS_Q + 16 * MiB;
constexpr size_t WS_COEF = WS_V;
constexpr size_t WS_CTL = 0;
constexpr size_t CTL_BYTES = 32768;

constexpr int LDS_BYTES = 147456;

namespace pg8 {
constexpr int BM = 256, BK = 64, HALF = 128, HTB = HALF * BK * 2, STAGE_BYTES = 8 * HTB, NXCD = 8, WGM = 8;
__host__ __device__ __forceinline__ int lds_byte(int r, int c) { const int st = (r >> 4) * 2 + (c >> 5), rr = r & 15, cc = c & 31, ob = rr * 64 + cc * 2; return st * 1024 + (ob ^ (((ob >> 9) & 1) << 5)); }
__host__ __device__ __forceinline__ void stage_rc(int b, int& R, int& C) { const int st = b / 1024, sb = b % 1024, swz = sb ^ (((sb >> 9) & 1) << 5); R = (st >> 1) * 16 + swz / 64; C = (st & 1) * 32 + (swz % 64) / 2; }
__host__ __device__ __forceinline__ int perm32(int rho) { const int n = rho >> 4, i = rho & 15; return 8 * (i >> 2) + 4 * n + (i & 3); }
struct Unit { int pm, pn; };
struct Gemm { const bf16* A; const bf16* Bt; int M, N, K; };
struct StaticOrder {
    int nM, nN, nwg, G, c;
    __device__ void init(int M, int N, int G_, int c_) { nM = M / BM; nN = N / BM; nwg = nM * nN; G = G_; c = c_; }
    __device__ bool next(int i, Unit& u) const {
        const long L = (long)i * G + c; if (L >= nwg) return false;
        int wgid = (int)L; { const int q = nwg / NXCD, r = nwg % NXCD, xcd = wgid % NXCD, off = wgid / NXCD; wgid = (xcd < r ? xcd * (q + 1) : r * (q + 1) + (xcd - r) * q) + off; }
        const int nig = WGM * nN, gid = wgid / nig, fm = gid * WGM, gsz = (nM - fm) < WGM ? (nM - fm) : WGM;
        u.pm = fm + ((wgid % nig) % gsz); u.pn = (wgid % nig) / gsz; return true;
    }
};

template <class Epi, bool ALIGN_EPI, bool SP2>
__device__ __forceinline__ void gemm_phase(LAS unsigned char* lds, const Gemm g, const StaticOrder& S, const Epi& E) {
    const int tid = phase_tid(), wid = __builtin_amdgcn_readfirstlane(tid >> 6), lane = tid & 63, wr = wid >> 2, wc = wid & 3, fr = lane & 15, fq = lane >> 4;
    const int K = g.K, nt = K / BK;
    unsigned voffA[2], voffB[2];
#pragma unroll
    for (int i = 0; i < 2; ++i) { int R, C; stage_rc(tid * 16 + i * 8192, R, C); const int Rb = Epi::PERM ? ((R & ~31) + perm32(R & 31)) : R;
        voffA[i] = (unsigned)(R * K + C) * 2u; voffB[i] = (unsigned)(Rb * K + C) * 2u; }
    const size_t kstep = (size_t)(BK * 2);
    const size_t hstep = (size_t)HALF * K * 2;
    const size_t tstep = 2 * hstep;
    const unsigned ldsw = (unsigned)wid * 1024u;
    const int aoff = lds_byte(wr * 64 + fr, fq * 8), boff = lds_byte(wc * 32 + fr, fq * 8);
#define PG8_SA(b, h) (((b) * 2 + (h)) * HTB)
#define PG8_SB(b, h) ((4 + (b) * 2 + (h)) * HTB)
#define PG8_STAGE(bufoff, gbase, voff) do { _Pragma("unroll") for (int _i = 0; _i < 2; ++_i) \
        __builtin_amdgcn_global_load_lds((const unsigned*)((const char*)(gbase) + (voff)[_i]), (LAS unsigned*)(lds + (bufoff) + ldsw + _i * 8192), 16, 0, 0); } while (0)
#define PG8_LDA(dst, b, h) do { _Pragma("unroll") for (int m = 0; m < 4; ++m) _Pragma("unroll") for (int k = 0; k < 2; ++k) dst[m][k] = *(const LAS bf16x8*)(lds + PG8_SA(b, h) + aoff + m * 2048 + k * 1024); } while (0)
#define PG8_LDB(dst, b, h) do { _Pragma("unroll") for (int n = 0; n < 2; ++n) _Pragma("unroll") for (int k = 0; k < 2; ++k) dst[n][k] = *(const LAS bf16x8*)(lds + PG8_SB(b, h) + boff + n * 2048 + k * 1024); } while (0)
#define PG8_MMA(ai, bj, At, Bt) do { __builtin_amdgcn_s_setprio(1); _Pragma("unroll") for (int m = 0; m < 4; ++m) _Pragma("unroll") for (int n = 0; n < 2; ++n) _Pragma("unroll") for (int k = 0; k < 2; ++k) \
        acc[ai][bj][m][n] = __builtin_amdgcn_mfma_f32_16x16x32_bf16(Bt[n][k], At[m][k], acc[ai][bj][m][n], 0, 0, 0); __builtin_amdgcn_s_setprio(0); } while (0)
#define PG8_WAIT_V(n) asm volatile("s_waitcnt vmcnt(" #n ")" ::: "memory")
#define PG8_WAIT_L(n) asm volatile("s_waitcnt lgkmcnt(" #n ")" ::: "memory")
#define PG8_BAR __builtin_amdgcn_s_barrier()
#define PG8_SCHED __builtin_amdgcn_sched_barrier(0)
    Unit cur, nxt; int ui = 0;
    if (!S.next(0, cur)) return;
    f32x4 acc[2][2][4][2];
#pragma unroll
    for (int a = 0; a < 2; ++a)
#pragma unroll
        for (int b = 0; b < 2; ++b)
#pragma unroll
            for (int m = 0; m < 4; ++m)
#pragma unroll
                for (int n = 0; n < 2; ++n) acc[a][b][m][n] = (f32x4){0.f, 0.f, 0.f, 0.f};
    bf16x8 At[4][2], B0[2][2], B1[2][2];
    const char* cA = (const char*)g.A + (size_t)cur.pm * tstep; const char* cB = (const char*)g.Bt + (size_t)cur.pn * tstep;
    if constexpr (SP2) {
        PG8_STAGE(PG8_SB(0, 0), cB, voffB); PG8_STAGE(PG8_SB(0, 1), cB + hstep, voffB); PG8_STAGE(PG8_SA(0, 0), cA, voffA); PG8_STAGE(PG8_SA(0, 1), cA + hstep, voffA);
        if (wr == 1) PG8_BAR;
        PG8_WAIT_V(2); PG8_BAR;
        PG8_STAGE(PG8_SB(1, 0), cB + kstep, voffB); PG8_STAGE(PG8_SA(1, 0), cA + kstep, voffA); PG8_STAGE(PG8_SB(1, 1), cB + hstep + kstep, voffB);
        PG8_WAIT_V(6); PG8_BAR;
    } else {
        PG8_STAGE(PG8_SB(0, 0), cB, voffB); PG8_STAGE(PG8_SA(0, 0), cA, voffA); PG8_STAGE(PG8_SB(0, 1), cB + hstep, voffB); PG8_STAGE(PG8_SA(0, 1), cA + hstep, voffA);
        if (wr == 1) PG8_BAR;
        PG8_WAIT_V(4); PG8_BAR;
        PG8_STAGE(PG8_SB(1, 0), cB + kstep, voffB); PG8_STAGE(PG8_SA(1, 0), cA + kstep, voffA); PG8_STAGE(PG8_SB(1, 1), cB + hstep + kstep, voffB);
        PG8_WAIT_V(6); PG8_BAR;
    }
    for (;;) {
        const bool has_next = S.next(ui + 1, nxt);
        const char* nA = has_next ? (const char*)g.A + (size_t)nxt.pm * tstep : cA; const char* nB = has_next ? (const char*)g.Bt + (size_t)nxt.pn * tstep : cB;
        for (int t = 0; t < nt; t += 2) {
            if constexpr (Epi::MIDK) { if (t == nt / 2) E.mid(acc, cur, wr, wc, fr, fq); }
            const bool last = (t == nt - 2);
            const char* a1 = cA + (size_t)(t + 1) * kstep;
            const char* a2 = last ? nA : cA + (size_t)(t + 2) * kstep; const char* b2 = last ? nB : cB + (size_t)(t + 2) * kstep;
            const char* a3 = a2 + kstep; const char* b3 = b2 + kstep;
            if constexpr (SP2) {
            PG8_LDB(B0, 0, 0); PG8_LDB(B1, 0, 1); PG8_SCHED; PG8_LDA(At, 0, 0); PG8_STAGE(PG8_SA(1, 1), a1 + hstep, voffA);
            PG8_WAIT_V(8); PG8_WAIT_L(0); PG8_BAR; PG8_MMA(0, 0, At, B0); PG8_MMA(0, 1, At, B1); PG8_BAR; PG8_SCHED;
            PG8_LDA(At, 0, 1); PG8_STAGE(PG8_SB(0, 0), b2, voffB); PG8_STAGE(PG8_SB(0, 1), b2 + hstep, voffB); PG8_STAGE(PG8_SA(0, 0), a2, voffA);
            PG8_WAIT_V(8); PG8_WAIT_L(0); PG8_BAR; PG8_MMA(1, 0, At, B0); PG8_MMA(1, 1, At, B1); PG8_BAR; PG8_SCHED;
            PG8_LDB(B0, 1, 0); PG8_LDB(B1, 1, 1); PG8_SCHED; PG8_LDA(At, 1, 0); PG8_STAGE(PG8_SA(0, 1), a2 + hstep, voffA);
            PG8_WAIT_V(8); PG8_WAIT_L(0); PG8_BAR; PG8_MMA(0, 0, At, B0); PG8_MMA(0, 1, At, B1); PG8_BAR; PG8_SCHED;
            PG8_LDA(At, 1, 1); PG8_STAGE(PG8_SB(1, 0), b3, voffB); PG8_STAGE(PG8_SB(1, 1), b3 + hstep, voffB); PG8_STAGE(PG8_SA(1, 0), a3, voffA);
            PG8_WAIT_V(8); PG8_WAIT_L(0); PG8_BAR; PG8_MMA(1, 0, At, B0); PG8_MMA(1, 1, At, B1); PG8_BAR; PG8_SCHED;
            } else {
            PG8_LDB(B0, 0, 0); PG8_SCHED; PG8_LDA(At, 0, 0); PG8_STAGE(PG8_SA(1, 1), a1 + hstep, voffA);
            PG8_WAIT_L(8); PG8_BAR; PG8_WAIT_L(0); PG8_MMA(0, 0, At, B0); PG8_BAR; PG8_SCHED;
            PG8_LDB(B1, 0, 1); PG8_STAGE(PG8_SB(0, 0), b2, voffB);
            PG8_BAR; PG8_WAIT_L(0); PG8_MMA(0, 1, At, B1); PG8_BAR;
            PG8_LDA(At, 0, 1); PG8_STAGE(PG8_SA(0, 0), a2, voffA);
            PG8_BAR; PG8_WAIT_L(0); PG8_MMA(1, 0, At, B0); PG8_BAR; PG8_SCHED;
            PG8_STAGE(PG8_SB(0, 1), b2 + hstep, voffB);
            PG8_WAIT_V(6); PG8_BAR; PG8_MMA(1, 1, At, B1); PG8_BAR;
            PG8_LDB(B0, 1, 0); PG8_SCHED; PG8_LDA(At, 1, 0); PG8_STAGE(PG8_SA(0, 1), a2 + hstep, voffA);
            PG8_WAIT_L(8); PG8_BAR; PG8_WAIT_L(0); PG8_MMA(0, 0, At, B0); PG8_BAR; PG8_SCHED;
            PG8_LDB(B1, 1, 1); PG8_STAGE(PG8_SB(1, 0), b3, voffB);
            PG8_BAR; PG8_WAIT_L(0); PG8_MMA(0, 1, At, B1); PG8_BAR;
            PG8_LDA(At, 1, 1); PG8_STAGE(PG8_SA(1, 0), a3, voffA);
            PG8_BAR; PG8_WAIT_L(0); PG8_MMA(1, 0, At, B0); PG8_BAR; PG8_SCHED;
            PG8_STAGE(PG8_SB(1, 1), b3 + hstep, voffB);
            PG8_WAIT_V(6); PG8_BAR; PG8_MMA(1, 1, At, B1); PG8_BAR;
            }
        }
        if constexpr (ALIGN_EPI) { if (wr == 0) PG8_BAR; }
        E(acc, cur, wr, wc, fr, fq);
        if (!has_next) break;
#pragma unroll
        for (int a = 0; a < 2; ++a)
#pragma unroll
            for (int b = 0; b < 2; ++b)
#pragma unroll
                for (int m = 0; m < 4; ++m)
#pragma unroll
                    for (int n = 0; n < 2; ++n) acc[a][b][m][n] = (f32x4){0.f, 0.f, 0.f, 0.f};
        cur = nxt; cA = nA; cB = nB; ++ui;
        if constexpr (ALIGN_EPI) { if (wr == 1) PG8_BAR; }
    }
    PG8_WAIT_V(0);
    if constexpr (!ALIGN_EPI) { if (wr == 0) PG8_BAR; }
    PG8_BAR;
#undef PG8_SA
#undef PG8_SB
#undef PG8_STAGE
#undef PG8_LDA
#undef PG8_LDB
#undef PG8_MMA
#undef PG8_WAIT_V
#undef PG8_WAIT_L
#undef PG8_BAR
#undef PG8_SCHED
}
}

typedef const f32x4 (&AccRef)[2][2][4][2];

__device__ __forceinline__ u32x4 pack8(f32x4 v0, f32x4 v1) { u32x4 w; w.x = pk2(v0[0], v0[1]); w.y = pk2(v0[2], v0[3]); w.z = pk2(v1[0], v1[1]); w.w = pk2(v1[2], v1[3]); return w; }
__device__ __forceinline__ float sigm(float x) { return __builtin_amdgcn_rcpf(1.f + __builtin_amdgcn_exp2f(-1.4426950408889634f * x)); }

struct EpiInProj {
    static constexpr bool PERM = true; static constexpr bool MIDK = false;
    unsigned char* ws; const float* qnw; const float* knw;
    __device__ __forceinline__ void operator()(AccRef acc, const pg8::Unit& u, int wr, int wc, int fr, int fq) const {
        const int pn = u.pn; const size_t row0 = (size_t)u.pm * 256 + wr * 64 + fr;
        bf16* const V = (bf16*)(ws + WS_V); bf16* const KI = (bf16*)(ws + WS_KI); float* const WI = (float*)(ws + WS_WI);
        if (pn == 10 || pn == 11) {
            bf16* vb = V + ((size_t)((u.pm >> 4) * 8 + 4 * (pn & 1) + (wc >> 1)) * 4096 + (u.pm & 15) * 256 + wr * 64) * 64 + (wc & 1) * 2048 + fr * 32 + 8 * fq;
#pragma unroll
            for (int ai = 0; ai < 2; ++ai)
#pragma unroll
                for (int m = 0; m < 4; ++m)
#pragma unroll
                    for (int bj = 0; bj < 2; ++bj) *(u32x4*)(vb + (size_t)(2 * bj * 4096 + ai * 128) * 64 + m * 16 * 32) = pack8(acc[ai][bj][m][0], acc[ai][bj][m][1]);
        } else if (pn < 6 || (pn >= 12 && pn < 14)) {
            bf16* base = (bf16*)(ws + (pn < 6 ? WS_CB + (size_t)(pn >> 1) * (64 * MiB) : WS_QI));
            static_assert(WS_CC == WS_CB + 64 * MiB && WS_CX == WS_CB + 128 * MiB, "cb | cc | cx are consecutive 64 MiB regions");
            const int col0 = (pn & 1) * 256 + wc * 32 + 8 * fq;
#pragma unroll
            for (int ai = 0; ai < 2; ++ai)
#pragma unroll
                for (int m = 0; m < 4; ++m) { bf16* rowp = base + (row0 + ai * 128 + m * 16) * 512 + col0;
#pragma unroll
                    for (int bj = 0; bj < 2; ++bj) *(u32x4*)(rowp + bj * 128) = pack8(acc[ai][bj][m][0], acc[ai][bj][m][1]); }
        } else if (pn < 10) {
            const bool isq = pn < 8; bf16* base = (bf16*)(ws + (isq ? WS_Q : WS_K)); const float* nw = isq ? qnw : knw; const float sc = isq ? C2 : 1.f;
            const int head = 4 * (pn & 1) + wc;
            f32x4 w[2][2];
#pragma unroll
            for (int bj = 0; bj < 2; ++bj)
#pragma unroll
                for (int n = 0; n < 2; ++n) w[bj][n] = *(const f32x4*)(nw + 32 * bj + 8 * fq + 4 * n) * sc;
#pragma unroll
            for (int ai = 0; ai < 2; ++ai)
#pragma unroll
                for (int m = 0; m < 4; ++m) {
                    float ss = 0.f;
#pragma unroll
                    for (int bj = 0; bj < 2; ++bj)
#pragma unroll
                        for (int n = 0; n < 2; ++n) { const f32x4 x = acc[ai][bj][m][n]; ss += (x[0] * x[0] + x[1] * x[1]) + (x[2] * x[2] + x[3] * x[3]); }
                    ss += __shfl_xor(ss, 16); ss += __shfl_xor(ss, 32);
                    const float r = __builtin_amdgcn_rsqf(ss * (1.f / 64.f) + EPS);
                    bf16* rowp = isq ? base + (row0 + ai * 128 + m * 16) * 512 + head * 64 + 8 * fq
                                     : base + ((size_t)((u.pm >> 4) * 8 + head) * 4096 + (u.pm & 15) * 256 + wr * 64 + ai * 128) * 64 + fq * 512 + (fr + m * 16) * 8;
#pragma unroll
                    for (int bj = 0; bj < 2; ++bj) *(u32x4*)(rowp + (isq ? bj * 32 : bj * 4 * 512)) = pack8(acc[ai][bj][m][0] * r * w[bj][0], acc[ai][bj][m][1] * r * w[bj][1]);
                }
        } else if (pn < 22) {
            bf16* base = (bf16*)(ws + (pn < 18 ? WS_GC : WS_GA)); const int col0 = ((pn - 14) & 3) * 256 + wc * 32 + 8 * fq;
#pragma unroll
            for (int ai = 0; ai < 2; ++ai)
#pragma unroll
                for (int m = 0; m < 4; ++m) { bf16* rowp = base + (row0 + ai * 128 + m * 16) * 1024 + col0;
#pragma unroll
                    for (int bj = 0; bj < 2; ++bj) { f32x4 a = acc[ai][bj][m][0], b = acc[ai][bj][m][1];
#pragma unroll
                        for (int j = 0; j < 4; ++j) { a[j] = sigm(a[j]); b[j] = sigm(b[j]); }
                        *(u32x4*)(rowp + bj * 128) = pack8(a, b); } }
        } else {
            if (wc < 2) {
#pragma unroll
                for (int ai = 0; ai < 2; ++ai)
#pragma unroll
                    for (int m = 0; m < 4; ++m) { const size_t tr = row0 + ai * 128 + m * 16; const int c0 = wc * 32 + 8 * fq;
                        *(u32x4*)(KI + ((tr >> 5) * 4 + (c0 >> 4)) * 512 + ((c0 >> 3) & 1) * 256 + (tr & 31) * 8) = pack8(acc[ai][0][m][0], acc[ai][0][m][1]); }
            } else if (wc == 2 && fq == 0) {
#pragma unroll
                for (int ai = 0; ai < 2; ++ai)
#pragma unroll
                    for (int m = 0; m < 4; ++m) { float* p = WI + (row0 + ai * 128 + m * 16) * 8; *(f32x4*)p = acc[ai][0][m][0]; *(f32x4*)(p + 4) = acc[ai][0][m][1]; }
            }
        }
    }
};

struct EpiMixFused {
    static constexpr bool PERM = true; static constexpr bool MIDK = true;
    const bf16* GC; const bf16* GA; bf16* MIX;
    __device__ __forceinline__ void mid(f32x4 (&acc)[2][2][4][2], const pg8::Unit& u, int wr, int wc, int fr, int fq) const {
        unsigned base = (unsigned)((u.pm * 256 + wr * 64 + fr) * 1024 + u.pn * 256 + wc * 32 + 8 * fq);
        asm volatile("" : "+v"(base));
#define MIX_R(GCV, GAV) ((GCV) * __builtin_amdgcn_rcpf(fmaxf((GAV), 1e-20f)))
#pragma unroll
        for (int ai = 0; ai < 2; ++ai)
            {
                u32x4 gc[4][2], ga[4][2];
#pragma unroll
                for (int mm = 0; mm < 4; ++mm)
#pragma unroll
                    for (int bj = 0; bj < 2; ++bj) { const size_t off = (size_t)base + (size_t)(ai * 128 + mm * 16) * 1024 + bj * 128; gc[mm][bj] = *(const u32x4*)(GC + off); ga[mm][bj] = *(const u32x4*)(GA + off); }
#pragma unroll
                for (int mm = 0; mm < 4; ++mm)
#pragma unroll
                    for (int bj = 0; bj < 2; ++bj) { f32x4& a = acc[ai][bj][mm][0]; f32x4& b = acc[ai][bj][mm][1]; const u32x4 c = gc[mm][bj], g = ga[mm][bj];
                        a[0] *= MIX_R(bflo(c.x), bflo(g.x)); a[1] *= MIX_R(bfhi(c.x), bfhi(g.x)); a[2] *= MIX_R(bflo(c.y), bflo(g.y)); a[3] *= MIX_R(bfhi(c.y), bfhi(g.y));
                        b[0] *= MIX_R(bflo(c.z), bflo(g.z)); b[1] *= MIX_R(bfhi(c.z), bfhi(g.z)); b[2] *= MIX_R(bflo(c.w), bflo(g.w)); b[3] *= MIX_R(bfhi(c.w), bfhi(g.w)); }
                asm volatile("" ::: "memory");
            }
#undef MIX_R
    }
    __device__ __forceinline__ void operator()(AccRef acc, const pg8::Unit& u, int wr, int wc, int fr, int fq) const {
        const size_t row0 = (size_t)u.pm * 256 + wr * 64 + fr; const int col0 = u.pn * 256 + wc * 32 + 8 * fq;
        u32x4 gq[2][4][2];
#pragma unroll
        for (int ai = 0; ai < 2; ++ai)
#pragma unroll
            for (int m = 0; m < 4; ++m)
#pragma unroll
                for (int bj = 0; bj < 2; ++bj) gq[ai][m][bj] = *(const u32x4*)(GA + (row0 + ai * 128 + m * 16) * 1024 + col0 + bj * 128);
        __builtin_amdgcn_sched_barrier(0);
#pragma unroll
        for (int ai = 0; ai < 2; ++ai)
#pragma unroll
            for (int m = 0; m < 4; ++m) { const size_t off = (row0 + ai * 128 + m * 16) * 1024 + col0;
#pragma unroll
                for (int bj = 0; bj < 2; ++bj) {
                    const u32x4 g = gq[ai][m][bj];
                    f32x4 a = acc[ai][bj][m][0], b = acc[ai][bj][m][1];
                    a[0] *= fmaxf(bflo(g.x), 1e-20f); a[1] *= fmaxf(bfhi(g.x), 1e-20f); a[2] *= fmaxf(bflo(g.y), 1e-20f); a[3] *= fmaxf(bfhi(g.y), 1e-20f);
                    b[0] *= fmaxf(bflo(g.z), 1e-20f); b[1] *= fmaxf(bfhi(g.z), 1e-20f); b[2] *= fmaxf(bflo(g.w), 1e-20f); b[3] *= fmaxf(bfhi(g.w), 1e-20f);
                    *(u32x4*)(MIX + off + bj * 128) = pack8(a, b); } }
    }
};

struct EpiDelta {
    static constexpr bool PERM = true; static constexpr bool MIDK = false;
    const float* MOD; bf16* O;
    __device__ __forceinline__ void operator()(AccRef acc, const pg8::Unit& u, int wr, int wc, int fr, int fq) const {
        const size_t row0 = (size_t)u.pm * 256 + wr * 64 + fr; const int col0 = u.pn * 256 + wc * 32 + 8 * fq;
        const float* g1 = MOD + (size_t)(u.pm >> 4) * 6144 + 2048;
        f32x4 gv[2][2];
#pragma unroll
        for (int bj = 0; bj < 2; ++bj)
#pragma unroll
            for (int n = 0; n < 2; ++n) gv[bj][n] = *(const f32x4*)(g1 + col0 + bj * 128 + 4 * n);
#pragma unroll
        for (int ai = 0; ai < 2; ++ai)
#pragma unroll
            for (int m = 0; m < 4; ++m) { bf16* rowp = O + (row0 + ai * 128 + m * 16) * 1024 + col0;
#pragma unroll
                for (int bj = 0; bj < 2; ++bj) *(u32x4*)(rowp + bj * 128) = pack8(acc[ai][bj][m][0] * gv[bj][0], acc[ai][bj][m][1] * gv[bj][1]); }
    }
};

struct EpiPlain {
    static constexpr bool PERM = true; static constexpr bool MIDK = false;
    bf16* O;
    __device__ __forceinline__ void operator()(AccRef acc, const pg8::Unit& u, int wr, int wc, int fr, int fq) const {
        const size_t row0 = (size_t)u.pm * 256 + wr * 64 + fr; const int col0 = u.pn * 256 + wc * 32 + 8 * fq;
#pragma unroll
        for (int ai = 0; ai < 2; ++ai)
#pragma unroll
            for (int m = 0; m < 4; ++m) { bf16* rowp = O + (row0 + ai * 128 + m * 16) * 1024 + col0;
#pragma unroll
                for (int bj = 0; bj < 2; ++bj) *(u32x4*)(rowp + bj * 128) = pack8(acc[ai][bj][m][0], acc[ai][bj][m][1]); }
    }
};

struct Args { const float* in[17]; float* out; unsigned char* ws; int ph_lo, ph_hi; };

__device__ __forceinline__ void transpose_item(const float* W, int ldw, int k0, int n0, int ncols, bf16* WT, int K, int drow0, LAS float* scr, int lane) {
    const int n_ = lane & 31, nn_ = n_ < ncols ? n_ : 0;
    float tv[32];
#pragma unroll
    for (int i = 0; i < 32; ++i) tv[i] = W[(size_t)(k0 + 2 * i + (lane >> 5)) * ldw + n0 + nn_];
#pragma unroll
    for (int i = 0; i < 32; ++i) scr[(2 * i + (lane >> 5)) * 33 + n_] = n_ < ncols ? tv[i] : 0.f;
    LDS_WAIT(); asm volatile("" ::: "memory");
    const int c = lane & 7;
#pragma unroll
    for (int j = 0; j < 4; ++j) { const int n = (lane >> 3) + 8 * j; const LAS float* s = scr + (8 * c) * 33 + n;
        u32x4 o; o.x = pk2(s[0 * 33], s[1 * 33]); o.y = pk2(s[2 * 33], s[3 * 33]); o.z = pk2(s[4 * 33], s[5 * 33]); o.w = pk2(s[6 * 33], s[7 * 33]);
        *(u32x4*)(WT + (size_t)(drow0 + n) * K + k0 + 8 * c) = o; }
    LDS_WAIT(); asm volatile("" ::: "memory");
}
__device__ __forceinline__ void cvt_stream(const float* src, bf16* dst, size_t n8, size_t i0, size_t stride) {
    for (size_t i = i0; i < n8; i += stride) { const f32x4 a = *(const f32x4*)(src + 8 * i), b = *(const f32x4*)(src + 8 * i + 4); *(u32x4*)(dst + 8 * i) = pack8(a, b); }
}

typedef unsigned v6u_t __attribute__((ext_vector_type(6)));
typedef float v32f_t __attribute__((ext_vector_type(32)));
typedef __bf16 v32bf_t __attribute__((ext_vector_type(32)));
struct __attribute__((packed, aligned(4))) U3 { unsigned x, y, z; };
__device__ __forceinline__ unsigned enc_e2m3(float y) {
    const float a = fminf(fabsf(y), 7.5f);
    const float r = a < 2.f ? a * 8.f : (a < 4.f ? a * 4.f + 8.f : a * 2.f + 16.f);
    unsigned c = (unsigned)__builtin_rintf(r); c = c > 31u ? 31u : c;
    return c | ((__float_as_uint(y) >> 26) & 32u);
}
__device__ __forceinline__ float dec_e2m3(unsigned c) {
    const unsigned m = c & 31u; const float fm = (float)m;
    const float v = m < 16u ? fm * 0.125f : (m < 24u ? fm * 0.25f - 2.f : fm * 0.5f - 8.f);
    return (c & 32u) ? -v : v;
}
__device__ __forceinline__ unsigned wave_max_dpp(unsigned x) {
    { const unsigned y = (unsigned)__builtin_amdgcn_update_dpp(0, (int)x, 0x141, 0xF, 0xF, false); x = x > y ? x : y; }
    { const unsigned y = (unsigned)__builtin_amdgcn_update_dpp(0, (int)x, 0x1B, 0xF, 0xF, false); x = x > y ? x : y; }
    { const unsigned y = (unsigned)__builtin_amdgcn_update_dpp(0, (int)x, 0xB1, 0xF, 0xF, false); x = x > y ? x : y; }
    { const unsigned y = (unsigned)__builtin_amdgcn_update_dpp(0, (int)x, 0x128, 0xF, 0xF, false); x = x > y ? x : y; }
    const unsigned a = (unsigned)__builtin_amdgcn_readlane((int)x, 0), b = (unsigned)__builtin_amdgcn_readlane((int)x, 16), c = (unsigned)__builtin_amdgcn_readlane((int)x, 32), d = (unsigned)__builtin_amdgcn_readlane((int)x, 48);
    const unsigned ab = a > b ? a : b, cd = c > d ? c : d; return ab > cd ? ab : cd;
}
__device__ __forceinline__ unsigned enc_e2m1(float y) {
    const float a = fminf(fabsf(y), 6.f);
    const float r = a < 2.f ? a * 2.f : (a < 4.f ? a + 2.f : a * 0.5f + 4.f);
    unsigned c = (unsigned)__builtin_rintf(r); c = c > 7u ? 7u : c;
    return c | ((__float_as_uint(y) >> 28) & 8u);
}
template <bool FP4>
__device__ __forceinline__ void cvt_rows_fpx(const float* src, unsigned char* dst, float* rs, int gw, int nw, int lane) {
    constexpr float VMAX = FP4 ? 6.f : 7.5f;
#pragma unroll 4
    for (int row = gw; row < 16384; row += nw) {
        const float* sp = src + (size_t)row * 1024 + 16 * lane;
        const f32x4 a = *(const f32x4*)sp, b = *(const f32x4*)(sp + 4), c = *(const f32x4*)(sp + 8), d = *(const f32x4*)(sp + 12);
        const float v[16] = {a[0], a[1], a[2], a[3], b[0], b[1], b[2], b[3], c[0], c[1], c[2], c[3], d[0], d[1], d[2], d[3]};
        float m = 0.f;
#pragma unroll
        for (int j = 0; j < 16; ++j) m = fmaxf(m, fabsf(v[j]));
        m = __uint_as_float(wave_max_dpp(__float_as_uint(m)));
        const float sc = m > 0.f ? VMAX / m : 0.f;
        unsigned q[16];
        if constexpr (FP4) {
#pragma unroll
            for (int j = 0; j < 16; ++j) q[j] = enc_e2m1(v[j] * sc);
            u32x2 w;
            w.x = q[0] | (q[1] << 4) | (q[2] << 8) | (q[3] << 12) | (q[4] << 16) | (q[5] << 20) | (q[6] << 24) | (q[7] << 28);
            w.y = q[8] | (q[9] << 4) | (q[10] << 8) | (q[11] << 12) | (q[12] << 16) | (q[13] << 20) | (q[14] << 24) | (q[15] << 28);
            *(u32x2*)(dst + (size_t)row * 512 + 8 * lane) = w;
        } else {
#pragma unroll
            for (int j = 0; j < 16; ++j) q[j] = enc_e2m3(v[j] * sc);
            U3 w;
            w.x = q[0] | (q[1] << 6) | (q[2] << 12) | (q[3] << 18) | (q[4] << 24) | (q[5] << 30);
            w.y = (q[5] >> 2) | (q[6] << 4) | (q[7] << 10) | (q[8] << 16) | (q[9] << 22) | (q[10] << 28);
            w.z = (q[10] >> 4) | (q[11] << 2) | (q[12] << 8) | (q[13] << 14) | (q[14] << 20) | (q[15] << 26);
            *(U3*)(dst + (size_t)row * 768 + 12 * lane) = w;
        }
        if (lane == 0) rs[row] = m * (1.f / VMAX);
    }
}
__device__ __forceinline__ void p0_prologue(LAS unsigned char* lds, const Args& a, int G, int blk) {
    const int tid = threadIdx.x, lane = tid & 63, wave = __builtin_amdgcn_readfirstlane(tid >> 6);
    unsigned char* ws = a.ws;
    for (int task = blk; task < 96; task += G) {
        LAS float* sl = (LAS float*)(lds + 67584);
#pragma unroll
        for (int j = 0; j < NB * DM / 4 / 512; ++j) {
            const int i4 = tid + 512 * j; f32x4 v = ((const f32x4*)a.in[1])[i4];
#pragma unroll
            for (int e = 0; e < 4; ++e) v[e] = v[e] * __builtin_amdgcn_rcpf(1.f + __expf(-v[e]));
            *(LAS f32x4*)(sl + 4 * i4) = v;
        }
        __syncthreads();
        const int col = task * 64 + lane, kb = wave * 128;
        float acc[16];
#pragma unroll
        for (int b = 0; b < 16; ++b) acc[b] = 0.f;
        const float* wp = a.in[2] + col;
#pragma unroll 4
        for (int k = kb; k < kb + 128; k += 4) {
            const float w0 = wp[(size_t)(k + 0) * 6144], w1 = wp[(size_t)(k + 1) * 6144], w2 = wp[(size_t)(k + 2) * 6144], w3 = wp[(size_t)(k + 3) * 6144];
#pragma unroll
            for (int b = 0; b < 16; ++b) { const f32x4 s = *(const LAS f32x4*)(sl + b * 1024 + k); acc[b] += (s[0] * w0 + s[1] * w1) + (s[2] * w2 + s[3] * w3); }
        }
        LAS float* red = (LAS float*)lds;
#pragma unroll
        for (int b = 0; b < 16; ++b) red[(wave * 16 + b) * 64 + lane] = acc[b];
        __syncthreads();
        for (int o = tid; o < 1024; o += 512) { const int b = o >> 6, cl = o & 63; float s = 0.f;
#pragma unroll
            for (int w = 0; w < 8; ++w) s += red[(w * 16 + b) * 64 + cl];
            ((float*)(ws + WS_MOD))[b * 6144 + task * 64 + cl] = s + a.in[3][task * 64 + cl]; }
        __syncthreads();
    }
    LAS float* scr = (LAS float*)(lds + wave * 8448);
    const int gw = blk * NWAVES + wave, NGW = G * NWAVES;
    constexpr int I_IN = 184 * 16, I_CO = 8 * 32, I_AO = 8 * 32, I_O = 16 * 32, I_PQ = 16 * 32;
    const bool tsplit = G > 96 + 32; const int tgw = tsplit ? (blk - 96) * NWAVES + wave : gw, tngw = tsplit ? (G - 96) * NWAVES : NGW;
    for (int it = (tsplit && blk < 96) ? (1 << 30) : tgw; it < I_IN + I_CO + I_AO + I_O + I_PQ; it += tngw) {
        int r = it;
        if (r < I_IN) {
            const int dg = r >> 4, kb = r & 15, tile = dg >> 3, gi = dg & 7; int src, nc = 32;
            if (tile < 6 || (tile >= 10 && tile < 14)) src = 32 * dg;
            else if (tile < 10) src = tile * 256 + 32 * (2 * (gi & 3) + (gi >> 2));
            else if (tile < 22) src = 3656 + 32 * (dg - 112);
            else { if (gi < 2) src = 3584 + 32 * gi; else if (gi == 2) { src = 3648; nc = 8; } else { src = 0; nc = 0; } }
            transpose_item(a.in[5], 5704, kb * 64, src, nc, (bf16*)(ws + WS_WIN), 1024, dg * 32, scr, lane); continue; }
        r -= I_IN;
        if (r < I_CO) { transpose_item(a.in[7], 1024, (r >> 5) * 64, (r & 31) * 32, 32, (bf16*)(ws + WS_WCO), 1024, (r & 31) * 32, scr, lane); continue; } r -= I_CO;
        if (r < I_AO) { transpose_item(a.in[10], 1024, (r >> 5) * 64, (r & 31) * 32, 32, (bf16*)(ws + WS_WCO) + 512, 1024, (r & 31) * 32, scr, lane); continue; } r -= I_AO;
        if (r < I_O) { transpose_item(a.in[11], 1024, (r >> 5) * 64, (r & 31) * 32, 32, (bf16*)(ws + WS_WO), 1024, (r & 31) * 32, scr, lane); continue; } r -= I_O;
        transpose_item(a.in[13], 1024, (r >> 5) * 64, (r & 31) * 32, 32, (bf16*)(ws + WS_WPQ), 1024, (r & 31) * 32, scr, lane);
    }
    const size_t gt = (size_t)blk * 512 + tid, NT_ = (size_t)G * 512;
    cvt_stream(a.in[14], (bf16*)(ws + WS_SK), (size_t)16 * 128 * 64 / 8, gt, NT_);
    cvt_rows_fpx<true>(a.in[15], ws + WS_PU, (float*)(ws + WS_RSU), gw, NGW, lane);
    cvt_rows_fpx<true>(a.in[16], ws + WS_PV, (float*)(ws + WS_RSV), gw, NGW, lane);
}

__device__ __forceinline__ float wave_sum_dpp(float x) {
    x += __uint_as_float((unsigned)__builtin_amdgcn_update_dpp(0, (int)__float_as_uint(x), 0x141, 0xF, 0xF, false));
    x += __uint_as_float((unsigned)__builtin_amdgcn_update_dpp(0, (int)__float_as_uint(x), 0x1B, 0xF, 0xF, false));
    x += __uint_as_float((unsigned)__builtin_amdgcn_update_dpp(0, (int)__float_as_uint(x), 0xB1, 0xF, 0xF, false));
    x += __uint_as_float((unsigned)__builtin_amdgcn_update_dpp(0, (int)__float_as_uint(x), 0x128, 0xF, 0xF, false));
    const int xi = (int)__float_as_uint(x);
    return (__uint_as_float((unsigned)__builtin_amdgcn_readlane(xi, 0)) + __uint_as_float((unsigned)__builtin_amdgcn_readlane(xi, 16))) +
           (__uint_as_float((unsigned)__builtin_amdgcn_readlane(xi, 32)) + __uint_as_float((unsigned)__builtin_amdgcn_readlane(xi, 48)));
}
template <bool RESID> __device__ __forceinline__ void norm_phase(const float* X, const float* nw, const float* MOD, int sh_off, bf16* O, int G, int blk, float* OUT = nullptr) {
    const int tid_ = phase_tid(); const int lane = tid_ & 63, wave = __builtin_amdgcn_readfirstlane(tid_ >> 6);
    const int stride = G * NWAVES;
    for (int m0 = blk * NWAVES + wave; m0 < T; m0 += 2 * stride) {
        const int m1 = (m0 + stride < T) ? m0 + stride : m0;
        f32x4 va[4], vb[4]; float sa = 0.f, sbb = 0.f;
        const f32x4* xa = (const f32x4*)(X + (size_t)m0 * DM) + lane; const f32x4* xb = (const f32x4*)(X + (size_t)m1 * DM) + lane;
#pragma unroll
        for (int j = 0; j < 4; ++j) { va[j] = xa[64 * j]; vb[j] = xb[64 * j]; }
        if (RESID) {
            const unsigned long long* da = (const unsigned long long*)(O + (size_t)m0 * DM) + lane; const unsigned long long* db = (const unsigned long long*)(O + (size_t)m1 * DM) + lane;
            f32x4* oa4 = (f32x4*)(OUT + (size_t)m0 * DM) + lane; f32x4* ob4 = (f32x4*)(OUT + (size_t)m1 * DM) + lane;
#pragma unroll
            for (int j = 0; j < 4; ++j) { const unsigned long long pa = da[64 * j], pb = db[64 * j];
                va[j] += (f32x4){bflo((unsigned)pa), bfhi((unsigned)pa), bflo((unsigned)(pa >> 32)), bfhi((unsigned)(pa >> 32))};
                vb[j] += (f32x4){bflo((unsigned)pb), bfhi((unsigned)pb), bflo((unsigned)(pb >> 32)), bfhi((unsigned)(pb >> 32))};
                oa4[64 * j] = va[j]; ob4[64 * j] = vb[j]; }
        }
#pragma unroll
        for (int j = 0; j < 4; ++j) { sa += (va[j].x * va[j].x + va[j].y * va[j].y) + (va[j].z * va[j].z + va[j].w * va[j].w); sbb += (vb[j].x * vb[j].x + vb[j].y * vb[j].y) + (vb[j].z * vb[j].z + vb[j].w * vb[j].w); }
        const float ra = __builtin_amdgcn_rsqf(wave_sum_dpp(sa) * (1.f / DM) + EPS), rb = __builtin_amdgcn_rsqf(wave_sum_dpp(sbb) * (1.f / DM) + EPS);
        const float* mda = MOD + (size_t)(m0 >> 12) * 6144 + sh_off; const float* mdb = MOD + (size_t)(m1 >> 12) * 6144 + sh_off;
        unsigned long long* oa = (unsigned long long*)(O + (size_t)m0 * DM) + lane; unsigned long long* ob = (unsigned long long*)(O + (size_t)m1 * DM) + lane;
#pragma unroll
        for (int j = 0; j < 4; ++j) {
            const f32x4 w = ((const f32x4*)nw)[lane + 64 * j];
            const f32x4 ha = (va[j] * ra * w) * (((const f32x4*)(mda + 1024))[lane + 64 * j] + 1.f) + ((const f32x4*)mda)[lane + 64 * j];
            const f32x4 hb = (vb[j] * rb * w) * (((const f32x4*)(mdb + 1024))[lane + 64 * j] + 1.f) + ((const f32x4*)mdb)[lane + 64 * j];
            oa[64 * j] = (unsigned long long)pk2(ha.x, ha.y) | ((unsigned long long)pk2(ha.z, ha.w) << 32);
            ob[64 * j] = (unsigned long long)pk2(hb.x, hb.y) | ((unsigned long long)pk2(hb.z, hb.w) << 32);
        }
    }
}

__device__ __forceinline__ void conv_phase(const bf16* CB, const bf16* CC, const bf16* CX, const float* cw, bf16* UA, int G, int blk) {
    const int ctid = phase_tid(); const int lane = ctid & 63, wave = __builtin_amdgcn_readfirstlane(ctid >> 6);
    const int c8 = lane * 8;
    float w[3][8];
#pragma unroll
    for (int j = 0; j < 3; ++j) { const f32x4 w0 = *(const f32x4*)(cw + j * 512 + c8), w1 = *(const f32x4*)(cw + j * 512 + c8 + 4);
        w[j][0] = w0[0]; w[j][1] = w0[1]; w[j][2] = w0[2]; w[j][3] = w0[3]; w[j][4] = w1[0]; w[j][5] = w1[1]; w[j][6] = w1[2]; w[j][7] = w1[3]; }
    constexpr int RUN = 32;
#define CONV_PROD(P, A, B) do { P[0] = bflo(A.x) * bflo(B.x); P[1] = bfhi(A.x) * bfhi(B.x); P[2] = bflo(A.y) * bflo(B.y); P[3] = bfhi(A.y) * bfhi(B.y); \
        P[4] = bflo(A.z) * bflo(B.z); P[5] = bfhi(A.z) * bfhi(B.z); P[6] = bflo(A.w) * bflo(B.w); P[7] = bfhi(A.w) * bfhi(B.w); } while (0)
    for (int task = blk * NWAVES + wave; task < T / RUN; task += G * NWAVES) {
        const size_t row0 = (size_t)task * RUN; const int t0 = (int)(row0 & (SEQ - 1));
        float p1[8], p2[8];
        if (t0 != 0) {
            const u32x4 a1 = *(const u32x4*)(CC + (row0 - 1) * 512 + c8), b1 = *(const u32x4*)(CX + (row0 - 1) * 512 + c8), a2 = *(const u32x4*)(CC + (row0 - 2) * 512 + c8), b2 = *(const u32x4*)(CX + (row0 - 2) * 512 + c8);
            CONV_PROD(p1, a1, b1); CONV_PROD(p2, a2, b2);
        } else {
#pragma unroll
            for (int e = 0; e < 8; ++e) { p1[e] = 0.f; p2[e] = 0.f; }
        }
#pragma unroll 4
        for (int r = 0; r < RUN; ++r) {
            const size_t row = row0 + r;
            const u32x4 a = *(const u32x4*)(CC + row * 512 + c8), b = *(const u32x4*)(CX + row * 512 + c8), g = *(const u32x4*)(CB + row * 512 + c8);
            float p0[8], o[8]; CONV_PROD(p0, a, b);
#pragma unroll
            for (int e = 0; e < 8; ++e) { o[e] = (w[0][e] * p2[e] + w[1][e] * p1[e]) + w[2][e] * p0[e]; p2[e] = p1[e]; p1[e] = p0[e]; }
            u32x4 q; q.x = pk2(o[0] * bflo(g.x), o[1] * bfhi(g.x)); q.y = pk2(o[2] * bflo(g.y), o[3] * bfhi(g.y));
            q.z = pk2(o[4] * bflo(g.z), o[5] * bfhi(g.z)); q.w = pk2(o[6] * bflo(g.w), o[7] * bfhi(g.w));
            *(u32x4*)(UA + row * 1024 + c8) = q;
        }
    }
#undef CONV_PROD
}

template <int N> __device__ __forceinline__ void bitonic_sort_desc(unsigned* a) {
#pragma unroll
    for (int k = 2; k <= N; k <<= 1)
#pragma unroll
        for (int j = k >> 1; j > 0; j >>= 1)
#pragma unroll
            for (int i = 0; i < N; ++i) { const int l = i ^ j; if (l > i) { const bool desc = (i & k) == 0; const unsigned x = a[i], y = a[l]; const unsigned mx = x > y ? x : y, mn = x > y ? y : x; a[i] = desc ? mx : mn; a[l] = desc ? mn : mx; } }
}
__device__ __forceinline__ void merge_top16(unsigned* a, const unsigned* b) {
#pragma unroll
    for (int i = 0; i < 16; ++i) { const unsigned y = b[15 - i]; a[i] = a[i] > y ? a[i] : y; }
#pragma unroll
    for (int j = 8; j > 0; j >>= 1)
#pragma unroll
        for (int i = 0; i < 16; ++i) if ((i & j) == 0) { const unsigned x = a[i], y = a[i + j]; a[i] = x > y ? x : y; a[i + j] = x > y ? y : x; }
}
__device__ __forceinline__ void top16_of_64(unsigned* a) {
    bitonic_sort_desc<16>(a); bitonic_sort_desc<16>(a + 16); bitonic_sort_desc<16>(a + 32); bitonic_sort_desc<16>(a + 48);
    merge_top16(a, a + 16); merge_top16(a + 32, a + 48); merge_top16(a, a + 32);
}
template <int NR> __device__ __forceinline__ int count_ge(const unsigned* k, unsigned cand) {
    int cv = 0;
#pragma unroll
    for (int r = 0; r < NR; ++r) cv += (k[r] >= cand) ? 1 : 0;
    cv += __builtin_amdgcn_update_dpp(0, cv, 0x141, 0xF, 0xF, false); cv += __builtin_amdgcn_update_dpp(0, cv, 0x1B, 0xF, 0xF, false);
    cv += __builtin_amdgcn_update_dpp(0, cv, 0xB1, 0xF, 0xF, false); cv += __builtin_amdgcn_update_dpp(0, cv, 0x128, 0xF, 0xF, false);
    return __builtin_amdgcn_readlane(cv, 0) + __builtin_amdgcn_readlane(cv, 16) + __builtin_amdgcn_readlane(cv, 32) + __builtin_amdgcn_readlane(cv, 48);
}
template <int NR> __device__ __forceinline__ unsigned descent256(const unsigned* k) {
    unsigned tau = 0u;
    for (int bit = 31; bit >= 0; --bit) {
        const unsigned cand = tau | (1u << bit);
        const int cnt = count_ge<NR>(k, cand);
        if (cnt >= 256) tau = cand;
        if (cnt == 256) break;
    }
    return tau;
}
template <int NR> __device__ __forceinline__ void select_query(const LAS unsigned* row, int nvalid, int tq, LAS unsigned long long* mrow, int lane) {
    unsigned k[NR];
    const bool lowhalf = lane < 32;
#define SEL_LOAD() _Pragma("unroll") for (int r = 0; r < NR; ++r) { const unsigned v = row[64 * r + lane]; k[r] = (64 * r + 64 <= nvalid) ? v : ((64 * r < nvalid && lowhalf) ? v : 0u); }
    SEL_LOAD()
    unsigned tau = 0u;
    if (tq >= 256) {
        if constexpr (NR > 16) {
#pragma unroll
            for (int g = 0; g < NR / 16; ++g) bitonic_sort_desc<16>(k + 16 * g);
            if constexpr (NR == 64) { merge_top16(k, k + 16); merge_top16(k + 32, k + 48); merge_top16(k, k + 32); }
            else if constexpr (NR == 48) { merge_top16(k, k + 16); merge_top16(k, k + 32); }
            else merge_top16(k, k + 16);
            tau = descent256<16>(k);
            const bool bad = __ballot(k[15] >= tau) != 0ull;
            SEL_LOAD()
            if (bad) tau = descent256<NR>(k);
        } else tau = descent256<NR>(k);
    }
#undef SEL_LOAD
    if (tau == 0u) tau = 1u;
#pragma unroll
    for (int r = 0; r < 64; ++r) { const unsigned long long m = r < NR ? __ballot(k[r < NR ? r : 0] >= tau) : 0ull; if (lane == 0) mrow[r * 8] = m; }
}

#ifndef PROBE_SUB
#define PROBE_SUB 0
#endif
__device__ __forceinline__ void indexer_phase(LAS unsigned char* lds, const bf16* QI, const bf16* KI, const float* WI, unsigned long long* MASK, int G, int blk) {
    volatile LAS unsigned long long* pst = (volatile LAS unsigned long long*)(lds + LDS_BYTES - 48);
    LAS unsigned* sc = (LAS unsigned*)lds;
    const int tid = phase_tid(), lane = tid & 63, wave = __builtin_amdgcn_readfirstlane(tid >> 6), r32 = lane & 31, hi = lane >> 5;
    const int ra = (r32 >> 4) & 1, rb = (r32 >> 3) & 1, rc = (r32 >> 2) & 1, rd = r32 & 3;
    bf16x8 aq[2][4]; bf16x8 bk[2][4];
    LAS float* wvl = (LAS float*)(lds + 136192);
#define IDX_UNIT_GEOM(uid_) const int b = (uid_) >> 9; int j = (uid_) & 511; if (j >= 256) j = 767 - j; const int tq0 = 8 * j; const size_t row0 = (size_t)b * SEQ + tq0; const int nkt = (tq0 + 8 + 31) >> 5; \
        const bf16* kbase = KI + (size_t)b * (SEQ / 32) * 2048 + lane * 8;
#define IDX_UNIT_LOAD() do { \
        _Pragma("unroll") for (int rt = 0; rt < 2; ++rt) { \
            const bf16* qp = QI + (row0 + rt * 4 + 2 * rc + ra) * 512 + (4 * rb + rd) * 64 + hi * 8; \
            _Pragma("unroll") for (int d0 = 0; d0 < 4; ++d0) aq[rt][d0] = *(const bf16x8*)(qp + d0 * 16); } \
        { int kt = wave; if (kt >= nkt) kt = nkt - 1; \
            _Pragma("unroll") for (int d0 = 0; d0 < 4; ++d0) bk[0][d0] = *(const bf16x8*)(kbase + (size_t)kt * 2048 + d0 * 512); } } while (0)
    if (blk < T / 8) { IDX_UNIT_GEOM(blk) IDX_UNIT_LOAD(); if (tid < 64) wvl[tid] = WI[row0 * 8 + tid]; }
    __syncthreads();
    for (int uid = blk; uid < T / 8; uid += G) {
        IDX_UNIT_GEOM(uid)
        { int kt = wave + NWAVES; if (kt >= nkt) kt = nkt - 1;
#pragma unroll
            for (int d0 = 0; d0 < 4; ++d0) bk[1][d0] = *(const bf16x8*)(kbase + (size_t)kt * 2048 + d0 * 512); }
        if (PROBE_SUB && threadIdx.x == 0) pst[3] = __builtin_amdgcn_s_memrealtime();
#define IDX_TILE(JT, JJ) { \
                constexpr int jj = (JJ); \
                int kt = wave + NWAVES * (JT); asm volatile("" : "+s"(kt));       \
                const bool live = kt < nkt; \
                const int key = 32 * kt + r32; \
                f32x16 acc0 = {}, acc1 = {}; \
                _Pragma("unroll") for (int d0 = 0; d0 < 4; ++d0) { acc0 = __builtin_amdgcn_mfma_f32_32x32x16_bf16(aq[0][d0], bk[jj][d0], acc0, 0, 0, 0); acc1 = __builtin_amdgcn_mfma_f32_32x32x16_bf16(aq[1][d0], bk[jj][d0], acc1, 0, 0, 0); } \
                { int ktn = kt + 2 * NWAVES; if (ktn >= nkt) ktn = nkt - 1;            \
                    _Pragma("unroll") for (int d0 = 0; d0 < 4; ++d0) bk[jj][d0] = *(const bf16x8*)(kbase + (size_t)ktn * 2048 + d0 * 512); } \
                _Pragma("unroll") for (int rt = 0; rt < 2; ++rt) \
                    _Pragma("unroll") for (int a2 = 0; a2 < 2; ++a2) { \
                        const int ql = rt * 4 + 2 * hi + a2; \
                        int wo_ = ql * 8; asm volatile("" : "+v"(wo_));            \
                        const f32x4 wA_ = *(const LAS f32x4*)(wvl + wo_), wB_ = *(const LAS f32x4*)(wvl + wo_ + 4); \
                        float sv = 0.f; \
                        _Pragma("unroll") for (int i = 0; i < 8; ++i) { const int xb = (int)__float_as_uint(rt ? acc1[8 * a2 + i] : acc0[8 * a2 + i]); \
                            asm("v_fmac_f32 %0, %1, %2" : "+v"(sv) : "v"(__uint_as_float((unsigned)(xb > 0 ? xb : 0))), "v"(i < 4 ? wA_[i & 3] : wB_[i & 3])); }        \
                        const unsigned ck = (key <= tq0 + ql) ? ((ordf(sv) & 0xfffff000u) | (unsigned)(4095 - key)) : 0u; \
                        sc[live ? ql * 4096 + key : 33792 + lane] = ck; \
                    } \
                __builtin_amdgcn_sched_barrier(0); }
        {
            const int ntw = ((nkt + 31) >> 5) << 2;
#pragma unroll 1
            for (int jt = 0; jt < ntw; jt += 2) { IDX_TILE(jt, 0) IDX_TILE(jt + 1, 1) }
        }
#undef IDX_TILE
        __syncthreads();
        if (uid + G < T / 8) { IDX_UNIT_GEOM(uid + G) IDX_UNIT_LOAD(); if (tid < 64) wvl[tid] = WI[row0 * 8 + tid]; }
        if (PROBE_SUB == 1 && threadIdx.x == 0) pst[2] += __builtin_amdgcn_s_memrealtime() - pst[3];
        if (PROBE_SUB == 2 && threadIdx.x == 0) pst[3] = __builtin_amdgcn_s_memrealtime();
        {
            const int tq = tq0 + wave, nvalid = 32 * nkt;
            LAS unsigned long long* mrow = (LAS unsigned long long*)(lds + 131072) + wave;
            const LAS unsigned* rowp = sc + wave * 4096;
            if (nvalid <= 1024) select_query<16>(rowp, nvalid, tq, mrow, lane);
            else if (nvalid <= 2048) select_query<32>(rowp, nvalid, tq, mrow, lane);
            else if (nvalid <= 3072) select_query<48>(rowp, nvalid, tq, mrow, lane);
            else select_query<64>(rowp, nvalid, tq, mrow, lane);
        }
        __syncthreads();
        __hip_atomic_store(MASK + ((size_t)b * 64 + (tid >> 3)) * SEQ + tq0 + (tid & 7), ((const LAS unsigned long long*)(lds + 131072))[tid], __ATOMIC_RELAXED, __HIP_MEMORY_SCOPE_AGENT);
        if (PROBE_SUB == 2 && threadIdx.x == 0) pst[2] += __builtin_amdgcn_s_memrealtime() - pst[3];
    }
}

namespace att {
constexpr int KCP = 1040, KSLOT = 8 * KCP, VDH = 4160, VSLOT = 2 * VDH;
constexpr int L_K = 0, L_V = 4 * KSLOT, L_OST = L_V + 4 * VSLOT, L_END = L_OST + NWAVES * 4096;
__device__ __forceinline__ int crow(int r, int hi) { return (r & 3) + 8 * (r >> 2) + 4 * hi; }
#define SBAR() __builtin_amdgcn_sched_barrier(0)
__device__ __forceinline__ void qkt(f32x16& p0, f32x16& p1, const LAS unsigned char* kb, const bf16x8* qr, const f32x16& negm) {
#pragma unroll
    for (int d0 = 0; d0 < 4; ++d0) {
        const bf16x8 b0 = *(const LAS bf16x8*)(kb + d0 * 2 * KCP);
        const bf16x8 b1 = *(const LAS bf16x8*)(kb + d0 * 2 * KCP + 512);
        if (d0 == 0) { p0 = __builtin_amdgcn_mfma_f32_32x32x16_bf16(b0, qr[0], negm, 0, 0, 0); p1 = __builtin_amdgcn_mfma_f32_32x32x16_bf16(b1, qr[0], negm, 0, 0, 0); }
        else { p0 = __builtin_amdgcn_mfma_f32_32x32x16_bf16(b0, qr[d0], p0, 0, 0, 0); p1 = __builtin_amdgcn_mfma_f32_32x32x16_bf16(b1, qr[d0], p1, 0, 0, 0); } }
}
__device__ __forceinline__ void pv(f32x16* o, f32x16& osum, int vb, bf16x8 pa0, bf16x8 pa1, bf16x8 pa2, bf16x8 pa3) {
    {
        const bf16x8 ones = {0x3f80, 0x3f80, 0x3f80, 0x3f80, 0x3f80, 0x3f80, 0x3f80, 0x3f80};
        osum = __builtin_amdgcn_mfma_f32_32x32x16_bf16(pa0, ones, osum, 0, 0, 0); osum = __builtin_amdgcn_mfma_f32_32x32x16_bf16(pa1, ones, osum, 0, 0, 0);
        osum = __builtin_amdgcn_mfma_f32_32x32x16_bf16(pa2, ones, osum, 0, 0, 0); osum = __builtin_amdgcn_mfma_f32_32x32x16_bf16(pa3, ones, osum, 0, 0, 0);
    }
    s16x4 lo[2][4], hi[2][4];
#pragma unroll
    for (int d0 = 0; d0 < 2; ++d0)
#pragma unroll
        for (int ks = 0; ks < 4; ++ks) {
            asm volatile("ds_read_b64_tr_b16 %0,%1 offset:%c2" : "=&v"(lo[d0][ks]) : "v"(vb), "i"(d0 * VDH + ks * 1024) : "memory");
            asm volatile("ds_read_b64_tr_b16 %0,%1 offset:%c2" : "=&v"(hi[d0][ks]) : "v"(vb), "i"(d0 * VDH + ks * 1024 + 512) : "memory"); }
    asm volatile("s_waitcnt lgkmcnt(0)" ::: "memory"); SBAR();
#pragma unroll
    for (int d0 = 0; d0 < 2; ++d0) {
#define PK(k) (bf16x8){lo[d0][k][0], lo[d0][k][1], lo[d0][k][2], lo[d0][k][3], hi[d0][k][0], hi[d0][k][1], hi[d0][k][2], hi[d0][k][3]}
        o[d0] = __builtin_amdgcn_mfma_f32_32x32x16_bf16(pa0, PK(0), o[d0], 0, 0, 0);
        o[d0] = __builtin_amdgcn_mfma_f32_32x32x16_bf16(pa1, PK(1), o[d0], 0, 0, 0);
        o[d0] = __builtin_amdgcn_mfma_f32_32x32x16_bf16(pa2, PK(2), o[d0], 0, 0, 0);
        o[d0] = __builtin_amdgcn_mfma_f32_32x32x16_bf16(pa3, PK(3), o[d0], 0, 0, 0);
#undef PK
    }
}

__device__ __forceinline__ void attn_phase(LAS unsigned char* lds, const bf16* Q, const bf16* K, const bf16* V, const unsigned long long* MASK, const float* qnw, const float* knw, bf16* UA, int G, int blk) {
    const int tid = phase_tid(), lane = tid & 63, r32 = lane & 31, hi = lane >> 5, wid = __builtin_amdgcn_readfirstlane(tid >> 6);
    float mq = fabsf(qnw[lane]), mk = fabsf(knw[lane]);
#pragma unroll
    for (int o = 1; o < 64; o <<= 1) { mq = fmaxf(mq, __shfl_xor(mq, o)); mk = fmaxf(mk, __shfl_xor(mk, o)); }
    const float nb = -(8.f * 1.4426950408889634f) * mq * mk;
    f32x16 negm;
#pragma unroll
    for (int r = 0; r < 16; ++r) negm[r] = nb;
    const unsigned kdst = L_K + (tid & 7) * KCP + (tid >> 3) * 16;
    const unsigned vdst = L_V + ((tid & 7) >> 2) * VDH + ((tid >> 3) >> 4) * 1024 + ((tid >> 3) & 15) * 64 + (tid & 3) * 16;
    const LAS unsigned char* kp0 = lds + L_K + hi * KCP + r32 * 16;
    const int vb0 = (int)(uintptr_t)(lds + L_V) + ((lane >> 4) & 1) * 32 + (lane & 3) * 8 + (4 * hi + ((lane & 15) >> 2)) * 64;
    for (int uid = blk; uid < 2048; uid += G) {
        const int ui = uid >> 8; int c = uid & 255; c = (c & 7) * 32 + (c >> 3);
        int bh = c >> 1; const int s = c & 1, pp = ui >> 1; int qb = (ui & 1) ? 15 - (2 * pp + s) : (2 * pp + s);
        if (G == 256) {
            const int jx = (uid & 255) >> 3;
            bh = 16 * (uid & 7) + 2 * ui + (jx >> 4); qb = (ui & 1) ? 15 - (jx & 15) : (jx & 15);
        }
        const int b = bh >> 3, h = bh & 7, q0 = qb * 256;
        const size_t rowbase = (size_t)b * SEQ;
        const bf16* Qw = Q + (rowbase + q0 + wid * 32) * 512 + h * 64;
        bf16* Ow = UA + (rowbase + q0 + wid * 32) * 1024 + 512 + h * 64;
        bf16x8 qr[4];
#pragma unroll
        for (int d0 = 0; d0 < 4; ++d0) qr[d0] = *(const bf16x8*)(Qw + (size_t)r32 * 512 + d0 * 16 + hi * 8);
        const int NT = 4 * (qb + 1);
        const unsigned long long* mptr = MASK + (size_t)b * 64 * SEQ + q0 + wid * 32 + r32;
        const bf16* ksrc = K + ((size_t)bh * SEQ) * 64 + wid * 512 + lane * 8;
        const bf16* vsrc = V + ((size_t)bh * SEQ) * 64 + (wid >> 2) * 2048 + (wid & 3) * 512 + lane * 8;
#define ATT_DMA(TILE, SLOT) do { \
            __builtin_amdgcn_global_load_lds((const unsigned*)(ksrc + (size_t)(TILE) * 4096), (LAS unsigned*)(lds + L_K + (SLOT) * KSLOT + wid * KCP), 16, 0, 0); \
            __builtin_amdgcn_global_load_lds((const unsigned*)(vsrc + (size_t)(TILE) * 4096), (LAS unsigned*)(lds + L_V + (SLOT) * VSLOT + (wid >> 2) * VDH + (wid & 3) * 1024), 16, 0, 0); } while (0)
        f32x16 o[2]; o[0] = f32x16{}; o[1] = f32x16{};
        f32x16 osum = f32x16{};
        const int T2 = NT / 2;
        unsigned long long mwq[2][2], mw[2];
#pragma unroll
        for (int sb_ = 0; sb_ < 2; ++sb_) { ATT_DMA(sb_, sb_); mw[sb_] = mptr[(size_t)sb_ * SEQ]; mwq[1][sb_] = mptr[(size_t)(2 + sb_) * SEQ]; mwq[0][sb_] = 0ull; }
        asm volatile("s_waitcnt vmcnt(0)" ::: "memory");
        __syncthreads();
        const int qmax = q0 + wid * 32 + 31;
#define ATT_SUB(P, SB) if (64 * (2 * t + (SB)) <= qmax) { \
                f32x16 p0, p1; \
                qkt(p0, p1, kp0 + ((P) * 2 + (SB)) * KSLOT, qr, negm); \
                const unsigned mlo = (unsigned)mw[SB] >> (4 * hi), mhi = (unsigned)(mw[SB] >> 32) >> (4 * hi); \
                _Pragma("unroll") for (int r = 0; r < 16; ++r) { p0[r] = __builtin_amdgcn_exp2f(p0[r]); p1[r] = __builtin_amdgcn_exp2f(p1[r]); } \
                  \
                unsigned pk_[16]; \
                _Pragma("unroll") for (int i = 0; i < 8; ++i) { const int bp = ((2 * i) & 3) + 8 * ((2 * i) >> 2); \
                    const unsigned m0a = (unsigned)__builtin_amdgcn_sbfe((int)mlo, bp, 1), m0b = (unsigned)__builtin_amdgcn_sbfe((int)mlo, bp + 1, 1); \
                    const unsigned m1a = (unsigned)__builtin_amdgcn_sbfe((int)mhi, bp, 1), m1b = (unsigned)__builtin_amdgcn_sbfe((int)mhi, bp + 1, 1); \
                    pk_[i] = pk2(p0[2 * i], p0[2 * i + 1]) & __builtin_amdgcn_perm(m0b, m0a, 0x05040100u); \
                    pk_[8 + i] = pk2(p1[2 * i], p1[2 * i + 1]) & __builtin_amdgcn_perm(m1b, m1a, 0x05040100u); } \
                const u32x4 pw0 = (u32x4){pk_[0], pk_[1], pk_[2], pk_[3]}, pw1 = (u32x4){pk_[4], pk_[5], pk_[6], pk_[7]}; \
                const u32x4 pw2 = (u32x4){pk_[8], pk_[9], pk_[10], pk_[11]}, pw3 = (u32x4){pk_[12], pk_[13], pk_[14], pk_[15]}; \
                pv(o, osum, vb0 + ((P) * 2 + (SB)) * VSLOT, __builtin_bit_cast(bf16x8, pw0), __builtin_bit_cast(bf16x8, pw1), __builtin_bit_cast(bf16x8, pw2), __builtin_bit_cast(bf16x8, pw3)); \
            }
#define ATT_STEP(P)    \
        { \
            { const int tp = (t + 2 < T2) ? t + 2 : T2 - 1, tn = (t + 1 < T2) ? t + 1 : T2 - 1;       \
              _Pragma("unroll") for (int sb_ = 0; sb_ < 2; ++sb_) { ATT_DMA(2 * tn + sb_, (1 - (P)) * 2 + sb_); mwq[P][sb_] = mptr[(size_t)(2 * tp + sb_) * SEQ]; } } \
            ATT_SUB(P, 0) \
            ATT_SUB(P, 1) \
            _Pragma("unroll") for (int sb_ = 0; sb_ < 2; ++sb_) mw[sb_] = mwq[1 - (P)][sb_]; \
            asm volatile("s_waitcnt vmcnt(0)" ::: "memory");               \
            __syncthreads(); \
        }
        for (int t = 0; t < T2; t += 2) {
            ATT_STEP(0)
            ++t;
            ATT_STEP(1)
            --t;
        }
#undef ATT_STEP
#undef ATT_SUB
#undef ATT_DMA
        float rli[16];
#pragma unroll
        for (int r = 0; r < 16; ++r) rli[r] = __builtin_amdgcn_rcpf(osum[r]);
        LAS bf16* stg = (LAS bf16*)(lds + L_OST) + wid * 2048;
#pragma unroll
        for (int r = 0; r < 16; ++r) { const int orow = crow(r, hi);
#pragma unroll
            for (int d0 = 0; d0 < 2; ++d0) stg[orow * 64 + d0 * 32 + r32] = (bf16)(pk2(o[d0][r] * rli[r], 0.f) & 0xffffu); }
        LDS_WAIT();
#pragma unroll
        for (int i = 0; i < 4; ++i) { const int row = i * 8 + (lane >> 3), ch = lane & 7; const u32x4 v = *(const LAS u32x4*)(stg + row * 64 + ch * 8); *(u32x4*)(Ow + (size_t)row * 1024 + ch * 8) = v; }
        LDS_WAIT();
    }
}
#undef SBAR
}

__device__ __forceinline__ void peer_route_phase(LAS unsigned char* lds, const bf16* PQ, const bf16* SK, unsigned short* EIDX, float* EG, int G, int blk) {
    const int tid = phase_tid(), lane = tid & 63, r32 = lane & 31, hi = lane >> 5, wave = __builtin_amdgcn_readfirstlane(tid >> 6);
    LAS unsigned* win = (LAS unsigned*)(lds + wave * 16384);
    const int gw = blk * NWAVES + wave, NGW = G * NWAVES, h = gw & 7;
    const int gstep = NGW >> 3;
#define RT_LOADQ(tgr, st) do { int tg_ = (tgr) + ((st) >> 1) * gstep; if (tg_ >= T / 32) tg_ = (tgr); const size_t t0_ = (size_t)tg_ * 32; \
        _Pragma("unroll") for (int d0 = 0; d0 < 4; ++d0) bq[d0] = *(const bf16x8*)(PQ + (t0_ + r32) * 1024 + 128 * h + 64 * ((st) & 1) + 16 * d0 + 8 * hi); } while (0)
#define RT_LOADK(st) do { const int p_ = 2 * h + ((st) & 1); \
        _Pragma("unroll") for (int nb = 0; nb < 4; ++nb) \
            _Pragma("unroll") for (int d0 = 0; d0 < 4; ++d0) skv[nb][d0] = *(const bf16x8*)(SK + ((size_t)p_ * 128 + 32 * nb + r32) * 64 + 16 * d0 + 8 * hi); } while (0)
    bf16x8 bq[4], skv[4][4];
    if ((gw >> 3) < T / 32) { RT_LOADQ(gw >> 3, 0); RT_LOADK(0); }
    for (int tg0 = gw >> 3; tg0 < T / 32; tg0 += 2 * gstep) {
#pragma unroll 1
        for (int st = 0; st < 4; ++st) {
            unsigned ck[64];
#pragma unroll
            for (int nb = 0; nb < 4; ++nb) {
                f32x16 acc = {};
#pragma unroll
                for (int d0 = 0; d0 < 4; ++d0) acc = __builtin_amdgcn_mfma_f32_32x32x16_bf16(skv[nb][d0], bq[d0], acc, 0, 0, 0);
#pragma unroll
                for (int r = 0; r < 16; ++r) ck[nb * 16 + r] = (ordf(acc[r]) & ~0x7fu) | (unsigned)(127 - (32 * nb + att::crow(r, hi)));
            }
            __builtin_amdgcn_sched_barrier(0);
            { int tgn = tg0 + 2 * gstep; if (tgn >= T / 32) tgn = tg0;
              const int tgq = st < 3 ? tg0 : tgn, stq = (st + 1) & 3;
              RT_LOADQ(tgq, stq); }
            __builtin_amdgcn_sched_barrier(0);
            top16_of_64(ck);
            __builtin_amdgcn_sched_barrier(0);
            RT_LOADK(st + 1);
            __builtin_amdgcn_sched_barrier(0);
            unsigned pb[16];
#pragma unroll
            for (int i = 0; i < 16; ++i) { auto rr = __builtin_amdgcn_permlane32_swap(ck[i], ck[i], false, false); pb[i] = hi ? rr[0] : rr[1]; }
            merge_top16(ck, pb);
#pragma unroll
            for (int i = 0; i < 16; ++i) win[(st * 16 + i) * 64 + lane] = ck[i];
            __builtin_amdgcn_sched_barrier(0);
        }
        LDS_WAIT();
        const LAS unsigned* wl0 = win + (hi * 2) * 16 * 64 + lane;
        const bool own = hi == 0 || tg0 + gstep < T / 32;
        const size_t t0 = (size_t)(tg0 + hi * gstep) * 32;
        float v0[16], v1[16];
#pragma unroll
        for (int i = 0; i < 16; ++i) { v0[i] = unordf(wl0[i * 64] & ~0x7fu); v1[i] = unordf(wl0[(16 + i) * 64] & ~0x7fu); }
        unsigned c2[64];
        {
            int n = 0;
#pragma unroll
            for (int i = 0; i < 16; ++i)
#pragma unroll
                for (int j = 0; j < 16; ++j) if ((i + 1) * (j + 1) <= 16) { c2[n] = (ordf(v0[i] + v1[j]) & ~0xffu) | (unsigned)(255 - (16 * i + j)); ++n; }
#pragma unroll
            for (int q = 50; q < 64; ++q) c2[q] = 0u;
        }
        top16_of_64(c2);
        float sc[16]; unsigned ex[16];
#pragma unroll
        for (int k = 0; k < 16; ++k) {
            const unsigned f = c2[k]; const int idx = 255 - (int)(f & 0xffu), i = idx >> 4, j = idx & 15;
            const unsigned w0 = wl0[i * 64], w1 = wl0[(16 + j) * 64];
            ex[k] = (127u - (w0 & 0x7fu)) * 128u + (127u - (w1 & 0x7fu));
            sc[k] = unordf(w0 & ~0x7fu) + unordf(w1 & ~0x7fu);
        }
        const float mx = sc[0];
        float sum = 0.f;
#pragma unroll
        for (int k = 0; k < 16; ++k) { sc[k] = __expf(sc[k] - mx); sum += sc[k]; }
        const float inv = 1.f / sum;
#pragma unroll
        for (int k = 0; k < 16; ++k) sc[k] *= inv;
        if (own) {
            unsigned short* ep = EIDX + (t0 + r32) * 128 + h * 16; float* gp = EG + (t0 + r32) * 128 + h * 16;
            *(u32x4*)ep = (u32x4){ex[0] | (ex[1] << 16), ex[2] | (ex[3] << 16), ex[4] | (ex[5] << 16), ex[6] | (ex[7] << 16)};
            *(u32x4*)(ep + 8) = (u32x4){ex[8] | (ex[9] << 16), ex[10] | (ex[11] << 16), ex[12] | (ex[13] << 16), ex[14] | (ex[15] << 16)};
#pragma unroll
            for (int q = 0; q < 4; ++q) *(f32x4*)(gp + 4 * q) = (f32x4){sc[4 * q], sc[4 * q + 1], sc[4 * q + 2], sc[4 * q + 3]};
        }
        LDS_WAIT();
    }
#undef RT_LOADQ
#undef RT_LOADK
}

__device__ __forceinline__ f32x2 gelu_pk(f32x2 v) {
    const f32x2 av = __builtin_elementwise_abs(v), dd = av * 0.2316418882f + 1.0f;
    f32x2 tt; tt.x = __builtin_amdgcn_rcpf(dd.x); tt.y = __builtin_amdgcn_rcpf(dd.y);
    f32x2 q = tt * 0.5307027145f + (-0.7265760135f); q = q * tt + 0.7107068705f; q = q * tt + (-0.142248368f); q = q * tt + 0.127414796f; q = q * tt;
    const f32x2 sq = (v * v) * (-0.72134752044f);
    f32x2 ee; ee.x = __builtin_amdgcn_exp2f(sq.x); ee.y = __builtin_amdgcn_exp2f(sq.y);
    const f32x2 mm = v * (q * ee), rr = v - mm;
    f32x2 o; o.x = v.x < 0.f ? mm.x : rr.x; o.y = v.y < 0.f ? mm.y : rr.y; return o;
}
__device__ __forceinline__ float dpp_f(float x, const int ctrl_sel) {
    const int xi = (int)__float_as_uint(x); int r;
    if (ctrl_sel == 0) r = __builtin_amdgcn_update_dpp(0, xi, 0x128, 0xF, 0xF, false);
    else if (ctrl_sel == 1) r = __builtin_amdgcn_update_dpp(0, xi, 0x141, 0xF, 0xF, false);
    else if (ctrl_sel == 2) r = __builtin_amdgcn_update_dpp(0, xi, 0x1B, 0xF, 0xF, false);
    else r = __builtin_amdgcn_update_dpp(0, xi, 0xB1, 0xF, 0xF, false);
    return __uint_as_float((unsigned)r);
}
__device__ __forceinline__ float reduce8_rows(float* d, int lane) {
#pragma unroll
    for (int i = 0; i < 4; ++i) { auto r = __builtin_amdgcn_permlane32_swap(__float_as_uint(d[i]), __float_as_uint(d[i + 4]), false, false); d[i] = __uint_as_float(r[0]) + __uint_as_float(r[1]); }
#pragma unroll
    for (int i = 0; i < 2; ++i) { auto r = __builtin_amdgcn_permlane16_swap(__float_as_uint(d[i]), __float_as_uint(d[i + 2]), false, false); d[i] = __uint_as_float(r[0]) + __uint_as_float(r[1]); }
    const bool up = lane & 8; const float keep = up ? d[1] : d[0], send = up ? d[0] : d[1];
    float x = keep + dpp_f(send, 0);
    x += dpp_f(x, 1); x += dpp_f(x, 2); x += dpp_f(x, 3);
    return x;
}
typedef int v8i_t __attribute__((ext_vector_type(8)));
__device__ __forceinline__ void peer_u_simple(LAS unsigned char* lds, const bf16* H2, tab_ptr PU, const float* RSU, const float* RSV, unsigned short* EIDX, const float* EG, float* COEF, unsigned short* CCODE, float* CSC, int G, int blk) {
    const int tid_ = phase_tid(); const int lane = tid_ & 63, wave = __builtin_amdgcn_readfirstlane(tid_ >> 6);
    constexpr int NG = 8;
    LAS unsigned char* wl = lds + wave * 17728;
    constexpr int RP = 528;
    LAS int* sid = (LAS int*)(wl + 8448);
    LAS float* sgt = (LAS float*)(wl + 8448 + 512);
    LAS float* res = (LAS float*)(wl + 8448 + 1024);
    LAS float* sul = (LAS float*)(wl + 9536);
    LAS float* gtl = (LAS float*)(wl + 9536 + 4096);
    const unsigned c0 = 16u * (lane & 31), d0 = (lane < 32 ? 0u : 528u) + c0;
    const unsigned long long lt = (1ull << lane) - 1ull;
    const int n16 = lane & 15, g4 = lane >> 4;
    const int stride = G * NWAVES;
    for (int tb = blk * NWAVES + wave; tb < T; tb += NG * stride) {
        int idlo[NG], idhi[NG]; float clo[NG], chi[NG]; int tt[NG]; int tcl[NG];
        int lp = (int)threadIdx.x; asm volatile("" : "+v"(lp)); lp &= 63;
        float g_lo[NG], g_hi[NG];
#pragma unroll
        for (int i = 0; i < NG; ++i) {
            const bool act_i = tb + i * stride < T; const int t = act_i ? tb + i * stride : tb; tt[i] = act_i ? t : -1; tcl[i] = t;
            const unsigned short* ep = EIDX + (size_t)t * 128;
            idlo[i] = ep[lp]; idhi[i] = ep[64 + lp]; g_lo[i] = EG[(size_t)t * 128 + lp]; g_hi[i] = EG[(size_t)t * 128 + 64 + lp];
        }
        u32x4 hq[8][4];
        {
            int tl = tcl[0];
#pragma unroll
            for (int i = 1; i < NG; ++i) tl = (lp & 7) == i ? tcl[i] : tl;
            const bf16* hp = H2 + (size_t)tl * 1024 + 32 * (lp >> 4);
#pragma unroll
            for (int s8 = 0; s8 < 8; ++s8) { hq[s8][0] = __builtin_nontemporal_load((const u32x4*)(hp + 128 * s8)); hq[s8][1] = __builtin_nontemporal_load((const u32x4*)(hp + 128 * s8 + 8)); hq[s8][2] = __builtin_nontemporal_load((const u32x4*)(hp + 128 * s8 + 16)); hq[s8][3] = __builtin_nontemporal_load((const u32x4*)(hp + 128 * s8 + 24)); }
        }
        __builtin_amdgcn_sched_barrier(0);
        float rsu_lo[NG], rsu_hi[NG], rsv_lo[NG], rsv_hi[NG];
#pragma unroll
        for (int i = 0; i < NG; ++i) {
            int il = idlo[i], ih = idhi[i]; float gl = g_lo[i], gh = g_hi[i];
            const int blo = il >> 10, bhi = ih >> 10; int plo = 0, phi = 0, base = 0;
#pragma unroll
            for (int bb = 0; bb < 16; ++bb) {
                const unsigned long long ml = __ballot(blo == bb), mh = __ballot(bhi == bb);
                const int nl = __popcll(ml);
                plo = (blo == bb) ? base + __popcll(ml & lt) : plo;
                phi = (bhi == bb) ? base + nl + __popcll(mh & lt) : phi;
                base += nl + __popcll(mh);
            }
            sid[plo] = il; sid[phi] = ih; sgt[plo] = gl; sgt[phi] = gh;
            il = sid[lp]; ih = sid[64 + lp]; gl = sgt[lp]; gh = sgt[64 + lp];
            if (tt[i] >= 0) { unsigned short* ep = EIDX + (size_t)tcl[i] * 128; ep[lp] = (unsigned short)il; ep[64 + lp] = (unsigned short)ih; }
            rsu_lo[i] = RSU[il]; rsu_hi[i] = RSU[ih]; rsv_lo[i] = RSV[il]; rsv_hi[i] = RSV[ih];
            idlo[i] = il; idhi[i] = ih; g_lo[i] = gl; g_hi[i] = gh; clo[i] = 0.f; chi[i] = 0.f;
        }
        v8i_t hB[8]; int hexp;
        {
            typedef unsigned short u16x2_t __attribute__((ext_vector_type(2)));
            u16x2_t mx = {0, 0};
#pragma unroll
            for (int s8 = 0; s8 < 8; ++s8)
#pragma unroll
                for (int j = 0; j < 4; ++j) {
                    mx = __builtin_elementwise_max(mx, __builtin_bit_cast(u16x2_t, hq[s8][j].x & 0x7fff7fffu)); mx = __builtin_elementwise_max(mx, __builtin_bit_cast(u16x2_t, hq[s8][j].y & 0x7fff7fffu));
                    mx = __builtin_elementwise_max(mx, __builtin_bit_cast(u16x2_t, hq[s8][j].z & 0x7fff7fffu)); mx = __builtin_elementwise_max(mx, __builtin_bit_cast(u16x2_t, hq[s8][j].w & 0x7fff7fffu));
                }
            unsigned m = mx.x > mx.y ? (unsigned)mx.x : (unsigned)mx.y;
            { const unsigned y = (unsigned)__shfl_xor((int)m, 16); m = m > y ? m : y; }
            { const unsigned y = (unsigned)__shfl_xor((int)m, 32); m = m > y ? m : y; }
            const float tq = __uint_as_float(m << 16) * (1.f / 7.5f);
            hexp = tq > 1.f ? (int)((__float_as_uint(tq) - 1u) >> 23) - 126 : 0;
            const float hdiv = __uint_as_float((unsigned)(127 + hexp) << 23);
#pragma unroll
            for (int s8 = 0; s8 < 8; ++s8) {
                typedef unsigned v16u_t __attribute__((ext_vector_type(16)));
                const v16u_t wv = {hq[s8][0].x, hq[s8][0].y, hq[s8][0].z, hq[s8][0].w, hq[s8][1].x, hq[s8][1].y, hq[s8][1].z, hq[s8][1].w, hq[s8][2].x, hq[s8][2].y, hq[s8][2].z, hq[s8][2].w, hq[s8][3].x, hq[s8][3].y, hq[s8][3].z, hq[s8][3].w};
                const v6u_t e6 = __builtin_amdgcn_cvt_scalef32_pk32_fp6_bf16(__builtin_bit_cast(v32bf_t, wv), hdiv);
                hB[s8] = (v8i_t){(int)e6[0], (int)e6[1], (int)e6[2], (int)e6[3], (int)e6[4], (int)e6[5], 0, 0};
            }
        }
#pragma unroll
        for (int i = 0; i < NG; ++i) {
            const float hs = __uint_as_float((unsigned)(127 + __builtin_amdgcn_readlane(hexp, i)) << 23);
            sul[i * 128 + lp] = rsu_lo[i] * hs; sul[i * 128 + 64 + lp] = rsu_hi[i] * hs;
            gtl[i * 128 + lp] = g_lo[i] * rsv_lo[i]; gtl[i * 128 + 64 + lp] = g_hi[i] * rsv_hi[i];
        }
#define PU_LOAD(RB, HH, P) do { const int hh_ = (HH), l0_ = (hh_ & 7) * 8; \
            const int idA_ = hh_ < 8 ? idlo[2 * (P)] : idhi[2 * (P)], idB_ = hh_ < 8 ? idlo[2 * (P) + 1] : idhi[2 * (P) + 1]; \
            _Pragma("unroll") for (int j = 0; j < 8; ++j) { const int idq_ = j < 4 ? idA_ : idB_; const int lq_ = l0_ + 2 * (j & 3); \
                const unsigned o0_ = 512u * (unsigned)__builtin_amdgcn_readlane(idq_, lq_), o1_ = 512u * (unsigned)__builtin_amdgcn_readlane(idq_, lq_ + 1); \
                RB[j] = *(const u32x4*)(PU + ((lane < 32 ? o0_ : o1_) + c0)); } } while (0)
#define PU_TOLDS(RB) do { _Pragma("unroll") for (int j = 0; j < 8; ++j) *(LAS u32x4*)(wl + j * 2 * RP + d0) = RB[j]; } while (0)
#define PU_COMP(HH, P) do { const int hh_ = (HH), l0_ = (hh_ & 7) * 8; \
            f32x4 acc_ = {0.f, 0.f, 0.f, 0.f}; const LAS unsigned char* ap_ = wl + n16 * RP + 16 * g4; \
            _Pragma("unroll") for (int s8 = 0; s8 < 8; ++s8) { \
                const u32x4 a0_ = *(const LAS u32x4*)(ap_ + 64 * s8); \
                const v8i_t A_ = {(int)a0_.x, (int)a0_.y, (int)a0_.z, (int)a0_.w, 0, 0, 0, 0}; \
                acc_ = __builtin_amdgcn_mfma_scale_f32_16x16x128_f8f6f4(A_, hB[s8], acc_, 4, 2, 0, 0x7f7f7f7f, 0, 0x7f7f7f7f); } \
            asm volatile("" : "+v"(acc_));                                          \
            if (g4 < 2 ? n16 == 2 * (P) : n16 == 2 * (P) + 1) *(LAS f32x4*)(res + 4 * g4) = acc_;        \
            const int r = (lane - l0_) & 7;                                         \
            const float a0 = res[r], a1 = res[8 + r]; \
            const int so_ = (hh_ < 8 ? 0 : 64) + lane; \
            const f32x2 gg = gelu_pk((f32x2){a0 * sul[2 * (P) * 128 + so_], a1 * sul[(2 * (P) + 1) * 128 + so_]}); \
            const float gA_ = gtl[2 * (P) * 128 + so_], gB_ = gtl[(2 * (P) + 1) * 128 + so_]; \
            const bool mine = (lane >> 3) == (hh_ & 7); \
            if (hh_ < 8) { clo[2 * (P)] = mine ? gA_ * gg.x : clo[2 * (P)]; clo[2 * (P) + 1] = mine ? gB_ * gg.y : clo[2 * (P) + 1]; } \
            else         { chi[2 * (P)] = mine ? gA_ * gg.x : chi[2 * (P)]; chi[2 * (P) + 1] = mine ? gB_ * gg.y : chi[2 * (P) + 1]; } } while (0)
#define PU_STAGE(RB, HH, P, HN, PN) do { PU_TOLDS(RB); __builtin_amdgcn_sched_barrier(0); PU_LOAD(RB, HN, PN); __builtin_amdgcn_sched_barrier(0); PU_COMP(HH, P); __builtin_amdgcn_sched_barrier(0); } while (0)
        {
            u32x4 r0[8], r1[8];
            PU_LOAD(r0, 0, 0);
            PU_LOAD(r1, 0, 1);
#pragma unroll 1
            for (int h = 0; h < 16; ++h) {
                const int hn = h < 15 ? h + 1 : 15;
                PU_STAGE(r0, h, 0, h, 2);
                PU_STAGE(r1, h, 1, h, 3);
                PU_STAGE(r0, h, 2, hn, 0);
                PU_STAGE(r1, h, 3, hn, 1);
            }
        }
#undef PU_LOAD
#undef PU_TOLDS
#undef PU_COMP
#undef PU_STAGE
        int le = (int)threadIdx.x; asm volatile("" : "+v"(le)); le &= 63;
#pragma unroll
        for (int i = 0; i < NG; ++i) {
            const unsigned mxb = wave_max_dpp(max(__float_as_uint(clo[i]) & 0x7fffffffu, __float_as_uint(chi[i]) & 0x7fffffffu));
            const float tq = __uint_as_float(mxb) * (1.f / 7.5f);
            int ec = (int)((__float_as_uint(tq) - 1u) >> 23) - 126; ec = ec < -100 ? -100 : ec;
            const float sc = __uint_as_float((unsigned)(127 + ec) << 23), isc = __uint_as_float((unsigned)(127 - ec) << 23);
            const float ql = clo[i] * isc, qh = chi[i] * isc;
            const unsigned hl = enc_e2m3(ql), hh = enc_e2m3(qh);
            const unsigned ll = enc_e2m3((ql - dec_e2m3(hl)) * 16.f), lh = enc_e2m3((qh - dec_e2m3(hh)) * 16.f);
            if (tt[i] >= 0) {
                CCODE[(size_t)tt[i] * 128 + le] = (unsigned short)(hl | (ll << 8)); CCODE[(size_t)tt[i] * 128 + 64 + le] = (unsigned short)(hh | (lh << 8));
                if (le == 0) CSC[tt[i]] = sc;
            }
        }
    }
}
__device__ __forceinline__ void place6(unsigned code, unsigned sh, unsigned& d0, unsigned& d1, unsigned& d2) {
    const unsigned long long lo = sh < 64u ? ((unsigned long long)code << (sh & 63u)) : 0ull;
    d0 = (unsigned)lo; d1 = (unsigned)(lo >> 32);
    d2 = sh >= 64u ? code << ((sh - 64u) & 31u) : (sh > 58u ? code >> ((64u - sh) & 31u) : 0u);
}
__device__ __forceinline__ void peer_v_phase(LAS unsigned char* lds, tab_ptr PV, const unsigned short* EIDX, const unsigned short* CCODE, const float* CSC, const float* MOD, float* OUT, int G, int blk) {
    const int tid_ = phase_tid(); const int lane = tid_ & 63, wave = __builtin_amdgcn_readfirstlane(tid_ >> 6);
    LAS unsigned char* wl = lds + wave * 8448;
    constexpr int RP = 528;
    const unsigned c0 = 16u * (lane & 31), d0 = (lane < 32 ? 0u : 528u) + c0;
    const int m16 = lane & 15, g4 = lane >> 4;
    const unsigned sh6 = 6u * (unsigned)m16;
    const unsigned l12 = 12u * (unsigned)lane;
    const int stride = G * NWAVES;
    for (int tb = blk * NWAVES + wave; tb < T; tb += 4 * stride) {
        f32x4 acc[4][4]; unsigned idw[4], cww[4]; int tt[4]; bool act[4];
        int ln = (int)threadIdx.x; asm volatile("" : "+v"(ln)); ln &= 63;
#pragma unroll
        for (int i = 0; i < 4; ++i) {
            act[i] = tb + i * stride < T; const int t = act[i] ? tb + i * stride : tb; tt[i] = t;
#pragma unroll
            for (int j = 0; j < 4; ++j) acc[i][j] = (f32x4){0.f, 0.f, 0.f, 0.f};
            const unsigned short* ep = EIDX + (size_t)t * 128;
            idw[i] = (unsigned)ep[ln] | ((unsigned)ep[64 + ln] << 16);
            cww[i] = (unsigned)CCODE[(size_t)t * 128 + ln] | ((unsigned)CCODE[(size_t)t * 128 + 64 + ln] << 16);
        }
#define PV_LOAD(RB, HH, P) do { const int hh_ = (HH), l0_ = (hh_ & 7) * 8; const int hs_ = hh_ < 8 ? 0 : 16; \
            _Pragma("unroll") for (int j = 0; j < 8; ++j) { const unsigned idq_ = j < 4 ? idw[2 * (P)] : idw[2 * (P) + 1]; const int lq_ = l0_ + 2 * (j & 3); \
                const unsigned o0_ = 512u * (((unsigned)__builtin_amdgcn_readlane((int)idq_, lq_) >> hs_) & 0xffffu), o1_ = 512u * (((unsigned)__builtin_amdgcn_readlane((int)idq_, lq_ + 1) >> hs_) & 0xffffu); \
                RB[j] = *(const u32x4*)(PV + ((lane < 32 ? o0_ : o1_) + c0)); } } while (0)
#define PV_TOLDS(RB) do { _Pragma("unroll") for (int j = 0; j < 8; ++j) *(LAS u32x4*)(wl + j * 2 * RP + d0) = RB[j]; } while (0)
#define PV_COMP(HH, P) do { const int hh_ = (HH), l0_ = (hh_ & 7) * 8; \
            _Pragma("unroll") for (int tk = 0; tk < 2; ++tk) { \
                const unsigned cw_ = hh_ < 8 ? cww[2 * (P) + tk] & 0xffffu : cww[2 * (P) + tk] >> 16; \
                const unsigned w0_ = (unsigned)__shfl((int)cw_, l0_ + 2 * g4), w1_ = (unsigned)__shfl((int)cw_, l0_ + 2 * g4 + 1); \
                unsigned h0_, h1_, h2_, h3_, h4_, h5_, q0_, q1_, q2_, q3_, q4_, q5_; \
                place6(w0_ & 63u, sh6, h0_, h1_, h2_); place6(w1_ & 63u, sh6, h3_, h4_, h5_); \
                place6((w0_ >> 8) & 63u, sh6, q0_, q1_, q2_); place6((w1_ >> 8) & 63u, sh6, q3_, q4_, q5_); \
                const v8i_t Ah_ = {(int)h0_, (int)h1_, (int)h2_, (int)h3_, (int)h4_, (int)h5_, 0, 0}, Al_ = {(int)q0_, (int)q1_, (int)q2_, (int)q3_, (int)q4_, (int)q5_, 0, 0}; \
                const LAS unsigned char* bp_ = wl + (8 * tk + 2 * g4) * RP + 8 * m16; \
                _Pragma("unroll") for (int T4 = 0; T4 < 4; ++T4) { \
                    const u32x2 r0_ = *(const LAS u32x2*)(bp_ + 128 * T4), r1_ = *(const LAS u32x2*)(bp_ + 128 * T4 + RP); \
                    const v8i_t B_ = {(int)r0_.x, (int)r0_.y, (int)r1_.x, (int)r1_.y, 0, 0, 0, 0}; \
                    acc[2 * (P) + tk][T4] = __builtin_amdgcn_mfma_scale_f32_16x16x128_f8f6f4(Ah_, B_, acc[2 * (P) + tk][T4], 2, 4, 0, 0x7f7f7f7f, 0, 0x7f7f7f7f); \
                    acc[2 * (P) + tk][T4] = __builtin_amdgcn_mfma_scale_f32_16x16x128_f8f6f4(Al_, B_, acc[2 * (P) + tk][T4], 2, 4, 0, 0x7b7b7b7b, 0, 0x7f7f7f7f); } } } while (0)
        {
            u32x4 r0[8], r1[8];
            PV_LOAD(r0, 0, 0);
            PV_LOAD(r1, 0, 1);
#pragma unroll 1
            for (int h = 0; h < 16; ++h) {
                const int hn = h < 15 ? h + 1 : 15;
                PV_TOLDS(r0);
                __builtin_amdgcn_sched_barrier(0);
                PV_LOAD(r0, hn, 0);
                __builtin_amdgcn_sched_barrier(0);
                PV_COMP(h, 0);
                __builtin_amdgcn_sched_barrier(0);
                PV_TOLDS(r1);
                __builtin_amdgcn_sched_barrier(0);
                PV_LOAD(r1, hn, 1);
                __builtin_amdgcn_sched_barrier(0);
                PV_COMP(h, 1);
                __builtin_amdgcn_sched_barrier(0);
            }
        }
#undef PV_LOAD
#undef PV_TOLDS
#undef PV_COMP
        int le = (int)threadIdx.x; asm volatile("" : "+v"(le)); le &= 63;
#pragma unroll
        for (int i = 0; i < 4; ++i) {
            if (act[i]) {
                const float* g2 = MOD + (size_t)(tt[i] >> 12) * 6144 + 5120;
                float* op = OUT + (size_t)tt[i] * 1024;
                const float csc_i = CSC[tt[i]];
#pragma unroll
                for (int T4 = 0; T4 < 4; ++T4) {
                    const int col = 256 * T4 + 16 * (le & 15) + 4 * (le >> 4);
                    const f32x4 g = *(const f32x4*)(g2 + col), x1 = __builtin_nontemporal_load((const f32x4*)(op + col));
                    __builtin_nontemporal_store(x1 + (g * csc_i) * acc[i][T4], (f32x4*)(op + col));
                }
            }
        }
    }
}
#define XB_TMO      128
#define XB_XCNT(j)  (256  + 64 * (j))
#define XB_XSUB(j)  (1280 + 64 * (j))
#define XB_XGEN(j)  (2304 + 64 * (j))
#define XB_TOP      3328
#define XB_TOPGEN   3392
#define XCD_BAR_WORDS 3456
#define XB_SPIN_CAP (1u << 20)
__device__ __forceinline__ unsigned xb_ld(unsigned* p)              { return __hip_atomic_load(p, __ATOMIC_RELAXED, __HIP_MEMORY_SCOPE_AGENT); }
__device__ __forceinline__ unsigned xb_add(unsigned* p, unsigned v) { return __hip_atomic_fetch_add(p, v, __ATOMIC_RELAXED, __HIP_MEMORY_SCOPE_AGENT); }
__device__ __forceinline__ unsigned xb_xcc_id() { return (unsigned)__builtin_amdgcn_s_getreg((3 << 11) | 20) & 0xFu; }
#define XB_SPIN(cond, bar) do { unsigned _sp = 0; while (cond) { __builtin_amdgcn_s_sleep(1); \
    if ((++_sp & 255u) == 0u) { if (xb_ld(&(bar)[XB_TMO])) break; if (_sp > XB_SPIN_CAP) { atomicAdd(&(bar)[XB_TMO], 1u); break; } } } } while (0)
struct XcdBarrier { unsigned* bar; unsigned x; volatile LAS unsigned* st; };
__device__ __forceinline__ XcdBarrier xcd_barrier_post(unsigned* bar, volatile LAS unsigned* st) {
    XcdBarrier b; b.bar = bar; b.x = xb_xcc_id(); b.st = st;
    if (threadIdx.x == 0) (void)xb_add(&bar[XB_XCNT(b.x)], 1u);
    return b;
}
__device__ __forceinline__ void xcd_barrier_complete(unsigned* bar, unsigned x, unsigned& nloc, unsigned& nx) {
    const unsigned G = gridDim.x * gridDim.y * gridDim.z;
    unsigned sum, cnt, mine, sp = 0u;
    for (;;) {
        sum = 0u; cnt = 0u; mine = 0u;
#pragma unroll
        for (unsigned j = 0; j < 16; ++j) { const unsigned c = xb_ld(&bar[XB_XCNT(j)]); sum += c; cnt += (c > 0u) ? 1u : 0u; mine = (j == x) ? c : mine; }
        if (sum == G) break;
        __builtin_amdgcn_s_sleep(1);
        if ((++sp & 255u) == 0u) { if (xb_ld(&bar[XB_TMO])) break; if (sp > XB_SPIN_CAP) { atomicAdd(&bar[XB_TMO], 1u); break; } }
    }
    nloc = mine > 0u ? mine : 1u; nx = cnt > 0u ? cnt : 1u;
}
__device__ __forceinline__ void xcd_barrier(const XcdBarrier& b) {
    asm volatile("s_waitcnt vmcnt(0)" ::: "memory");
    __syncthreads();
    if (threadIdx.x == 0) {
        unsigned* bar = b.bar;
        __builtin_amdgcn_s_waitcnt(0);
        unsigned nloc = b.st[0], nx = b.st[1];
        if (nloc == 0u) { xcd_barrier_complete(bar, b.x, nloc, nx); b.st[0] = nloc; b.st[1] = nx; }
        const unsigned old = xb_add(&bar[XB_XSUB(b.x)], 1u);
        const unsigned gen = old / nloc;
        if (old + 1u == (gen + 1u) * nloc) {
            __builtin_amdgcn_fence(__ATOMIC_RELEASE, "agent");
            asm volatile("s_waitcnt vmcnt(0)" ::: "memory");
            const unsigned og = xb_add(&bar[XB_TOP], 1u);
            const unsigned tg = og / nx;
            if (og + 1u == (tg + 1u) * nx) xb_add(&bar[XB_TOPGEN], 1u);
            else XB_SPIN(xb_ld(&bar[XB_TOPGEN]) == tg, bar);
            __builtin_amdgcn_fence(__ATOMIC_ACQUIRE, "agent");
            xb_add(&bar[XB_XGEN(b.x)], 1u);
            asm volatile("s_waitcnt vmcnt(0)" ::: "memory");
        } else {
            XB_SPIN(xb_ld(&bar[XB_XGEN(b.x)]) == gen, bar);
            __builtin_amdgcn_fence(__ATOMIC_ACQUIRE, "agent");
            asm volatile("s_waitcnt vmcnt(0)" ::: "memory");
        }
    }
    __syncthreads();
}

constexpr int N_PHASES = 12;
#ifndef PROBE_K
#define PROBE_K -1
#endif
__global__ void __launch_bounds__(NWAVES * 64, 2) mk_fwd(Args a) {
    extern __shared__ __attribute__((aligned(16))) unsigned char lds_raw[];
    LAS unsigned char* lds = (LAS unsigned char*)lds_raw;
    cg::grid_group grid = cg::this_grid();
    const int G = gridDim.x, blk = blockIdx.x;
    unsigned char* ws = a.ws;
    float* MOD = (float*)(ws + WS_MOD);
    bf16* H = (bf16*)(ws + WS_H);
    bf16 *CB = (bf16*)(ws + WS_CB), *CC = (bf16*)(ws + WS_CC), *CX = (bf16*)(ws + WS_CX), *Qb = (bf16*)(ws + WS_Q), *Kb = (bf16*)(ws + WS_K), *Vb = (bf16*)(ws + WS_V), *QI = (bf16*)(ws + WS_QI);
    bf16 *GC = (bf16*)(ws + WS_GC), *GA = (bf16*)(ws + WS_GA), *KI = (bf16*)(ws + WS_KI); float* WI = (float*)(ws + WS_WI);
    unsigned long long* MASK = (unsigned long long*)(ws + WS_MASK);
    bf16* PQ = (bf16*)(ws + WS_PQ); unsigned short* EIDX = (unsigned short*)(ws + WS_EIDX); float* EG = (float*)(ws + WS_EG); float* COEF = (float*)(ws + WS_COEF);
#define IN(k) (a.ph_lo <= (k) && (k) < a.ph_hi)
#define SEAM(k) do { if (IN(k) && IN((k) + 1)) { if ((k) == 0) grid.sync(); else xcd_barrier(xbar); } if (PROBE_K == (k) && threadIdx.x == 0) pst[1] = __builtin_amdgcn_s_memrealtime(); if (PROBE_K == (k) + 1 && threadIdx.x == 0) pst[0] = __builtin_amdgcn_s_memrealtime(); } while (0)
    volatile LAS unsigned* xst = (volatile LAS unsigned*)(lds + LDS_BYTES - 64);
    if (threadIdx.x < 4) xst[threadIdx.x] = 0u;
    __syncthreads();
    const XcdBarrier xbar = xcd_barrier_post((unsigned*)(ws + WS_CTL), xst);

    volatile LAS unsigned long long* pst = (volatile LAS unsigned long long*)(lds + LDS_BYTES - 48);
    if (PROBE_K >= 0 && threadIdx.x == 0) { pst[0] = 0; pst[1] = 0; pst[2] = 0; pst[3] = 0; }
    if (PROBE_K == 0 && threadIdx.x == 0) pst[0] = __builtin_amdgcn_s_memrealtime();
    if (IN(0)) p0_prologue(lds, a, G, blk);
    SEAM(0);
    if (IN(1)) norm_phase<false>(a.in[0], a.in[4], MOD, 0, H, G, blk);
    SEAM(1);
    if (IN(2)) {
        pg8::Gemm g{H, (const bf16*)(ws + WS_WIN), T, NIN_PAD, DM}; pg8::StaticOrder S; S.init(T, NIN_PAD, G, blk);
        EpiInProj E{ws, a.in[8], a.in[9]};
        pg8::gemm_phase<EpiInProj, true, true>(lds, g, S, E);
    }
    SEAM(2);
    if (IN(3)) { if (PROBE_SUB == 3 && threadIdx.x == 0) pst[3] = __builtin_amdgcn_s_memrealtime(); conv_phase(CB, CC, CX, a.in[6], H, G, blk); if (PROBE_SUB == 3) { __syncthreads(); if (threadIdx.x == 0) pst[2] += __builtin_amdgcn_s_memrealtime() - pst[3]; }
        indexer_phase(lds, QI, KI, WI, MASK, G, blk); }
    SEAM(3);
    if (IN(4)) att::attn_phase(lds, Qb, Kb, Vb, MASK, a.in[8], a.in[9], H, G, blk);
    SEAM(4);
    if (IN(5)) {
        pg8::Gemm g{H, (const bf16*)(ws + WS_WCO), T, DM, DM}; pg8::StaticOrder S; S.init(T, DM, G, blk);
        EpiMixFused E{GC, GA, CB};
        pg8::gemm_phase<EpiMixFused, true, true>(lds, g, S, E);
    }
    SEAM(5);
    if (IN(6)) {
        pg8::Gemm g{CB, (const bf16*)(ws + WS_WO), T, DM, DM}; pg8::StaticOrder S; S.init(T, DM, G, blk);
        EpiDelta E{MOD, H};
        pg8::gemm_phase<EpiDelta, true, true>(lds, g, S, E);
    }
    SEAM(6);
    if (IN(7)) norm_phase<true>(a.in[0], a.in[12], MOD, 3072, H, G, blk, a.out);
    SEAM(7);
    if (IN(8)) {
        pg8::Gemm g{H, (const bf16*)(ws + WS_WPQ), T, DM, DM}; pg8::StaticOrder S; S.init(T, DM, G, blk);
        EpiPlain E{PQ};
        pg8::gemm_phase<EpiPlain, true, true>(lds, g, S, E);
    }
    SEAM(8);
    if (IN(9)) peer_route_phase(lds, PQ, (const bf16*)(ws + WS_SK), EIDX, EG, G, blk);
    SEAM(9);
    if (IN(10)) peer_u_simple(lds, H, (tab_ptr)(ws + WS_PU), (const float*)(ws + WS_RSU), (const float*)(ws + WS_RSV), EIDX, EG, COEF, (unsigned short*)(ws + WS_CCODE), (float*)(ws + WS_CSC), G, blk);
    SEAM(10);
    if (IN(11)) peer_v_phase(lds, (tab_ptr)(ws + WS_PV), EIDX, (const unsigned short*)(ws + WS_CCODE), (const float*)(ws + WS_CSC), MOD, a.out, G, blk);
    if (PROBE_K >= 0) {
        xcd_barrier(xbar);
        if (blk != 0 || threadIdx.x != 0) return;
        if (PROBE_K == 11) pst[1] = __builtin_amdgcn_s_memrealtime();
        const unsigned long long te = __builtin_amdgcn_s_memrealtime();
        const unsigned long long span = PROBE_SUB ? pst[2] : pst[1] - pst[0];
        while (__builtin_amdgcn_s_memrealtime() - te < span) __builtin_amdgcn_s_sleep(20);
    }
#undef IN
#undef SEAM
}

#ifndef MK_N_LAUNCHES
#define MK_N_LAUNCHES 1
#endif
extern "C" void kernel_launch(void* const* d_in, const int* in_sizes, int n_in, void* d_out, int out_size, void* d_ws, size_t ws_size, hipStream_t stream) {
    static int grid = 0;
    if (grid == 0) {
        if (n_in != 17 || in_sizes[0] != T * DM || out_size != T * DM || ws_size < WS_END) {
            fprintf(stderr, "kernel_launch: unexpected problem: n_in %d in0 %d out %d ws %zu (need %zu); nothing launched\n", n_in, n_in > 0 ? in_sizes[0] : -1, out_size, ws_size, (size_t)WS_END); grid = -1; return; }
        int dev = 0, cus = 0, per_cu = 0;
        hipGetDevice(&dev); hipDeviceGetAttribute(&cus, hipDeviceAttributeMultiprocessorCount, dev);
        if (hipFuncSetAttribute((const void*)mk_fwd, hipFuncAttributeMaxDynamicSharedMemorySize, LDS_BYTES) != hipSuccess) { fprintf(stderr, "kernel_launch: hipFuncSetAttribute failed\n"); grid = -1; return; }
        if (hipOccupancyMaxActiveBlocksPerMultiprocessor(&per_cu, (const void*)mk_fwd, NWAVES * 64, LDS_BYTES) != hipSuccess || per_cu < 1) { fprintf(stderr, "kernel_launch: occupancy query says %d blocks per CU\n", per_cu); grid = -1; return; }
        grid = cus;
    }
    if (grid < 0) return;
    if (hipMemsetAsync((char*)d_ws + WS_CTL, 0, CTL_BYTES, stream) != hipSuccess) { fprintf(stderr, "kernel_launch: hipMemsetAsync failed\n"); return; }
    Args a{};
    for (int i = 0; i < 17; ++i) a.in[i] = (const float*)d_in[i];
    a.out = (float*)d_out; a.ws = (unsigned char*)d_ws;
    for (int li = 0; li < MK_N_LAUNCHES; ++li) {
        a.ph_lo = li * (N_PHASES / MK_N_LAUNCHES); a.ph_hi = (li + 1) * (N_PHASES / MK_N_LAUNCHES);
        void* args[] = {&a};
        hipError_t e = hipLaunchCooperativeKernel((const void*)mk_fwd, dim3(grid), dim3(NWAVES * 64), args, LDS_BYTES, stream);
        if (e != hipSuccess) { fprintf(stderr, "kernel_launch: cooperative launch %d failed: %s (grid %d)\n", li, hipGetErrorString(e), grid); break; }
    }
}
```
